# Optimizing an MI355X kernel written in HIP

```python
import jax, jax.numpy as jnp
from jax import lax
import numpy as np

D_MODEL = 1024
BATCH = 2
SEQ = 8192
DEPTH = 2

N_MIXERS = 2
HEAD_DIM = 64
N_HEADS = D_MODEL // HEAD_DIM
FOX_HEADS = N_HEADS
DSA_Q_HEADS = N_HEADS
DSA_KV_HEADS = 4
GROUP = DSA_Q_HEADS // DSA_KV_HEADS
IDX_HEADS = 8
IDX_DIM = 64
TOPK_MAX = 256
Q_BLOCK = 128
D_FF = 2816
CONV_WIDTH = 3
EPS = 1e-6
FORGET_BIAS = 3.0
N_FOX_LAYERS = (DEPTH + 1) // 2
N_DSA_LAYERS = DEPTH // 2

FOX_IN = 3 * FOX_HEADS * HEAD_DIM + FOX_HEADS
DSA_QW = DSA_Q_HEADS * HEAD_DIM
DSA_KVW = DSA_KV_HEADS * HEAD_DIM
DSA_SPLITS = [DSA_QW, DSA_QW + DSA_KVW, DSA_QW + 2 * DSA_KVW,
              DSA_QW + 2 * DSA_KVW + IDX_HEADS * IDX_DIM,
              DSA_QW + 2 * DSA_KVW + IDX_HEADS * IDX_DIM + IDX_DIM]
DSA_IN = DSA_SPLITS[-1] + IDX_HEADS

kernel_name = 'hybrid_fox_dsa_convffn'


def rms_norm(x, g):
    xf = x.astype(jnp.float32)
    y = xf * lax.rsqrt(jnp.mean(xf * xf, axis=-1, keepdims=True) + EPS)
    return (y * g.astype(jnp.float32)).astype(x.dtype)


def modulate(x, g, shift, scale):
    return rms_norm(x, g) * (1 + scale[:, None, :]) + shift[:, None, :]


def alibi_slopes(n):
    return jnp.exp2(-8.0 * jnp.arange(1, n + 1, dtype=jnp.float32) / n)


def to_blocks(a):
    b, l = a.shape[:2]
    return jnp.moveaxis(a.reshape(b, l // Q_BLOCK, Q_BLOCK, *a.shape[2:]), 1, 0)


def from_blocks(a):
    nb, b, q = a.shape[:3]
    return jnp.moveaxis(a, 0, 1).reshape(b, nb * q, *a.shape[3:])


def forgetting_attention(h, w_in, b_f, g_q, g_k, w_out):
    b, l, _ = h.shape
    dq = FOX_HEADS * HEAD_DIM
    q, k, v, f_logit = jnp.split(h @ w_in, [dq, 2 * dq, 3 * dq], axis=-1)
    q = rms_norm(q.reshape(b, l, FOX_HEADS, HEAD_DIM), g_q)
    k = rms_norm(k.reshape(b, l, FOX_HEADS, HEAD_DIM), g_k).astype(jnp.float32)
    v = v.reshape(b, l, FOX_HEADS, HEAD_DIM)
    log_f = jax.nn.log_sigmoid((f_logit + b_f).astype(jnp.float32))
    cum = jnp.cumsum(log_f, axis=1)
    cum_k = jnp.transpose(cum, (0, 2, 1))
    pos = jnp.arange(l)
    scale = HEAD_DIM ** -0.5

    def block(args):
        qb, cqb, pb = args
        s = jnp.einsum('bqhd,bkhd->bhqk', qb.astype(jnp.float32), k) * scale
        s = s + jnp.transpose(cqb, (0, 2, 1))[..., None] - cum_k[:, :, None, :]
        s = jnp.where(pos[None, :] <= pb[:, None], s, -jnp.inf)
        p = jax.nn.softmax(s, axis=-1)
        return jnp.einsum('bhqk,bkhd->bqhd', p.astype(v.dtype), v)

    o = lax.map(block, (to_blocks(q), to_blocks(cum), pos.reshape(-1, Q_BLOCK)))
    o = from_blocks(o).reshape(b, l, dq)
    return o @ w_out


def sparse_indexed_attention(h, w_in, g_q, g_k, g_kidx, w_out):
    b, l, _ = h.shape
    top_k = min(TOPK_MAX, l // 4)
    q, k, v, q_idx, k_idx, w_idx = jnp.split(h @ w_in, DSA_SPLITS, axis=-1)
    q = rms_norm(q.reshape(b, l, DSA_KV_HEADS, GROUP, HEAD_DIM), g_q)
    k = rms_norm(k.reshape(b, l, DSA_KV_HEADS, HEAD_DIM), g_k)
    v = v.reshape(b, l, DSA_KV_HEADS, HEAD_DIM)
    q_idx = q_idx.reshape(b, l, IDX_HEADS, IDX_DIM)
    k_idx = rms_norm(k_idx, g_kidx).astype(jnp.float32)
    w_idx = w_idx.astype(jnp.float32) * (IDX_HEADS ** -0.5 * IDX_DIM ** -0.5)
    slopes = alibi_slopes(DSA_Q_HEADS).reshape(DSA_KV_HEADS, GROUP)
    pos = jnp.arange(l)
    scale = HEAD_DIM ** -0.5
    gather = jax.vmap(lambda a, i: a[i])

    def block(args):
        qb, qib, wib, pb = args
        rel = jax.nn.relu(jnp.einsum('bqhd,bkd->bqhk', qib.astype(jnp.float32), k_idx))
        score = jnp.einsum('bqhk,bqh->bqk', rel, wib)
        score = jnp.where(pos[None, None, :] <= pb[None, :, None], score, -jnp.inf)
        _, idx = lax.top_k(score, top_k)
        valid = idx <= pb[None, :, None]
        k_sel = gather(k, idx).astype(jnp.float32)
        v_sel = gather(v, idx)
        s = jnp.einsum('bqgrd,bqkgd->bqgrk', qb.astype(jnp.float32), k_sel) * scale
        dist = (pb[None, :, None] - idx).astype(jnp.float32)
        s = s - slopes[None, None, :, :, None] * dist[:, :, None, None, :]
        s = jnp.where(valid[:, :, None, None, :], s, -jnp.inf)
        p = jax.nn.softmax(s, axis=-1)
        return jnp.einsum('bqgrk,bqkgd->bqgrd', p.astype(v_sel.dtype), v_sel)

    o = lax.map(block, (to_blocks(q), to_blocks(q_idx), to_blocks(w_idx),
                        pos.reshape(-1, Q_BLOCK)))
    o = from_blocks(o).reshape(b, l, DSA_QW)
    return o @ w_out


def conv_gated_mlp(h, w_up, conv_w, conv_b, w_down):
    a, g = jnp.split(h @ w_up, 2, axis=-1)
    a = lax.conv_general_dilated(a, conv_w[:, None, :], window_strides=(1,),
                                 padding=[(CONV_WIDTH - 1, 0)],
                                 dimension_numbers=('NWC', 'WIO', 'NWC'),
                                 feature_group_count=D_FF) + conv_b
    return (jax.nn.silu(a) * g) @ w_down


def setup_inputs(seed: int = 0) -> dict:
    key = jax.random.key(seed)
    ks = jax.random.split(key, 24)
    f32 = jnp.float32

    def dense(k, shape, fan_in, mult=1.0):
        return jax.random.normal(k, shape, f32) * (mult * fan_in ** -0.5)

    def gain(k, shape):
        return 1.0 + 0.02 * jax.random.normal(k, shape, f32)

    return {
        'x': jax.random.normal(ks[0], (BATCH, SEQ, D_MODEL), f32),
        'c': jax.random.normal(ks[1], (BATCH, D_MODEL), f32),
        'w_ada': dense(ks[2], (DEPTH, D_MODEL, 6 * D_MODEL), D_MODEL, 0.5),
        'b_ada': 0.01 * jax.random.normal(ks[3], (DEPTH, 6 * D_MODEL), f32),
        'g_norm_mix': gain(ks[4], (DEPTH, D_MODEL)),
        'g_norm_ffn': gain(ks[5], (DEPTH, D_MODEL)),
        'fox_w_in': dense(ks[6], (N_FOX_LAYERS, D_MODEL, FOX_IN), D_MODEL),
        'fox_b_f': FORGET_BIAS + 0.1 * jax.random.normal(ks[7], (N_FOX_LAYERS, FOX_HEADS), f32),
        'fox_g_q': gain(ks[8], (N_FOX_LAYERS, HEAD_DIM)),
        'fox_g_k': gain(ks[9], (N_FOX_LAYERS, HEAD_DIM)),
        'fox_w_out': dense(ks[10], (N_FOX_LAYERS, FOX_HEADS * HEAD_DIM, D_MODEL), FOX_HEADS * HEAD_DIM),
        'dsa_w_in': dense(ks[11], (N_DSA_LAYERS, D_MODEL, DSA_IN), D_MODEL),
        'dsa_g_q': gain(ks[12], (N_DSA_LAYERS, HEAD_DIM)),
        'dsa_g_k': gain(ks[13], (N_DSA_LAYERS, HEAD_DIM)),
        'dsa_g_kidx': gain(ks[14], (N_DSA_LAYERS, IDX_DIM)),
        'dsa_w_out': dense(ks[15], (N_DSA_LAYERS, DSA_QW, D_MODEL), DSA_QW),
        'ffn_w_up': dense(ks[16], (DEPTH, D_MODEL, 2 * D_FF), D_MODEL),
        'ffn_conv_w': dense(ks[17], (DEPTH, CONV_WIDTH, D_FF), CONV_WIDTH),
        'ffn_conv_b': 0.01 * jax.random.normal(ks[18], (DEPTH, D_FF), f32),
        'ffn_w_down': dense(ks[19], (DEPTH, D_FF, D_MODEL), D_FF),
    }


def reference(x, c, w_ada, b_ada, g_norm_mix, g_norm_ffn, fox_w_in, fox_b_f, fox_g_q,
              fox_g_k, fox_w_out, dsa_w_in, dsa_g_q, dsa_g_k, dsa_g_kidx, dsa_w_out,
              ffn_w_up, ffn_conv_w, ffn_conv_b, ffn_w_down):
    c_act = jax.nn.silu(c)
    for i in range(DEPTH):
        mod = c_act @ w_ada[i] + b_ada[i]
        sh1, sc1, gt1, sh2, sc2, gt2 = jnp.split(mod, 6, axis=-1)
        h = modulate(x, g_norm_mix[i], sh1, sc1)
        j = i // N_MIXERS
        if i % N_MIXERS == 0:
            y = forgetting_attention(h, fox_w_in[j], fox_b_f[j], fox_g_q[j], fox_g_k[j], fox_w_out[j])
        else:
            y = sparse_indexed_attention(h, dsa_w_in[j], dsa_g_q[j], dsa_g_k[j], dsa_g_kidx[j], dsa_w_out[j])
        x = x + gt1[:, None, :] * y
        h = modulate(x, g_norm_ffn[i], sh2, sc2)
        x = x + gt2[:, None, :] * conv_gated_mlp(h, ffn_w_up[i], ffn_conv_w[i], ffn_conv_b[i], ffn_w_down[i])
    return x
```

```cpp
#include <hip/hip_runtime.h>
#include <cstdio>
#include <cstdint>
__device__ __forceinline__ float xsum16(float v) { const unsigned a = __builtin_bit_cast(unsigned, v); const auto r = __builtin_amdgcn_permlane16_swap(a, a, false, false); const unsigned r0 = r[0], r1 = r[1]; return __builtin_bit_cast(float, r0) + __builtin_bit_cast(float, r1); }
__device__ __forceinline__ float xsum32(float v) { const unsigned a = __builtin_bit_cast(unsigned, v); const auto r = __builtin_amdgcn_permlane32_swap(a, a, false, false); const unsigned r0 = r[0], r1 = r[1]; return __builtin_bit_cast(float, r0) + __builtin_bit_cast(float, r1); }
__device__ __forceinline__ float xmax16(float v) { const unsigned a = __builtin_bit_cast(unsigned, v); const auto r = __builtin_amdgcn_permlane16_swap(a, a, false, false); const unsigned r0 = r[0], r1 = r[1]; return fmaxf(__builtin_bit_cast(float, r0), __builtin_bit_cast(float, r1)); }
__device__ __forceinline__ float xmax32(float v) { const unsigned a = __builtin_bit_cast(unsigned, v); const auto r = __builtin_amdgcn_permlane32_swap(a, a, false, false); const unsigned r0 = r[0], r1 = r[1]; return fmaxf(__builtin_bit_cast(float, r0), __builtin_bit_cast(float, r1)); }
template <int CTRL> __device__ __forceinline__ float dppf(float v) { return __builtin_bit_cast(float, __builtin_amdgcn_update_dpp(0, __builtin_bit_cast(int, v), CTRL, 0xf, 0xf, true)); }
namespace pg8 {
#define PG8_LAS __attribute__((address_space(3)))
typedef unsigned short bf16_t;
typedef short bf16x8 __attribute__((ext_vector_type(8)));
typedef float f32x4 __attribute__((ext_vector_type(4)));
typedef unsigned u32x4 __attribute__((ext_vector_type(4)));
typedef int pg8_v8i __attribute__((ext_vector_type(8)));
typedef short pg8_bf16x16 __attribute__((ext_vector_type(16)));
constexpr int BM = 256, BK = 64, HALF = 128, HTB = HALF * BK * 2  , STAGE_BYTES = 8 * HTB, NXCD = 8, WGM = 2;

__host__ __device__ __forceinline__ int lds_byte(int r, int c) { const int st = (r >> 4) * 2 + (c >> 5), rr = r & 15, cc = c & 31, ob = rr * 64 + cc * 2; return st * 1024 + (ob ^ (((ob >> 9) & 1) << 5)); }
__host__ __device__ __forceinline__ void stage_rc(int b, int& R, int& C) { const int st = b / 1024, sb = b % 1024, swz = sb ^ (((sb >> 9) & 1) << 5); R = (st >> 1) * 16 + swz / 64; C = (st & 1) * 32 + (swz % 64) / 2; }
__host__ __device__ __forceinline__ int perm32(int rho) { const int n = rho >> 4, i = rho & 15; return 8 * (i >> 2) + 4 * n + (i & 3); }

struct Unit { int pm, pn; };
struct Gemm { const bf16_t* A; const bf16_t* Bt; int M, N, K, lda, ldb; int sa, sb; };

struct StaticOrder {
    int nM, nN, nwg, G, c;
    __host__ __device__ void init(int M, int N, int G_, int c_) { nM = M / BM; nN = N / BM; nwg = nM * nN; G = G_; c = c_; }
    __host__ __device__ __forceinline__ bool next(int i, Unit& u) const {
        const long L = (long)i * G + c; if (L >= nwg) return false;
        int wgid = (int)L; { const int q = nwg / NXCD, r = nwg % NXCD, xcd = wgid % NXCD, off = wgid / NXCD; wgid = (xcd < r ? xcd * (q + 1) : r * (q + 1) + (xcd - r) * q) + off; }
        const int nig = WGM * nN, gid = wgid / nig, fm = gid * WGM, gsz = (nM - fm) < WGM ? (nM - fm) : WGM;
        u.pm = fm + ((wgid % nig) % gsz); u.pn = (wgid % nig) / gsz; return true;
    }
    __device__ __forceinline__ void a_ready(const Unit&) const {}
    __device__ __forceinline__ void done(const Unit&) const {}
};

__device__ __forceinline__ unsigned cvt_pk_bf16(float lo, float hi) { unsigned r; asm volatile("v_cvt_pk_bf16_f32 %0, %1, %2" : "=v"(r) : "v"(lo), "v"(hi)); return r; }
typedef float f32x2 __attribute__((ext_vector_type(2)));
struct EpiBf16 {
    static constexpr bool PERM = true, AFTER_DRAIN = false;
    bf16_t* O; int ldc;
    __device__ __forceinline__ void operator()(const f32x4 (&acc)[2][2][4][2], const Unit& u, int wr, int wc, int fr, int fq) const {
        const int row0 = u.pm * BM + wr * 64 + fr; const int col0 = u.pn * BM + wc * 32 + 8 * fq;
#pragma unroll
        for (int ai = 0; ai < 2; ++ai)
#pragma unroll
            for (int m = 0; m < 4; ++m) { bf16_t* rowp = O + (size_t)(row0 + ai * HALF + m * 16) * ldc + col0;
#pragma unroll
                for (int bj = 0; bj < 2; ++bj) { const f32x4 v0 = acc[ai][bj][m][0], v1 = acc[ai][bj][m][1];
                    u32x4 w; w.x = cvt_pk_bf16(v0[0], v0[1]); w.y = cvt_pk_bf16(v0[2], v0[3]); w.z = cvt_pk_bf16(v1[0], v1[1]); w.w = cvt_pk_bf16(v1[2], v1[3]);
                    *(u32x4*)(rowp + bj * HALF) = w; } }
    }
};
struct EpiHeads {
    static constexpr bool PERM = true, AFTER_DRAIN = false;
    bf16_t* base[4]; int tile0[4]; int ldc[4]; int kind[4]; const float* gain[4]; float scale[4]; int f8[4];
    int ntens;
    __device__ __forceinline__ void operator()(const f32x4 (&acc)[2][2][4][2], const Unit& u, int wr, int wc, int fr, int fq) const {
        bf16_t* O = base[0]; int t0 = tile0[0], ld = ldc[0], kd = kind[0], o8 = f8[0]; const float* gn = gain[0]; float sc = scale[0];
#pragma unroll
        for (int i = 1; i < 4; ++i) if (i < ntens && u.pn >= tile0[i]) { O = base[i]; t0 = tile0[i]; ld = ldc[i]; kd = kind[i]; gn = gain[i]; sc = scale[i]; o8 = f8[i]; }
        const int head = (u.pn - t0) * 4 + wc; const int row0 = u.pm * BM + wr * 64 + fr;
        f32x4 gv[2][2];
#pragma unroll
        for (int bj = 0; bj < 2; ++bj)
#pragma unroll
            for (int n = 0; n < 2; ++n) gv[bj][n] = (kd == 1) ? *(const f32x4*)(gn + 32 * bj + 8 * fq + 4 * n) * sc : (f32x4){sc, sc, sc, sc};
#pragma unroll
        for (int ai = 0; ai < 2; ++ai)
#pragma unroll
            for (int m = 0; m < 4; ++m) {
                float rs = 1.f;
                if (kd == 1) { float ss = 0.f;
#pragma unroll
                    for (int bj = 0; bj < 2; ++bj)
#pragma unroll
                        for (int n = 0; n < 2; ++n) { const f32x4 x = acc[ai][bj][m][n]; ss += (x[0] * x[0] + x[1] * x[1]) + (x[2] * x[2] + x[3] * x[3]); }
                    ss = xsum32(xsum16(ss));
                    rs = __builtin_amdgcn_rsqf(ss * (1.0f / 64.0f) + 1e-6f); }
                if (o8) {
                    unsigned char* rowb = (unsigned char*)O + (size_t)(row0 + ai * HALF + m * 16) * ld + head * 64 + 8 * fq;
#pragma unroll
                    for (int bj = 0; bj < 2; ++bj) { const f32x4 v0 = acc[ai][bj][m][0] * rs * gv[bj][0], v1 = acc[ai][bj][m][1] * rs * gv[bj][1];
                        int w0 = 0, w1 = 0; w0 = __builtin_amdgcn_cvt_pk_fp8_f32(v0[0], v0[1], w0, false); w0 = __builtin_amdgcn_cvt_pk_fp8_f32(v0[2], v0[3], w0, true);
                        w1 = __builtin_amdgcn_cvt_pk_fp8_f32(v1[0], v1[1], w1, false); w1 = __builtin_amdgcn_cvt_pk_fp8_f32(v1[2], v1[3], w1, true);
                        typedef unsigned u32x2 __attribute__((ext_vector_type(2))); *(u32x2*)(rowb + bj * 32) = (u32x2){(unsigned)w0, (unsigned)w1}; }
                } else {
                bf16_t* rowp = O + (size_t)(row0 + ai * HALF + m * 16) * ld + head * 64 + 8 * fq;
#pragma unroll
                for (int bj = 0; bj < 2; ++bj) { const f32x4 v0 = acc[ai][bj][m][0] * rs * gv[bj][0], v1 = acc[ai][bj][m][1] * rs * gv[bj][1];
                    u32x4 w; w.x = cvt_pk_bf16(v0[0], v0[1]); w.y = cvt_pk_bf16(v0[2], v0[3]); w.z = cvt_pk_bf16(v1[0], v1[1]); w.w = cvt_pk_bf16(v1[2], v1[3]);
                    *(u32x4*)(rowp + bj * 32) = w; } } }
    }
};
template <bool BIN16, bool BOUT16>
struct EpiRes {
    static constexpr bool PERM = false, AFTER_DRAIN = false;
    const void* base; void* out; const float* gate; int gate_bstride; int rows_per_batch;
    __device__ __forceinline__ void operator()(const f32x4 (&acc)[2][2][4][2], const Unit& u, int wr, int wc, int fr, int fq) const {
        typedef unsigned u32x2 __attribute__((ext_vector_type(2)));
        const int col0 = u.pn * BM + wc * 32 + 4 * fq; const int b = (u.pm * BM) / rows_per_batch;
        f32x4 gv[2][2];
#pragma unroll
        for (int bj = 0; bj < 2; ++bj)
#pragma unroll
            for (int n = 0; n < 2; ++n) gv[bj][n] = *(const f32x4*)(gate + (size_t)b * gate_bstride + col0 + bj * HALF + n * 16);
#pragma unroll
        for (int ai = 0; ai < 2; ++ai)
#pragma unroll
            for (int m = 0; m < 4; ++m) { const size_t off = (size_t)(u.pm * BM + ai * HALF + wr * 64 + m * 16 + fr) * 1024 + col0;
#pragma unroll
                for (int bj = 0; bj < 2; ++bj)
#pragma unroll
                    for (int n = 0; n < 2; ++n) { const size_t o2 = off + bj * HALF + n * 16; f32x4 bs;
                        if (BIN16) { const u32x2 r = *(const u32x2*)((const bf16_t*)base + o2); bs = (f32x4){__uint_as_float(r.x << 16), __uint_as_float(r.x & 0xffff0000u), __uint_as_float(r.y << 16), __uint_as_float(r.y & 0xffff0000u)}; }
                        else bs = *(const f32x4*)((const float*)base + o2);
                        const f32x4 v = bs + gv[bj][n] * acc[ai][bj][m][n];
                        if (BOUT16) *(u32x2*)((bf16_t*)out + o2) = (u32x2){cvt_pk_bf16(v[0], v[1]), cvt_pk_bf16(v[2], v[3])};
                        else *(f32x4*)((float*)out + o2) = v; }
                if (m & 1) asm volatile("" ::: "memory"); }
    }
};
template <bool BIN16, bool BOUT16>
struct EpiResStaged {
    static constexpr bool PERM = false, AFTER_DRAIN = true;
    const void* base; void* out; const float* gate; int gate_bstride; int rows_per_batch;
    __device__ __forceinline__ void operator()(const f32x4 (&)[2][2][4][2], const Unit&, int, int, int, int) const {}
    __device__ __forceinline__ void fused(const f32x4 (&acc)[2][2][4][2], const Unit& u, int wr, int wc, int fr_in, int fq_in, PG8_LAS unsigned char* img, int wid, int lane_in) const {
        int fr = fr_in, fq = fq_in, lane = lane_in; asm volatile("" : "+v"(fr), "+v"(fq), "+v"(lane));
        const int col0 = u.pn * BM + wc * 32 + 4 * fq; const int b = (u.pm * BM) / rows_per_batch;
        f32x4 gv[2][2];
#pragma unroll
        for (int bj = 0; bj < 2; ++bj)
#pragma unroll
            for (int n = 0; n < 2; ++n) gv[bj][n] = *(const f32x4*)(gate + (size_t)b * gate_bstride + col0 + bj * HALF + n * 16);
#pragma unroll
        for (int ai = 0; ai < 2; ++ai) {
            u32x4 bs16[8]; f32x4 bs32[BIN16 ? 1 : 8][2];
#pragma unroll
            for (int rnd = 0; rnd < 8; ++rnd) { const int q = rnd * 512 + wid * 64 + lane, row = q >> 5, c8 = q & 31; const size_t o = (size_t)(u.pm * BM + ai * HALF + row) * 1024 + u.pn * BM + 8 * c8;
                if constexpr (BIN16) bs16[rnd] = *(const u32x4*)((const bf16_t*)base + o);
                else { bs32[rnd][0] = *(const f32x4*)((const float*)base + o); bs32[rnd][1] = *(const f32x4*)((const float*)base + o + 4); } }
#pragma unroll
            for (int bj = 0; bj < 2; ++bj)
#pragma unroll
                for (int m = 0; m < 4; ++m)
#pragma unroll
                    for (int n = 0; n < 2; ++n) { const int hrow = wr * 64 + m * 16 + fr, chunk = (bj * HALF + wc * 32 + n * 16 + 4 * fq) >> 2;
                        *(PG8_LAS f32x4*)(img + hrow * 1024 + ((chunk ^ ((hrow & 15) << 2)) << 4)) = gv[bj][n] * acc[ai][bj][m][n]; }
            asm volatile("s_waitcnt lgkmcnt(0)" ::: "memory"); __builtin_amdgcn_s_barrier(); asm volatile("" ::: "memory");
#pragma unroll
            for (int rnd = 0; rnd < 8; ++rnd) { const int q = rnd * 512 + wid * 64 + lane, row = q >> 5, c8 = q & 31; const size_t o = (size_t)(u.pm * BM + ai * HALF + row) * 1024 + u.pn * BM + 8 * c8;
                const PG8_LAS unsigned char* ip = img + row * 1024 + (((2 * c8) ^ ((row & 15) << 2)) << 4);
                const f32x4 g0 = *(const PG8_LAS f32x4*)ip, g1 = *(const PG8_LAS f32x4*)(ip + 16);
                f32x4 b0, b1;
                if constexpr (BIN16) { const u32x4 r = bs16[rnd];
                    b0 = (f32x4){__uint_as_float(r.x << 16), __uint_as_float(r.x & 0xffff0000u), __uint_as_float(r.y << 16), __uint_as_float(r.y & 0xffff0000u)};
                    b1 = (f32x4){__uint_as_float(r.z << 16), __uint_as_float(r.z & 0xffff0000u), __uint_as_float(r.w << 16), __uint_as_float(r.w & 0xffff0000u)}; }
                else { b0 = bs32[rnd][0]; b1 = bs32[rnd][1]; }
                const f32x4 v0 = b0 + g0, v1 = b1 + g1;
                if constexpr (BOUT16) *(u32x4*)((bf16_t*)out + o) = (u32x4){cvt_pk_bf16(v0[0], v0[1]), cvt_pk_bf16(v0[2], v0[3]), cvt_pk_bf16(v1[0], v1[1]), cvt_pk_bf16(v1[2], v1[3])};
                else { *(f32x4*)((float*)out + o) = v0; *(f32x4*)((float*)out + o + 4) = v1; } }
            if (ai == 0) { asm volatile("s_waitcnt lgkmcnt(0)" ::: "memory"); __builtin_amdgcn_s_barrier(); asm volatile("" ::: "memory"); }
        }
    }
};
template <bool BIN16, int HMODE>
struct EpiResNormStaged {
    static constexpr bool PERM = false, AFTER_DRAIN = true;
    const void* base; void* out; const float* gate; int gate_bstride; int rows_per_batch;
    const float* gnorm; const float* modL; int sh_chunk, sc_chunk; bf16_t* hout; unsigned char* hout8; float* xslots; unsigned* cnt; PG8_LAS unsigned char* tbl;
    __device__ __forceinline__ void operator()(const f32x4 (&)[2][2][4][2], const Unit&, int, int, int, int) const {}
    __device__ __forceinline__ void fused(const f32x4 (&acc)[2][2][4][2], const Unit& u, int wr, int wc, int fr_in, int fq_in, PG8_LAS unsigned char* img, int wid, int lane_in) const {
        int fr = fr_in, fq = fq_in, lane = lane_in; asm volatile("" : "+v"(fr), "+v"(fq), "+v"(lane));
        const int col0 = u.pn * BM + wc * 32 + 4 * fq; const int b = (u.pm * BM) / rows_per_batch;
        PG8_LAS float* Pt = (PG8_LAS float*)tbl; PG8_LAS float* St = (PG8_LAS float*)(tbl + 1024); PG8_LAS unsigned* flag = (PG8_LAS unsigned*)(tbl + 2048);
        f32x4 gv[2][2];
#pragma unroll
        for (int bj = 0; bj < 2; ++bj)
#pragma unroll
            for (int n = 0; n < 2; ++n) gv[bj][n] = *(const f32x4*)(gate + (size_t)b * gate_bstride + col0 + bj * HALF + n * 16);
        constexpr bool KEEP = BIN16;
        u32x4 wk[KEEP ? 8 : 1];
#pragma unroll
        for (int ai = 0; ai < 2; ++ai) {
            u32x4 bs16[8]; f32x4 bs32[BIN16 ? 1 : 8][2];
#pragma unroll
            for (int rnd = 0; rnd < 8; ++rnd) { const int q = rnd * 512 + wid * 64 + lane, row = q >> 5, c8 = q & 31; const size_t o = (size_t)(u.pm * BM + ai * HALF + row) * 1024 + u.pn * BM + 8 * c8;
                if constexpr (BIN16) bs16[rnd] = *(const u32x4*)((const bf16_t*)base + o);
                else { bs32[rnd][0] = *(const f32x4*)((const float*)base + o); bs32[rnd][1] = *(const f32x4*)((const float*)base + o + 4); } }
#pragma unroll
            for (int bj = 0; bj < 2; ++bj)
#pragma unroll
                for (int m = 0; m < 4; ++m)
#pragma unroll
                    for (int n = 0; n < 2; ++n) { const int hrow = wr * 64 + m * 16 + fr, chunk = (bj * HALF + wc * 32 + n * 16 + 4 * fq) >> 2;
                        *(PG8_LAS f32x4*)(img + hrow * 1024 + ((chunk ^ ((hrow & 15) << 2)) << 4)) = gv[bj][n] * acc[ai][bj][m][n]; }
            asm volatile("s_waitcnt lgkmcnt(0)" ::: "memory"); __builtin_amdgcn_s_barrier(); asm volatile("" ::: "memory");
#pragma unroll
            for (int rnd = 0; rnd < 8; ++rnd) { const int q = rnd * 512 + wid * 64 + lane, row = q >> 5, c8 = q & 31; const size_t o = (size_t)(u.pm * BM + ai * HALF + row) * 1024 + u.pn * BM + 8 * c8;
                const PG8_LAS unsigned char* ip = img + row * 1024 + (((2 * c8) ^ ((row & 15) << 2)) << 4);
                const f32x4 g0 = *(const PG8_LAS f32x4*)ip, g1 = *(const PG8_LAS f32x4*)(ip + 16);
                f32x4 b0, b1;
                if constexpr (BIN16) { const u32x4 r = bs16[rnd];
                    b0 = (f32x4){__uint_as_float(r.x << 16), __uint_as_float(r.x & 0xffff0000u), __uint_as_float(r.y << 16), __uint_as_float(r.y & 0xffff0000u)};
                    b1 = (f32x4){__uint_as_float(r.z << 16), __uint_as_float(r.z & 0xffff0000u), __uint_as_float(r.w << 16), __uint_as_float(r.w & 0xffff0000u)}; }
                else { b0 = bs32[rnd][0]; b1 = bs32[rnd][1]; }
                const f32x4 v0 = b0 + g0, v1 = b1 + g1;
                const u32x4 w = (u32x4){cvt_pk_bf16(v0[0], v0[1]), cvt_pk_bf16(v0[2], v0[3]), cvt_pk_bf16(v1[0], v1[1]), cvt_pk_bf16(v1[2], v1[3])};
                *(u32x4*)((bf16_t*)out + o) = w; if constexpr (KEEP) { if (ai == 1) wk[rnd] = w; }
                float ss = 0.f;
#pragma unroll
                for (int k = 0; k < 4; ++k) { const float lo = __uint_as_float(w[k] << 16), hi = __uint_as_float(w[k] & 0xffff0000u); ss += lo * lo + hi * hi; }
                ss += dppf<0xB1>(ss); ss += dppf<0x4E>(ss); ss += dppf<0x141>(ss); ss += dppf<0x140>(ss); ss = xsum16(ss);
                if (c8 == 0) Pt[ai * HALF + row] = ss; }
            asm volatile("s_waitcnt lgkmcnt(0)" ::: "memory"); __builtin_amdgcn_s_barrier(); asm volatile("" ::: "memory");
        }
        const int c8n = lane & 31; const int gcol = u.pn * BM + 8 * c8n;
        f32x4 G0, G1, S0, S1;
        { const f32x4 g0 = *(const f32x4*)(gnorm + gcol), g1 = *(const f32x4*)(gnorm + gcol + 4);
          const f32x4 c0 = *(const f32x4*)(modL + (size_t)b * 6144 + sc_chunk * 1024 + gcol), c1 = *(const f32x4*)(modL + (size_t)b * 6144 + sc_chunk * 1024 + gcol + 4);
          G0 = g0 * (c0 + 1.0f); G1 = g1 * (c1 + 1.0f); S0 = *(const f32x4*)(modL + (size_t)b * 6144 + sh_chunk * 1024 + gcol); S1 = *(const f32x4*)(modL + (size_t)b * 6144 + sh_chunk * 1024 + gcol + 4); }
        const int trow = wid * 32 + (lane & 31);
        if (lane < 32) __hip_atomic_store(xslots + ((size_t)(u.pm * BM + trow) * 4 + u.pn), Pt[trow], __ATOMIC_RELAXED, __HIP_MEMORY_SCOPE_AGENT);
        asm volatile("s_waitcnt vmcnt(0)" ::: "memory");
        if (lane == 0) __hip_atomic_fetch_add(cnt + 16 * u.pm, 1u, __ATOMIC_RELAXED, __HIP_MEMORY_SCOPE_AGENT);
        if (wid == 0) {
            unsigned sp = 0u;
            while ((unsigned)__builtin_amdgcn_readfirstlane(__hip_atomic_load(cnt + 16 * u.pm, __ATOMIC_RELAXED, __HIP_MEMORY_SCOPE_AGENT)) < 32u) { __builtin_amdgcn_s_sleep(1); if (++sp > (1u << 22)) break; }
            __builtin_amdgcn_fence(__ATOMIC_ACQUIRE, "agent");
            if (lane == 0) flag[0] = sp;
        }
        asm volatile("s_waitcnt vmcnt(0) lgkmcnt(0)" ::: "memory"); __builtin_amdgcn_s_barrier(); asm volatile("" ::: "memory");
        if (lane < 32) { const float* sl = xslots + (size_t)(u.pm * BM + trow) * 4; float t = 0.f;
#pragma unroll
            for (int k = 0; k < 4; ++k) t += __hip_atomic_load(sl + k, __ATOMIC_RELAXED, __HIP_MEMORY_SCOPE_AGENT);
            St[trow] = __builtin_amdgcn_rsqf(t * (1.0f / 1024.0f) + 1e-6f); }
        asm volatile("s_waitcnt lgkmcnt(0)" ::: "memory"); __builtin_amdgcn_s_barrier(); asm volatile("" ::: "memory");
#pragma unroll
        for (int hf = 0; hf < 2; ++hf) {
            u32x4 xr[8];
            if (!KEEP || hf == 0) {
#pragma unroll
                for (int rnd = 0; rnd < 8; ++rnd) { const int q = rnd * 512 + wid * 64 + lane, row = q >> 5; xr[rnd] = *(const u32x4*)((const bf16_t*)out + (size_t)(u.pm * BM + hf * HALF + row) * 1024 + gcol); } }
#pragma unroll
            for (int rnd = 0; rnd < 8; ++rnd) { const int q = rnd * 512 + wid * 64 + lane, row = q >> 5; const size_t o = (size_t)(u.pm * BM + hf * HALF + row) * 1024 + gcol;
                const float rs = St[hf * HALF + row]; u32x4 r; if (KEEP && hf == 1) r = wk[KEEP ? rnd : 0]; else r = xr[rnd];
                const f32x4 x0 = (f32x4){__uint_as_float(r.x << 16), __uint_as_float(r.x & 0xffff0000u), __uint_as_float(r.y << 16), __uint_as_float(r.y & 0xffff0000u)};
                const f32x4 x1 = (f32x4){__uint_as_float(r.z << 16), __uint_as_float(r.z & 0xffff0000u), __uint_as_float(r.w << 16), __uint_as_float(r.w & 0xffff0000u)};
                const f32x4 h0 = x0 * rs * G0 + S0, h1 = x1 * rs * G1 + S1;
                int w0 = 0, w1 = 0; w0 = __builtin_amdgcn_cvt_pk_fp8_f32(h0[0], h0[1], w0, false); w0 = __builtin_amdgcn_cvt_pk_fp8_f32(h0[2], h0[3], w0, true);
                w1 = __builtin_amdgcn_cvt_pk_fp8_f32(h1[0], h1[1], w1, false); w1 = __builtin_amdgcn_cvt_pk_fp8_f32(h1[2], h1[3], w1, true);
                typedef unsigned u32x2 __attribute__((ext_vector_type(2)));
                *(u32x2*)(hout8 + o) = (u32x2){(unsigned)w0, (unsigned)w1};
                if constexpr (HMODE == 2) *(u32x4*)(hout + o) = (u32x4){cvt_pk_bf16(h0[0], h0[1]), cvt_pk_bf16(h0[2], h0[3]), cvt_pk_bf16(h1[0], h1[1]), cvt_pk_bf16(h1[2], h1[3])}; }
        }
    }
};
struct EpiConvGate {
    static constexpr bool PERM = true, AFTER_DRAIN = false;
    bf16_t* U; const float* cw; const float* cb; float* sideA0; float* sideG0; float* sideA1; PG8_LAS float* halo; PG8_LAS unsigned char* stage;
    __device__ __forceinline__ void operator()(const f32x4 (&acc)[2][2][4][2], const Unit& u, int wr, int wc, int fr_in, int fq_in) const {
        constexpr int FFc = 2816;
        int fr = fr_in, fq = fq_in; asm volatile("" : "+v"(fr), "+v"(fq));
        const int colt = u.pn * 128 + wc * 32 + 8 * fq;
        const int lcol = wc * 32 + 8 * fq;
        if (fr >= 14) {
#pragma unroll
            for (int ai = 0; ai < 2; ++ai)
#pragma unroll
                for (int n = 0; n < 2; ++n) *(PG8_LAS f32x4*)(halo + ((ai * 2 + wr) * 2 + (fr - 14)) * 128 + lcol + 4 * n) = acc[ai][0][3][n];
        }
        asm volatile("s_waitcnt lgkmcnt(0)" ::: "memory"); __builtin_amdgcn_s_barrier(); asm volatile("" ::: "memory");
        typedef float f32x2 __attribute__((ext_vector_type(2)));
#define CG_DPP(x, ctrl) __int_as_float(__builtin_amdgcn_update_dpp(0, __float_as_int(x), ctrl, 0xf, 0xf, true))
        const bool lane0 = (fr == 0), lane01 = (fr < 2);
        const int wid8 = wr * 4 + wc, lane64 = fq * 16 + fr;
#pragma unroll
        for (int ai = 0; ai < 2; ++ai) {
#pragma unroll
            for (int n = 0; n < 2; ++n) {
                const f32x4 w0 = *(const f32x4*)(cw + colt + 4 * n), w1 = *(const f32x4*)(cw + FFc + colt + 4 * n), w2 = *(const f32x4*)(cw + 2 * FFc + colt + 4 * n), bb = *(const f32x4*)(cb + colt + 4 * n);
                f32x4 w1b, w0b;
#pragma unroll
                for (int e4 = 0; e4 < 4; ++e4) { w1b[e4] = lane0 ? w1[e4] : 0.f; w0b[e4] = lane01 ? w0[e4] : 0.f; }
                const int pb = (wr == 1) ? (ai * 2) : ((ai == 1) ? 1 : 0); const int hr = (fr >= 14) ? (fr - 14) : 0;
                const f32x4 prv = *(const PG8_LAS f32x4*)(halo + (pb * 2 + hr) * 128 + lcol + 4 * n);
#pragma unroll
                for (int m = 0; m < 4; ++m) {
                    const f32x4 x = acc[ai][0][m][n], gt = acc[ai][1][m][n]; const f32x4 pv = (m == 0) ? prv : acc[ai][0][m - 1][n];
                    f32x4 sv;
#pragma unroll
                    for (int e4 = 0; e4 < 4; ++e4) {
                        float t = fmaf(w2[e4], x[e4], bb[e4]);
                        t = fmaf(CG_DPP(x[e4], 0x111), w1[e4], t);
                        t = fmaf(CG_DPP(pv[e4], 0x121), w1b[e4], t);
                        t = fmaf(CG_DPP(x[e4], 0x112), w0[e4], t);
                        t = fmaf(CG_DPP(pv[e4], 0x122), w0b[e4], t);
                        sv[e4] = t;
                    }
                    f32x4 uo;
#pragma unroll
                    for (int p = 0; p < 2; ++p) {
                        const f32x2 s2 = (f32x2){sv[2 * p], sv[2 * p + 1]}; const f32x2 g2 = (f32x2){gt[2 * p], gt[2 * p + 1]};
                        const f32x2 a2 = s2 * -1.4426950408889634f;
                        const f32x2 d2 = (f32x2){__builtin_amdgcn_exp2f(fminf(a2[0], 60.f)), __builtin_amdgcn_exp2f(fminf(a2[1], 60.f))} + 1.0f;
                        const float r = __builtin_amdgcn_rcpf(d2[0] * d2[1]);
                        const f32x2 inv = (f32x2){d2[1], d2[0]} * r;
                        const f32x2 u2 = (s2 * g2) * inv;
                        uo[2 * p] = u2[0]; uo[2 * p + 1] = u2[1];
                    }
                    const int hrow = wr * 64 + m * 16 + fr, trow = ai * HALF + hrow;
                    int w8 = 0; w8 = __builtin_amdgcn_cvt_pk_fp8_f32(uo[0], uo[1], w8, false); w8 = __builtin_amdgcn_cvt_pk_fp8_f32(uo[2], uo[3], w8, true);
                    { const int cb4 = lcol + 4 * n; *(PG8_LAS unsigned*)(stage + hrow * 128 + ((((cb4 >> 4) ^ ((hrow >> 1) & 7)) << 4) | (cb4 & 15))) = (unsigned)w8; }
                    if (ai == 0 && m == 0) {
                        if (trow < 2) { *(f32x4*)(sideA0 + ((size_t)u.pm * 2 + trow) * FFc + colt + 4 * n) = x; *(f32x4*)(sideG0 + ((size_t)u.pm * 2 + trow) * FFc + colt + 4 * n) = gt; } }
                    if (ai == 1 && m == 3) { if (trow >= 254) *(f32x4*)(sideA1 + ((size_t)u.pm * 2 + (trow - 254)) * FFc + colt + 4 * n) = x; }
                }
            }
            asm volatile("s_waitcnt lgkmcnt(0)" ::: "memory"); __builtin_amdgcn_s_barrier(); asm volatile("" ::: "memory");
#pragma unroll
            for (int rnd = 0; rnd < 2; ++rnd) { const int q = rnd * 512 + wid8 * 64 + lane64, hrow = q >> 3, c = q & 7;
                const u32x4 v = *(const PG8_LAS u32x4*)(stage + hrow * 128 + ((c ^ ((hrow >> 1) & 7)) << 4));
                if (ai == 1 || hrow >= 2) *(u32x4*)((unsigned char*)U + (size_t)(u.pm * BM + ai * HALF + hrow) * FFc + u.pn * 128 + c * 16) = v; }
            if (ai == 0) { asm volatile("s_waitcnt lgkmcnt(0)" ::: "memory"); __builtin_amdgcn_s_barrier(); asm volatile("" ::: "memory"); }
        }
#undef CG_DPP
        asm volatile("s_waitcnt lgkmcnt(0)" ::: "memory"); __builtin_amdgcn_s_barrier(); asm volatile("" ::: "memory");
    }
};
template <class Epi, class Sched, bool ALIGN_EPI = false, bool SP2 = false, bool F8 = false>
__device__ __forceinline__ void gemm_phase(PG8_LAS unsigned char* lds, const Gemm g, const Sched& S, const Epi& E, const int tid) {
    const int wid = __builtin_amdgcn_readfirstlane(tid >> 6), lane = tid & 63, wr = wid >> 2, wc = wid & 3, fr = lane & 15, fq = lane >> 4;
    const int K = g.K, nt = K / BK;
    unsigned voffA[2], voffB[2];
#pragma unroll
    for (int i = 0; i < 2; ++i) { int R, C; stage_rc(tid * 16 + i * 8192, R, C); const int Rb = Epi::PERM ? ((R & ~31) + perm32(R & 31)) : R;
        voffA[i] = (unsigned)(R * g.lda + C) * 2u; voffB[i] = (unsigned)(Rb * g.ldb + C) * 2u; }
    const size_t kstep = (size_t)(BK * 2);
    const size_t hstepA = (size_t)HALF * g.lda * 2, hstepB = (size_t)HALF * g.ldb * 2;
    const size_t tstepA = 2 * hstepA, tstepB = 2 * hstepB;
    const unsigned ldsw = (unsigned)wid * 1024u;
    const int aoff = lds_byte(wr * 64 + fr, fq * 8), boff = lds_byte(wc * 32 + fr, fq * 8);
#define PG8_SA(b, h) (((b) * 2 + (h)) * HTB)
#define PG8_SB(b, h) ((4 + (b) * 2 + (h)) * HTB)
#define PG8_STAGE(bufoff, gbase, voff) do { _Pragma("unroll") for (int _i = 0; _i < 2; ++_i) \
        __builtin_amdgcn_global_load_lds((const unsigned*)((const char*)(gbase) + (voff)[_i]), (PG8_LAS unsigned*)(lds + (bufoff) + ldsw + _i * 8192), 16, 0, 0); } while (0)
#define PG8_LDA(dst, b, h) do { _Pragma("unroll") for (int m = 0; m < 4; ++m) { dst[m].lo = *(const PG8_LAS bf16x8*)(lds + PG8_SA(b, h) + aoff + m * 2048); dst[m].hi = *(const PG8_LAS bf16x8*)(lds + PG8_SA(b, h) + aoff + m * 2048 + 1024); } } while (0)
#define PG8_LDB(dst, b, h) do { _Pragma("unroll") for (int n = 0; n < 2; ++n) { dst[n].lo = *(const PG8_LAS bf16x8*)(lds + PG8_SB(b, h) + boff + n * 2048); dst[n].hi = *(const PG8_LAS bf16x8*)(lds + PG8_SB(b, h) + boff + n * 2048 + 1024); } } while (0)
#define PG8_MMA(ai, bj, At, Bt) do { __builtin_amdgcn_s_setprio(1); _Pragma("unroll") for (int m = 0; m < 4; ++m) _Pragma("unroll") for (int n = 0; n < 2; ++n) { \
        if constexpr (F8) asm volatile("v_mfma_scale_f32_16x16x128_f8f6f4 %0, %1, %2, %0, %3, %4 op_sel_hi:[0,0,0]" : "+v"(acc[ai][bj][m][n]) : "v"(__builtin_bit_cast(pg8_v8i, Bt[n])), "v"(__builtin_bit_cast(pg8_v8i, At[m])), "v"(f8sb), "v"(f8sa));   \
        else { acc[ai][bj][m][n] = __builtin_amdgcn_mfma_f32_16x16x32_bf16(Bt[n].lo, At[m].lo, acc[ai][bj][m][n], 0, 0, 0); acc[ai][bj][m][n] = __builtin_amdgcn_mfma_f32_16x16x32_bf16(Bt[n].hi, At[m].hi, acc[ai][bj][m][n], 0, 0, 0); } } \
        __builtin_amdgcn_s_setprio(0); } while (0)
#define PG8_WAIT_V(n) asm volatile("s_waitcnt vmcnt(" #n ")" ::: "memory")
#define PG8_WAIT_L(n) asm volatile("s_waitcnt lgkmcnt(" #n ")" ::: "memory")
#define PG8_BAR __builtin_amdgcn_s_barrier()
#define PG8_SCHED __builtin_amdgcn_sched_barrier(0)
    Unit cur, nxt; int ui = 0;
    if (!S.next(0, cur)) return;
    f32x4 acc[2][2][4][2];
#pragma unroll
    for (int a = 0; a < 2; ++a)
#pragma unroll
        for (int b = 0; b < 2; ++b)
#pragma unroll
            for (int m = 0; m < 4; ++m)
#pragma unroll
                for (int n = 0; n < 2; ++n) acc[a][b][m][n] = (f32x4){0.f, 0.f, 0.f, 0.f};
    const int f8sa = g.sa, f8sb = g.sb; (void)f8sa; (void)f8sb;
    pg8_bf16x16 At[4], B0[2], B1[2];
    const char* cA = (const char*)g.A + (size_t)cur.pm * tstepA; const char* cB = (const char*)g.Bt + (size_t)cur.pn * tstepB;
    S.a_ready(cur);
    if constexpr (SP2) {
        PG8_STAGE(PG8_SB(0, 0), cB, voffB); PG8_STAGE(PG8_SB(0, 1), cB + hstepB, voffB); PG8_STAGE(PG8_SA(0, 0), cA, voffA); PG8_STAGE(PG8_SA(0, 1), cA + hstepA, voffA);
        if (wr == 1) PG8_BAR;
        PG8_WAIT_V(2); PG8_BAR;
        PG8_STAGE(PG8_SB(1, 0), cB + kstep, voffB); PG8_STAGE(PG8_SA(1, 0), cA + kstep, voffA); PG8_STAGE(PG8_SB(1, 1), cB + hstepB + kstep, voffB);
        PG8_WAIT_V(6); PG8_BAR;
    } else {
        PG8_STAGE(PG8_SB(0, 0), cB, voffB); PG8_STAGE(PG8_SA(0, 0), cA, voffA); PG8_STAGE(PG8_SB(0, 1), cB + hstepB, voffB); PG8_STAGE(PG8_SA(0, 1), cA + hstepA, voffA);
        if (wr == 1) PG8_BAR;
        PG8_WAIT_V(4); PG8_BAR;
        PG8_STAGE(PG8_SB(1, 0), cB + kstep, voffB); PG8_STAGE(PG8_SA(1, 0), cA + kstep, voffA); PG8_STAGE(PG8_SB(1, 1), cB + hstepB + kstep, voffB);
        PG8_WAIT_V(6); PG8_BAR;
    }
    for (;;) {
        const bool has_next = S.next(ui + 1, nxt);
        const char* nA = has_next ? (const char*)g.A + (size_t)nxt.pm * tstepA : cA; const char* nB = has_next ? (const char*)g.Bt + (size_t)nxt.pn * tstepB : cB;
#pragma unroll 1
        for (int t = 0; t < nt; t += 2) {
            const bool last = (t == nt - 2);
            const char* a1 = cA + (size_t)(t + 1) * kstep;
            const char* a2 = last ? nA : cA + (size_t)(t + 2) * kstep; const char* b2 = last ? nB : cB + (size_t)(t + 2) * kstep;
            const char* a3 = a2 + kstep; const char* b3 = b2 + kstep;
            if (last && has_next) S.a_ready(nxt);
            if constexpr (SP2) {
            PG8_LDB(B0, 0, 0); PG8_LDB(B1, 0, 1); PG8_SCHED; PG8_LDA(At, 0, 0); PG8_STAGE(PG8_SA(1, 1), a1 + hstepA, voffA);
            PG8_WAIT_V(8); PG8_WAIT_L(0); PG8_BAR; PG8_MMA(0, 0, At, B0); PG8_MMA(0, 1, At, B1); PG8_BAR; PG8_SCHED;
            PG8_LDA(At, 0, 1); PG8_STAGE(PG8_SB(0, 0), b2, voffB); PG8_STAGE(PG8_SB(0, 1), b2 + hstepB, voffB); PG8_STAGE(PG8_SA(0, 0), a2, voffA);
            PG8_WAIT_V(8); PG8_WAIT_L(0); PG8_BAR; PG8_MMA(1, 0, At, B0); PG8_MMA(1, 1, At, B1); PG8_BAR; PG8_SCHED;
            PG8_LDB(B0, 1, 0); PG8_LDB(B1, 1, 1); PG8_SCHED; PG8_LDA(At, 1, 0); PG8_STAGE(PG8_SA(0, 1), a2 + hstepA, voffA);
            PG8_WAIT_V(8); PG8_WAIT_L(0); PG8_BAR; PG8_MMA(0, 0, At, B0); PG8_MMA(0, 1, At, B1); PG8_BAR; PG8_SCHED;
            PG8_LDA(At, 1, 1); PG8_STAGE(PG8_SB(1, 0), b3, voffB); PG8_STAGE(PG8_SB(1, 1), b3 + hstepB, voffB); PG8_STAGE(PG8_SA(1, 0), a3, voffA);
            PG8_WAIT_V(8); PG8_WAIT_L(0); PG8_BAR; PG8_MMA(1, 0, At, B0); PG8_MMA(1, 1, At, B1); PG8_BAR; PG8_SCHED;
            } else {
            PG8_LDB(B0, 0, 0); PG8_SCHED; PG8_LDA(At, 0, 0); PG8_STAGE(PG8_SA(1, 1), a1 + hstepA, voffA);
            PG8_WAIT_L(8); PG8_BAR; PG8_WAIT_L(0); PG8_MMA(0, 0, At, B0); PG8_BAR; PG8_SCHED;
            PG8_LDB(B1, 0, 1); PG8_STAGE(PG8_SB(0, 0), b2, voffB);
            PG8_BAR; PG8_WAIT_L(0); PG8_MMA(0, 1, At, B1); PG8_BAR;
            PG8_LDA(At, 0, 1); PG8_STAGE(PG8_SA(0, 0), a2, voffA);
            PG8_BAR; PG8_WAIT_L(0); PG8_MMA(1, 0, At, B0); PG8_BAR; PG8_SCHED;
            PG8_STAGE(PG8_SB(0, 1), b2 + hstepB, voffB);
            PG8_WAIT_V(6); PG8_BAR; PG8_MMA(1, 1, At, B1); PG8_BAR;
            PG8_LDB(B0, 1, 0); PG8_SCHED; PG8_LDA(At, 1, 0); PG8_STAGE(PG8_SA(0, 1), a2 + hstepA, voffA);
            PG8_WAIT_L(8); PG8_BAR; PG8_WAIT_L(0); PG8_MMA(0, 0, At, B0); PG8_BAR; PG8_SCHED;
            PG8_LDB(B1, 1, 1); PG8_STAGE(PG8_SB(1, 0), b3, voffB);
            PG8_BAR; PG8_WAIT_L(0); PG8_MMA(0, 1, At, B1); PG8_BAR;
            PG8_LDA(At, 1, 1); PG8_STAGE(PG8_SA(1, 0), a3, voffA);
            PG8_BAR; PG8_WAIT_L(0); PG8_MMA(1, 0, At, B0); PG8_BAR; PG8_SCHED;
            PG8_STAGE(PG8_SB(1, 1), b3 + hstepB, voffB);
            PG8_WAIT_V(6); PG8_BAR; PG8_MMA(1, 1, At, B1); PG8_BAR;
            }
        }
        if constexpr (ALIGN_EPI) { if (wr == 0) PG8_BAR; }
        if constexpr (F8) {
            asm volatile("s_nop 15\n\ts_nop 7" : "+v"(acc[0][0][0][0]), "+v"(acc[0][0][0][1]), "+v"(acc[0][0][1][0]), "+v"(acc[0][0][1][1]), "+v"(acc[0][0][2][0]), "+v"(acc[0][0][2][1]), "+v"(acc[0][0][3][0]), "+v"(acc[0][0][3][1]), "+v"(acc[0][1][0][0]), "+v"(acc[0][1][0][1]), "+v"(acc[0][1][1][0]), "+v"(acc[0][1][1][1]), "+v"(acc[0][1][2][0]), "+v"(acc[0][1][2][1]), "+v"(acc[0][1][3][0]), "+v"(acc[0][1][3][1]) :: "memory");
            asm volatile("" : "+v"(acc[1][0][0][0]), "+v"(acc[1][0][0][1]), "+v"(acc[1][0][1][0]), "+v"(acc[1][0][1][1]), "+v"(acc[1][0][2][0]), "+v"(acc[1][0][2][1]), "+v"(acc[1][0][3][0]), "+v"(acc[1][0][3][1]), "+v"(acc[1][1][0][0]), "+v"(acc[1][1][0][1]), "+v"(acc[1][1][1][0]), "+v"(acc[1][1][1][1]), "+v"(acc[1][1][2][0]), "+v"(acc[1][1][2][1]), "+v"(acc[1][1][3][0]), "+v"(acc[1][1][3][1]) :: "memory"); }
        if constexpr (!Epi::AFTER_DRAIN) { E(acc, cur, wr, wc, fr, fq); S.done(cur); }
        if (!has_next) break;
#pragma unroll
        for (int a = 0; a < 2; ++a)
#pragma unroll
            for (int b = 0; b < 2; ++b)
#pragma unroll
                for (int m = 0; m < 4; ++m)
#pragma unroll
                    for (int n = 0; n < 2; ++n) acc[a][b][m][n] = (f32x4){0.f, 0.f, 0.f, 0.f};
        cur = nxt; cA = nA; cB = nB; ++ui;
        if constexpr (ALIGN_EPI) { if (wr == 1) PG8_BAR; }
    }
    PG8_WAIT_V(0);
    if constexpr (!ALIGN_EPI) { if (wr == 0) PG8_BAR; }
    PG8_BAR;
    if constexpr (Epi::AFTER_DRAIN) { E.fused(acc, cur, wr, wc, fr, fq, lds, wid, lane); S.done(cur); }
#undef PG8_SA
#undef PG8_SB
#undef PG8_STAGE
#undef PG8_LDA
#undef PG8_LDB
#undef PG8_MMA
#undef PG8_WAIT_V
#undef PG8_WAIT_L
#undef PG8_BAR
#undef PG8_SCHED
}
}

#include <hip/hip_bf16.h>
#include <cmath>
namespace attn_body {
using bf16=__hip_bfloat16;
using bf16x8=__attribute__((ext_vector_type(8)))short;
using s16x4=__attribute__((ext_vector_type(4)))short;
using f32x16=__attribute__((ext_vector_type(16)))float;
using u32x4=__attribute__((ext_vector_type(4)))unsigned;
constexpr int BATCH=2,NHEAD=16,SEQ=8192,D=64,DM=NHEAD*D;
constexpr int NW=8,QBLK=32,QB=QBLK*NW,KVBLK=64,NQB=SEQ/QB;
constexpr int ATTN_PITCH=DM, ATTN_UNIT_ROWS=QB;
__device__ __forceinline__ int crow(int r,int hi){return (r&3)+8*(r>>2)+4*hi;}
#define SBAR() __builtin_amdgcn_sched_barrier(0)
__device__ __forceinline__ void cmask(f32x16&p0,f32x16&p1,int jb,int qrel,int hi){
  const float NEG=-INFINITY; int kb=64*jb+4*hi;
  #pragma unroll
  for(int r=0;r<16;++r){int kv=kb+(r&3)+8*(r>>2); if(kv>qrel)p0[r]=NEG; if(kv+32>qrel)p1[r]=NEG;}
}

constexpr int NSLOT=3, SLOTB=8192, KSLOTB=10240;
constexpr int LDS_K=0, LDS_V=NSLOT*KSLOTB, LDS_WS=LDS_V+NSLOT*SLOTB, LDS_OST=LDS_WS+NW*64*4, LDS_BYTES=LDS_OST+NW*4096;
#define KOFF(sl) ((sl)+((sl)>>2))
constexpr float C2=0.125f*1.4426950408889634f;
__device__ __forceinline__ void glds16(const void*gsrc,unsigned lds_dst){unsigned keep;
  asm volatile("s_mov_b32 %0, m0\n\ts_mov_b32 m0, %2\n\ts_nop 0\n\tglobal_load_lds_dwordx4 %1, off\n\ts_mov_b32 m0, %0":"=&s"(keep):"v"(gsrc),"s"(lds_dst):"memory");}
__device__ __forceinline__ void glds4(const void*gsrc,unsigned lds_dst){unsigned keep;
  asm volatile("s_mov_b32 %0, m0\n\ts_mov_b32 m0, %2\n\ts_nop 0\n\tglobal_load_lds_dword %1, off\n\ts_mov_b32 m0, %0":"=&s"(keep):"v"(gsrc),"s"(lds_dst):"memory");}
__device__ __forceinline__ float max3f(float a,float b,float c){float r;asm("v_max3_f32 %0, %1, %2, %3":"=v"(r):"v"(a),"v"(b),"v"(c));return r;}
__device__ __forceinline__ float max2f(float a,float b){float r;asm("v_max_f32_e32 %0, %1, %2":"=v"(r):"v"(a),"v"(b));return r;}
__device__ __forceinline__ float fadd_s(float a,float b){float r;asm("v_add_f32_e32 %0, %1, %2":"=v"(r):"v"(a),"v"(b));return r;}
__device__ __forceinline__ float fsub_s(float a,float b){float r;asm("v_sub_f32_e32 %0, %1, %2":"=v"(r):"v"(a),"v"(b));return r;}
typedef float f32x2_t __attribute__((ext_vector_type(2))); typedef __bf16 bf16x2_t __attribute__((ext_vector_type(2)));
__device__ __forceinline__ unsigned cvtpk_s(float lo,float hi){f32x2_t v={lo,hi};bf16x2_t b=__builtin_convertvector(v,bf16x2_t);return __builtin_bit_cast(unsigned,b);}
#define WAIT_BAR(N) asm volatile("s_waitcnt vmcnt(" #N ") lgkmcnt(0)\n\ts_barrier":::"memory")

__device__ __forceinline__ void qkt(f32x16&p0,f32x16&p1,const char*Kslot,const bf16x8*qr,const bf16x8 qe,int r32,int hi){
  const char*kb=Kslot+hi*1024+r32*16;
  { const bf16x8 e0=*reinterpret_cast<const bf16x8*>(kb+8192); const bf16x8 e1=*reinterpret_cast<const bf16x8*>(kb+8192+512); const f32x16 z=f32x16{};
    p0=__builtin_amdgcn_mfma_f32_32x32x16_bf16(e0,qe,z,0,0,0); p1=__builtin_amdgcn_mfma_f32_32x32x16_bf16(e1,qe,z,0,0,0); }
  #pragma unroll
  for(int d0=0;d0<4;++d0){
    const bf16x8 b0=*reinterpret_cast<const bf16x8*>(kb+d0*2048);
    const bf16x8 b1=*reinterpret_cast<const bf16x8*>(kb+d0*2048+512);
    {p0=__builtin_amdgcn_mfma_f32_32x32x16_bf16(b0,qr[d0],p0,0,0,0);p1=__builtin_amdgcn_mfma_f32_32x32x16_bf16(b1,qr[d0],p1,0,0,0);}}
}
typedef __attribute__((address_space(3))) const char* lds_cptr;
typedef short v4i16_t __attribute__((ext_vector_type(4)));
__device__ __forceinline__ void kload8(bf16x8*kf,lds_cptr kp){
  kf[0]=*(const __attribute__((address_space(3))) bf16x8*)(kp);      kf[1]=*(const __attribute__((address_space(3))) bf16x8*)(kp+512);
  kf[2]=*(const __attribute__((address_space(3))) bf16x8*)(kp+2048); kf[3]=*(const __attribute__((address_space(3))) bf16x8*)(kp+2560);
  kf[4]=*(const __attribute__((address_space(3))) bf16x8*)(kp+4096); kf[5]=*(const __attribute__((address_space(3))) bf16x8*)(kp+4608);
  kf[6]=*(const __attribute__((address_space(3))) bf16x8*)(kp+6144); kf[7]=*(const __attribute__((address_space(3))) bf16x8*)(kp+6656);
  kf[8]=*(const __attribute__((address_space(3))) bf16x8*)(kp+8192); kf[9]=*(const __attribute__((address_space(3))) bf16x8*)(kp+8704);
}
__device__ __forceinline__ void kload2(bf16x8*kf,lds_cptr kp,int j){ kf[2*j]=*(const __attribute__((address_space(3))) bf16x8*)(kp+j*2048); kf[2*j+1]=*(const __attribute__((address_space(3))) bf16x8*)(kp+j*2048+512); }
__device__ __forceinline__ s16x4 vtr(lds_cptr p){ return __builtin_bit_cast(s16x4,__builtin_amdgcn_ds_read_tr16_b64_v4i16((__attribute__((address_space(3))) v4i16_t*)p)); }
__device__ __forceinline__ float rowmax(const f32x16&p0,const f32x16&p1){
  float a=max3f(p0[0],p0[1],p1[0]),b=max3f(p0[2],p0[3],p1[1]);a=max3f(a,p1[2],p1[3]);
  #pragma unroll
  for(int r=4;r<16;r+=4){a=max3f(a,p0[r],p0[r+1]);b=max3f(b,p0[r+2],p0[r+3]);a=max3f(a,p1[r],p1[r+1]);b=max3f(b,p1[r+2],p1[r+3]);}
  const float m=max2f(a,b);
  auto rr=__builtin_amdgcn_permlane32_swap(__float_as_uint(m),__float_as_uint(m),false,false);
  return max2f(__uint_as_float(rr[0]),__uint_as_float(rr[1]));
}
__device__ __forceinline__ void pv(f32x16*o,int vb,bf16x8 pa0,bf16x8 pa1,bf16x8 pa2,bf16x8 pa3){
  #pragma unroll
  for(int d0=0;d0<2;++d0){s16x4 lo[4],hi[4];
    #pragma unroll
    for(int ks=0;ks<4;++ks){
      asm volatile("ds_read_b64_tr_b16 %0,%1 offset:%c2":"=&v"(lo[ks]):"v"(vb),"i"(d0*4096+ks*1024):"memory");
      asm volatile("ds_read_b64_tr_b16 %0,%1 offset:%c2":"=&v"(hi[ks]):"v"(vb),"i"(d0*4096+ks*1024+512):"memory");}
    asm volatile("s_waitcnt lgkmcnt(0)":::"memory");SBAR();
    #define PK(k) (bf16x8){lo[k][0],lo[k][1],lo[k][2],lo[k][3],hi[k][0],hi[k][1],hi[k][2],hi[k][3]}
    o[d0]=__builtin_amdgcn_mfma_f32_32x32x16_bf16(pa0,PK(0),o[d0],0,0,0);
    o[d0]=__builtin_amdgcn_mfma_f32_32x32x16_bf16(pa1,PK(1),o[d0],0,0,0);
    o[d0]=__builtin_amdgcn_mfma_f32_32x32x16_bf16(pa2,PK(2),o[d0],0,0,0);
    o[d0]=__builtin_amdgcn_mfma_f32_32x32x16_bf16(pa3,PK(3),o[d0],0,0,0);
    #undef PK
  }
}

#ifndef ATTN_STORE16
#define ATTN_STORE16(p,v) (*(u32x4*)(p)=(v))
#endif
__device__ __forceinline__ bf16x8 make_qe(float m,int hi){
  const unsigned um=__float_as_uint(m); unsigned h0=(um+0x7fffu+((um>>16)&1u))&0xffff0000u; const float r1=m-__uint_as_float(h0);
  const unsigned u1=__float_as_uint(r1); unsigned h1=(u1+0x7fffu+((u1>>16)&1u))&0xffff0000u; const float r2=r1-__uint_as_float(h1);
  const unsigned u2=__float_as_uint(r2); unsigned h2=(u2+0x7fffu+((u2>>16)&1u))&0xffff0000u;
  u32x4 w; w.x=0x3f803f80u; w.y=0x3f80u|(h0^0x80000000u); w.z=((h1^0x80000000u)>>16)|(h2^0x80000000u); w.w=0u;
  if(hi){w.x=0u;w.y=0u;w.z=0u;} return __builtin_bit_cast(bf16x8,w); }
template<int THRL> __device__ __forceinline__ void attn_unit(int b,int h,int qb,const bf16*Q,const bf16*__restrict__ K,const bf16*__restrict__ V,bf16*O,const bf16*__restrict__ KE,const float*__restrict__ BETA,float qkmax,char*shm,const int tid){
  const int lane=tid&63,r32=lane&31,hi=lane>>5; const int wid=__builtin_amdgcn_readfirstlane(tid>>6);
  const long rowbase=(long)b*SEQ; const int q0=qb*QB;
  const bf16*Qw=Q+(rowbase+q0+wid*QBLK)*DM+h*D;
  const float*bet=BETA+(long)(b*NHEAD+h)*SEQ; const int NTF=(q0+QB)/KVBLK; int t0;
  { const float thr=bet[q0]-37.f-2.f*qkmax; const int l0=lane,l1=lane+64;
    const bool s0=(l0<NTF-4)&&(bet[64*l0+63]<thr), s1=(l1<NTF-4)&&(bet[64*l1+63]<thr);
    const unsigned long long m0=__ballot(s0), m1=__ballot(s1);
    int n0=(~m0)?__builtin_ctzll(~m0):64; if(n0==64) n0+=(~m1)?__builtin_ctzll(~m1):64;
    t0=__builtin_amdgcn_readfirstlane(n0)&~1; }
  const bf16*Kh=K+(rowbase+(long)t0*KVBLK)*DM+h*D,*Vh=V+(rowbase+(long)t0*KVBLK)*DM+h*D;
  const char*KEh=(const char*)KE+((long)(b*NHEAD+h)*(SEQ/KVBLK)+t0)*2048+wid*256+lane*4;
  const unsigned lds0=(unsigned)(uintptr_t)shm;
  float*wsf=(float*)(shm+LDS_WS)+wid*64;
  const bf16*ksrc=Kh+(long)lane*DM+wid*8;
  const bf16*vsrc=Vh+(long)(16*(wid&3)+(lane>>2))*DM+(wid>>2)*32+(lane&3)*8;
  const unsigned kdst=lds0+LDS_K+wid*1024, vdst=lds0+LDS_V+wid*1024, kedst=lds0+LDS_K+8192+wid*256;
  #define DMA_K(t,slot) do{ glds16(ksrc+(long)(t)*KVBLK*DM,(unsigned)__builtin_amdgcn_readfirstlane(kdst+KOFF(slot))); glds4(KEh+(long)(t)*2048,(unsigned)__builtin_amdgcn_readfirstlane(kedst+KOFF(slot))); }while(0)
  #define DMA_V(t,slot) glds16(vsrc+(long)(t)*KVBLK*DM,(unsigned)__builtin_amdgcn_readfirstlane(vdst+(slot)))
  const int vb0=(int)(lds0+LDS_V)+((lane>>4)&1)*32+(lane&3)*8+(4*hi+((lane&15)>>2))*64;
  const char*Kbase=shm+LDS_K; bf16x8 kf[10];
  const lds_cptr shm3=(lds_cptr)shm; const lds_cptr kp0=shm3+LDS_K+hi*1024+r32*16; const lds_cptr vp0=shm3+LDS_V+((lane>>4)&1)*32+(lane&3)*8+(4*hi+((lane&15)>>2))*64;
  const int NT=NTF-t0;
  DMA_K(0,0);DMA_V(0,0);DMA_K(1,SLOTB);
  bf16x8 qr[4];
  #pragma unroll
  for(int d0=0;d0<4;++d0)qr[d0]=*reinterpret_cast<const bf16x8*>(&Qw[(long)r32*DM+d0*16+hi*8]);
  float mhat=bet[q0+wid*QBLK+r32],l_reg=0.f;f32x16 o[2];o[0]=f32x16{};o[1]=f32x16{}; bf16x8 qe=make_qe(mhat,hi);
  const int qrel=wid*QBLK+r32;
  #define CMASK(P0,P1,t) do{int jb_=(t)-(NT-4); if(jb_>=0)cmask(P0,P1,jb_,qrel,hi);}while(0)
  bool resc=false;
  #define START(P0,P1) do{ resc=false; _Pragma("unroll") for(int r=0;r<16;++r)P0[r]=__builtin_amdgcn_exp2f(P0[r]); }while(0)
  #define RESC() do{ if(resc){ asm volatile("s_waitcnt lgkmcnt(0)":::"memory"); \
      _Pragma("unroll") for(int d_=0;d_<2;++d_) _Pragma("unroll") for(int r=0;r<16;++r)o[d_][r]*=wsf[crow(r,hi)]; } }while(0)
  f32x16 pA0,pA1,pB0,pB1;
  int sl_prev=0,sl_cur=0,sl_next=SLOTB;
  #define ROT() do{sl_prev=sl_cur;sl_cur=sl_next;sl_next=(sl_next==(NSLOT-1)*SLOTB)?0:sl_next+SLOTB;}while(0)
  DMA_K(2,2*SLOTB);
  WAIT_BAR(5);
  qkt(pA0,pA1,Kbase,qr,qe,r32,hi);asm volatile("s_nop 15\n\ts_nop 7":"+v"(pA0),"+v"(pA1));CMASK(pA0,pA1,0);
  START(pA0,pA1);
  _Pragma("unroll") for(int r=0;r<16;++r)pA1[r]=__builtin_amdgcn_exp2f(pA1[r]);
  WAIT_BAR(0);
  DMA_K(3,0);DMA_V(1,SLOTB);
  ROT();
  kload8(kf,kp0+KOFF(sl_cur));
  WAIT_BAR(3);
  s16x4 vlo[8],vhi[8]; u32x4 pw0,pw1,pw2,pw3;
  #define PKW(P,B) cvtpk_s(P[B],P[B+1])
  #define PAF(k) __builtin_bit_cast(bf16x8,pw##k)
  #define VFR(i) (bf16x8){vlo[i][0],vlo[i][1],vlo[i][2],vlo[i][3],vhi[i][0],vhi[i][1],vhi[i][2],vhi[i][3]}
  #define PIN(x) asm volatile("":"+v"(x))
  #define MX3(a,b,c) __builtin_fmaxf(__builtin_fmaxf((a),(b)),(c))
  #define GAPA(MF,A0,A1,A2,A3,W0,W1,PW) do{ MF; sacc+=A0; sacc+=A1; sacc+=A2; sacc+=A3; PIN(sacc); W0; W1; PIN(PW); SBAR(); }while(0)
  #define EX(v) __builtin_amdgcn_exp2f(v)
  #define GAPB(MF,X,B) do{ MF; X[B]=EX(X[B]); X[B+1]=EX(X[B+1]); X[B+2]=EX(X[B+2]); X[B+3]=EX(X[B+3]); PIN(X); SBAR(); }while(0)
  #define VRD(i) do{ vlo[i]=vtr(vp_+(((i)>>2)*4096+((i)&3)*1024)); vhi[i]=vtr(vp_+(((i)>>2)*4096+((i)&3)*1024+512)); }while(0)
  #define KRD(G,j) do{ if(G){ kload2(kf,kp0+KOFF(sl_next),j); SBAR(); } }while(0)
  #define KRDE(G) do{ if(G){ kf[8]=*(const __attribute__((address_space(3))) bf16x8*)(kp0+KOFF(sl_next)+8192); kf[9]=*(const __attribute__((address_space(3))) bf16x8*)(kp0+KOFF(sl_next)+8704); SBAR(); } }while(0)
  #define STEP(C0,C1,P0,P1,t,GK,GV,GL) do{ SBAR(); \
    const lds_cptr vp_=vp0+sl_prev; \
    VRD(0); SBAR(); float sacc=(P0[0]+P0[1]); \
    C0=__builtin_amdgcn_mfma_f32_32x32x16_bf16(kf[8],qe,f32x16{},0,0,0); C1=__builtin_amdgcn_mfma_f32_32x32x16_bf16(kf[9],qe,f32x16{},0,0,0); SBAR(); \
    GAPA(C0=__builtin_amdgcn_mfma_f32_32x32x16_bf16(kf[0],qr[0],C0,0,0,0), P0[2],P0[3],P0[4],P0[5],     pw0[0]=PKW(P0,0), pw0[1]=PKW(P0,2), pw0); \
    VRD(4); SBAR(); GAPA(C1=__builtin_amdgcn_mfma_f32_32x32x16_bf16(kf[1],qr[0],C1,0,0,0), P0[6],P0[7],P0[8],P0[9],     pw0[2]=PKW(P0,4), pw0[3]=PKW(P0,6), pw0); \
    VRD(1); SBAR(); GAPA(C0=__builtin_amdgcn_mfma_f32_32x32x16_bf16(kf[2],qr[1],C0,0,0,0),   P0[10],P0[11],P0[12],P0[13], pw1[0]=PKW(P0,8), pw1[1]=PKW(P0,10), pw1); \
    VRD(5); SBAR(); GAPA(C1=__builtin_amdgcn_mfma_f32_32x32x16_bf16(kf[3],qr[1],C1,0,0,0),   P0[14],P0[15],P1[0],P1[1],   pw1[2]=PKW(P0,12),pw1[3]=PKW(P0,14), pw1); \
    VRD(2); SBAR(); GAPA(C0=__builtin_amdgcn_mfma_f32_32x32x16_bf16(kf[4],qr[2],C0,0,0,0),   P1[2],P1[3],P1[4],P1[5],     pw2[0]=PKW(P1,0), pw2[1]=PKW(P1,2), pw2); \
    VRD(6); SBAR(); GAPA(C1=__builtin_amdgcn_mfma_f32_32x32x16_bf16(kf[5],qr[2],C1,0,0,0),   P1[6],P1[7],P1[8],P1[9],     pw2[2]=PKW(P1,4), pw2[3]=PKW(P1,6), pw2); \
    VRD(3); SBAR(); GAPA(C0=__builtin_amdgcn_mfma_f32_32x32x16_bf16(kf[6],qr[3],C0,0,0,0),   P1[10],P1[11],P1[12],P1[13], pw3[0]=PKW(P1,8), pw3[1]=PKW(P1,10), pw3); \
    VRD(7); SBAR(); GAPA(C1=__builtin_amdgcn_mfma_f32_32x32x16_bf16(kf[7],qr[3],C1,0,0,0),   P1[14],P1[15],0.f,0.f,       pw3[2]=PKW(P1,12),pw3[3]=PKW(P1,14), pw3); \
    l_reg+=sacc; \
    if(GK){DMA_K((t)+3,sl_cur);} if(GV){DMA_V((t)+1,sl_next);} \
    CMASK(C0,C1,t); \
    { float a=MX3(C0[0],C0[1],C1[0]),b=MX3(C0[2],C0[3],C1[1]); a=MX3(a,C1[2],C1[3]); \
      _Pragma("unroll") for(int r=4;r<16;r+=4){a=MX3(a,C0[r],C0[r+1]);b=MX3(b,C0[r+2],C0[r+3]);a=MX3(a,C1[r],C1[r+1]);b=MX3(b,C1[r+2],C1[r+3]);} \
      float rm=__builtin_fmaxf(a,b); { auto rr=__builtin_amdgcn_permlane32_swap(__float_as_uint(rm),__float_as_uint(rm),false,false); rm=__builtin_fmaxf(__uint_as_float(rr[0]),__uint_as_float(rr[1])); } \
      resc=false; \
      if(__builtin_expect(__any(rm>(float)THRL),0)){ const float dl=__builtin_fmaxf(rm,0.f); mhat+=dl; \
        _Pragma("unroll") for(int r=0;r<16;++r){C0[r]-=dl;C1[r]-=dl;} \
        qe=make_qe(mhat,hi); \
        const float f=__builtin_amdgcn_exp2f(-dl); l_reg*=f; if(hi==0)wsf[r32]=f; resc=true; } } \
    SBAR(); \
    GAPB(o[0]=__builtin_amdgcn_mfma_f32_32x32x16_bf16(PAF(0),VFR(0),o[0],0,0,0), C0,0); \
    GAPB(o[1]=__builtin_amdgcn_mfma_f32_32x32x16_bf16(PAF(0),VFR(4),o[1],0,0,0), C0,4); \
    KRD(GL,0); GAPB(o[0]=__builtin_amdgcn_mfma_f32_32x32x16_bf16(PAF(1),VFR(1),o[0],0,0,0), C0,8); \
    KRD(GL,1); GAPB(o[1]=__builtin_amdgcn_mfma_f32_32x32x16_bf16(PAF(1),VFR(5),o[1],0,0,0), C0,12); \
    KRD(GL,2); GAPB(o[0]=__builtin_amdgcn_mfma_f32_32x32x16_bf16(PAF(2),VFR(2),o[0],0,0,0), C1,0); \
    KRD(GL,3); GAPB(o[1]=__builtin_amdgcn_mfma_f32_32x32x16_bf16(PAF(2),VFR(6),o[1],0,0,0), C1,4); \
    KRDE(GL); GAPB(o[0]=__builtin_amdgcn_mfma_f32_32x32x16_bf16(PAF(3),VFR(3),o[0],0,0,0), C1,8); \
    GAPB(o[1]=__builtin_amdgcn_mfma_f32_32x32x16_bf16(PAF(3),VFR(7),o[1],0,0,0), C1,12); \
    }while(0)
  int t=1;
  #undef CMASK
  #define CMASK(P0,P1,t) do{}while(0)
  for(;t+5<NT;t+=2){
    STEP(pB0,pB1,pA0,pA1,t,true,true,true);     WAIT_BAR(3); RESC(); ROT();
    STEP(pA0,pA1,pB0,pB1,t+1,true,true,true);   WAIT_BAR(3); RESC(); ROT();
  }
  #undef CMASK
  #define CMASK(P0,P1,t) do{int jb_=(t)-(NT-4); if(jb_>=0)cmask(P0,P1,jb_,qrel,hi);}while(0)
  #define ENDW(tt) do{ if((tt)+3<NT){WAIT_BAR(3);} else if((tt)+2<NT){WAIT_BAR(1);} else {WAIT_BAR(0);} }while(0)
  for(;t+1<NT;t+=2){
    STEP(pB0,pB1,pA0,pA1,t,(t+3<NT),(t+1<NT),(t+1<NT));       ENDW(t);   RESC(); ROT();
    STEP(pA0,pA1,pB0,pB1,t+1,(t+4<NT),(t+2<NT),(t+2<NT));     ENDW(t+1); RESC(); ROT();
  }
  STEP(pB0,pB1,pA0,pA1,NT-1,false,false,false); RESC();
  { float sacc=pB0[0]+pB0[1]; _Pragma("unroll") for(int r=2;r<16;++r)sacc+=pB0[r]; _Pragma("unroll") for(int r=0;r<16;++r)sacc+=pB1[r]; l_reg+=sacc;
    pw0=(u32x4){PKW(pB0,0),PKW(pB0,2),PKW(pB0,4),PKW(pB0,6)};pw1=(u32x4){PKW(pB0,8),PKW(pB0,10),PKW(pB0,12),PKW(pB0,14)};pw2=(u32x4){PKW(pB1,0),PKW(pB1,2),PKW(pB1,4),PKW(pB1,6)};pw3=(u32x4){PKW(pB1,8),PKW(pB1,10),PKW(pB1,12),PKW(pB1,14)};
    SBAR(); pv(o,vb0+sl_cur,PAF(0),PAF(1),PAF(2),PAF(3)); }
  #undef PKW
  #undef PAF
  #undef VFR
  #undef PIN
  #undef MX3
  #undef GAPA
  #undef GAPB
  #undef EX
  #undef VRD
  #undef KRD
  #undef KRDE
  #undef STEP
  #undef ENDW
  {auto rr=__builtin_amdgcn_permlane32_swap(__float_as_uint(l_reg),__float_as_uint(l_reg),false,false);l_reg=__uint_as_float(rr[0])+__uint_as_float(rr[1]);}
  if(hi==0)wsf[32+r32]=l_reg;asm volatile("s_waitcnt lgkmcnt(0)":::"memory");
  float rli[16];
  #pragma unroll
  for(int r=0;r<16;++r)rli[r]=__builtin_amdgcn_rcpf(wsf[32+crow(r,hi)]);
  int lane_e=lane; asm volatile("":"+v"(lane_e));
  const int r32e=lane_e&31,hie=lane_e>>5;
  unsigned char*Ow=(unsigned char*)O+((rowbase+q0+wid*QBLK)*DM+h*D);
  { unsigned char*stg=(unsigned char*)(shm+LDS_OST)+wid*4096;
    #pragma unroll
    for(int r=0;r<16;++r){const int orow=crow(r,hie); const float sc32=32.f*rli[r];
      #pragma unroll
      for(int d0=0;d0<2;++d0)stg[orow*64+d0*32+r32e]=(unsigned char)__builtin_amdgcn_cvt_pk_fp8_f32(o[d0][r]*sc32,0.f,0,false);}
    asm volatile("s_waitcnt lgkmcnt(0)":::"memory");
    typedef unsigned u32x2_t __attribute__((ext_vector_type(2)));
    #pragma unroll
    for(int i=0;i<4;++i){const int row=i*8+(lane_e>>3),ch=lane_e&7; const u32x2_t v=*(const u32x2_t*)(stg+row*64+ch*8); *(u32x2_t*)(Ow+(long)row*DM+ch*8)=v;} }
  asm volatile("s_waitcnt lgkmcnt(0)\n\ts_barrier":::"memory");
  #undef DMA_K
  #undef DMA_V
  #undef CMASK
  #undef START
  #undef RESC
  #undef ROT
}
constexpr int ATTN_LDS_BYTES=LDS_BYTES;
struct AttnTensors { const bf16* Q; const bf16* K; const bf16* V; bf16* O; };
struct AttnUnit { int bh; int qb; };
struct StaticOrder {
  int vcu;
  __device__ __forceinline__ explicit StaticOrder(int grid,int block):vcu((block%8)*(grid/8)+block/8){}
  __device__ __forceinline__ bool next(int i,AttnUnit&u)const{ if(i>=4)return false; const int s=vcu&7; u.bh=vcu>>3; u.qb=(i==0)?s:(i==1)?15-s:(i==2)?16+s:31-s; return true; }
  __device__ __forceinline__ void a_ready(const AttnUnit&)const{}
  __device__ __forceinline__ void done(const AttnUnit&)const{}
};
template<class Sched,int THRL=8> __device__ __forceinline__ void attn_phase(char*lds,const AttnTensors&T,const Sched&S){
  AttnUnit u;
  for(int i=0;S.next(i,u);++i){ S.a_ready(u); attn_unit<THRL>(u.bh/NHEAD,u.bh%NHEAD,u.qb,T.Q,T.K,T.V,T.O,lds); S.done(u); }
}
#undef SBAR
#undef WAIT_BAR
}

#ifndef MK_DUP
#define MK_DUP 0
#endif
constexpr int NWAVES = 8, NTHREADS = 512;
constexpr int BATCH = 2, T = 8192, D = 1024, H = 16, HD = 64, FF = 2816, FF2 = 5632;
constexpr int M = BATCH * T;
constexpr int FOX_IN = 3088, DSA_IN = 2120;
constexpr float EPS = 1e-6f;
constexpr float LOG2E = 1.4426950408889634f;

constexpr size_t MiB = 1u << 20;
constexpr size_t WS_CTL = 0, CTL_ZERO_BYTES = 32 * 1024;
constexpr size_t WS_MOD = 1 * MiB;
constexpr size_t WS_XS = 2 * MiB;
constexpr int CW_NS = 1024;
constexpr size_t WS_WUP0 = 8 * MiB, WS_WUP1 = 19 * MiB;
constexpr size_t WS_WDN0 = 30 * MiB, WS_WDN1 = 35 * MiB + 512 * 1024;
constexpr size_t WS_WDIN = 41 * MiB;
constexpr size_t WS_WDTAIL = 45 * MiB;
constexpr size_t WS_WDOUT = 45 * MiB + 512 * 1024;
constexpr size_t WS_H = 48 * MiB;
constexpr size_t WS_R = 80 * MiB;
constexpr size_t WS_WFIN = WS_R, WS_WFOUT = WS_R + 6 * MiB;
constexpr size_t WS_Q = WS_R + 8 * MiB, WS_K = WS_R + 40 * MiB, WS_V = WS_R + 72 * MiB;
constexpr size_t WS_LOGF = WS_R + 104 * MiB;
constexpr size_t WS_BETA = WS_R + 105 * MiB;
constexpr size_t WS_KE = WS_R + 106 * MiB;
constexpr size_t WS_O = WS_R + 114 * MiB;
constexpr size_t WS_XB = WS_R + 144 * MiB;
constexpr size_t WS_U = WS_R;
constexpr size_t WS_SA0 = WS_R + 96 * MiB, WS_SG0 = WS_R + 98 * MiB, WS_SA1 = WS_R + 100 * MiB;
constexpr size_t WS_Q1 = WS_R, WS_K1 = WS_R + 32 * MiB, WS_V1 = WS_R + 40 * MiB;
constexpr size_t WS_QI = WS_R + 48 * MiB;
constexpr size_t WS_KI = WS_R + 64 * MiB;
constexpr size_t WS_WI = WS_R + 66 * MiB;
constexpr size_t WS_H8 = WS_R + 84 * MiB;
constexpr size_t WS_O1 = WS_R + 67 * MiB;
constexpr size_t WS_END = 256 * MiB;
static_assert(WS_U + (size_t)M * FF * 2 <= WS_SA0 && WS_SA1 + 2 * MiB <= WS_END, "d_ws map");
constexpr int CW_BAR = 4096;
static_assert((CW_BAR + 3456) * 4 <= 32 * 1024, "control words inside the per-call memset");
constexpr int CW_AQ = 256;
constexpr int CW_DQ = 512;

constexpr int RING_OFF = 0, RING_BYTES = 131072;
constexpr int LDSCTL_OFF = RING_BYTES, MISC_OFF = LDSCTL_OFF + 320;
constexpr int HALO_OFF = 131584;
constexpr int LDS_BYTES = 147456;

#define GAS __attribute__((address_space(1)))
#define LAS __attribute__((address_space(3)))
typedef unsigned short bf16;
typedef unsigned v4u __attribute__((ext_vector_type(4)));
typedef unsigned v2u __attribute__((ext_vector_type(2)));
typedef float f32x4 __attribute__((ext_vector_type(4)));
typedef short bf16x8 __attribute__((ext_vector_type(8)));
typedef GAS unsigned gu32;
#define RLX_AGENT __ATOMIC_RELAXED, __HIP_MEMORY_SCOPE_AGENT
#define LDS_WAIT() asm volatile("s_waitcnt lgkmcnt(0)" ::: "memory")
#define VM_WAIT() asm volatile("s_waitcnt vmcnt(0)" ::: "memory")
__device__ __forceinline__ unsigned f2bf(float f) { unsigned u = __builtin_bit_cast(unsigned, f); return (u + 0x7fffu + ((u >> 16) & 1u)) >> 16; }
__device__ __forceinline__ unsigned pk2(float lo, float hi) { return f2bf(lo) | (f2bf(hi) << 16); }
__device__ __forceinline__ float bf2f(unsigned b) { return __builtin_bit_cast(float, b << 16); }
#define XB_TMO      128
#define XB_XCNT(j)  (256  + 64 * (j))
#define XB_XSUB(j)  (1280 + 64 * (j))
#define XB_XGEN(j)  (2304 + 64 * (j))
#define XB_TOP      3328
#define XB_TOPGEN   3392
#define XCD_BAR_WORDS 3456
#define XB_SPIN_CAP (1u << 18)

__device__ __forceinline__ unsigned xb_ld(unsigned* p)              { return __hip_atomic_load(p, __ATOMIC_RELAXED, __HIP_MEMORY_SCOPE_AGENT); }
__device__ __forceinline__ unsigned xb_add(unsigned* p, unsigned v) { return __hip_atomic_fetch_add(p, v, __ATOMIC_RELAXED, __HIP_MEMORY_SCOPE_AGENT); }
__device__ __forceinline__ unsigned xb_xcc_id() { return (unsigned)__builtin_amdgcn_s_getreg((3 << 11) | 20) & 0xFu; }
#define XB_SPIN(cond, bar) do { unsigned _sp = 0; while (cond) { __builtin_amdgcn_s_sleep(1); \
    if ((++_sp & 255u) == 0u) { if (xb_ld(&(bar)[XB_TMO])) break; if (_sp > XB_SPIN_CAP) { atomicAdd(&(bar)[XB_TMO], 1u); break; } } } } while (0)

struct XcdBarrier {
    unsigned* bar; unsigned x;
    volatile LAS unsigned* st;
};

__device__ __forceinline__ XcdBarrier xcd_barrier_post(unsigned* bar, volatile LAS unsigned* st) {
    XcdBarrier b; b.bar = bar; b.x = xb_xcc_id(); b.st = st;
    if (threadIdx.x == 0) (void)xb_add(&bar[XB_XCNT(b.x)], 1u);
    return b;
}
__device__ __forceinline__ void xcd_barrier_complete(unsigned* bar, unsigned x, unsigned& nloc, unsigned& nx) {
    const unsigned G = gridDim.x * gridDim.y * gridDim.z;
    unsigned sum, cnt, mine, sp = 0u;
    for (;;) {
        sum = 0u; cnt = 0u; mine = 0u;
#pragma unroll
        for (unsigned j = 0; j < 16; ++j) { const unsigned c = xb_ld(&bar[XB_XCNT(j)]); sum += c; cnt += (c > 0u) ? 1u : 0u; mine = (j == x) ? c : mine; }
        if (sum == G) break;
        __builtin_amdgcn_s_sleep(1);
        if ((++sp & 255u) == 0u) { if (xb_ld(&bar[XB_TMO])) break; if (sp > XB_SPIN_CAP) { atomicAdd(&bar[XB_TMO], 1u); break; } }
    }
    nloc = mine > 0u ? mine : 1u; nx = cnt > 0u ? cnt : 1u;
}

__device__ __forceinline__ void xcd_barrier(const XcdBarrier& b) {
    asm volatile("s_waitcnt vmcnt(0)" ::: "memory");
    __syncthreads();
    if (threadIdx.x == 0) {
        unsigned* bar = b.bar;
        __builtin_amdgcn_s_waitcnt(0);
        unsigned nloc = b.st[0], nx = b.st[1];
        if (nloc == 0u) { xcd_barrier_complete(bar, b.x, nloc, nx); b.st[0] = nloc; b.st[1] = nx; }
        const unsigned old = xb_add(&bar[XB_XSUB(b.x)], 1u);
        const unsigned gen = old / nloc;
        if (old + 1u == (gen + 1u) * nloc) {
            __builtin_amdgcn_fence(__ATOMIC_RELEASE, "agent");
            asm volatile("s_waitcnt vmcnt(0)" ::: "memory");
            const unsigned og = xb_add(&bar[XB_TOP], 1u);
            const unsigned tg = og / nx;
            if (og + 1u == (tg + 1u) * nx) xb_add(&bar[XB_TOPGEN], 1u);
            else XB_SPIN(xb_ld(&bar[XB_TOPGEN]) == tg, bar);
            __builtin_amdgcn_fence(__ATOMIC_ACQUIRE, "agent");
            xb_add(&bar[XB_XGEN(b.x)], 1u);
            asm volatile("s_waitcnt vmcnt(0)" ::: "memory");
        } else {
            XB_SPIN(xb_ld(&bar[XB_XGEN(b.x)]) == gen, bar);
            __builtin_amdgcn_fence(__ATOMIC_ACQUIRE, "agent");
            asm volatile("s_waitcnt vmcnt(0)" ::: "memory");
        }
    }
    __syncthreads();
}

__device__ __forceinline__ float wave_sum(float v) {
    v += dppf<0xB1>(v); v += dppf<0x4E>(v); v += dppf<0x141>(v); v += dppf<0x140>(v);
    return xsum32(xsum16(v));
}
__device__ __forceinline__ float wave_max(float v) {
    v = fmaxf(v, dppf<0xB1>(v)); v = fmaxf(v, dppf<0x4E>(v)); v = fmaxf(v, dppf<0x141>(v)); v = fmaxf(v, dppf<0x140>(v));
    return xmax32(xmax16(v));
}
template <int F8S>
__device__ __forceinline__ void p0_transpose_item(const float* W, int ldw, int K, bf16* WT, int k0, int n0, int drow, LAS float* scr, int lane) {
#pragma unroll 8
    for (int i = 0; i < 32; ++i) { const int kk = 2 * i + (lane >> 5); scr[kk * 33 + (lane & 31)] = W[(size_t)(k0 + kk) * ldw + n0 + (lane & 31)]; }
    LDS_WAIT(); asm volatile("" ::: "memory");
    const int c = lane & 7;
#pragma unroll
    for (int j = 0; j < 4; ++j) { const int n = (lane >> 3) + 8 * j; const LAS float* s = scr + (8 * c) * 33 + n;
        if (F8S) { const float sc8 = (float)(1 << F8S); int w0 = 0, w1 = 0;
            w0 = __builtin_amdgcn_cvt_pk_fp8_f32(s[0 * 33] * sc8, s[1 * 33] * sc8, w0, false); w0 = __builtin_amdgcn_cvt_pk_fp8_f32(s[2 * 33] * sc8, s[3 * 33] * sc8, w0, true);
            w1 = __builtin_amdgcn_cvt_pk_fp8_f32(s[4 * 33] * sc8, s[5 * 33] * sc8, w1, false); w1 = __builtin_amdgcn_cvt_pk_fp8_f32(s[6 * 33] * sc8, s[7 * 33] * sc8, w1, true);
            *(GAS v2u*)((unsigned char*)WT + (size_t)(drow + n) * K + k0 + 8 * c) = (v2u){(unsigned)w0, (unsigned)w1}; }
        else { v4u o; o.x = pk2(s[0 * 33], s[1 * 33]); o.y = pk2(s[2 * 33], s[3 * 33]); o.z = pk2(s[4 * 33], s[5 * 33]); o.w = pk2(s[6 * 33], s[7 * 33]);
        *(GAS v4u*)(WT + (size_t)(drow + n) * K + k0 + 8 * c) = o; } }
    LDS_WAIT(); asm volatile("" ::: "memory");
}
template <int HP, int F8S = 0>
__device__ __forceinline__ void p0_matrix(const float* W, int ldw, int K, int ncols, bf16* WT, LAS float* scr, int lane, int gw, int NGW, int& base) {
    const int nblk = ncols / 32, items = (K / 64) * nblk;
    int first = gw - (base % NGW); if (first < 0) first += NGW;
    for (int r = first; r < items; r += NGW) {
        const int kb = r / nblk, nb = r % nblk, n0 = 32 * nb;
        int drow = n0;
        if (HP == 1) { const int tile = n0 >> 8, nl = n0 & 255, wc = nl >> 6, bj = (nl >> 5) & 1; drow = tile * 256 + 128 * bj + 32 * wc; }
        if (HP == 2) { const int isg = n0 >= FF, j = isg ? n0 - FF : n0; drow = (j >> 7) * 256 + (isg ? 128 : 0) + (j & 127); }
        p0_transpose_item<F8S>(W, ldw, K, WT, 64 * kb, n0, drow, scr, lane);
    }
    base += items;
}

struct Ptrs {
    const float *x, *c, *w_ada, *b_ada, *g_mix, *g_ffn, *fox_w_in, *fox_b_f, *fox_g_q, *fox_g_k, *fox_w_out,
                *dsa_w_in, *dsa_g_q, *dsa_g_k, *dsa_g_kidx, *dsa_w_out, *ffn_w_up, *ffn_conv_w, *ffn_conv_b, *ffn_w_down;
    float* out; unsigned char* ws;
};

__device__ __forceinline__ void p0_prologue(const Ptrs& P, LAS unsigned char* lds, int tid, int lane, int wave, int vcu, int G) {
    unsigned char* ws = P.ws;
    LAS float* scr = (LAS float*)(lds + RING_OFF + wave * 16384);
    const int gw = vcu * NWAVES + wave, NGW = G * NWAVES;
    int base = 0;
    p0_matrix<1, 5>(P.fox_w_in, FOX_IN, D, 3 * D, (bf16*)(ws + WS_WFIN), scr, lane, gw, NGW, base);
    p0_matrix<0, 5>(P.fox_w_out, D, D, D, (bf16*)(ws + WS_WFOUT), scr, lane, gw, NGW, base);
    p0_matrix<2, 5>(P.ffn_w_up, FF2, D, FF2, (bf16*)(ws + WS_WUP0), scr, lane, gw, NGW, base);
    p0_matrix<0, 6>(P.ffn_w_down, D, FF, D, (bf16*)(ws + WS_WDN0), scr, lane, gw, NGW, base);
    p0_matrix<1, 5>(P.dsa_w_in, DSA_IN, D, 3 * D / 2, (bf16*)(ws + WS_WDIN), scr, lane, gw, NGW, base);
    p0_matrix<1>(P.dsa_w_in + 3 * D / 2, DSA_IN, D, D / 2, (bf16*)(ws + WS_WDIN + 2 * MiB), scr, lane, gw, NGW, base);
    p0_matrix<0, 5>(P.dsa_w_out, D, D, D, (bf16*)(ws + WS_WDOUT), scr, lane, gw, NGW, base);
    p0_matrix<2, 5>(P.ffn_w_up + (size_t)D * FF2, FF2, D, FF2, (bf16*)(ws + WS_WUP1), scr, lane, gw, NGW, base);
    p0_matrix<0, 6>(P.ffn_w_down + (size_t)FF * D, D, FF, D, (bf16*)(ws + WS_WDN1), scr, lane, gw, NGW, base);
    { bf16* wt = (bf16*)(ws + WS_WDTAIL); const int gt = vcu * NTHREADS + tid, NT_ = G * NTHREADS;
      for (int i = gt; i < 80 * D; i += NT_) { const int n = i / D, k = i % D; wt[i] = (n < 72) ? (bf16)f2bf(P.dsa_w_in[(size_t)k * DSA_IN + 2048 + n]) : (bf16)0; } }
    __syncthreads();
    { LAS float* cact = (LAS float*)(lds + RING_OFF);
      LAS float* part = (LAS float*)(lds + RING_OFF + 8192);
      for (int i = tid; i < 2 * D; i += NTHREADS) { const float v = P.c[i]; cact[i] = v / (1.f + __expf(-v)); }
      __syncthreads();
      float* MOD = (float*)(ws + WS_MOD);
      for (int task = vcu; task < 2 * 96; task += G) {
          const int layer = task / 96, cg = task % 96, col = cg * 64 + lane;
          const float* w = P.w_ada + (size_t)layer * D * 6144 + col;
          float a0 = 0.f, a1 = 0.f;
#pragma unroll 32
          for (int k = wave * 128; k < wave * 128 + 128; ++k) { const float wv = w[(size_t)k * 6144]; a0 += cact[k] * wv; a1 += cact[D + k] * wv; }
          part[(wave * 2 + 0) * 64 + lane] = a0; part[(wave * 2 + 1) * 64 + lane] = a1;
          __syncthreads();
          if (wave < 2) { float s = 0.f;
#pragma unroll
              for (int w8 = 0; w8 < 8; ++w8) s += part[(w8 * 2 + wave) * 64 + lane];
              MOD[((size_t)layer * 2 + wave) * 6144 + col] = s + P.b_ada[layer * 6144 + col]; }
          __syncthreads();
      } }
}

template <bool FGATE, bool XIN16, int OUT8 = 0>
__device__ __forceinline__ void norm_phase(const void* xin, const float* gnorm, const float* modL, int sh_chunk, int sc_chunk, bf16* hout, unsigned char* hout8,
                                           const float* fox_w_in, const float* b_f, float* logf, LAS unsigned char* lds, int tid, int lane, int wave, int vcu, int G) {
    LAS float* wft = (LAS float*)(lds + RING_OFF);
    if (FGATE) {
        for (int i = tid; i < 16 * D; i += NTHREADS) { const int c = i >> 4, hh = i & 15; wft[hh * D + c] = fox_w_in[(size_t)c * FOX_IN + 3 * D + hh]; }
        __syncthreads();
    }
    const int gw = vcu * NWAVES + wave, NGW = G * NWAVES;
    for (int b = 0; b < BATCH; ++b) {
        f32x4 Gv[4], Sv[4];
#pragma unroll
        for (int j = 0; j < 4; ++j) { const int c = 4 * lane + 256 * j;
            const f32x4 g4 = *(const f32x4*)(gnorm + c), sc4 = *(const f32x4*)(modL + (size_t)b * 6144 + sc_chunk * D + c);
            Gv[j] = g4 * (sc4 + 1.0f); Sv[j] = *(const f32x4*)(modL + (size_t)b * 6144 + sh_chunk * D + c); }
        for (int t = gw; t < T; t += NGW) {
            const size_t m = (size_t)b * T + t;
            f32x4 v[4]; float ss = 0.f;
            if (XIN16) { const GAS v2u* xr = (const GAS v2u*)((const bf16*)xin + m * D) + lane;
#pragma unroll
                for (int j = 0; j < 4; ++j) { const v2u r = xr[64 * j]; v[j] = (f32x4){__uint_as_float(r.x << 16), __uint_as_float(r.x & 0xffff0000u), __uint_as_float(r.y << 16), __uint_as_float(r.y & 0xffff0000u)}; }
            } else { const GAS f32x4* xr = (const GAS f32x4*)((const float*)xin + m * D) + lane;
#pragma unroll
                for (int j = 0; j < 4; ++j) v[j] = xr[64 * j]; }
#pragma unroll
            for (int j = 0; j < 4; ++j) ss += (v[j].x * v[j].x + v[j].y * v[j].y) + (v[j].z * v[j].z + v[j].w * v[j].w);
            const float rstd = __builtin_amdgcn_rsqf(wave_sum(ss) * (1.f / D) + EPS);
            GAS unsigned long long* o8 = (GAS unsigned long long*)(hout + m * D) + lane;
#pragma unroll
            for (int j = 0; j < 4; ++j) { v[j] = v[j] * rstd * Gv[j] + Sv[j];
                if (OUT8) { int w8 = 0; w8 = __builtin_amdgcn_cvt_pk_fp8_f32(v[j].x, v[j].y, w8, false); w8 = __builtin_amdgcn_cvt_pk_fp8_f32(v[j].z, v[j].w, w8, true);
                    ((GAS unsigned*)(hout8 + m * D))[lane + 64 * j] = (unsigned)w8; }
                if (OUT8 != 1) o8[64 * j] = (unsigned long long)pk2(v[j].x, v[j].y) | ((unsigned long long)pk2(v[j].z, v[j].w) << 32); }
            if (FGATE) {
                float acc[16];
                typedef float f32x2 __attribute__((ext_vector_type(2)));
#pragma unroll
                for (int hh = 0; hh < 16; ++hh) { f32x2 a2 = (f32x2){0.f, 0.f};
#pragma unroll
                    for (int j = 0; j < 4; ++j) { const f32x4 w4 = *(const LAS f32x4*)(wft + hh * D + 256 * j + 4 * lane);
                        a2 = (f32x2){v[j].x, v[j].y} * (f32x2){w4.x, w4.y} + a2; a2 = (f32x2){v[j].z, v[j].w} * (f32x2){w4.z, w4.w} + a2; }
                    acc[hh] = a2.x + a2.y; if ((hh & 3) == 3) asm volatile("" : "+v"(acc[hh]) :: "memory"); }
                float b8[8], c4[4];
#pragma unroll
                for (int i = 0; i < 8; ++i) { const auto rr = __builtin_amdgcn_permlane32_swap(__builtin_bit_cast(unsigned, acc[i]), __builtin_bit_cast(unsigned, acc[i + 8]), false, false); const unsigned r0 = rr[0], r1 = rr[1];
                    b8[i] = __builtin_bit_cast(float, r0) + __builtin_bit_cast(float, r1); }
#pragma unroll
                for (int i = 0; i < 4; ++i) { const auto rr = __builtin_amdgcn_permlane16_swap(__builtin_bit_cast(unsigned, b8[i]), __builtin_bit_cast(unsigned, b8[i + 4]), false, false); const unsigned r0 = rr[0], r1 = rr[1];
                    c4[i] = __builtin_bit_cast(float, r0) + __builtin_bit_cast(float, r1); }
#pragma unroll
                for (int i = 0; i < 4; ++i) { float t = c4[i]; t += dppf<0xB1>(t); t += dppf<0x4E>(t); t += dppf<0x141>(t); t += dppf<0x140>(t); c4[i] = t; }
                const int j4 = lane & 15; float r = c4[0]; r = (j4 == 1) ? c4[1] : r; r = (j4 == 2) ? c4[2] : r; r = (j4 == 3) ? c4[3] : r;
                const int row16 = lane >> 4, head = (row16 >> 1) * 8 + (row16 & 1) * 4 + j4;
                if (j4 < 4) { const float z = r + b_f[head]; logf[m * 16 + head] = fminf(z, 0.f) - log1pf(__expf(-fabsf(z))); }
            }
        }
    }
    if (FGATE) __syncthreads();
}

__device__ __forceinline__ void fox_scan(const float* logf, float* BETA, unsigned char* KE, int seq, LAS float* red  , int tid, int lane, int wave) {
    const int b = seq >> 4, hh = seq & 15;
    float v[16]; float run = 0.f;
#pragma unroll
    for (int k = 0; k < 16; ++k) { run += logf[((size_t)b * T + 16 * tid + k) * 16 + hh]; v[k] = run; }
    float inc = run;
#pragma unroll
    for (int o = 1; o < 64; o <<= 1) { const float n = __shfl_up(inc, o); if (lane >= o) inc += n; }
    if (lane == 63) red[wave] = inc;
    __syncthreads();
    float pre = inc - run;
#pragma unroll
    for (int w8 = 0; w8 < 8; ++w8) if (w8 < wave) pre += red[w8];
#pragma unroll
    for (int k = 0; k < 16; ++k) {
        const int t = 16 * tid + k; const float be = -(pre + v[k]) * LOG2E;
        BETA[(size_t)seq * T + t] = be;
        const unsigned h0 = f2bf(be); const float r1 = be - bf2f(h0); const unsigned h1 = f2bf(r1); const float r2 = r1 - bf2f(h1); const unsigned h2 = f2bf(r2);
        unsigned char* tile = KE + ((size_t)seq * (T / 64) + (t >> 6)) * 2048 + (t & 63) * 16;
        v4u e; e.x = h0 | (h1 << 16); e.y = h2 | 0x3f800000u; e.z = 0x3f803f80u; e.w = 0u;
        *(GAS v4u*)tile = e; *(GAS v4u*)(tile + 1024) = (v4u){0u, 0u, 0u, 0u};
    }
    __syncthreads();
}

__device__ __forceinline__ void conv_fixup(bf16* U, const float* sideA0, const float* sideG0, const float* sideA1, const float* cw, const float* cb, int pm, int tid) {
    const bool bstart = (pm % (T / 256)) == 0;
    for (int i = tid; i < 2 * (FF / 4); i += NTHREADS) {
        const int r = i / (FF / 4), c = (i % (FF / 4)) * 4;
        const f32x4 a0 = *(const f32x4*)(sideA0 + ((size_t)pm * 2 + r) * FF + c), g0 = *(const f32x4*)(sideG0 + ((size_t)pm * 2 + r) * FF + c);
        const f32x4 z = (f32x4){0.f, 0.f, 0.f, 0.f};
        f32x4 m1, m2;
        if (r == 1) { m1 = *(const f32x4*)(sideA0 + ((size_t)pm * 2) * FF + c); m2 = bstart ? z : *(const f32x4*)(sideA1 + ((size_t)(pm - 1) * 2 + 1) * FF + c); }
        else { m1 = bstart ? z : *(const f32x4*)(sideA1 + ((size_t)(pm - 1) * 2 + 1) * FF + c); m2 = bstart ? z : *(const f32x4*)(sideA1 + ((size_t)(pm - 1) * 2) * FF + c); }
        const f32x4 w0 = *(const f32x4*)(cw + c), w1 = *(const f32x4*)(cw + FF + c), w2 = *(const f32x4*)(cw + 2 * FF + c), bb = *(const f32x4*)(cb + c);
        float uo[4];
#pragma unroll
        for (int e = 0; e < 4; ++e) { const float s = fmaf(w0[e], m2[e], fmaf(w1[e], m1[e], fmaf(w2[e], a0[e], bb[e]))); uo[e] = s * __builtin_amdgcn_rcpf(1.f + __builtin_amdgcn_exp2f(-LOG2E * s)) * g0[e]; }
        { int w8 = 0; w8 = __builtin_amdgcn_cvt_pk_fp8_f32(uo[0], uo[1], w8, false); w8 = __builtin_amdgcn_cvt_pk_fp8_f32(uo[2], uo[3], w8, true);
          *(GAS unsigned*)((unsigned char*)U + ((size_t)pm * 256 + r) * FF + c) = (unsigned)w8; }
    }
    asm volatile("s_waitcnt vmcnt(0)" ::: "memory");
    __syncthreads();
}
namespace dsa {
typedef float f32x16 __attribute__((ext_vector_type(16)));
typedef unsigned long long u64;
constexpr int QT = 16;
constexpr int TOPK = 256;
constexpr int HIST_OFF = 0;
constexpr int SEL_OFF = 135168;
constexpr int ST_OFF = 143360;
constexpr int CAP = 1024;
constexpr float WSCALE = 0.04419417382415922f;

__device__ __forceinline__ void tail_phase(const bf16* Hb, const bf16* WT, const float* g_kidx, bf16* KI, float* WI, int lane, int gw, int NGW) {
    const int n16 = lane & 15, q4 = lane >> 4;
    for (int task = gw; task < M / 16; task += NGW) {
        const int row0 = task * 16;
        f32x4 acc[5];
#pragma unroll
        for (int cb = 0; cb < 5; ++cb) acc[cb] = (f32x4){0.f, 0.f, 0.f, 0.f};
        const bf16* ap = Hb + (size_t)(row0 + n16) * D + 8 * q4;
        const bf16* bp = WT + (size_t)n16 * D + 8 * q4;
#pragma unroll 4
        for (int s = 0; s < 32; ++s) {
            const bf16x8 a = *(const GAS bf16x8*)(ap + 32 * s);
#pragma unroll
            for (int cb = 0; cb < 5; ++cb) { const bf16x8 b = *(const GAS bf16x8*)(bp + (size_t)cb * 16 * D + 32 * s); acc[cb] = __builtin_amdgcn_mfma_f32_16x16x32_bf16(a, b, acc[cb], 0, 0, 0); }
        }
        float gk[4];
#pragma unroll
        for (int cb = 0; cb < 4; ++cb) gk[cb] = g_kidx[16 * cb + n16];
#pragma unroll
        for (int i = 0; i < 4; ++i) {
            const int tok = row0 + 4 * q4 + i;
            float ss = (acc[0][i] * acc[0][i] + acc[1][i] * acc[1][i]) + (acc[2][i] * acc[2][i] + acc[3][i] * acc[3][i]);
            ss += __shfl_xor(ss, 1); ss += __shfl_xor(ss, 2); ss += __shfl_xor(ss, 4); ss += __shfl_xor(ss, 8);
            const float rs = __builtin_amdgcn_rsqf(ss * (1.f / 64.f) + EPS);
#pragma unroll
            for (int cb = 0; cb < 4; ++cb) KI[(size_t)tok * 64 + 16 * cb + n16] = (bf16)f2bf(acc[cb][i] * rs * gk[cb]);
            if (n16 < 8) WI[(size_t)tok * 8 + n16] = acc[4][i] * WSCALE;
        }
    }
}

__device__ __forceinline__ v4u f8x8_to_bf16(unsigned a, unsigned b) {
    typedef float f32x2 __attribute__((ext_vector_type(2)));
    const f32x2 a0 = __builtin_amdgcn_cvt_pk_f32_fp8((int)a, false), a1 = __builtin_amdgcn_cvt_pk_f32_fp8((int)a, true), b0 = __builtin_amdgcn_cvt_pk_f32_fp8((int)b, false), b1 = __builtin_amdgcn_cvt_pk_f32_fp8((int)b, true);
    v4u r; r.x = __builtin_amdgcn_perm(__float_as_uint(a0.y), __float_as_uint(a0.x), 0x07060302u); r.y = __builtin_amdgcn_perm(__float_as_uint(a1.y), __float_as_uint(a1.x), 0x07060302u);
    r.z = __builtin_amdgcn_perm(__float_as_uint(b0.y), __float_as_uint(b0.x), 0x07060302u); r.w = __builtin_amdgcn_perm(__float_as_uint(b1.y), __float_as_uint(b1.x), 0x07060302u); return r;
}
__device__ __forceinline__ u64 make_key(float s, int kidx) {
    const unsigned u = __float_as_uint(s); const unsigned sk = u ^ ((unsigned)((int)u >> 31) | 0x80000000u);
    return ((u64)sk << 13) | (u64)(8191 - kidx);
}
__device__ __forceinline__ float relu_i(float x) { const int b = __float_as_int(x); return __int_as_float(b > 0 ? b : 0); }
__device__ __forceinline__ unsigned skey32(float s) { const unsigned u = __float_as_uint(s); return u ^ ((unsigned)((int)u >> 31) | 0x80000000u); }
template <int MODE, bool L0, int PROBE, bool ALLV, int SMUL>
__device__ __forceinline__ void idx_loop(const bf16x8 (&qa)[4][4], const bf16* KIb, int t0q, int nst, int st_begin, int st_end, int key_l, int hi, LAS unsigned char* lds, const u64 (&Pq)[4][2], unsigned hbase,
                                         bf16x8 (&kb)[4], bf16x8 (&kn)[4], f32x16& acc, int level, int hi_shift, int lo_shift, unsigned mask) {
    for (int st_ = st_begin; st_ < st_end; st_ += 8) {
        const int kidx = 32 * SMUL * st_ + key_l;
        unsigned sks[4][2];
        constexpr bool allvalid = ALLV;
#pragma unroll
        for (int rb = 0; rb < 4; ++rb) {
            f32x16 accN = f32x16{};
            if (rb < 3) {
#pragma unroll
                for (int ks = 0; ks < 4; ++ks) accN = __builtin_amdgcn_mfma_f32_32x32x16_bf16(qa[rb + 1][ks], kb[ks], accN, 0, 0, 0);
            } else {
#pragma unroll
                for (int ks = 0; ks < 4; ++ks) kb[ks] = kn[ks];
                { const int kx = (st_ + 16 < nst) ? kidx + 512 * SMUL : kidx;
#pragma unroll
                  for (int ks = 0; ks < 4; ++ks) kn[ks] = *(const GAS bf16x8*)(KIb + (size_t)(PROBE == 2 ? key_l : kx) * 64 + 16 * ks + 8 * hi); }
#pragma unroll
                for (int ks = 0; ks < 4; ++ks) accN = __builtin_amdgcn_mfma_f32_32x32x16_bf16(qa[0][ks], kb[ks], accN, 0, 0, 0);
            }
            __builtin_amdgcn_sched_barrier(0);
            float sc[2];
            { LAS const f32x4* wp = (LAS const f32x4*)(lds + ST_OFF + 1024 + (4 * rb + 2 * hi) * 32);
              const f32x4 w0 = wp[0], w1 = wp[1], w2 = wp[2], w3 = wp[3];
              float s0 = relu_i(acc[0]) * w0[0];
#pragma unroll
              for (int i = 1; i < 4; ++i) s0 = fmaf(relu_i(acc[i]), w0[i], s0);
#pragma unroll
              for (int i = 0; i < 4; ++i) s0 = fmaf(relu_i(acc[4 + i]), w1[i], s0);
              asm volatile("" : "+v"(s0));
              float s1 = relu_i(acc[8]) * w2[0];
#pragma unroll
              for (int i = 1; i < 4; ++i) s1 = fmaf(relu_i(acc[8 + i]), w2[i], s1);
#pragma unroll
              for (int i = 0; i < 4; ++i) s1 = fmaf(relu_i(acc[12 + i]), w3[i], s1);
              sc[0] = s0; sc[1] = s1; }
#pragma unroll
            for (int e = 0; e < 2; ++e) {
                const int ql = 4 * rb + 2 * hi + e; const int t = t0q + ql;
                const unsigned sk = skey32(sc[e]);
                if (L0 && MODE == 0) {
                    const unsigned skv = allvalid ? sk : ((kidx <= t) ? sk : 0u);
                    const unsigned addr = hbase + (unsigned)(4 * rb + e) * 8192u + ((skv >> 21) << 2);
                    const unsigned vv = (skv & 0x100000u) ? 0x10000u : 1u;
                    if (PROBE == 1) { asm volatile("" :: "v"(addr), "v"(vv)); }
                    else __hip_atomic_fetch_add((LAS unsigned*)(uintptr_t)addr, vv, __ATOMIC_RELAXED, __HIP_MEMORY_SCOPE_WORKGROUP);
                } else if (L0 && (MODE == 1 || MODE == 3)) {
                    sks[rb][e] = sk;
                } else {
                    const bool valid = kidx <= t;
                    const u64 K = ((u64)sk << 13) | (u64)(8191 - kidx);
                    if (MODE == 0) {
                        bool ok = valid;
                        if (level > 0) ok = ok && ((K >> hi_shift) == Pq[rb][e]);
                        if (ok) { const unsigned bin = (unsigned)(K >> lo_shift) & mask;
                            __hip_atomic_fetch_add((LAS unsigned*)(lds + HIST_OFF + ql * 8192) + (bin >> 1), 1u << (16 * (bin & 1)), __ATOMIC_RELAXED, __HIP_MEMORY_SCOPE_WORKGROUP); }
                    } else if (valid) {
                        const u64 pfx = K >> lo_shift;
                        LAS unsigned* st = (LAS unsigned*)(lds + ST_OFF + ql * 32);
                        if (pfx > Pq[rb][e]) {
                            const unsigned slot = __hip_atomic_fetch_add(st + 3, 1u, __ATOMIC_RELAXED, __HIP_MEMORY_SCOPE_WORKGROUP) & 0xffffu;
                            if (slot < (unsigned)TOPK) ((LAS unsigned short*)(lds + SEL_OFF))[ql * TOPK + slot] = (unsigned short)kidx;
                        } else if (pfx == Pq[rb][e]) {
                            const unsigned slot = __hip_atomic_fetch_add(st + 3, 0x10000u, __ATOMIC_RELAXED, __HIP_MEMORY_SCOPE_WORKGROUP) >> 16;
                            if (slot < (unsigned)CAP) ((LAS u64*)(lds + HIST_OFF))[ql * CAP + slot] = K;
                        }
                    }
                }
            }
            if (L0 && (MODE == 1 || MODE == 3) && (rb & 1)) {
                unsigned old[2][2];
#pragma unroll
                for (int r2 = 0; r2 < 2; ++r2)
#pragma unroll
                    for (int e = 0; e < 2; ++e) { const int rbb = rb - 1 + r2, ql = 4 * rbb + 2 * hi + e; const unsigned bin = sks[rbb][e] >> 20, Tb = (unsigned)Pq[rbb][e]; const bool valid = allvalid || (kidx <= t0q + ql);
                        old[r2][e] = 0u;
                        if (valid && bin >= Tb) old[r2][e] = __hip_atomic_fetch_add((LAS unsigned*)(lds + ST_OFF + ql * 32) + 3, (MODE == 1 && bin > Tb) ? 1u : 0x10000u, __ATOMIC_RELAXED, __HIP_MEMORY_SCOPE_WORKGROUP); }
#pragma unroll
                for (int r2 = 0; r2 < 2; ++r2)
#pragma unroll
                    for (int e = 0; e < 2; ++e) { const int rbb = rb - 1 + r2, ql = 4 * rbb + 2 * hi + e; const unsigned bin = sks[rbb][e] >> 20, Tb = (unsigned)Pq[rbb][e]; const bool valid = allvalid || (kidx <= t0q + ql);
                        if (MODE == 1 && valid && bin > Tb) { const unsigned slot = old[r2][e] & 0xffffu; if (slot < (unsigned)TOPK) ((LAS unsigned short*)(lds + SEL_OFF))[ql * TOPK + slot] = (unsigned short)kidx; }
                        else if (valid && (MODE == 3 ? bin >= Tb : bin == Tb)) { const unsigned slot = old[r2][e] >> 16; if (slot < (unsigned)CAP) ((LAS u64*)(lds + HIST_OFF))[ql * CAP + slot] = ((u64)sks[rbb][e] << 13) | (u64)(8191 - kidx); } }
            }
            acc = accN;
        }
    }
}
template <int MODE, bool L0, int PROBE = 0, int SMUL = 1>
__device__ __forceinline__ void idx_pass(const bf16x8 (&qa)[4][4], const bf16* KIb, int t0q, int nst, int wave, int lane_in, LAS unsigned char* lds, int level, int hi_shift, int lo_shift, unsigned mask) {
    int lane = lane_in; asm volatile("" : "+v"(lane));
    const int key_l = lane & 31, hi = lane >> 5;
    u64 Pq[4][2];
#pragma unroll
    for (int rb = 0; rb < 4; ++rb)
#pragma unroll
        for (int e = 0; e < 2; ++e) { const int ql = 4 * rb + 2 * hi + e; LAS const unsigned* st = (LAS const unsigned*)(lds + ST_OFF + ql * 32);
            Pq[rb][e] = (u64)st[0] | ((u64)st[1] << 32); }
    const unsigned hbase = (unsigned)(uintptr_t)(lds + HIST_OFF) + (unsigned)hi * 16384u;
    bf16x8 kb[4], kn[4];
    { const int kc = (wave < nst) ? 32 * SMUL * wave + key_l : key_l;
      const int kc2 = (wave + 8 < nst) ? kc + 256 * SMUL : kc;
#pragma unroll
      for (int ks = 0; ks < 4; ++ks) { kb[ks] = *(const GAS bf16x8*)(KIb + (size_t)kc * 64 + 16 * ks + 8 * hi); kn[ks] = *(const GAS bf16x8*)(KIb + (size_t)(PROBE == 2 ? key_l : kc2) * 64 + 16 * ks + 8 * hi); } }
    f32x16 acc = f32x16{};
#pragma unroll
    for (int ks = 0; ks < 4; ++ks) acc = __builtin_amdgcn_mfma_f32_32x32x16_bf16(qa[0][ks], kb[ks], acc, 0, 0, 0);
    if (SMUL != 1) {
        idx_loop<MODE, L0, PROBE, true, SMUL>(qa, KIb, t0q, nst, wave, nst, key_l, hi, lds, Pq, hbase, kb, kn, acc, level, hi_shift, lo_shift, mask);
        return;
    }
    const int nfull = (t0q + 1) >> 5; int st_split = wave; if (nfull > wave) st_split = wave + ((nfull - wave + 7) >> 3) * 8;
    idx_loop<MODE, L0, PROBE, true, 1>(qa, KIb, t0q, nst, wave, nfull, key_l, hi, lds, Pq, hbase, kb, kn, acc, level, hi_shift, lo_shift, mask);
    idx_loop<MODE, L0, PROBE, false, 1>(qa, KIb, t0q, nst, st_split, nst, key_l, hi, lds, Pq, hbase, kb, kn, acc, level, hi_shift, lo_shift, mask);
}

__device__ __forceinline__ void find_bin(LAS unsigned char* lds, int row, int lane_in, int bits) {
    int lane = lane_in; asm volatile("" : "+v"(lane));
    LAS unsigned* st = (LAS unsigned*)(lds + ST_OFF + row * 32);
    if (st[6] != 0u) return;
    const unsigned need = st[2];
    LAS const unsigned* hrow = (LAS const unsigned*)(lds + HIST_OFF + row * 8192) + 32 * lane;
    v4u hw[8]; unsigned tot = 0;
#pragma unroll
    for (int i = 0; i < 8; ++i) { hw[i] = *(LAS const v4u*)(hrow + 4 * i);
#pragma unroll
        for (int e = 0; e < 4; ++e) tot += (hw[i][e] & 0xffffu) + (hw[i][e] >> 16); }
    unsigned suf = tot;
#pragma unroll
    for (int o = 1; o < 64; o <<= 1) { const unsigned n = (unsigned)__builtin_amdgcn_ds_bpermute(((lane + o) & 63) << 2, (int)suf); if (lane + o < 64) suf += n; }
    const unsigned above = suf - tot;
    if (above < need && need <= suf) {
        unsigned running = above, T = 0, cT = 0; bool found = false;
#pragma unroll
        for (int i = 31; i >= 0; --i) {
            const unsigned w = hw[i >> 2][i & 3], h16 = w >> 16, l16 = w & 0xffffu;
            if (!found) {
                if (running + h16 >= need) { T = 64 * lane + 2 * i + 1; cT = h16; found = true; }
                else { running += h16;
                    if (running + l16 >= need) { T = 64 * lane + 2 * i; cT = l16; found = true; } else running += l16; } }
        }
        const u64 Pold = (u64)st[0] | ((u64)st[1] << 32); const u64 Pn = (Pold << bits) | (u64)T;
        st[0] = (unsigned)Pn; st[1] = (unsigned)(Pn >> 32); st[2] = need - running; st[5] = cT;
    }
}

__device__ __forceinline__ void finish_row(LAS unsigned char* lds, int row, int lane_in, int nbits) {
    int lane = lane_in; asm volatile("" : "+v"(lane));
    LAS unsigned* st = (LAS unsigned*)(lds + ST_OFF + row * 32);
    if (st[6] != 0u) return;
    const unsigned need = st[2]; unsigned nc = st[3] >> 16; if (nc > (unsigned)CAP) nc = CAP;
    unsigned base = st[3] & 0xffffu; if (base > (unsigned)TOPK) base = TOPK;
    LAS const u64* cand = (LAS const u64*)(lds + HIST_OFF) + row * CAP;
    const int nch = (int)((nc + 63u) >> 6);
    const u64 Pfix = ((u64)st[0] | ((u64)st[1] << 32)) << nbits;
    u64 thr = Pfix;
    if (nch <= 4) {
        u64 k[4];
#pragma unroll
        for (int ch = 0; ch < 4; ++ch) { const unsigned i = 64u * ch + lane; k[ch] = (i < nc) ? cand[i] : 0ull; }
        for (int bit = nbits - 1; bit >= 0; --bit) {
            const u64 c = thr | (1ull << bit); unsigned cnt = 0;
#pragma unroll
            for (int ch = 0; ch < 4; ++ch) cnt += (unsigned)__builtin_popcountll(__ballot(k[ch] >= c));
            if (cnt >= need) thr = c;
        }
#pragma unroll
        for (int ch = 0; ch < 4; ++ch) {
            const unsigned i = 64u * ch + lane; const bool s = (i < nc) && (k[ch] >= thr);
            const unsigned long long m = __ballot(s); const unsigned pos = base + (unsigned)__builtin_popcountll(m & ((1ull << lane) - 1ull));
            if (s && pos < (unsigned)TOPK) ((LAS unsigned short*)(lds + SEL_OFF))[row * TOPK + pos] = (unsigned short)(8191u - (unsigned)(k[ch] & 0x1fffull));
            base += (unsigned)__builtin_popcountll(m);
        }
    } else if (nch <= 8) {
        u64 k[8];
#pragma unroll
        for (int ch = 0; ch < 8; ++ch) { const unsigned i = 64u * ch + lane; k[ch] = (i < nc) ? cand[i] : 0ull; }
        for (int bit = nbits - 1; bit >= 0; --bit) {
            const u64 c = thr | (1ull << bit); unsigned cnt = 0;
#pragma unroll
            for (int ch = 0; ch < 8; ++ch) cnt += (unsigned)__builtin_popcountll(__ballot(k[ch] >= c));
            if (cnt >= need) thr = c;
        }
#pragma unroll
        for (int ch = 0; ch < 8; ++ch) {
            const unsigned i = 64u * ch + lane; const bool s = (i < nc) && (k[ch] >= thr);
            const unsigned long long m = __ballot(s); const unsigned pos = base + (unsigned)__builtin_popcountll(m & ((1ull << lane) - 1ull));
            if (s && pos < (unsigned)TOPK) ((LAS unsigned short*)(lds + SEL_OFF))[row * TOPK + pos] = (unsigned short)(8191u - (unsigned)(k[ch] & 0x1fffull));
            base += (unsigned)__builtin_popcountll(m);
        }
    } else if (nch <= 12) {
        u64 k[12];
#pragma unroll
        for (int ch = 0; ch < 12; ++ch) { const unsigned i = 64u * ch + lane; k[ch] = (i < nc) ? cand[i] : 0ull; }
        for (int bit = nbits - 1; bit >= 0; --bit) {
            const u64 c = thr | (1ull << bit); unsigned cnt = 0;
#pragma unroll
            for (int ch = 0; ch < 12; ++ch) cnt += (unsigned)__builtin_popcountll(__ballot(k[ch] >= c));
            if (cnt >= need) thr = c;
        }
#pragma unroll
        for (int ch = 0; ch < 12; ++ch) {
            const unsigned i = 64u * ch + lane; const bool s = (i < nc) && (k[ch] >= thr);
            const unsigned long long m = __ballot(s); const unsigned pos = base + (unsigned)__builtin_popcountll(m & ((1ull << lane) - 1ull));
            if (s && pos < (unsigned)TOPK) ((LAS unsigned short*)(lds + SEL_OFF))[row * TOPK + pos] = (unsigned short)(8191u - (unsigned)(k[ch] & 0x1fffull));
            base += (unsigned)__builtin_popcountll(m);
        }
    } else if (nch <= 16) {
        u64 k[16];
#pragma unroll
        for (int ch = 0; ch < 16; ++ch) { const unsigned i = 64u * ch + lane; k[ch] = (i < nc) ? cand[i] : 0ull; }
        for (int bit = nbits - 1; bit >= 0; --bit) {
            const u64 c = thr | (1ull << bit); unsigned cnt = 0;
#pragma unroll
            for (int ch = 0; ch < 16; ++ch) cnt += (unsigned)__builtin_popcountll(__ballot(k[ch] >= c));
            if (cnt >= need) thr = c;
        }
#pragma unroll
        for (int ch = 0; ch < 16; ++ch) {
            const unsigned i = 64u * ch + lane; const bool s = (i < nc) && (k[ch] >= thr);
            const unsigned long long m = __ballot(s); const unsigned pos = base + (unsigned)__builtin_popcountll(m & ((1ull << lane) - 1ull));
            if (s && pos < (unsigned)TOPK) ((LAS unsigned short*)(lds + SEL_OFF))[row * TOPK + pos] = (unsigned short)(8191u - (unsigned)(k[ch] & 0x1fffull));
            base += (unsigned)__builtin_popcountll(m);
        }
    } else {
        for (int bit = nbits - 1; bit >= 0; --bit) {
            const u64 c = thr | (1ull << bit); unsigned cnt = 0;
            for (int ch = 0; ch < nch; ++ch) { const unsigned i = 64u * ch + lane; const u64 k = (i < nc) ? cand[i] : 0ull; cnt += (unsigned)__builtin_popcountll(__ballot(k >= c)); }
            if (cnt >= need) thr = c;
        }
        for (int ch = 0; ch < nch; ++ch) {
            const unsigned i = 64u * ch + lane; const u64 k = (i < nc) ? cand[i] : 0ull; const bool s = (i < nc) && (k >= thr);
            const unsigned long long m = __ballot(s); const unsigned pos = base + (unsigned)__builtin_popcountll(m & ((1ull << lane) - 1ull));
            if (s && pos < (unsigned)TOPK) ((LAS unsigned short*)(lds + SEL_OFF))[row * TOPK + pos] = (unsigned short)(8191u - (unsigned)(k & 0x1fffull));
            base += (unsigned)__builtin_popcountll(m);
        }
    }
    if (lane == 0) st[3] = base;
}

__device__ __forceinline__ void sparse_attn_row(LAS unsigned char* lds, int row, int b, int t, const bf16* Q1, bf16* O1, const unsigned char* K1, const unsigned char* V1, int wave, int lane_in) {
    int lane = lane_in; asm volatile("" : "+v"(lane));
    const int n16 = lane & 15, q4 = lane >> 4, gl = n16 >> 2;
    LAS const unsigned short* sel = (LAS const unsigned short*)(lds + SEL_OFF) + row * TOPK;
    unsigned cnt = ((LAS const unsigned*)(lds + ST_OFF + row * 32))[3] & 0xffffu; if (cnt > (unsigned)TOPK) cnt = TOPK;
    const bf16* qrow = Q1 + ((size_t)b * T + t) * D; bf16* orow = O1 + ((size_t)b * T + t) * D;
    bf16x8 bq[8];
    { const bf16x8 q0 = *(const GAS bf16x8*)(qrow + n16 * 64 + 16 * q4), q1 = *(const GAS bf16x8*)(qrow + n16 * 64 + 16 * q4 + 8); const bf16x8 z = (bf16x8){0, 0, 0, 0, 0, 0, 0, 0};
#pragma unroll
      for (int s = 0; s < 8; ++s) bq[s] = ((s >> 1) == gl) ? ((s & 1) ? q1 : q0) : z; }
    const float slope = __builtin_amdgcn_exp2f(-0.5f * (float)(n16 + 1)) * LOG2E;
    const unsigned char* Kb = K1 + (size_t)b * T * 256; const unsigned char* Vb = V1 + (size_t)b * T * 256;
    f32x4 sc[16];
    v4u vst[2][8];
    constexpr int KD = 3;
    v4u kfn[KD][4];
#pragma unroll
    for (int d = 0; d < KD; ++d) { const unsigned pos = 16u * d + n16; const unsigned kidx = (pos < cnt) ? (unsigned)sel[pos] : 0u; const unsigned char* kp = Kb + (size_t)kidx * 256 + 16 * q4;
#pragma unroll
      for (int g = 0; g < 4; ++g) kfn[d][g] = *(const GAS v4u*)(kp + 64 * g); }
#pragma unroll
    for (int blk = 0; blk < 16; ++blk) {
        bf16x8 kf[8];
#pragma unroll
        for (int g = 0; g < 4; ++g) { const v4u lo = f8x8_to_bf16(kfn[blk % KD][g].x, kfn[blk % KD][g].y), hi8 = f8x8_to_bf16(kfn[blk % KD][g].z, kfn[blk % KD][g].w); kf[2 * g] = __builtin_bit_cast(bf16x8, lo); kf[2 * g + 1] = __builtin_bit_cast(bf16x8, hi8); }
        if (blk + KD < 16) { const unsigned pos = 16u * (blk + KD) + n16; const unsigned kidx = (pos < cnt) ? (unsigned)sel[pos] : 0u; const unsigned char* kp = Kb + (size_t)kidx * 256 + 16 * q4;
#pragma unroll
            for (int g = 0; g < 4; ++g) kfn[blk % KD][g] = *(const GAS v4u*)(kp + 64 * g); }
        if (blk >= 14) {
            const int d = blk - 14;
#pragma unroll
            for (int i = 0; i < 8; ++i) { const unsigned pos = 32u * d + 4u * i + q4; const unsigned kidx = (pos < cnt) ? (unsigned)sel[pos] : 0u; vst[d][i] = *(const GAS v4u*)(Vb + (size_t)kidx * 256 + 16 * n16); }
        }
        f32x4 a = (f32x4){0.f, 0.f, 0.f, 0.f};
#pragma unroll
        for (int s = 0; s < 8; ++s) a = __builtin_amdgcn_mfma_f32_16x16x32_bf16(kf[s], bq[s], a, 0, 0, 0);
        const unsigned long long i4 = *(LAS const unsigned long long*)(sel + 16 * blk + 4 * q4);
#pragma unroll
        for (int i = 0; i < 4; ++i) { const unsigned p = 16u * blk + 4u * q4 + i; const int ki = (int)((i4 >> (16 * i)) & 0xffffull);
            a[i] = (p < cnt) ? (a[i] - slope * (float)(t - ki)) : -INFINITY; }
        sc[blk] = a;
    }
    float mx = -INFINITY;
#pragma unroll
    for (int blk = 0; blk < 16; ++blk) mx = fmaxf(fmaxf(fmaxf(mx, sc[blk][0]), fmaxf(sc[blk][1], sc[blk][2])), sc[blk][3]);
    mx = xmax32(xmax16(mx));
    float lsum = 0.f;
#pragma unroll
    for (int blk = 0; blk < 16; ++blk)
#pragma unroll
        for (int i = 0; i < 4; ++i) { const float p = __builtin_amdgcn_exp2f(sc[blk][i] - mx); sc[blk][i] = p; lsum += p; }
    lsum = xsum32(xsum16(lsum));
    LAS unsigned char* vbuf = lds + HIST_OFF + wave * 16384;
    f32x4 o[4];
#pragma unroll
    for (int db = 0; db < 4; ++db) o[db] = (f32x4){0.f, 0.f, 0.f, 0.f};
#pragma unroll
    for (int J = 0; J < 8; ++J) {
#pragma unroll
        for (int i = 0; i < 8; ++i) { const int key = 4 * i + q4; LAS unsigned char* dst = vbuf + key * 512 + ((n16 ^ (key & 7)) << 5);
            *(LAS v4u*)dst = f8x8_to_bf16(vst[J & 1][i].x, vst[J & 1][i].y); *(LAS v4u*)(dst + 16) = f8x8_to_bf16(vst[J & 1][i].z, vst[J & 1][i].w); }
        if (J + 2 < 8) {
#pragma unroll
            for (int i = 0; i < 8; ++i) { const unsigned pos = 32u * (J + 2) + 4u * i + q4; const unsigned kidx = (pos < cnt) ? (unsigned)sel[pos] : 0u; vst[J & 1][i] = *(const GAS v4u*)(Vb + (size_t)kidx * 256 + 16 * n16); }
        }
        asm volatile("s_waitcnt lgkmcnt(0)" ::: "memory");
        v4u pb; pb.x = pk2(sc[2 * J][0], sc[2 * J][1]); pb.y = pk2(sc[2 * J][2], sc[2 * J][3]); pb.z = pk2(sc[2 * J + 1][0], sc[2 * J + 1][1]); pb.w = pk2(sc[2 * J + 1][2], sc[2 * J + 1][3]);
#pragma unroll
        for (int g = 0; g < 4; ++g) {
            const v4u pg = (g == gl) ? pb : (v4u){0u, 0u, 0u, 0u};
#pragma unroll
            for (int db = 0; db < 4; ++db) {
                const int qq = n16 >> 2, pp = n16 & 3; const int col = 64 * g + 16 * db + 4 * pp;
                const int r0 = 4 * q4 + qq, r1 = 16 + 4 * q4 + qq;
                const int a0 = r0 * 512 + ((((col >> 4) ^ (r0 & 7)) << 5) | ((col & 15) << 1)), a1 = r1 * 512 + ((((col >> 4) ^ (r1 & 7)) << 5) | ((col & 15) << 1));
                v2u lo, hi2;
                asm volatile("ds_read_b64_tr_b16 %0, %1" : "=v"(lo) : "v"((unsigned)(uintptr_t)(vbuf + a0)) : "memory");
                asm volatile("ds_read_b64_tr_b16 %0, %1" : "=v"(hi2) : "v"((unsigned)(uintptr_t)(vbuf + a1)) : "memory");
                asm volatile("s_waitcnt lgkmcnt(0)" : "+v"(lo), "+v"(hi2) :: "memory");
                const v4u av = (v4u){lo.x, lo.y, hi2.x, hi2.y};
                o[db] = __builtin_amdgcn_mfma_f32_16x16x32_bf16(__builtin_bit_cast(bf16x8, av), __builtin_bit_cast(bf16x8, pg), o[db], 0, 0, 0);
            }
        }
        asm volatile("s_waitcnt lgkmcnt(0)" ::: "memory");
    }
    const float rl = 1.f / lsum;
#pragma unroll
    for (int db = 0; db < 4; ++db) { v2u w; w.x = pk2(o[db][0] * rl, o[db][1] * rl); w.y = pk2(o[db][2] * rl, o[db][3] * rl);
        *(GAS v2u*)(orow + n16 * 64 + 16 * db + 4 * q4) = w; }
}

typedef long i64_t;
__device__ __forceinline__ void canon_sel(LAS unsigned char* lds, LAS unsigned short* sel, unsigned cnt, int wave, int lane) {
    LAS unsigned* bm = (LAS unsigned*)(lds + HIST_OFF + wave * 16384); LAS unsigned* pf = bm + 256;
    *(LAS v4u*)(bm + 4 * lane) = (v4u){0u, 0u, 0u, 0u};
    const v2u e = *(const LAS v2u*)(sel + 4 * lane);
    unsigned idx[4] = {e.x & 0xffffu, e.x >> 16, e.y & 0xffffu, e.y >> 16};
    LDS_WAIT();
#pragma unroll
    for (int i = 0; i < 4; ++i) if ((unsigned)(4 * lane + i) < cnt) __hip_atomic_fetch_or(bm + (idx[i] >> 5), 1u << (idx[i] & 31u), __ATOMIC_RELAXED, __HIP_MEMORY_SCOPE_WORKGROUP);
    LDS_WAIT();
    const v4u w = *(const LAS v4u*)(bm + 4 * lane);
    const unsigned c0 = __builtin_popcount(w.x), c1 = __builtin_popcount(w.y), c2 = __builtin_popcount(w.z), c3 = __builtin_popcount(w.w), tot = c0 + c1 + c2 + c3;
    int sc = (int)tot;
    sc += __builtin_amdgcn_update_dpp(0, sc, 0x111, 0xf, 0xf, false); sc += __builtin_amdgcn_update_dpp(0, sc, 0x112, 0xf, 0xf, false);
    sc += __builtin_amdgcn_update_dpp(0, sc, 0x114, 0xf, 0xf, false); sc += __builtin_amdgcn_update_dpp(0, sc, 0x118, 0xf, 0xf, false);
    sc += __builtin_amdgcn_update_dpp(0, sc, 0x142, 0xa, 0xf, false);
    sc += __builtin_amdgcn_update_dpp(0, sc, 0x143, 0xc, 0xf, false);
    const unsigned ex = (unsigned)sc - tot;
    *(LAS v4u*)(pf + 4 * lane) = (v4u){ex, ex + c0, ex + c0 + c1, ex + c0 + c1 + c2};
    LDS_WAIT();
#pragma unroll
    for (int i = 0; i < 4; ++i) if ((unsigned)(4 * lane + i) < cnt) { const unsigned wd = idx[i] >> 5; const unsigned r = pf[wd] + __builtin_popcount(bm[wd] & ((1u << (idx[i] & 31u)) - 1u)); sel[r] = (unsigned short)idx[i]; }
    LDS_WAIT();
}
__device__ __forceinline__ void sparse_attn_row8(LAS unsigned char* lds, int row, int b, int t, const bf16* Q1, bf16* O1, const unsigned char* K1, const unsigned char* V1, int wave, int lane_in) {
    int lane = lane_in; asm volatile("" : "+v"(lane));
    const int n16 = lane & 15, q4 = lane >> 4, gl = n16 >> 2;
    LAS unsigned short* sel = (LAS unsigned short*)(lds + SEL_OFF) + row * TOPK;
    unsigned cnt = ((LAS const unsigned*)(lds + ST_OFF + row * 32))[3] & 0xffffu; if (cnt > (unsigned)TOPK) cnt = TOPK;
    canon_sel(lds, sel, cnt, wave, lane);
    if (cnt < (unsigned)TOPK) {
        for (unsigned i = cnt + lane; i < (unsigned)TOPK; i += 64u) sel[i] = 0;
        asm volatile("s_waitcnt lgkmcnt(0)" ::: "memory");
    }
    const bf16* qrow = Q1 + ((size_t)b * T + t) * D; bf16* orow = O1 + ((size_t)b * T + t) * D;
    i64_t qs0, qs1;
    { const v4u a = *(const GAS v4u*)(qrow + n16 * 64 + 16 * q4), c = *(const GAS v4u*)(qrow + n16 * 64 + 16 * q4 + 8);
      int w0 = 0, w1 = 0, w2 = 0, w3 = 0;
      w0 = __builtin_amdgcn_cvt_pk_fp8_f32(bf2f(a.x & 0xffffu), bf2f(a.x >> 16), w0, false); w0 = __builtin_amdgcn_cvt_pk_fp8_f32(bf2f(a.y & 0xffffu), bf2f(a.y >> 16), w0, true);
      w1 = __builtin_amdgcn_cvt_pk_fp8_f32(bf2f(a.z & 0xffffu), bf2f(a.z >> 16), w1, false); w1 = __builtin_amdgcn_cvt_pk_fp8_f32(bf2f(a.w & 0xffffu), bf2f(a.w >> 16), w1, true);
      w2 = __builtin_amdgcn_cvt_pk_fp8_f32(bf2f(c.x & 0xffffu), bf2f(c.x >> 16), w2, false); w2 = __builtin_amdgcn_cvt_pk_fp8_f32(bf2f(c.y & 0xffffu), bf2f(c.y >> 16), w2, true);
      w3 = __builtin_amdgcn_cvt_pk_fp8_f32(bf2f(c.z & 0xffffu), bf2f(c.z >> 16), w3, false); w3 = __builtin_amdgcn_cvt_pk_fp8_f32(bf2f(c.w & 0xffffu), bf2f(c.w >> 16), w3, true);
      qs0 = (i64_t)(((u64)(unsigned)w1 << 32) | (u64)(unsigned)w0); qs1 = (i64_t)(((u64)(unsigned)w3 << 32) | (u64)(unsigned)w2); }
    i64_t bq0[4], bq1[4];
#pragma unroll
    for (int g = 0; g < 4; ++g) { bq0[g] = (g == gl) ? qs0 : (i64_t)0; bq1[g] = (g == gl) ? qs1 : (i64_t)0; }
    const float slope = __builtin_amdgcn_exp2f(-0.5f * (float)(n16 + 1)) * LOG2E;
    const unsigned char* Kb = K1 + (size_t)b * T * 256; const unsigned char* Vb = V1 + (size_t)b * T * 256;
    const int vkey = lane >> 1, vpar = lane & 1;
    f32x4 sc[16];
    v4u vst[2][8];
    constexpr int KD = 3;
    v4u kfn[KD][4];
#pragma unroll
    for (int d = 0; d < KD; ++d) { const unsigned kidx = (unsigned)sel[16 * d + n16]; const unsigned char* kp = Kb + (size_t)kidx * 256 + 16 * q4;
#pragma unroll
      for (int g = 0; g < 4; ++g) kfn[d][g] = *(const GAS v4u*)(kp + 64 * g); }
#pragma unroll
    for (int blk = 0; blk < 16; ++blk) {
        f32x4 a = (f32x4){0.f, 0.f, 0.f, 0.f};
#pragma unroll
        for (int g = 0; g < 4; ++g) {
            const v4u ch = kfn[blk % KD][g];
            const i64_t k0 = (i64_t)(((u64)ch.y << 32) | (u64)ch.x), k1 = (i64_t)(((u64)ch.w << 32) | (u64)ch.z);
            a = __builtin_amdgcn_mfma_f32_16x16x32_fp8_fp8(k0, bq0[g], a, 0, 0, 0);
            a = __builtin_amdgcn_mfma_f32_16x16x32_fp8_fp8(k1, bq1[g], a, 0, 0, 0);
        }
        if (blk + KD < 16) { const unsigned kidx = (unsigned)sel[16 * (blk + KD) + n16]; const unsigned char* kp = Kb + (size_t)kidx * 256 + 16 * q4;
#pragma unroll
            for (int g = 0; g < 4; ++g) kfn[blk % KD][g] = *(const GAS v4u*)(kp + 64 * g); }
        if (blk >= 14) { const int d = blk - 14;
#pragma unroll
            for (int k = 0; k < 8; ++k) vst[d][k] = *(const GAS v4u*)(Vb + (size_t)sel[32 * d + 4 * k + q4] * 256 + 16 * n16); }
        const unsigned long long i4 = *(LAS const unsigned long long*)(sel + 16 * blk + 4 * q4);
#pragma unroll
        for (int i = 0; i < 4; ++i) { const unsigned pz = 16u * blk + 4u * q4 + i; const int ki = (int)((i4 >> (16 * i)) & 0xffffull);
            a[i] = (pz < cnt) ? (a[i] - slope * (float)(t - ki)) : -INFINITY; }
        sc[blk] = a;
    }
    float mx = -INFINITY;
#pragma unroll
    for (int blk = 0; blk < 16; ++blk) mx = fmaxf(fmaxf(fmaxf(mx, sc[blk][0]), fmaxf(sc[blk][1], sc[blk][2])), sc[blk][3]);
    mx = xmax32(xmax16(mx));
    float lsum = 0.f;
    mx -= 8.f;
#pragma unroll
    for (int blk = 0; blk < 16; ++blk)
#pragma unroll
        for (int i = 0; i < 4; ++i) { const float pv = __builtin_amdgcn_exp2f(sc[blk][i] - mx); sc[blk][i] = pv; lsum += pv; }
    lsum = xsum32(xsum16(lsum));
    LAS unsigned char* vbuf = lds + HIST_OFF + wave * 16384;
    unsigned vdst[4];
#pragma unroll
    for (int j = 0; j < 4; ++j) vdst[j] = (unsigned)(uintptr_t)vbuf + (unsigned)vkey * 256u + (unsigned)((((2 * j) ^ (vkey & 7)) << 5) | (vpar << 4));
    const int qq = n16 >> 2, pp = n16 & 3; const int r0 = 4 * q4 + qq, r1 = 16 + 4 * q4 + qq;
    f32x4 oe[2], oo[2];
#pragma unroll
    for (int d = 0; d < 2; ++d) { oe[d] = (f32x4){0.f, 0.f, 0.f, 0.f}; oo[d] = (f32x4){0.f, 0.f, 0.f, 0.f}; }
#pragma unroll
    for (int J = 0; J < 8; ++J) {
        LAS unsigned char* slot = vbuf + (J & 1) * 8192;
#pragma unroll
        for (int k = 0; k < 8; ++k) { const int key = 4 * k + q4; *(LAS v4u*)(slot + key * 256 + ((((n16 >> 1) ^ (key & 7)) << 5) | ((n16 & 1) << 4))) = vst[J & 1][k]; }
        if (J + 2 < 8) {
#pragma unroll
            for (int k = 0; k < 8; ++k) vst[J & 1][k] = *(const GAS v4u*)(Vb + (size_t)sel[32 * (J + 2) + 4 * k + q4] * 256 + 16 * n16); }
        asm volatile("s_waitcnt lgkmcnt(0)" ::: "memory");
        int p0 = 0, p1 = 0;
        p0 = __builtin_amdgcn_cvt_pk_fp8_f32(sc[2 * J][0], sc[2 * J][1], p0, false); p0 = __builtin_amdgcn_cvt_pk_fp8_f32(sc[2 * J][2], sc[2 * J][3], p0, true);
        p1 = __builtin_amdgcn_cvt_pk_fp8_f32(sc[2 * J + 1][0], sc[2 * J + 1][1], p1, false); p1 = __builtin_amdgcn_cvt_pk_fp8_f32(sc[2 * J + 1][2], sc[2 * J + 1][3], p1, true);
        const i64_t pb = (i64_t)(((u64)(unsigned)p1 << 32) | (u64)(unsigned)p0);
        v2u trl[8], trh[8];
#pragma unroll
        for (int sg = 0; sg < 8; ++sg) {
            const int a0 = r0 * 256 + (((sg ^ (r0 & 7)) << 5) | (pp << 3)), a1 = r1 * 256 + (((sg ^ (r1 & 7)) << 5) | (pp << 3));
            asm volatile("ds_read_b64_tr_b16 %0, %1" : "=v"(trl[sg]) : "v"((unsigned)(uintptr_t)(slot + a0)) : "memory");
            asm volatile("ds_read_b64_tr_b16 %0, %1" : "=v"(trh[sg]) : "v"((unsigned)(uintptr_t)(slot + a1)) : "memory");
        }
        asm volatile("s_waitcnt lgkmcnt(0)" : "+v"(trl[0]), "+v"(trl[1]), "+v"(trl[2]), "+v"(trl[3]), "+v"(trl[4]), "+v"(trl[5]), "+v"(trl[6]), "+v"(trl[7]),
                                               "+v"(trh[0]), "+v"(trh[1]), "+v"(trh[2]), "+v"(trh[3]), "+v"(trh[4]), "+v"(trh[5]), "+v"(trh[6]), "+v"(trh[7]) :: "memory");
#pragma unroll
        for (int g = 0; g < 4; ++g) {
            const i64_t pg = (g == gl) ? pb : (i64_t)0;
#pragma unroll
            for (int dbp = 0; dbp < 2; ++dbp) {
                const v2u lo = trl[2 * g + dbp], hi2 = trh[2 * g + dbp];
                const unsigned e0 = __builtin_amdgcn_perm(lo.y, lo.x, 0x06040200u), o0 = __builtin_amdgcn_perm(lo.y, lo.x, 0x07050301u);
                const unsigned e1 = __builtin_amdgcn_perm(hi2.y, hi2.x, 0x06040200u), o1 = __builtin_amdgcn_perm(hi2.y, hi2.x, 0x07050301u);
                const i64_t ae = (i64_t)(((u64)e1 << 32) | (u64)e0), ao = (i64_t)(((u64)o1 << 32) | (u64)o0);
                oe[dbp] = __builtin_amdgcn_mfma_f32_16x16x32_fp8_fp8(ae, pg, oe[dbp], 0, 0, 0);
                oo[dbp] = __builtin_amdgcn_mfma_f32_16x16x32_fp8_fp8(ao, pg, oo[dbp], 0, 0, 0);
            }
        }
    }
    (void)vdst;
    const float rl = 32.f / lsum;
#pragma unroll
    for (int dbp = 0; dbp < 2; ++dbp) {
        int w0 = 0, w1 = 0;
        w0 = __builtin_amdgcn_cvt_pk_fp8_f32(oe[dbp][0] * rl, oo[dbp][0] * rl, w0, false); w0 = __builtin_amdgcn_cvt_pk_fp8_f32(oe[dbp][1] * rl, oo[dbp][1] * rl, w0, true);
        w1 = __builtin_amdgcn_cvt_pk_fp8_f32(oe[dbp][2] * rl, oo[dbp][2] * rl, w1, false); w1 = __builtin_amdgcn_cvt_pk_fp8_f32(oe[dbp][3] * rl, oo[dbp][3] * rl, w1, true);
        *(GAS v2u*)((unsigned char*)O1 + ((size_t)b * T + t) * D + n16 * 64 + 32 * dbp + 8 * q4) = (v2u){(unsigned)w0, (unsigned)w1}; }
}

__device__ __forceinline__ void unit(LAS unsigned char* lds, int b, int t0q, const bf16* Q1, bf16* O1, const unsigned char* K1, const unsigned char* V1, const bf16* QI, const bf16* KI, const float* WI, int tid_in, int wave) {
    int tid = tid_in; asm volatile("" : "+v"(tid)); const int lane = tid & 63;
    const int hi = lane >> 5, r32 = lane & 31;
    if (tid < QT * 8) ((LAS float*)(lds + ST_OFF + 1024))[tid] = WI[((size_t)b * T + t0q) * 8 + tid];
    if (tid < QT) { LAS unsigned* st = (LAS unsigned*)(lds + ST_OFF + tid * 32); const int t = t0q + tid;
        unsigned z; asm volatile("v_mov_b32 %0, 0" : "=v"(z));
        st[0] = z; st[1] = z; st[2] = z + (unsigned)TOPK; st[3] = z; st[4] = z; st[5] = z; st[6] = (t + 1 <= TOPK) ? 1u : z; st[7] = z; }
    for (int i = tid; i < 32768 / 4; i += NTHREADS) ((LAS v4u*)(lds + HIST_OFF))[i] = (v4u){0u, 0u, 0u, 0u};
    bf16x8 qa[4][4];
    { const int qlr = 2 * ((r32 >> 2) & 1) + (r32 >> 4), hd = 4 * ((r32 >> 3) & 1) + (r32 & 3);
#pragma unroll
      for (int rb = 0; rb < 4; ++rb) { const bf16* qp = QI + ((size_t)b * T + t0q + 4 * rb + qlr) * 512 + hd * 64 + 8 * hi;
#pragma unroll
          for (int ks = 0; ks < 4; ++ks) qa[rb][ks] = *(const GAS bf16x8*)(qp + 16 * ks); } }
    const int nst = (t0q + QT + 31) >> 5;
    const bf16* KIb = KI + (size_t)b * T * 64;
    bool done = false;
    if (t0q >= 2048) {
        const int nfull_ = (t0q + 1) >> 5, nsamp = (nfull_ + 7) >> 3;
        if (tid < QT) { LAS unsigned* st = (LAS unsigned*)(lds + ST_OFF + tid * 32); const unsigned n = (unsigned)(t0q + tid + 1), ns = 32u * (unsigned)nsamp; st[2] = (512u * ns + n - 1u) / n; }
        __syncthreads();
        idx_pass<0, true, 0, 8>(qa, KIb, t0q, nsamp, wave, lane, lds, 0, 45, 33, 4095u);
        __syncthreads();
        find_bin(lds, 2 * wave, lane, 12); find_bin(lds, 2 * wave + 1, lane, 12);
        __syncthreads();
        idx_pass<3, true>(qa, KIb, t0q, nst, wave, lane, lds, 0, 0, 33, 0u);
        __syncthreads();
        bool bad = false;
#pragma unroll
        for (int r = 0; r < QT; ++r) { const unsigned c = ((LAS const unsigned*)(lds + ST_OFF + r * 32))[3] >> 16; bad = bad || c < (unsigned)TOPK || c > (unsigned)CAP; }
        __syncthreads();
        if (!bad) {
            if (tid < QT) { LAS unsigned* st = (LAS unsigned*)(lds + ST_OFF + tid * 32); st[0] = 0u; st[1] = 0u; st[2] = (unsigned)TOPK; }
            __syncthreads();
            { int lane_c; asm volatile("v_mbcnt_lo_u32_b32 %0, -1, 0\n\tv_mbcnt_hi_u32_b32 %0, -1, %0" : "=v"(lane_c));
              finish_row(lds, 2 * wave, lane_c, 45); finish_row(lds, 2 * wave + 1, lane_c, 45); }
            __syncthreads();
            done = true;
        } else {
            if (tid < QT) { LAS unsigned* st = (LAS unsigned*)(lds + ST_OFF + tid * 32); st[0] = 0u; st[1] = 0u; st[2] = (unsigned)TOPK; st[3] = 0u; st[4] = 0u; st[5] = 0u; }
            for (int i = tid; i < 32768 / 4; i += NTHREADS) ((LAS v4u*)(lds + HIST_OFF))[i] = (v4u){0u, 0u, 0u, 0u};
            __syncthreads();
        }
    }
    int level = 0, lo_shift = 33;
    if (!done) {
    for (;;) {
        const int hi_shift = 45 - 12 * level; lo_shift = (level == 3) ? 0 : 33 - 12 * level; const int bits = (level == 3) ? 9 : 12; const unsigned mask = (1u << bits) - 1u;
        if (level > 0) { for (int i = tid; i < 32768 / 4; i += NTHREADS) ((LAS v4u*)(lds + HIST_OFF))[i] = (v4u){0u, 0u, 0u, 0u}; }
        __syncthreads();
        if (MK_DUP & 512) {
            if (MK_DUP & 1024) idx_pass<0, true, 1>(qa, KIb, t0q, nst, wave, lane, lds, level, hi_shift, lo_shift, mask);
            else if (MK_DUP & 2048) idx_pass<0, true, 2>(qa, KIb, t0q, nst, wave, lane, lds, level, hi_shift, lo_shift, mask);
            else idx_pass<0, true>(qa, KIb, t0q, nst, wave, lane, lds, level, hi_shift, lo_shift, mask);
            __syncthreads();
            for (int i = tid; i < 32768 / 4; i += NTHREADS) ((LAS v4u*)(lds + HIST_OFF))[i] = (v4u){0u, 0u, 0u, 0u};
            __syncthreads();
        }
        if (level == 0) idx_pass<0, true>(qa, KIb, t0q, nst, wave, lane, lds, level, hi_shift, lo_shift, mask);
        else idx_pass<0, false>(qa, KIb, t0q, nst, wave, lane, lds, level, hi_shift, lo_shift, mask);
        __syncthreads();
        find_bin(lds, 2 * wave, lane, bits); find_bin(lds, 2 * wave + 1, lane, bits);
        __syncthreads();
        bool more = false;
        if (level < 3) {
#pragma unroll
            for (int r = 0; r < QT; ++r) { LAS const unsigned* st = (LAS const unsigned*)(lds + ST_OFF + r * 32); more = more || (st[6] == 0u && st[5] > (unsigned)CAP); }
        }
        if (!more) break;
        ++level;
    }
    __syncthreads();
    if (MK_DUP & 4096) { idx_pass<1, true>(qa, KIb, t0q, nst, wave, lane, lds, level, 0, lo_shift, 0u); __syncthreads(); if (tid < QT) ((LAS unsigned*)(lds + ST_OFF + tid * 32))[3] = 0u; __syncthreads(); }
    if (level == 0) idx_pass<1, true>(qa, KIb, t0q, nst, wave, lane, lds, level, 0, lo_shift, 0u);
    else idx_pass<1, false>(qa, KIb, t0q, nst, wave, lane, lds, level, 0, lo_shift, 0u);
    __syncthreads();
    finish_row(lds, 2 * wave, lane, lo_shift); finish_row(lds, 2 * wave + 1, lane, lo_shift);
    __syncthreads();
    }
#pragma unroll 1
    for (int rr = 0; rr < (MK_DUP & 256 ? 4 : 2); ++rr) sparse_attn_row8(lds, 2 * wave + (rr & 1), b, t0q + 2 * wave + (rr & 1), Q1, O1, K1, V1, wave, lane);
    __syncthreads();
}
}
#if defined(__HIP_DEVICE_COMPILE__)
typedef const __attribute__((address_space(4))) Ptrs* KArgs;
__device__ __forceinline__ const Ptrs* get_args() { KArgs p = (KArgs)__builtin_amdgcn_kernarg_segment_ptr(); asm volatile("" : "+s"(p)); return (const Ptrs*)p; }
#else
__device__ __forceinline__ const Ptrs* get_args() { return nullptr; }
#endif
#define DUP(bit, ...) do { if (MK_DUP & (1 << (bit))) { __VA_ARGS__; GRID_BAR(); } } while (0)
__global__ void __launch_bounds__(NTHREADS, 2) hybrid_fwd(Ptrs Pbyval) {
    extern __shared__ __attribute__((aligned(16))) unsigned char lds_raw[];
    LAS unsigned char* lds = (LAS unsigned char*)lds_raw;
    volatile LAS unsigned* MISC = (volatile LAS unsigned*)(lds + MISC_OFF);
    const int tid0 = threadIdx.x; const int wave_s = __builtin_amdgcn_readfirstlane(tid0 >> 6);
#define FRESH_IDS() const Ptrs P = *get_args(); unsigned char* ws = P.ws; gu32* ctl = (gu32*)(ws + WS_CTL); float* MOD = (float*)(ws + WS_MOD); bf16* Hb = (bf16*)(ws + WS_H); (void)ctl; (void)MOD; (void)Hb; int tid; asm volatile("v_mbcnt_lo_u32_b32 %0, -1, 0\n\tv_mbcnt_hi_u32_b32 %0, -1, %0\n\tv_lshl_or_b32 %0, %1, 6, %0" : "=&v"(tid) : "s"(wave_s)); const int lane = tid & 63; const int wave = __builtin_amdgcn_readfirstlane(tid >> 6); (void)lane; (void)wave
    const int G = gridDim.x; const int bx = blockIdx.x; const int vcu = (G % 8 == 0) ? (bx % 8) * (G / 8) + bx / 8 : bx;
    for (int u = tid0; u < (LDS_BYTES - LDSCTL_OFF) / 4; u += NTHREADS) ((LAS unsigned*)(lds + LDSCTL_OFF))[u] = 0u;
    __syncthreads();
    XcdBarrier bar = xcd_barrier_post((unsigned*)((gu32*)(Pbyval.ws + WS_CTL) + CW_BAR), MISC + 8);
#define GRID_BAR() xcd_barrier(bar)

#define PH_PROLOGUE() do { FRESH_IDS(); p0_prologue(P, lds, tid, lane, wave, vcu, G); } while (0)
#define PH_NORM1_L0() do { FRESH_IDS(); norm_phase<true, false, 1>(P.x, P.g_mix, MOD, 0, 1, Hb, (unsigned char*)Hb, P.fox_w_in, P.fox_b_f, (float*)(ws + WS_LOGF), lds, tid, lane, wave, vcu, G); } while (0)
#define PH_NORM1_L1() do { FRESH_IDS(); norm_phase<false, true, 2>((const bf16*)(ws + WS_XB), P.g_mix + D, MOD + (size_t)2 * 6144, 0, 1, Hb, ws + WS_H8, nullptr, nullptr, nullptr, lds, tid, lane, wave, vcu, G); } while (0)
#define PH_NORM2(layer) do { FRESH_IDS(); norm_phase<false, true, 1>((const bf16*)(ws + WS_XB), P.g_ffn + layer * D, MOD + (size_t)layer * 2 * 6144, 3, 4, Hb, (unsigned char*)Hb, nullptr, nullptr, nullptr, lds, tid, lane, wave, vcu, G); } while (0)
#define PH_QKV() do { \
        { FRESH_IDS(); for (int seq = bx; seq < 32; seq += G) fox_scan((const float*)(ws + WS_LOGF), (float*)(ws + WS_BETA), ws + WS_KE, seq, (LAS float*)(lds + RING_OFF), tid, lane, wave); } \
        { FRESH_IDS(); \
            pg8::Gemm g{Hb, (const bf16*)(ws + WS_WFIN), M, 3 * D, D / 2, D / 2, D / 2, 0x7f7f7f7f, 0x7a7a7a7a}; pg8::StaticOrder S; S.init(M, 3 * D, G, bx); \
            pg8::EpiHeads E{}; E.ntens = 3; \
            E.base[0] = (bf16*)(ws + WS_Q); E.tile0[0] = 0; E.ldc[0] = D; E.kind[0] = 1; E.gain[0] = P.fox_g_q; E.scale[0] = attn_body::C2; \
            E.base[1] = (bf16*)(ws + WS_K); E.tile0[1] = 4; E.ldc[1] = D; E.kind[1] = 1; E.gain[1] = P.fox_g_k; E.scale[1] = 1.f; \
            E.base[2] = (bf16*)(ws + WS_V); E.tile0[2] = 8; E.ldc[2] = D; E.kind[2] = 0; E.gain[2] = P.fox_g_k; E.scale[2] = 1.f; \
            E.base[3] = E.base[2]; E.tile0[3] = 1 << 30; E.ldc[3] = D; E.kind[3] = 0; E.gain[3] = P.fox_g_k; E.scale[3] = 1.f; \
            pg8::gemm_phase<pg8::EpiHeads, pg8::StaticOrder, true, true, true>(lds + RING_OFF, g, S, E, tid); } } while (0)
#define PH_FOXATTN(qword) do { FRESH_IDS(); \
            float qkmax; \
            { const float gq = wave_max(fabsf(P.fox_g_q[lane])), gk = wave_max(fabsf(P.fox_g_k[lane])); qkmax = 64.f * attn_body::C2 * gq * gk * 1.02f + 0.5f; } \
            for (;;) { \
                if (tid == 0) MISC[16] = __hip_atomic_fetch_add(ctl + (qword), 1u, RLX_AGENT); \
                __syncthreads(); \
                const int id = (int)MISC[16]; \
                __syncthreads(); \
                if (id >= 32 * 32) break; \
                const int qb = 31 - (id >> 5), bh = id & 31; \
                attn_body::attn_unit<8>(bh >> 4, bh & 15, qb, (const attn_body::bf16*)(ws + WS_Q), (const attn_body::bf16*)(ws + WS_K), (const attn_body::bf16*)(ws + WS_V), \
                                        (attn_body::bf16*)(ws + WS_O), (const attn_body::bf16*)(ws + WS_KE), (const float*)(ws + WS_BETA), qkmax, (char*)lds_raw + RING_OFF, tid); \
            } } while (0)
#define PH_OUTPROJ(layer, OBUF, WBUF) do { FRESH_IDS(); \
            pg8::Gemm g{(const bf16*)(ws + (OBUF)), (const bf16*)(ws + (WBUF)), M, D, D / 2, D / 2, D / 2, 0x7a7a7a7a, 0x7a7a7a7a}; pg8::StaticOrder S; S.init(M, D, G, bx); \
              \
            if (layer == 0) { if (S.nwg <= G) { pg8::EpiResNormStaged<false, 1> E{P.x, ws + WS_XB, MOD + 2 * D, 6144, T, P.g_ffn, MOD, 3, 4, Hb, (unsigned char*)Hb, (float*)(ws + WS_XS), (unsigned*)(ctl + CW_NS), lds + HALO_OFF}; \
                    pg8::gemm_phase<pg8::EpiResNormStaged<false, 1>, pg8::StaticOrder, true, true, true>(lds + RING_OFF, g, S, E, tid); } \
                else { pg8::EpiRes<false, true> E{P.x, ws + WS_XB, MOD + 2 * D, 6144, T}; pg8::gemm_phase<pg8::EpiRes<false, true>, pg8::StaticOrder, true, true, true>(lds + RING_OFF, g, S, E, tid); } } \
            else { if (S.nwg <= G) { pg8::EpiResNormStaged<true, 1> E{ws + WS_XB, ws + WS_XB, MOD + (size_t)2 * 6144 + 2 * D, 6144, T, P.g_ffn + D, MOD + (size_t)2 * 6144, 3, 4, Hb, (unsigned char*)Hb, (float*)(ws + WS_XS) + (size_t)2 * M * 4, (unsigned*)(ctl + CW_NS + 2048), lds + HALO_OFF}; \
                    pg8::gemm_phase<pg8::EpiResNormStaged<true, 1>, pg8::StaticOrder, true, true, true>(lds + RING_OFF, g, S, E, tid); } \
                else { pg8::EpiRes<true, true> E{ws + WS_XB, ws + WS_XB, MOD + (size_t)2 * 6144 + 2 * D, 6144, T}; pg8::gemm_phase<pg8::EpiRes<true, true>, pg8::StaticOrder, true, true, true>(lds + RING_OFF, g, S, E, tid); } } } while (0)
#define PH_UP(layer) do { FRESH_IDS(); \
            pg8::Gemm g{Hb, (const bf16*)(ws + (layer == 0 ? WS_WUP0 : WS_WUP1)), M, FF2, D / 2, D / 2, D / 2, 0x7f7f7f7f, 0x7a7a7a7a}; pg8::StaticOrder S; S.init(M, FF2, G, bx); \
            pg8::EpiConvGate E{(bf16*)(ws + WS_U), P.ffn_conv_w + (size_t)layer * 3 * FF, P.ffn_conv_b + (size_t)layer * FF, (float*)(ws + WS_SA0), (float*)(ws + WS_SG0), (float*)(ws + WS_SA1), (LAS float*)(lds + HALO_OFF), lds + RING_OFF + 3 * 16384  }; \
            pg8::gemm_phase<pg8::EpiConvGate, pg8::StaticOrder, true, true, true>(lds + RING_OFF, g, S, E, tid); } while (0)
#define PH_DOWN(layer) do { FRESH_IDS(); \
            pg8::Gemm g{(const bf16*)(ws + WS_U), (const bf16*)(ws + (layer == 0 ? WS_WDN0 : WS_WDN1)), M, D, FF / 2, FF / 2, FF / 2, 0x7f7f7f7f, 0x79797979}; pg8::StaticOrder S; S.init(M, D, G, bx); \
            { pg8::Unit u0; for (int i_ = 0; S.next(i_, u0); ++i_) conv_fixup((bf16*)(ws + WS_U), (const float*)(ws + WS_SA0), (const float*)(ws + WS_SG0), (const float*)(ws + WS_SA1), P.ffn_conv_w + (size_t)layer * 3 * FF, P.ffn_conv_b + (size_t)layer * FF, u0.pm, tid); } \
            if (layer == 0) { if (S.nwg <= G) { pg8::EpiResNormStaged<true, 2> E{ws + WS_XB, ws + WS_XB, MOD + 5 * D, 6144, T, P.g_mix + D, MOD + (size_t)2 * 6144, 0, 1, Hb, ws + WS_H8, (float*)(ws + WS_XS) + (size_t)M * 4, (unsigned*)(ctl + CW_NS + 1024), lds + HALO_OFF}; \
                    pg8::gemm_phase<pg8::EpiResNormStaged<true, 2>, pg8::StaticOrder, true, true, true>(lds + RING_OFF, g, S, E, tid); } \
                else { pg8::EpiRes<true, true> E{ws + WS_XB, ws + WS_XB, MOD + 5 * D, 6144, T}; pg8::gemm_phase<pg8::EpiRes<true, true>, pg8::StaticOrder, true, true, true>(lds + RING_OFF, g, S, E, tid); } } \
            else { if (S.nwg <= G) { pg8::EpiResStaged<true, false> E{ws + WS_XB, P.out, MOD + (size_t)2 * 6144 + 5 * D, 6144, T}; pg8::gemm_phase<pg8::EpiResStaged<true, false>, pg8::StaticOrder, true, true, true>(lds + RING_OFF, g, S, E, tid); } \
                else { pg8::EpiRes<true, false> E{ws + WS_XB, P.out, MOD + (size_t)2 * 6144 + 5 * D, 6144, T}; pg8::gemm_phase<pg8::EpiRes<true, false>, pg8::StaticOrder, true, true, true>(lds + RING_OFF, g, S, E, tid); } } } while (0)
#define PH_DSAIN() do { FRESH_IDS(); \
              \
            if (G % 16 != 0) dsa::tail_phase(Hb, (const bf16*)(ws + WS_WDTAIL), P.dsa_g_kidx, (bf16*)(ws + WS_KI), (float*)(ws + WS_WI), lane, vcu * NWAVES + wave, G * NWAVES); \
            else if (bx < G / 2) dsa::tail_phase(Hb, (const bf16*)(ws + WS_WDTAIL), P.dsa_g_kidx, (bf16*)(ws + WS_KI), (float*)(ws + WS_WI), lane, bx * NWAVES + wave, (G / 2) * NWAVES); \
              \
            { pg8::Gemm g{(const bf16*)(ws + WS_H8), (const bf16*)(ws + WS_WDIN), M, 3 * D / 2, D / 2, D / 2, D / 2, 0x7f7f7f7f, 0x7a7a7a7a}; pg8::StaticOrder S; S.init(M, 3 * D / 2, G, bx); \
              pg8::EpiHeads E{}; E.ntens = 3; \
              E.base[0] = (bf16*)(ws + WS_Q1); E.tile0[0] = 0; E.ldc[0] = D; E.kind[0] = 1; E.gain[0] = P.dsa_g_q; E.scale[0] = attn_body::C2; \
              E.base[1] = (bf16*)(ws + WS_K1); E.tile0[1] = 4; E.ldc[1] = 256; E.kind[1] = 1; E.gain[1] = P.dsa_g_k; E.scale[1] = 1.f; E.f8[1] = 1; \
              E.base[2] = (bf16*)(ws + WS_V1); E.tile0[2] = 5; E.ldc[2] = 256; E.kind[2] = 0; E.gain[2] = P.dsa_g_k; E.scale[2] = 1.f; E.f8[2] = 1; \
              E.base[3] = E.base[2]; E.tile0[3] = 1 << 30; E.ldc[3] = 256; E.kind[3] = 0; E.gain[3] = P.dsa_g_k; E.scale[3] = 1.f; \
              pg8::gemm_phase<pg8::EpiHeads, pg8::StaticOrder, true, true, true>(lds + RING_OFF, g, S, E, tid); } \
            { FRESH_IDS(); pg8::Gemm g{Hb, (const bf16*)(ws + WS_WDIN + 2 * MiB), M, D / 2, D, D, D, 0, 0}; pg8::StaticOrder S; S.init(M, D / 2, G, (G % 16 == 0) ? (bx + G / 2) % G : bx); \
              pg8::EpiHeads E{}; E.ntens = 1; \
              E.base[0] = (bf16*)(ws + WS_QI); E.tile0[0] = 0; E.ldc[0] = 512; E.kind[0] = 0; E.gain[0] = P.dsa_g_k; E.scale[0] = 1.f; \
              for (int i_ = 1; i_ < 4; ++i_) { E.base[i_] = E.base[0]; E.tile0[i_] = 1 << 30; E.ldc[i_] = 512; E.kind[i_] = 0; E.gain[i_] = P.dsa_g_k; E.scale[i_] = 1.f; } \
              pg8::gemm_phase<pg8::EpiHeads, pg8::StaticOrder, true, true>(lds + RING_OFF, g, S, E, tid); } } while (0)
#define PH_DSAUNITS(qword) do { FRESH_IDS(); \
            int qb_ = (bx & 1), tries_ = 0;      \
            for (;;) { \
                if (tid == 0) MISC[16] = __hip_atomic_fetch_add(ctl + (qword) + 64 * qb_, 1u, RLX_AGENT); \
                __syncthreads(); \
                const int id = (int)MISC[16]; \
                __syncthreads(); \
                if (id >= T / dsa::QT) { if (++tries_ >= 2) break; qb_ ^= 1; continue; } \
                const int b = qb_, t0q = (T / dsa::QT - 1 - id) * dsa::QT; \
                dsa::unit(lds, b, t0q, (const bf16*)(ws + WS_Q1), (bf16*)(ws + WS_O1), (const unsigned char*)(ws + WS_K1), (const unsigned char*)(ws + WS_V1), (const bf16*)(ws + WS_QI), (const bf16*)(ws + WS_KI), (const float*)(ws + WS_WI), tid, wave); \
            } } while (0)

    const bool fusedn = (M / 256) * (D / 256) <= G;
    PH_PROLOGUE(); GRID_BAR();                       DUP(0, PH_PROLOGUE());
    PH_NORM1_L0(); GRID_BAR();                       DUP(1, PH_NORM1_L0());
    PH_QKV(); GRID_BAR();                            DUP(2, PH_QKV());
    PH_FOXATTN(CW_AQ); GRID_BAR();                   DUP(3, PH_FOXATTN(CW_AQ + 64));
    PH_OUTPROJ(0, WS_O, WS_WFOUT); GRID_BAR();       DUP(10, PH_OUTPROJ(0, WS_O, WS_WFOUT));
    if (!fusedn) { PH_NORM2(0); GRID_BAR(); }
    PH_UP(0); GRID_BAR();                            DUP(5, PH_UP(0));
    PH_DOWN(0); GRID_BAR();
    if (!fusedn) { PH_NORM1_L1(); GRID_BAR(); }
    PH_DSAIN(); GRID_BAR();                          DUP(6, PH_DSAIN());
    PH_DSAUNITS(CW_DQ); GRID_BAR();                  DUP(7, PH_DSAUNITS(CW_DQ + 128));
    PH_OUTPROJ(1, WS_O1, WS_WDOUT); GRID_BAR();
    if (!fusedn) { PH_NORM2(1); GRID_BAR(); }
    PH_UP(1); GRID_BAR();
    PH_DOWN(1);
    if (MK_DUP & 512) { GRID_BAR(); PH_DOWN(1); }
}

extern "C" void kernel_launch(void* const* d_in, const int* in_sizes, int n_in, void* d_out, int out_size, void* d_ws, size_t ws_size, hipStream_t stream) {
    static int grid = 0;
    if (grid == 0) {
        if (n_in != 20 || in_sizes[0] != M * D || out_size != M * D || ws_size < WS_END) { fprintf(stderr, "kernel_launch: unexpected problem (n_in %d, in0 %d, out %d, ws %zu); nothing launched\n", n_in, n_in > 0 ? in_sizes[0] : -1, out_size, ws_size); grid = -1; return; }
        int dev = 0, cus = 0, per_cu = 0;
        if (hipGetDevice(&dev) != hipSuccess || hipDeviceGetAttribute(&cus, hipDeviceAttributeMultiprocessorCount, dev) != hipSuccess) { grid = -1; return; }
        if (hipFuncSetAttribute((const void*)hybrid_fwd, hipFuncAttributeMaxDynamicSharedMemorySize, LDS_BYTES) != hipSuccess) { fprintf(stderr, "kernel_launch: hipFuncSetAttribute failed\n"); grid = -1; return; }
        if (hipOccupancyMaxActiveBlocksPerMultiprocessor(&per_cu, (const void*)hybrid_fwd, NTHREADS, LDS_BYTES) != hipSuccess || per_cu < 1)
            fprintf(stderr, "kernel_launch: note: occupancy query reports %d workgroups per CU\n", per_cu);
        (void)hipGetLastError();
        grid = cus;
    }
    if (grid < 0) return;
    if (hipMemsetAsync((char*)d_ws + WS_CTL, 0, CTL_ZERO_BYTES, stream) != hipSuccess) return;
    Ptrs p{};
    p.x = (const float*)d_in[0]; p.c = (const float*)d_in[1]; p.w_ada = (const float*)d_in[2]; p.b_ada = (const float*)d_in[3]; p.g_mix = (const float*)d_in[4]; p.g_ffn = (const float*)d_in[5];
    p.fox_w_in = (const float*)d_in[6]; p.fox_b_f = (const float*)d_in[7]; p.fox_g_q = (const float*)d_in[8]; p.fox_g_k = (const float*)d_in[9]; p.fox_w_out = (const float*)d_in[10];
    p.dsa_w_in = (const float*)d_in[11]; p.dsa_g_q = (const float*)d_in[12]; p.dsa_g_k = (const float*)d_in[13]; p.dsa_g_kidx = (const float*)d_in[14]; p.dsa_w_out = (const float*)d_in[15];
    p.ffn_w_up = (const float*)d_in[16]; p.ffn_conv_w = (const float*)d_in[17]; p.ffn_conv_b = (const float*)d_in[18]; p.ffn_w_down = (const float*)d_in[19];
    p.out = (float*)d_out; p.ws = (unsigned char*)d_ws;
    hipLaunchKernelGGL(hybrid_fwd, dim3(grid), dim3(NTHREADS), LDS_BYTES, stream, p);
}
```

```cpp
#include <hip/hip_runtime.h>
#include <cstdio>
#include <cstdint>
__device__ __forceinline__ float xsum16(float v) { const unsigned a = __builtin_bit_cast(unsigned, v); const auto r = __builtin_amdgcn_permlane16_swap(a, a, false, false); const unsigned r0 = r[0], r1 = r[1]; return __builtin_bit_cast(float, r0) + __builtin_bit_cast(float, r1); }
__device__ __forceinline__ float xsum32(float v) { const unsigned a = __builtin_bit_cast(unsigned, v); const auto r = __builtin_amdgcn_permlane32_swap(a, a, false, false); const unsigned r0 = r[0], r1 = r[1]; return __builtin_bit_cast(float, r0) + __builtin_bit_cast(float, r1); }
__device__ __forceinline__ float xmax16(float v) { const unsigned a = __builtin_bit_cast(unsigned, v); const auto r = __builtin_amdgcn_permlane16_swap(a, a, false, false); const unsigned r0 = r[0], r1 = r[1]; return fmaxf(__builtin_bit_cast(float, r0), __builtin_bit_cast(float, r1)); }
__device__ __forceinline__ float xmax32(float v) { const unsigned a = __builtin_bit_cast(unsigned, v); const auto r = __builtin_amdgcn_permlane32_swap(a, a, false, false); const unsigned r0 = r[0], r1 = r[1]; return fmaxf(__builtin_bit_cast(float, r0), __builtin_bit_cast(float, r1)); }
template <int CTRL> __device__ __forceinline__ float dppf(float v) { return __builtin_bit_cast(float, __builtin_amdgcn_update_dpp(0, __builtin_bit_cast(int, v), CTRL, 0xf, 0xf, true)); }
namespace pg8 {
#define PG8_LAS __attribute__((address_space(3)))
typedef unsigned short bf16_t;
typedef short bf16x8 __attribute__((ext_vector_type(8)));
typedef float f32x4 __attribute__((ext_vector_type(4)));
typedef unsigned u32x4 __attribute__((ext_vector_type(4)));
typedef int pg8_v8i __attribute__((ext_vector_type(8)));
typedef short pg8_bf16x16 __attribute__((ext_vector_type(16)));
constexpr int BM = 256, BK = 64, HALF = 128, HTB = HALF * BK * 2  , STAGE_BYTES = 8 * HTB, NXCD = 8, WGM = 4;

__host__ __device__ __forceinline__ int lds_byte(int r, int c) { const int st = (r >> 4) * 2 + (c >> 5), rr = r & 15, cc = c & 31, ob = rr * 64 + cc * 2; return st * 1024 + (ob ^ (((ob >> 9) & 1) << 5)); }
__host__ __device__ __forceinline__ void stage_rc(int b, int& R, int& C) { const int st = b / 1024, sb = b % 1024, swz = sb ^ (((sb >> 9) & 1) << 5); R = (st >> 1) * 16 + swz / 64; C = (st & 1) * 32 + (swz % 64) / 2; }
__host__ __device__ __forceinline__ int perm32(int rho) { const int n = rho >> 4, i = rho & 15; return 8 * (i >> 2) + 4 * n + (i & 3); }

struct Unit { int pm, pn; };
struct Gemm { const bf16_t* A; const bf16_t* Bt; int M, N, K, lda, ldb; int sa, sb; };

struct StaticOrder {
    int nM, nN, nwg, G, c;
    __host__ __device__ void init(int M, int N, int G_, int c_) { nM = M / BM; nN = N / BM; nwg = nM * nN; G = G_; c = c_; }
    __host__ __device__ __forceinline__ bool next(int i, Unit& u) const {
        const long L = (long)i * G + c; if (L >= nwg) return false;
        int wgid = (int)L; { const int q = nwg / NXCD, r = nwg % NXCD, xcd = wgid % NXCD, off = wgid / NXCD; wgid = (xcd < r ? xcd * (q + 1) : r * (q + 1) + (xcd - r) * q) + off; }
        const int nig = WGM * nN, gid = wgid / nig, fm = gid * WGM, gsz = (nM - fm) < WGM ? (nM - fm) : WGM;
        u.pm = fm + ((wgid % nig) % gsz); u.pn = ((wgid % nig) / gsz + 3 * (int)(L % NXCD)) % nN; return true;
    }
    __device__ __forceinline__ void a_ready(const Unit&) const {}
    __device__ __forceinline__ void done(const Unit&) const {}
};

__device__ __forceinline__ unsigned cvt_pk_bf16(float lo, float hi) { unsigned r; asm volatile("v_cvt_pk_bf16_f32 %0, %1, %2" : "=v"(r) : "v"(lo), "v"(hi)); return r; }
typedef float f32x2 __attribute__((ext_vector_type(2)));
struct EpiBf16 {
    static constexpr bool PERM = true, AFTER_DRAIN = false;
    bf16_t* O; int ldc;
    __device__ __forceinline__ void operator()(const f32x4 (&acc)[2][2][4][2], const Unit& u, int wr, int wc, int fr, int fq) const {
        const int row0 = u.pm * BM + wr * 64 + fr; const int col0 = u.pn * BM + wc * 32 + 8 * fq;
#pragma unroll
        for (int ai = 0; ai < 2; ++ai)
#pragma unroll
            for (int m = 0; m < 4; ++m) { bf16_t* rowp = O + (size_t)(row0 + ai * HALF + m * 16) * ldc + col0;
#pragma unroll
                for (int bj = 0; bj < 2; ++bj) { const f32x4 v0 = acc[ai][bj][m][0], v1 = acc[ai][bj][m][1];
                    u32x4 w; w.x = cvt_pk_bf16(v0[0], v0[1]); w.y = cvt_pk_bf16(v0[2], v0[3]); w.z = cvt_pk_bf16(v1[0], v1[1]); w.w = cvt_pk_bf16(v1[2], v1[3]);
                    *(u32x4*)(rowp + bj * HALF) = w; } }
    }
};
struct EpiHeads {
    static constexpr bool PERM = true, AFTER_DRAIN = false;
    bf16_t* base[4]; int tile0[4]; int ldc[4]; int kind[4]; const float* gain[4]; float scale[4]; int f8[4];
    int ntens;
    __device__ __forceinline__ void operator()(const f32x4 (&acc)[2][2][4][2], const Unit& u, int wr, int wc, int fr, int fq) const {
        bf16_t* O = base[0]; int t0 = tile0[0], ld = ldc[0], kd = kind[0], o8 = f8[0]; const float* gn = gain[0]; float sc = scale[0];
#pragma unroll
        for (int i = 1; i < 4; ++i) if (i < ntens && u.pn >= tile0[i]) { O = base[i]; t0 = tile0[i]; ld = ldc[i]; kd = kind[i]; gn = gain[i]; sc = scale[i]; o8 = f8[i]; }
        const int head = (u.pn - t0) * 4 + wc; const int row0 = u.pm * BM + wr * 64 + fr;
        f32x4 gv[2][2];
#pragma unroll
        for (int bj = 0; bj < 2; ++bj)
#pragma unroll
            for (int n = 0; n < 2; ++n) gv[bj][n] = (kd == 1) ? *(const f32x4*)(gn + 32 * bj + 8 * fq + 4 * n) * sc : (f32x4){sc, sc, sc, sc};
#pragma unroll
        for (int ai = 0; ai < 2; ++ai)
#pragma unroll
            for (int m = 0; m < 4; ++m) {
                float rs = 1.f;
                if (kd == 1) { float ss = 0.f;
#pragma unroll
                    for (int bj = 0; bj < 2; ++bj)
#pragma unroll
                        for (int n = 0; n < 2; ++n) { const f32x4 x = acc[ai][bj][m][n]; ss += (x[0] * x[0] + x[1] * x[1]) + (x[2] * x[2] + x[3] * x[3]); }
                    ss = xsum32(xsum16(ss));
                    rs = __builtin_amdgcn_rsqf(ss * (1.0f / 64.0f) + 1e-6f); }
                if (o8) {
                    unsigned char* rowb = (unsigned char*)O + (size_t)(row0 + ai * HALF + m * 16) * ld + head * 64 + 8 * fq;
#pragma unroll
                    for (int bj = 0; bj < 2; ++bj) { const f32x4 v0 = acc[ai][bj][m][0] * rs * gv[bj][0], v1 = acc[ai][bj][m][1] * rs * gv[bj][1];
                        int w0 = 0, w1 = 0; w0 = __builtin_amdgcn_cvt_pk_fp8_f32(v0[0], v0[1], w0, false); w0 = __builtin_amdgcn_cvt_pk_fp8_f32(v0[2], v0[3], w0, true);
                        w1 = __builtin_amdgcn_cvt_pk_fp8_f32(v1[0], v1[1], w1, false); w1 = __builtin_amdgcn_cvt_pk_fp8_f32(v1[2], v1[3], w1, true);
                        typedef unsigned u32x2 __attribute__((ext_vector_type(2))); *(u32x2*)(rowb + bj * 32) = (u32x2){(unsigned)w0, (unsigned)w1}; }
                } else {
                bf16_t* rowp = O + (size_t)(row0 + ai * HALF + m * 16) * ld + head * 64 + 8 * fq;
#pragma unroll
                for (int bj = 0; bj < 2; ++bj) { const f32x4 v0 = acc[ai][bj][m][0] * rs * gv[bj][0], v1 = acc[ai][bj][m][1] * rs * gv[bj][1];
                    u32x4 w; w.x = cvt_pk_bf16(v0[0], v0[1]); w.y = cvt_pk_bf16(v0[2], v0[3]); w.z = cvt_pk_bf16(v1[0], v1[1]); w.w = cvt_pk_bf16(v1[2], v1[3]);
                    *(u32x4*)(rowp + bj * 32) = w; } } }
    }
};
template <bool BIN16, bool BOUT16>
struct EpiRes {
    static constexpr bool PERM = false, AFTER_DRAIN = false;
    const void* base; void* out; const float* gate; int gate_bstride; int rows_per_batch;
    __device__ __forceinline__ void operator()(const f32x4 (&acc)[2][2][4][2], const Unit& u, int wr, int wc, int fr, int fq) const {
        typedef unsigned u32x2 __attribute__((ext_vector_type(2)));
        const int col0 = u.pn * BM + wc * 32 + 4 * fq; const int b = (u.pm * BM) / rows_per_batch;
        f32x4 gv[2][2];
#pragma unroll
        for (int bj = 0; bj < 2; ++bj)
#pragma unroll
            for (int n = 0; n < 2; ++n) gv[bj][n] = *(const f32x4*)(gate + (size_t)b * gate_bstride + col0 + bj * HALF + n * 16);
#pragma unroll
        for (int ai = 0; ai < 2; ++ai)
#pragma unroll
            for (int m = 0; m < 4; ++m) { const size_t off = (size_t)(u.pm * BM + ai * HALF + wr * 64 + m * 16 + fr) * 1024 + col0;
#pragma unroll
                for (int bj = 0; bj < 2; ++bj)
#pragma unroll
                    for (int n = 0; n < 2; ++n) { const size_t o2 = off + bj * HALF + n * 16; f32x4 bs;
                        if (BIN16) { const u32x2 r = *(const u32x2*)((const bf16_t*)base + o2); bs = (f32x4){__uint_as_float(r.x << 16), __uint_as_float(r.x & 0xffff0000u), __uint_as_float(r.y << 16), __uint_as_float(r.y & 0xffff0000u)}; }
                        else bs = *(const f32x4*)((const float*)base + o2);
                        const f32x4 v = bs + gv[bj][n] * acc[ai][bj][m][n];
                        if (BOUT16) *(u32x2*)((bf16_t*)out + o2) = (u32x2){cvt_pk_bf16(v[0], v[1]), cvt_pk_bf16(v[2], v[3])};
                        else *(f32x4*)((float*)out + o2) = v; }
                if (m & 1) asm volatile("" ::: "memory"); }
    }
};
template <bool BIN16, bool BOUT16>
struct EpiResStaged {
    static constexpr bool PERM = false, AFTER_DRAIN = true;
    const void* base; void* out; const float* gate; int gate_bstride; int rows_per_batch;
    __device__ __forceinline__ void operator()(const f32x4 (&)[2][2][4][2], const Unit&, int, int, int, int) const {}
    __device__ __forceinline__ void fused(const f32x4 (&acc)[2][2][4][2], const Unit& u, int wr, int wc, int fr_in, int fq_in, PG8_LAS unsigned char* img, int wid, int lane_in) const {
        int fr = fr_in, fq = fq_in, lane = lane_in; asm volatile("" : "+v"(fr), "+v"(fq), "+v"(lane));
        const int col0 = u.pn * BM + wc * 32 + 4 * fq; const int b = (u.pm * BM) / rows_per_batch;
        f32x4 gv[2][2];
#pragma unroll
        for (int bj = 0; bj < 2; ++bj)
#pragma unroll
            for (int n = 0; n < 2; ++n) gv[bj][n] = *(const f32x4*)(gate + (size_t)b * gate_bstride + col0 + bj * HALF + n * 16);
#pragma unroll
        for (int ai = 0; ai < 2; ++ai) {
            u32x4 bs16[8]; f32x4 bs32[BIN16 ? 1 : 8][2];
#pragma unroll
            for (int rnd = 0; rnd < 8; ++rnd) { const int q = rnd * 512 + wid * 64 + lane, row = q >> 5, c8 = q & 31; const size_t o = (size_t)(u.pm * BM + ai * HALF + row) * 1024 + u.pn * BM + 8 * c8;
                if constexpr (BIN16) bs16[rnd] = *(const u32x4*)((const bf16_t*)base + o);
                else { bs32[rnd][0] = *(const f32x4*)((const float*)base + o); bs32[rnd][1] = *(const f32x4*)((const float*)base + o + 4); } }
#pragma unroll
            for (int bj = 0; bj < 2; ++bj)
#pragma unroll
                for (int m = 0; m < 4; ++m)
#pragma unroll
                    for (int n = 0; n < 2; ++n) { const int hrow = wr * 64 + m * 16 + fr, chunk = (bj * HALF + wc * 32 + n * 16 + 4 * fq) >> 2;
                        *(PG8_LAS f32x4*)(img + hrow * 1024 + ((chunk ^ ((hrow & 15) << 2)) << 4)) = gv[bj][n] * acc[ai][bj][m][n]; }
            asm volatile("s_waitcnt lgkmcnt(0)" ::: "memory"); __builtin_amdgcn_s_barrier(); asm volatile("" ::: "memory");
#pragma unroll
            for (int rnd = 0; rnd < 8; ++rnd) { const int q = rnd * 512 + wid * 64 + lane, row = q >> 5, c8 = q & 31; const size_t o = (size_t)(u.pm * BM + ai * HALF + row) * 1024 + u.pn * BM + 8 * c8;
                const PG8_LAS unsigned char* ip = img + row * 1024 + (((2 * c8) ^ ((row & 15) << 2)) << 4);
                const f32x4 g0 = *(const PG8_LAS f32x4*)ip, g1 = *(const PG8_LAS f32x4*)(ip + 16);
                f32x4 b0, b1;
                if constexpr (BIN16) { const u32x4 r = bs16[rnd];
                    b0 = (f32x4){__uint_as_float(r.x << 16), __uint_as_float(r.x & 0xffff0000u), __uint_as_float(r.y << 16), __uint_as_float(r.y & 0xffff0000u)};
                    b1 = (f32x4){__uint_as_float(r.z << 16), __uint_as_float(r.z & 0xffff0000u), __uint_as_float(r.w << 16), __uint_as_float(r.w & 0xffff0000u)}; }
                else { b0 = bs32[rnd][0]; b1 = bs32[rnd][1]; }
                const f32x4 v0 = b0 + g0, v1 = b1 + g1;
                if constexpr (BOUT16) *(u32x4*)((bf16_t*)out + o) = (u32x4){cvt_pk_bf16(v0[0], v0[1]), cvt_pk_bf16(v0[2], v0[3]), cvt_pk_bf16(v1[0], v1[1]), cvt_pk_bf16(v1[2], v1[3])};
                else { *(f32x4*)((float*)out + o) = v0; *(f32x4*)((float*)out + o + 4) = v1; } }
            if (ai == 0) { asm volatile("s_waitcnt lgkmcnt(0)" ::: "memory"); __builtin_amdgcn_s_barrier(); asm volatile("" ::: "memory"); }
        }
    }
};
template <bool BIN16, int HMODE>
struct EpiResNormStaged {
    static constexpr bool PERM = false, AFTER_DRAIN = true;
    const void* base; void* out; const float* gate; int gate_bstride; int rows_per_batch;
    const float* gnorm; const float* modL; int sh_chunk, sc_chunk; bf16_t* hout; unsigned char* hout8; float* xslots; unsigned* cnt; PG8_LAS unsigned char* tbl;
    __device__ __forceinline__ void operator()(const f32x4 (&)[2][2][4][2], const Unit&, int, int, int, int) const {}
    __device__ __forceinline__ void fused(const f32x4 (&acc)[2][2][4][2], const Unit& u, int wr, int wc, int fr_in, int fq_in, PG8_LAS unsigned char* img, int wid, int lane_in) const {
        int fr = fr_in, fq = fq_in, lane = lane_in; asm volatile("" : "+v"(fr), "+v"(fq), "+v"(lane));
        const int col0 = u.pn * BM + wc * 32 + 4 * fq; const int b = (u.pm * BM) / rows_per_batch;
        PG8_LAS float* Pt = (PG8_LAS float*)tbl; PG8_LAS float* St = (PG8_LAS float*)(tbl + 1024); PG8_LAS unsigned* flag = (PG8_LAS unsigned*)(tbl + 2048);
        f32x4 gv[2][2];
#pragma unroll
        for (int bj = 0; bj < 2; ++bj)
#pragma unroll
            for (int n = 0; n < 2; ++n) gv[bj][n] = *(const f32x4*)(gate + (size_t)b * gate_bstride + col0 + bj * HALF + n * 16);
        constexpr bool KEEP = BIN16;
        u32x4 wk[KEEP ? 8 : 1];
#pragma unroll
        for (int ai = 0; ai < 2; ++ai) {
            u32x4 bs16[8]; f32x4 bs32[BIN16 ? 1 : 8][2];
#pragma unroll
            for (int rnd = 0; rnd < 8; ++rnd) { const int q = rnd * 512 + wid * 64 + lane, row = q >> 5, c8 = q & 31; const size_t o = (size_t)(u.pm * BM + ai * HALF + row) * 1024 + u.pn * BM + 8 * c8;
                if constexpr (BIN16) bs16[rnd] = *(const u32x4*)((const bf16_t*)base + o);
                else { bs32[rnd][0] = *(const f32x4*)((const float*)base + o); bs32[rnd][1] = *(const f32x4*)((const float*)base + o + 4); } }
#pragma unroll
            for (int bj = 0; bj < 2; ++bj)
#pragma unroll
                for (int m = 0; m < 4; ++m)
#pragma unroll
                    for (int n = 0; n < 2; ++n) { const int hrow = wr * 64 + m * 16 + fr, chunk = (bj * HALF + wc * 32 + n * 16 + 4 * fq) >> 2;
                        *(PG8_LAS f32x4*)(img + hrow * 1024 + ((chunk ^ ((hrow & 15) << 2)) << 4)) = gv[bj][n] * acc[ai][bj][m][n]; }
            asm volatile("s_waitcnt lgkmcnt(0)" ::: "memory"); __builtin_amdgcn_s_barrier(); asm volatile("" ::: "memory");
#pragma unroll
            for (int rnd = 0; rnd < 8; ++rnd) { const int q = rnd * 512 + wid * 64 + lane, row = q >> 5, c8 = q & 31; const size_t o = (size_t)(u.pm * BM + ai * HALF + row) * 1024 + u.pn * BM + 8 * c8;
                const PG8_LAS unsigned char* ip = img + row * 1024 + (((2 * c8) ^ ((row & 15) << 2)) << 4);
                const f32x4 g0 = *(const PG8_LAS f32x4*)ip, g1 = *(const PG8_LAS f32x4*)(ip + 16);
                f32x4 b0, b1;
                if constexpr (BIN16) { const u32x4 r = bs16[rnd];
                    b0 = (f32x4){__uint_as_float(r.x << 16), __uint_as_float(r.x & 0xffff0000u), __uint_as_float(r.y << 16), __uint_as_float(r.y & 0xffff0000u)};
                    b1 = (f32x4){__uint_as_float(r.z << 16), __uint_as_float(r.z & 0xffff0000u), __uint_as_float(r.w << 16), __uint_as_float(r.w & 0xffff0000u)}; }
                else { b0 = bs32[rnd][0]; b1 = bs32[rnd][1]; }
                const f32x4 v0 = b0 + g0, v1 = b1 + g1;
                const u32x4 w = (u32x4){cvt_pk_bf16(v0[0], v0[1]), cvt_pk_bf16(v0[2], v0[3]), cvt_pk_bf16(v1[0], v1[1]), cvt_pk_bf16(v1[2], v1[3])};
                *(u32x4*)((bf16_t*)out + o) = w; if constexpr (KEEP) { if (ai == 1) wk[rnd] = w; }
                float ss = 0.f;
#pragma unroll
                for (int k = 0; k < 4; ++k) { const float lo = __uint_as_float(w[k] << 16), hi = __uint_as_float(w[k] & 0xffff0000u); ss += lo * lo + hi * hi; }
                ss += dppf<0xB1>(ss); ss += dppf<0x4E>(ss); ss += dppf<0x141>(ss); ss += dppf<0x140>(ss); ss = xsum16(ss);
                if (c8 == 0) Pt[ai * HALF + row] = ss; }
            asm volatile("s_waitcnt lgkmcnt(0)" ::: "memory"); __builtin_amdgcn_s_barrier(); asm volatile("" ::: "memory");
        }
        const int c8n = lane & 31; const int gcol = u.pn * BM + 8 * c8n;
        f32x4 G0, G1, S0, S1;
        { const f32x4 g0 = *(const f32x4*)(gnorm + gcol), g1 = *(const f32x4*)(gnorm + gcol + 4);
          const f32x4 c0 = *(const f32x4*)(modL + (size_t)b * 6144 + sc_chunk * 1024 + gcol), c1 = *(const f32x4*)(modL + (size_t)b * 6144 + sc_chunk * 1024 + gcol + 4);
          G0 = g0 * (c0 + 1.0f); G1 = g1 * (c1 + 1.0f); S0 = *(const f32x4*)(modL + (size_t)b * 6144 + sh_chunk * 1024 + gcol); S1 = *(const f32x4*)(modL + (size_t)b * 6144 + sh_chunk * 1024 + gcol + 4); }
        const int trow = wid * 32 + (lane & 31);
        if (lane < 32) __hip_atomic_store(xslots + ((size_t)(u.pm * BM + trow) * 4 + u.pn), Pt[trow], __ATOMIC_RELAXED, __HIP_MEMORY_SCOPE_AGENT);
        asm volatile("s_waitcnt vmcnt(0)" ::: "memory");
        if (lane == 0) __hip_atomic_fetch_add(cnt + 16 * u.pm, 1u, __ATOMIC_RELAXED, __HIP_MEMORY_SCOPE_AGENT);
        if (wid == 0) {
            unsigned sp = 0u;
            while ((unsigned)__builtin_amdgcn_readfirstlane(__hip_atomic_load(cnt + 16 * u.pm, __ATOMIC_RELAXED, __HIP_MEMORY_SCOPE_AGENT)) < 32u) { __builtin_amdgcn_s_sleep(1); if (++sp > (1u << 22)) break; }
            __builtin_amdgcn_fence(__ATOMIC_ACQUIRE, "agent");
            if (lane == 0) flag[0] = sp;
        }
        asm volatile("s_waitcnt vmcnt(0) lgkmcnt(0)" ::: "memory"); __builtin_amdgcn_s_barrier(); asm volatile("" ::: "memory");
        if (lane < 32) { const float* sl = xslots + (size_t)(u.pm * BM + trow) * 4; float t = 0.f;
#pragma unroll
            for (int k = 0; k < 4; ++k) t += __hip_atomic_load(sl + k, __ATOMIC_RELAXED, __HIP_MEMORY_SCOPE_AGENT);
            St[trow] = __builtin_amdgcn_rsqf(t * (1.0f / 1024.0f) + 1e-6f); }
        asm volatile("s_waitcnt lgkmcnt(0)" ::: "memory"); __builtin_amdgcn_s_barrier(); asm volatile("" ::: "memory");
#pragma unroll
        for (int hf = 0; hf < 2; ++hf) {
            u32x4 xr[8];
            if (!KEEP || hf == 0) {
#pragma unroll
                for (int rnd = 0; rnd < 8; ++rnd) { const int q = rnd * 512 + wid * 64 + lane, row = q >> 5; xr[rnd] = *(const u32x4*)((const bf16_t*)out + (size_t)(u.pm * BM + hf * HALF + row) * 1024 + gcol); } }
#pragma unroll
            for (int rnd = 0; rnd < 8; ++rnd) { const int q = rnd * 512 + wid * 64 + lane, row = q >> 5; const size_t o = (size_t)(u.pm * BM + hf * HALF + row) * 1024 + gcol;
                const float rs = St[hf * HALF + row]; u32x4 r; if (KEEP && hf == 1) r = wk[KEEP ? rnd : 0]; else r = xr[rnd];
                const f32x4 x0 = (f32x4){__uint_as_float(r.x << 16), __uint_as_float(r.x & 0xffff0000u), __uint_as_float(r.y << 16), __uint_as_float(r.y & 0xffff0000u)};
                const f32x4 x1 = (f32x4){__uint_as_float(r.z << 16), __uint_as_float(r.z & 0xffff0000u), __uint_as_float(r.w << 16), __uint_as_float(r.w & 0xffff0000u)};
                const f32x4 h0 = x0 * rs * G0 + S0, h1 = x1 * rs * G1 + S1;
                int w0 = 0, w1 = 0; w0 = __builtin_amdgcn_cvt_pk_fp8_f32(h0[0], h0[1], w0, false); w0 = __builtin_amdgcn_cvt_pk_fp8_f32(h0[2], h0[3], w0, true);
                w1 = __builtin_amdgcn_cvt_pk_fp8_f32(h1[0], h1[1], w1, false); w1 = __builtin_amdgcn_cvt_pk_fp8_f32(h1[2], h1[3], w1, true);
                typedef unsigned u32x2 __attribute__((ext_vector_type(2)));
                *(u32x2*)(hout8 + o) = (u32x2){(unsigned)w0, (unsigned)w1};
                if constexpr (HMODE == 2) *(u32x4*)(hout + o) = (u32x4){cvt_pk_bf16(h0[0], h0[1]), cvt_pk_bf16(h0[2], h0[3]), cvt_pk_bf16(h1[0], h1[1]), cvt_pk_bf16(h1[2], h1[3])}; }
        }
    }
};
struct EpiConvGate {
    static constexpr bool PERM = true, AFTER_DRAIN = false;
    bf16_t* U; const float* cw; const float* cb; float* sideA0; float* sideG0; float* sideA1; PG8_LAS float* halo; PG8_LAS unsigned char* stage;
    __device__ __forceinline__ void operator()(const f32x4 (&acc)[2][2][4][2], const Unit& u, int wr, int wc, int fr_in, int fq_in) const {
        constexpr int FFc = 2816;
        int fr = fr_in, fq = fq_in; asm volatile("" : "+v"(fr), "+v"(fq));
        const int colt = u.pn * 128 + wc * 32 + 8 * fq;
        const int lcol = wc * 32 + 8 * fq;
        if (fr >= 14) {
#pragma unroll
            for (int ai = 0; ai < 2; ++ai)
#pragma unroll
                for (int n = 0; n < 2; ++n) *(PG8_LAS f32x4*)(halo + ((ai * 2 + wr) * 2 + (fr - 14)) * 128 + lcol + 4 * n) = acc[ai][0][3][n];
        }
        asm volatile("s_waitcnt lgkmcnt(0)" ::: "memory"); __builtin_amdgcn_s_barrier(); asm volatile("" ::: "memory");
        typedef float f32x2 __attribute__((ext_vector_type(2)));
#define CG_DPP(x, ctrl) __int_as_float(__builtin_amdgcn_update_dpp(0, __float_as_int(x), ctrl, 0xf, 0xf, true))
        const bool lane0 = (fr == 0), lane01 = (fr < 2);
        const int wid8 = wr * 4 + wc, lane64 = fq * 16 + fr;
#pragma unroll
        for (int ai = 0; ai < 2; ++ai) {
#pragma unroll
            for (int n = 0; n < 2; ++n) {
                const f32x4 w0 = *(const f32x4*)(cw + colt + 4 * n), w1 = *(const f32x4*)(cw + FFc + colt + 4 * n), w2 = *(const f32x4*)(cw + 2 * FFc + colt + 4 * n), bb = *(const f32x4*)(cb + colt + 4 * n);
                f32x4 w1b, w0b;
#pragma unroll
                for (int e4 = 0; e4 < 4; ++e4) { w1b[e4] = lane0 ? w1[e4] : 0.f; w0b[e4] = lane01 ? w0[e4] : 0.f; }
                const int pb = (wr == 1) ? (ai * 2) : ((ai == 1) ? 1 : 0); const int hr = (fr >= 14) ? (fr - 14) : 0;
                const f32x4 prv = *(const PG8_LAS f32x4*)(halo + (pb * 2 + hr) * 128 + lcol + 4 * n);
#pragma unroll
                for (int m = 0; m < 4; ++m) {
                    const f32x4 x = acc[ai][0][m][n], gt = acc[ai][1][m][n]; const f32x4 pv = (m == 0) ? prv : acc[ai][0][m - 1][n];
                    f32x4 sv;
#pragma unroll
                    for (int e4 = 0; e4 < 4; ++e4) {
                        float t = fmaf(w2[e4], x[e4], bb[e4]);
                        t = fmaf(CG_DPP(x[e4], 0x111), w1[e4], t);
                        t = fmaf(CG_DPP(pv[e4], 0x121), w1b[e4], t);
                        t = fmaf(CG_DPP(x[e4], 0x112), w0[e4], t);
                        t = fmaf(CG_DPP(pv[e4], 0x122), w0b[e4], t);
                        sv[e4] = t;
                    }
                    f32x4 uo;
#pragma unroll
                    for (int p = 0; p < 2; ++p) {
                        const f32x2 s2 = (f32x2){sv[2 * p], sv[2 * p + 1]}; const f32x2 g2 = (f32x2){gt[2 * p], gt[2 * p + 1]};
                        const f32x2 a2 = s2 * -1.4426950408889634f;
                        const f32x2 d2 = (f32x2){__builtin_amdgcn_exp2f(fminf(a2[0], 60.f)), __builtin_amdgcn_exp2f(fminf(a2[1], 60.f))} + 1.0f;
                        const float r = __builtin_amdgcn_rcpf(d2[0] * d2[1]);
                        const f32x2 inv = (f32x2){d2[1], d2[0]} * r;
                        const f32x2 u2 = (s2 * g2) * inv;
                        uo[2 * p] = u2[0]; uo[2 * p + 1] = u2[1];
                    }
                    const int hrow = wr * 64 + m * 16 + fr, trow = ai * HALF + hrow;
                    int w8 = 0; w8 = __builtin_amdgcn_cvt_pk_fp8_f32(uo[0], uo[1], w8, false); w8 = __builtin_amdgcn_cvt_pk_fp8_f32(uo[2], uo[3], w8, true);
                    { const int cb4 = lcol + 4 * n; *(PG8_LAS unsigned*)(stage + hrow * 128 + ((((cb4 >> 4) ^ ((hrow >> 1) & 7)) << 4) | (cb4 & 15))) = (unsigned)w8; }
                    if (ai == 0 && m == 0) {
                        if (trow < 2) { *(f32x4*)(sideA0 + ((size_t)u.pm * 2 + trow) * FFc + colt + 4 * n) = x; *(f32x4*)(sideG0 + ((size_t)u.pm * 2 + trow) * FFc + colt + 4 * n) = gt; } }
                    if (ai == 1 && m == 3) { if (trow >= 254) *(f32x4*)(sideA1 + ((size_t)u.pm * 2 + (trow - 254)) * FFc + colt + 4 * n) = x; }
                }
            }
            asm volatile("s_waitcnt lgkmcnt(0)" ::: "memory"); __builtin_amdgcn_s_barrier(); asm volatile("" ::: "memory");
#pragma unroll
            for (int rnd = 0; rnd < 2; ++rnd) { const int q = rnd * 512 + wid8 * 64 + lane64, hrow = q >> 3, c = q & 7;
                const u32x4 v = *(const PG8_LAS u32x4*)(stage + hrow * 128 + ((c ^ ((hrow >> 1) & 7)) << 4));
                if (ai == 1 || hrow >= 2) *(u32x4*)((unsigned char*)U + (size_t)(u.pm * BM + ai * HALF + hrow) * FFc + u.pn * 128 + c * 16) = v; }
            if (ai == 0) { asm volatile("s_waitcnt lgkmcnt(0)" ::: "memory"); __builtin_amdgcn_s_barrier(); asm volatile("" ::: "memory"); }
        }
#undef CG_DPP
        asm volatile("s_waitcnt lgkmcnt(0)" ::: "memory"); __builtin_amdgcn_s_barrier(); asm volatile("" ::: "memory");
    }
};
template <class Epi, class Sched, bool ALIGN_EPI = false, bool SP2 = false, bool F8 = false>
__device__ __forceinline__ void gemm_phase(PG8_LAS unsigned char* lds, const Gemm g, const Sched& S, const Epi& E, const int tid) {
    const int wid = __builtin_amdgcn_readfirstlane(tid >> 6), lane = tid & 63, wr = wid >> 2, wc = wid & 3, fr = lane & 15, fq = lane >> 4;
    const int K = g.K, nt = K / BK;
    unsigned voffA[2], voffB[2];
#pragma unroll
    for (int i = 0; i < 2; ++i) { int R, C; stage_rc(tid * 16 + i * 8192, R, C); const int Rb = Epi::PERM ? ((R & ~31) + perm32(R & 31)) : R;
        voffA[i] = (unsigned)(R * g.lda + C) * 2u; voffB[i] = (unsigned)(Rb * g.ldb + C) * 2u; }
    const size_t kstep = (size_t)(BK * 2);
    const size_t hstepA = (size_t)HALF * g.lda * 2, hstepB = (size_t)HALF * g.ldb * 2;
    const size_t tstepA = 2 * hstepA, tstepB = 2 * hstepB;
    const unsigned ldsw = (unsigned)wid * 1024u;
    const int aoff = lds_byte(wr * 64 + fr, fq * 8), boff = lds_byte(wc * 32 + fr, fq * 8);
#define PG8_SA(b, h) (((b) * 2 + (h)) * HTB)
#define PG8_SB(b, h) ((4 + (b) * 2 + (h)) * HTB)
#define PG8_STAGE(bufoff, gbase, voff) do { _Pragma("unroll") for (int _i = 0; _i < 2; ++_i) \
        __builtin_amdgcn_global_load_lds((const unsigned*)((const char*)(gbase) + (voff)[_i]), (PG8_LAS unsigned*)(lds + (bufoff) + ldsw + _i * 8192), 16, 0, 0); } while (0)
#define PG8_LDA(dst, b, h) do { _Pragma("unroll") for (int m = 0; m < 4; ++m) { dst[m].lo = *(const PG8_LAS bf16x8*)(lds + PG8_SA(b, h) + aoff + m * 2048); dst[m].hi = *(const PG8_LAS bf16x8*)(lds + PG8_SA(b, h) + aoff + m * 2048 + 1024); } } while (0)
#define PG8_LDB(dst, b, h) do { _Pragma("unroll") for (int n = 0; n < 2; ++n) { dst[n].lo = *(const PG8_LAS bf16x8*)(lds + PG8_SB(b, h) + boff + n * 2048); dst[n].hi = *(const PG8_LAS bf16x8*)(lds + PG8_SB(b, h) + boff + n * 2048 + 1024); } } while (0)
#define PG8_MMA(ai, bj, At, Bt) do { __builtin_amdgcn_s_setprio(1); _Pragma("unroll") for (int m = 0; m < 4; ++m) _Pragma("unroll") for (int n = 0; n < 2; ++n) { \
        if constexpr (F8) asm volatile("v_mfma_scale_f32_16x16x128_f8f6f4 %0, %1, %2, %0, %3, %4 op_sel_hi:[0,0,0]" : "+v"(acc[ai][bj][m][n]) : "v"(__builtin_bit_cast(pg8_v8i, Bt[n])), "v"(__builtin_bit_cast(pg8_v8i, At[m])), "v"(f8sb), "v"(f8sa));   \
        else { acc[ai][bj][m][n] = __builtin_amdgcn_mfma_f32_16x16x32_bf16(Bt[n].lo, At[m].lo, acc[ai][bj][m][n], 0, 0, 0); acc[ai][bj][m][n] = __builtin_amdgcn_mfma_f32_16x16x32_bf16(Bt[n].hi, At[m].hi, acc[ai][bj][m][n], 0, 0, 0); } } \
        __builtin_amdgcn_s_setprio(0); } while (0)
#define PG8_WAIT_V(n) asm volatile("s_waitcnt vmcnt(" #n ")" ::: "memory")
#define PG8_WAIT_L(n) asm volatile("s_waitcnt lgkmcnt(" #n ")" ::: "memory")
#define PG8_BAR __builtin_amdgcn_s_barrier()
#define PG8_SCHED __builtin_amdgcn_sched_barrier(0)
    Unit cur, nxt; int ui = 0;
    if (!S.next(0, cur)) return;
    f32x4 acc[2][2][4][2];
#pragma unroll
    for (int a = 0; a < 2; ++a)
#pragma unroll
        for (int b = 0; b < 2; ++b)
#pragma unroll
            for (int m = 0; m < 4; ++m)
#pragma unroll
                for (int n = 0; n < 2; ++n) acc[a][b][m][n] = (f32x4){0.f, 0.f, 0.f, 0.f};
    const int f8sa = g.sa, f8sb = g.sb; (void)f8sa; (void)f8sb;
    pg8_bf16x16 At[4], B0[2], B1[2];
    const char* cA = (const char*)g.A + (size_t)cur.pm * tstepA; const char* cB = (const char*)g.Bt + (size_t)cur.pn * tstepB;
    S.a_ready(cur);
    if constexpr (SP2) {
        PG8_STAGE(PG8_SB(0, 0), cB, voffB); PG8_STAGE(PG8_SB(0, 1), cB + hstepB, voffB); PG8_STAGE(PG8_SA(0, 0), cA, voffA); PG8_STAGE(PG8_SA(0, 1), cA + hstepA, voffA);
        if (wr == 1) PG8_BAR;
        PG8_WAIT_V(2); PG8_BAR;
        PG8_STAGE(PG8_SB(1, 0), cB + kstep, voffB); PG8_STAGE(PG8_SA(1, 0), cA + kstep, voffA); PG8_STAGE(PG8_SB(1, 1), cB + hstepB + kstep, voffB);
        PG8_WAIT_V(6); PG8_BAR;
    } else {
        PG8_STAGE(PG8_SB(0, 0), cB, voffB); PG8_STAGE(PG8_SA(0, 0), cA, voffA); PG8_STAGE(PG8_SB(0, 1), cB + hstepB, voffB); PG8_STAGE(PG8_SA(0, 1), cA + hstepA, voffA);
        if (wr == 1) PG8_BAR;
        PG8_WAIT_V(4); PG8_BAR;
        PG8_STAGE(PG8_SB(1, 0), cB + kstep, voffB); PG8_STAGE(PG8_SA(1, 0), cA + kstep, voffA); PG8_STAGE(PG8_SB(1, 1), cB + hstepB + kstep, voffB);
        PG8_WAIT_V(6); PG8_BAR;
    }
    for (;;) {
        const bool has_next = S.next(ui + 1, nxt);
        const char* nA = has_next ? (const char*)g.A + (size_t)nxt.pm * tstepA : cA; const char* nB = has_next ? (const char*)g.Bt + (size_t)nxt.pn * tstepB : cB;
#pragma unroll 1
        for (int t = 0; t < nt; t += 2) {
            const bool last = (t == nt - 2);
            const char* a1 = cA + (size_t)(t + 1) * kstep;
            const char* a2 = last ? nA : cA + (size_t)(t + 2) * kstep; const char* b2 = last ? nB : cB + (size_t)(t + 2) * kstep;
            const char* a3 = a2 + kstep; const char* b3 = b2 + kstep;
            if (last && has_next) S.a_ready(nxt);
            if constexpr (SP2) {
            PG8_LDB(B0, 0, 0); PG8_LDB(B1, 0, 1); PG8_SCHED; PG8_LDA(At, 0, 0); PG8_STAGE(PG8_SA(1, 1), a1 + hstepA, voffA);
            PG8_WAIT_V(8); PG8_WAIT_L(0); PG8_BAR; PG8_MMA(0, 0, At, B0); PG8_MMA(0, 1, At, B1); PG8_BAR; PG8_SCHED;
            PG8_LDA(At, 0, 1); PG8_STAGE(PG8_SB(0, 0), b2, voffB); PG8_STAGE(PG8_SB(0, 1), b2 + hstepB, voffB); PG8_STAGE(PG8_SA(0, 0), a2, voffA);
            PG8_WAIT_V(8); PG8_WAIT_L(0); PG8_BAR; PG8_MMA(1, 0, At, B0); PG8_MMA(1, 1, At, B1); PG8_BAR; PG8_SCHED;
            PG8_LDB(B0, 1, 0); PG8_LDB(B1, 1, 1); PG8_SCHED; PG8_LDA(At, 1, 0); PG8_STAGE(PG8_SA(0, 1), a2 + hstepA, voffA);
            PG8_WAIT_V(8); PG8_WAIT_L(0); PG8_BAR; PG8_MMA(0, 0, At, B0); PG8_MMA(0, 1, At, B1); PG8_BAR; PG8_SCHED;
            PG8_LDA(At, 1, 1); PG8_STAGE(PG8_SB(1, 0), b3, voffB); PG8_STAGE(PG8_SB(1, 1), b3 + hstepB, voffB); PG8_STAGE(PG8_SA(1, 0), a3, voffA);
            PG8_WAIT_V(8); PG8_WAIT_L(0); PG8_BAR; PG8_MMA(1, 0, At, B0); PG8_MMA(1, 1, At, B1); PG8_BAR; PG8_SCHED;
            } else {
            PG8_LDB(B0, 0, 0); PG8_SCHED; PG8_LDA(At, 0, 0); PG8_STAGE(PG8_SA(1, 1), a1 + hstepA, voffA);
            PG8_WAIT_L(8); PG8_BAR; PG8_WAIT_L(0); PG8_MMA(0, 0, At, B0); PG8_BAR; PG8_SCHED;
            PG8_LDB(B1, 0, 1); PG8_STAGE(PG8_SB(0, 0), b2, voffB);
            PG8_BAR; PG8_WAIT_L(0); PG8_MMA(0, 1, At, B1); PG8_BAR;
            PG8_LDA(At, 0, 1); PG8_STAGE(PG8_SA(0, 0), a2, voffA);
            PG8_BAR; PG8_WAIT_L(0); PG8_MMA(1, 0, At, B0); PG8_BAR; PG8_SCHED;
            PG8_STAGE(PG8_SB(0, 1), b2 + hstepB, voffB);
            PG8_WAIT_V(6); PG8_BAR; PG8_MMA(1, 1, At, B1); PG8_BAR;
            PG8_LDB(B0, 1, 0); PG8_SCHED; PG8_LDA(At, 1, 0); PG8_STAGE(PG8_SA(0, 1), a2 + hstepA, voffA);
            PG8_WAIT_L(8); PG8_BAR; PG8_WAIT_L(0); PG8_MMA(0, 0, At, B0); PG8_BAR; PG8_SCHED;
            PG8_LDB(B1, 1, 1); PG8_STAGE(PG8_SB(1, 0), b3, voffB);
            PG8_BAR; PG8_WAIT_L(0); PG8_MMA(0, 1, At, B1); PG8_BAR;
            PG8_LDA(At, 1, 1); PG8_STAGE(PG8_SA(1, 0), a3, voffA);
            PG8_BAR; PG8_WAIT_L(0); PG8_MMA(1, 0, At, B0); PG8_BAR; PG8_SCHED;
            PG8_STAGE(PG8_SB(1, 1), b3 + hstepB, voffB);
            PG8_WAIT_V(6); PG8_BAR; PG8_MMA(1, 1, At, B1); PG8_BAR;
            }
        }
        if constexpr (ALIGN_EPI) { if (wr == 0) PG8_BAR; }
        if constexpr (F8) {
            asm volatile("s_nop 15\n\ts_nop 7" : "+v"(acc[0][0][0][0]), "+v"(acc[0][0][0][1]), "+v"(acc[0][0][1][0]), "+v"(acc[0][0][1][1]), "+v"(acc[0][0][2][0]), "+v"(acc[0][0][2][1]), "+v"(acc[0][0][3][0]), "+v"(acc[0][0][3][1]), "+v"(acc[0][1][0][0]), "+v"(acc[0][1][0][1]), "+v"(acc[0][1][1][0]), "+v"(acc[0][1][1][1]), "+v"(acc[0][1][2][0]), "+v"(acc[0][1][2][1]), "+v"(acc[0][1][3][0]), "+v"(acc[0][1][3][1]) :: "memory");
            asm volatile("" : "+v"(acc[1][0][0][0]), "+v"(acc[1][0][0][1]), "+v"(acc[1][0][1][0]), "+v"(acc[1][0][1][1]), "+v"(acc[1][0][2][0]), "+v"(acc[1][0][2][1]), "+v"(acc[1][0][3][0]), "+v"(acc[1][0][3][1]), "+v"(acc[1][1][0][0]), "+v"(acc[1][1][0][1]), "+v"(acc[1][1][1][0]), "+v"(acc[1][1][1][1]), "+v"(acc[1][1][2][0]), "+v"(acc[1][1][2][1]), "+v"(acc[1][1][3][0]), "+v"(acc[1][1][3][1]) :: "memory"); }
        if constexpr (!Epi::AFTER_DRAIN) { E(acc, cur, wr, wc, fr, fq); S.done(cur); }
        if (!has_next) break;
#pragma unroll
        for (int a = 0; a < 2; ++a)
#pragma unroll
            for (int b = 0; b < 2; ++b)
#pragma unroll
                for (int m = 0; m < 4; ++m)
#pragma unroll
                    for (int n = 0; n < 2; ++n) acc[a][b][m][n] = (f32x4){0.f, 0.f, 0.f, 0.f};
        cur = nxt; cA = nA; cB = nB; ++ui;
        if constexpr (ALIGN_EPI) { if (wr == 1) PG8_BAR; }
    }
    PG8_WAIT_V(0);
    if constexpr (!ALIGN_EPI) { if (wr == 0) PG8_BAR; }
    PG8_BAR;
    if constexpr (Epi::AFTER_DRAIN) { E.fused(acc, cur, wr, wc, fr, fq, lds, wid, lane); S.done(cur); }
#undef PG8_SA
#undef PG8_SB
#undef PG8_STAGE
#undef PG8_LDA
#undef PG8_LDB
#undef PG8_MMA
#undef PG8_WAIT_V
#undef PG8_WAIT_L
#undef PG8_BAR
#undef PG8_SCHED
}
}

#include <hip/hip_bf16.h>
#include <cmath>
namespace attn_body {
using bf16=__hip_bfloat16;
using bf16x8=__attribute__((ext_vector_type(8)))short;
using s16x4=__attribute__((ext_vector_type(4)))short;
using f32x16=__attribute__((ext_vector_type(16)))float;
using u32x4=__attribute__((ext_vector_type(4)))unsigned;
constexpr int BATCH=2,NHEAD=16,SEQ=8192,D=64,DM=NHEAD*D;
constexpr int NW=8,QBLK=32,QB=QBLK*NW,KVBLK=64,NQB=SEQ/QB;
constexpr int ATTN_PITCH=DM, ATTN_UNIT_ROWS=QB;
__device__ __forceinline__ int crow(int r,int hi){return (r&3)+8*(r>>2)+4*hi;}
#define SBAR() __builtin_amdgcn_sched_barrier(0)
__device__ __forceinline__ void cmask(f32x16&p0,f32x16&p1,int jb,int qrel,int hi){
  const float NEG=-INFINITY; int kb=64*jb+4*hi;
  #pragma unroll
  for(int r=0;r<16;++r){int kv=kb+(r&3)+8*(r>>2); if(kv>qrel)p0[r]=NEG; if(kv+32>qrel)p1[r]=NEG;}
}

constexpr int NSLOT=3, SLOTB=8192, KSLOTB=10240;
constexpr int LDS_K=0, LDS_V=NSLOT*KSLOTB, LDS_WS=LDS_V+NSLOT*SLOTB, LDS_OST=LDS_WS+NW*64*4, LDS_BYTES=LDS_OST+NW*4096;
#define KOFF(sl) ((sl)+((sl)>>2))
constexpr float C2=0.125f*1.4426950408889634f;
__device__ __forceinline__ void glds16(const void*gsrc,unsigned lds_dst){unsigned keep;
  asm volatile("s_mov_b32 %0, m0\n\ts_mov_b32 m0, %2\n\ts_nop 0\n\tglobal_load_lds_dwordx4 %1, off\n\ts_mov_b32 m0, %0":"=&s"(keep):"v"(gsrc),"s"(lds_dst):"memory");}
__device__ __forceinline__ void glds4(const void*gsrc,unsigned lds_dst){unsigned keep;
  asm volatile("s_mov_b32 %0, m0\n\ts_mov_b32 m0, %2\n\ts_nop 0\n\tglobal_load_lds_dword %1, off\n\ts_mov_b32 m0, %0":"=&s"(keep):"v"(gsrc),"s"(lds_dst):"memory");}
__device__ __forceinline__ float max3f(float a,float b,float c){float r;asm("v_max3_f32 %0, %1, %2, %3":"=v"(r):"v"(a),"v"(b),"v"(c));return r;}
__device__ __forceinline__ float max2f(float a,float b){float r;asm("v_max_f32_e32 %0, %1, %2":"=v"(r):"v"(a),"v"(b));return r;}
__device__ __forceinline__ float fadd_s(float a,float b){float r;asm("v_add_f32_e32 %0, %1, %2":"=v"(r):"v"(a),"v"(b));return r;}
__device__ __forceinline__ float fsub_s(float a,float b){float r;asm("v_sub_f32_e32 %0, %1, %2":"=v"(r):"v"(a),"v"(b));return r;}
typedef float f32x2_t __attribute__((ext_vector_type(2))); typedef __bf16 bf16x2_t __attribute__((ext_vector_type(2)));
__device__ __forceinline__ unsigned cvtpk_s(float lo,float hi){f32x2_t v={lo,hi};bf16x2_t b=__builtin_convertvector(v,bf16x2_t);return __builtin_bit_cast(unsigned,b);}
#define WAIT_BAR(N) asm volatile("s_waitcnt vmcnt(" #N ") lgkmcnt(0)\n\ts_barrier":::"memory")

__device__ __forceinline__ void qkt(f32x16&p0,f32x16&p1,const char*Kslot,const bf16x8*qr,const bf16x8 qe,int r32,int hi){
  const char*kb=Kslot+hi*1024+r32*16;
  { const bf16x8 e0=*reinterpret_cast<const bf16x8*>(kb+8192); const bf16x8 e1=*reinterpret_cast<const bf16x8*>(kb+8192+512); const f32x16 z=f32x16{};
    p0=__builtin_amdgcn_mfma_f32_32x32x16_bf16(e0,qe,z,0,0,0); p1=__builtin_amdgcn_mfma_f32_32x32x16_bf16(e1,qe,z,0,0,0); }
  #pragma unroll
  for(int d0=0;d0<4;++d0){
    const bf16x8 b0=*reinterpret_cast<const bf16x8*>(kb+d0*2048);
    const bf16x8 b1=*reinterpret_cast<const bf16x8*>(kb+d0*2048+512);
    {p0=__builtin_amdgcn_mfma_f32_32x32x16_bf16(b0,qr[d0],p0,0,0,0);p1=__builtin_amdgcn_mfma_f32_32x32x16_bf16(b1,qr[d0],p1,0,0,0);}}
}
typedef __attribute__((address_space(3))) const char* lds_cptr;
typedef short v4i16_t __attribute__((ext_vector_type(4)));
__device__ __forceinline__ void kload8(bf16x8*kf,lds_cptr kp){
  kf[0]=*(const __attribute__((address_space(3))) bf16x8*)(kp);      kf[1]=*(const __attribute__((address_space(3))) bf16x8*)(kp+512);
  kf[2]=*(const __attribute__((address_space(3))) bf16x8*)(kp+2048); kf[3]=*(const __attribute__((address_space(3))) bf16x8*)(kp+2560);
  kf[4]=*(const __attribute__((address_space(3))) bf16x8*)(kp+4096); kf[5]=*(const __attribute__((address_space(3))) bf16x8*)(kp+4608);
  kf[6]=*(const __attribute__((address_space(3))) bf16x8*)(kp+6144); kf[7]=*(const __attribute__((address_space(3))) bf16x8*)(kp+6656);
  kf[8]=*(const __attribute__((address_space(3))) bf16x8*)(kp+8192); kf[9]=*(const __attribute__((address_space(3))) bf16x8*)(kp+8704);
}
__device__ __forceinline__ void kload2(bf16x8*kf,lds_cptr kp,int j){ kf[2*j]=*(const __attribute__((address_space(3))) bf16x8*)(kp+j*2048); kf[2*j+1]=*(const __attribute__((address_space(3))) bf16x8*)(kp+j*2048+512); }
__device__ __forceinline__ s16x4 vtr(lds_cptr p){ return __builtin_bit_cast(s16x4,__builtin_amdgcn_ds_read_tr16_b64_v4i16((__attribute__((address_space(3))) v4i16_t*)p)); }
__device__ __forceinline__ float rowmax(const f32x16&p0,const f32x16&p1){
  float a=max3f(p0[0],p0[1],p1[0]),b=max3f(p0[2],p0[3],p1[1]);a=max3f(a,p1[2],p1[3]);
  #pragma unroll
  for(int r=4;r<16;r+=4){a=max3f(a,p0[r],p0[r+1]);b=max3f(b,p0[r+2],p0[r+3]);a=max3f(a,p1[r],p1[r+1]);b=max3f(b,p1[r+2],p1[r+3]);}
  const float m=max2f(a,b);
  auto rr=__builtin_amdgcn_permlane32_swap(__float_as_uint(m),__float_as_uint(m),false,false);
  return max2f(__uint_as_float(rr[0]),__uint_as_float(rr[1]));
}
__device__ __forceinline__ void pv(f32x16*o,int vb,bf16x8 pa0,bf16x8 pa1,bf16x8 pa2,bf16x8 pa3){
  #pragma unroll
  for(int d0=0;d0<2;++d0){s16x4 lo[4],hi[4];
    #pragma unroll
    for(int ks=0;ks<4;++ks){
      asm volatile("ds_read_b64_tr_b16 %0,%1 offset:%c2":"=&v"(lo[ks]):"v"(vb),"i"(d0*4096+ks*1024):"memory");
      asm volatile("ds_read_b64_tr_b16 %0,%1 offset:%c2":"=&v"(hi[ks]):"v"(vb),"i"(d0*4096+ks*1024+512):"memory");}
    asm volatile("s_waitcnt lgkmcnt(0)":::"memory");SBAR();
    #define PK(k) (bf16x8){lo[k][0],lo[k][1],lo[k][2],lo[k][3],hi[k][0],hi[k][1],hi[k][2],hi[k][3]}
    o[d0]=__builtin_amdgcn_mfma_f32_32x32x16_bf16(pa0,PK(0),o[d0],0,0,0);
    o[d0]=__builtin_amdgcn_mfma_f32_32x32x16_bf16(pa1,PK(1),o[d0],0,0,0);
    o[d0]=__builtin_amdgcn_mfma_f32_32x32x16_bf16(pa2,PK(2),o[d0],0,0,0);
    o[d0]=__builtin_amdgcn_mfma_f32_32x32x16_bf16(pa3,PK(3),o[d0],0,0,0);
    #undef PK
  }
}

#ifndef ATTN_STORE16
#define ATTN_STORE16(p,v) (*(u32x4*)(p)=(v))
#endif
__device__ __forceinline__ bf16x8 make_qe(float m,int hi){
  const unsigned um=__float_as_uint(m); unsigned h0=(um+0x7fffu+((um>>16)&1u))&0xffff0000u; const float r1=m-__uint_as_float(h0);
  const unsigned u1=__float_as_uint(r1); unsigned h1=(u1+0x7fffu+((u1>>16)&1u))&0xffff0000u; const float r2=r1-__uint_as_float(h1);
  const unsigned u2=__float_as_uint(r2); unsigned h2=(u2+0x7fffu+((u2>>16)&1u))&0xffff0000u;
  u32x4 w; w.x=0x3f803f80u; w.y=0x3f80u|(h0^0x80000000u); w.z=((h1^0x80000000u)>>16)|(h2^0x80000000u); w.w=0u;
  if(hi){w.x=0u;w.y=0u;w.z=0u;} return __builtin_bit_cast(bf16x8,w); }
template<int THRL> __device__ __forceinline__ void attn_unit(int b,int h,int qb,const bf16*Q,const bf16*__restrict__ K,const bf16*__restrict__ V,bf16*O,const bf16*__restrict__ KE,const float*__restrict__ BETA,float qkmax,char*shm,const int tid){
  const int lane=tid&63,r32=lane&31,hi=lane>>5; const int wid=__builtin_amdgcn_readfirstlane(tid>>6);
  const long rowbase=(long)b*SEQ; const int q0=qb*QB;
  const bf16*Qw=Q+(rowbase+q0+wid*QBLK)*DM+h*D;
  const float*bet=BETA+(long)(b*NHEAD+h)*SEQ; const int NTF=(q0+QB)/KVBLK; int t0;
  { const float thr=bet[q0]-37.f-2.f*qkmax; const int l0=lane,l1=lane+64;
    const bool s0=(l0<NTF-4)&&(bet[64*l0+63]<thr), s1=(l1<NTF-4)&&(bet[64*l1+63]<thr);
    const unsigned long long m0=__ballot(s0), m1=__ballot(s1);
    int n0=(~m0)?__builtin_ctzll(~m0):64; if(n0==64) n0+=(~m1)?__builtin_ctzll(~m1):64;
    t0=__builtin_amdgcn_readfirstlane(n0)&~1; }
  const bf16*Kh=K+(rowbase+(long)t0*KVBLK)*DM+h*D,*Vh=V+(rowbase+(long)t0*KVBLK)*DM+h*D;
  const char*KEh=(const char*)KE+((long)(b*NHEAD+h)*(SEQ/KVBLK)+t0)*2048+wid*256+lane*4;
  const unsigned lds0=(unsigned)(uintptr_t)shm;
  float*wsf=(float*)(shm+LDS_WS)+wid*64;
  const bf16*ksrc=Kh+(long)lane*DM+wid*8;
  const bf16*vsrc=Vh+(long)(16*(wid&3)+(lane>>2))*DM+(wid>>2)*32+(lane&3)*8;
  const unsigned kdst=lds0+LDS_K+wid*1024, vdst=lds0+LDS_V+wid*1024, kedst=lds0+LDS_K+8192+wid*256;
  #define DMA_K(t,slot) do{ glds16(ksrc+(long)(t)*KVBLK*DM,(unsigned)__builtin_amdgcn_readfirstlane(kdst+KOFF(slot))); glds4(KEh+(long)(t)*2048,(unsigned)__builtin_amdgcn_readfirstlane(kedst+KOFF(slot))); }while(0)
  #define DMA_V(t,slot) glds16(vsrc+(long)(t)*KVBLK*DM,(unsigned)__builtin_amdgcn_readfirstlane(vdst+(slot)))
  const int vb0=(int)(lds0+LDS_V)+((lane>>4)&1)*32+(lane&3)*8+(4*hi+((lane&15)>>2))*64;
  const char*Kbase=shm+LDS_K; bf16x8 kf[10];
  const lds_cptr shm3=(lds_cptr)shm; const lds_cptr kp0=shm3+LDS_K+hi*1024+r32*16; const lds_cptr vp0=shm3+LDS_V+((lane>>4)&1)*32+(lane&3)*8+(4*hi+((lane&15)>>2))*64;
  const int NT=NTF-t0;
  DMA_K(0,0);DMA_V(0,0);DMA_K(1,SLOTB);
  bf16x8 qr[4];
  #pragma unroll
  for(int d0=0;d0<4;++d0)qr[d0]=*reinterpret_cast<const bf16x8*>(&Qw[(long)r32*DM+d0*16+hi*8]);
  float mhat=bet[q0+wid*QBLK+r32],l_reg=0.f;f32x16 o[2];o[0]=f32x16{};o[1]=f32x16{}; bf16x8 qe=make_qe(mhat,hi);
  const int qrel=wid*QBLK+r32;
  #define CMASK(P0,P1,t) do{int jb_=(t)-(NT-4); if(jb_>=0)cmask(P0,P1,jb_,qrel,hi);}while(0)
  bool resc=false;
  #define START(P0,P1) do{ resc=false; _Pragma("unroll") for(int r=0;r<16;++r)P0[r]=__builtin_amdgcn_exp2f(P0[r]); }while(0)
  #define RESC() do{ if(resc){ asm volatile("s_waitcnt lgkmcnt(0)":::"memory"); \
      _Pragma("unroll") for(int d_=0;d_<2;++d_) _Pragma("unroll") for(int r=0;r<16;++r)o[d_][r]*=wsf[crow(r,hi)]; } }while(0)
  f32x16 pA0,pA1,pB0,pB1;
  int sl_prev=0,sl_cur=0,sl_next=SLOTB;
  #define ROT() do{sl_prev=sl_cur;sl_cur=sl_next;sl_next=(sl_next==(NSLOT-1)*SLOTB)?0:sl_next+SLOTB;}while(0)
  DMA_K(2,2*SLOTB);
  WAIT_BAR(5);
  qkt(pA0,pA1,Kbase,qr,qe,r32,hi);asm volatile("s_nop 15\n\ts_nop 7":"+v"(pA0),"+v"(pA1));CMASK(pA0,pA1,0);
  START(pA0,pA1);
  _Pragma("unroll") for(int r=0;r<16;++r)pA1[r]=__builtin_amdgcn_exp2f(pA1[r]);
  WAIT_BAR(0);
  DMA_K(3,0);DMA_V(1,SLOTB);
  ROT();
  kload8(kf,kp0+KOFF(sl_cur));
  WAIT_BAR(3);
  s16x4 vlo[8],vhi[8]; u32x4 pw0,pw1,pw2,pw3;
  #define PKW(P,B) cvtpk_s(P[B],P[B+1])
  #define PAF(k) __builtin_bit_cast(bf16x8,pw##k)
  #define VFR(i) (bf16x8){vlo[i][0],vlo[i][1],vlo[i][2],vlo[i][3],vhi[i][0],vhi[i][1],vhi[i][2],vhi[i][3]}
  #define PIN(x) asm volatile("":"+v"(x))
  #define MX3(a,b,c) __builtin_fmaxf(__builtin_fmaxf((a),(b)),(c))
  #define GAPA(MF,A0,A1,A2,A3,W0,W1,PW) do{ MF; sacc+=A0; sacc+=A1; sacc+=A2; sacc+=A3; PIN(sacc); W0; W1; PIN(PW); SBAR(); }while(0)
  #define EX(v) __builtin_amdgcn_exp2f(v)
  #define GAPB(MF,X,B) do{ MF; X[B]=EX(X[B]); X[B+1]=EX(X[B+1]); X[B+2]=EX(X[B+2]); X[B+3]=EX(X[B+3]); PIN(X); SBAR(); }while(0)
  #define VRD(i) do{ vlo[i]=vtr(vp_+(((i)>>2)*4096+((i)&3)*1024)); vhi[i]=vtr(vp_+(((i)>>2)*4096+((i)&3)*1024+512)); }while(0)
  #define KRD(G,j) do{ if(G){ kload2(kf,kp0+KOFF(sl_next),j); SBAR(); } }while(0)
  #define KRDE(G) do{ if(G){ kf[8]=*(const __attribute__((address_space(3))) bf16x8*)(kp0+KOFF(sl_next)+8192); kf[9]=*(const __attribute__((address_space(3))) bf16x8*)(kp0+KOFF(sl_next)+8704); SBAR(); } }while(0)
  #define STEP(C0,C1,P0,P1,t,GK,GV,GL) do{ SBAR(); \
    const lds_cptr vp_=vp0+sl_prev; \
    VRD(0); SBAR(); float sacc=(P0[0]+P0[1]); \
    C0=__builtin_amdgcn_mfma_f32_32x32x16_bf16(kf[8],qe,f32x16{},0,0,0); C1=__builtin_amdgcn_mfma_f32_32x32x16_bf16(kf[9],qe,f32x16{},0,0,0); SBAR(); \
    GAPA(C0=__builtin_amdgcn_mfma_f32_32x32x16_bf16(kf[0],qr[0],C0,0,0,0), P0[2],P0[3],P0[4],P0[5],     pw0[0]=PKW(P0,0), pw0[1]=PKW(P0,2), pw0); \
    VRD(4); SBAR(); GAPA(C1=__builtin_amdgcn_mfma_f32_32x32x16_bf16(kf[1],qr[0],C1,0,0,0), P0[6],P0[7],P0[8],P0[9],     pw0[2]=PKW(P0,4), pw0[3]=PKW(P0,6), pw0); \
    VRD(1); SBAR(); GAPA(C0=__builtin_amdgcn_mfma_f32_32x32x16_bf16(kf[2],qr[1],C0,0,0,0),   P0[10],P0[11],P0[12],P0[13], pw1[0]=PKW(P0,8), pw1[1]=PKW(P0,10), pw1); \
    VRD(5); SBAR(); GAPA(C1=__builtin_amdgcn_mfma_f32_32x32x16_bf16(kf[3],qr[1],C1,0,0,0),   P0[14],P0[15],P1[0],P1[1],   pw1[2]=PKW(P0,12),pw1[3]=PKW(P0,14), pw1); \
    VRD(2); SBAR(); GAPA(C0=__builtin_amdgcn_mfma_f32_32x32x16_bf16(kf[4],qr[2],C0,0,0,0),   P1[2],P1[3],P1[4],P1[5],     pw2[0]=PKW(P1,0), pw2[1]=PKW(P1,2), pw2); \
    VRD(6); SBAR(); GAPA(C1=__builtin_amdgcn_mfma_f32_32x32x16_bf16(kf[5],qr[2],C1,0,0,0),   P1[6],P1[7],P1[8],P1[9],     pw2[2]=PKW(P1,4), pw2[3]=PKW(P1,6), pw2); \
    VRD(3); SBAR(); GAPA(C0=__builtin_amdgcn_mfma_f32_32x32x16_bf16(kf[6],qr[3],C0,0,0,0),   P1[10],P1[11],P1[12],P1[13], pw3[0]=PKW(P1,8), pw3[1]=PKW(P1,10), pw3); \
    VRD(7); SBAR(); GAPA(C1=__builtin_amdgcn_mfma_f32_32x32x16_bf16(kf[7],qr[3],C1,0,0,0),   P1[14],P1[15],0.f,0.f,       pw3[2]=PKW(P1,12),pw3[3]=PKW(P1,14), pw3); \
    l_reg+=sacc; \
    if(GK){DMA_K((t)+3,sl_cur);} if(GV){DMA_V((t)+1,sl_next);} \
    CMASK(C0,C1,t); \
    { float a=MX3(C0[0],C0[1],C1[0]),b=MX3(C0[2],C0[3],C1[1]); a=MX3(a,C1[2],C1[3]); \
      _Pragma("unroll") for(int r=4;r<16;r+=4){a=MX3(a,C0[r],C0[r+1]);b=MX3(b,C0[r+2],C0[r+3]);a=MX3(a,C1[r],C1[r+1]);b=MX3(b,C1[r+2],C1[r+3]);} \
      float rm=__builtin_fmaxf(a,b); { auto rr=__builtin_amdgcn_permlane32_swap(__float_as_uint(rm),__float_as_uint(rm),false,false); rm=__builtin_fmaxf(__uint_as_float(rr[0]),__uint_as_float(rr[1])); } \
      resc=false; \
      if(__builtin_expect(__any(rm>(float)THRL),0)){ const float dl=__builtin_fmaxf(rm,0.f); mhat+=dl; \
        _Pragma("unroll") for(int r=0;r<16;++r){C0[r]-=dl;C1[r]-=dl;} \
        qe=make_qe(mhat,hi); \
        const float f=__builtin_amdgcn_exp2f(-dl); l_reg*=f; if(hi==0)wsf[r32]=f; resc=true; } } \
    SBAR(); \
    GAPB(o[0]=__builtin_amdgcn_mfma_f32_32x32x16_bf16(PAF(0),VFR(0),o[0],0,0,0), C0,0); \
    GAPB(o[1]=__builtin_amdgcn_mfma_f32_32x32x16_bf16(PAF(0),VFR(4),o[1],0,0,0), C0,4); \
    KRD(GL,0); GAPB(o[0]=__builtin_amdgcn_mfma_f32_32x32x16_bf16(PAF(1),VFR(1),o[0],0,0,0), C0,8); \
    KRD(GL,1); GAPB(o[1]=__builtin_amdgcn_mfma_f32_32x32x16_bf16(PAF(1),VFR(5),o[1],0,0,0), C0,12); \
    KRD(GL,2); GAPB(o[0]=__builtin_amdgcn_mfma_f32_32x32x16_bf16(PAF(2),VFR(2),o[0],0,0,0), C1,0); \
    KRD(GL,3); GAPB(o[1]=__builtin_amdgcn_mfma_f32_32x32x16_bf16(PAF(2),VFR(6),o[1],0,0,0), C1,4); \
    KRDE(GL); GAPB(o[0]=__builtin_amdgcn_mfma_f32_32x32x16_bf16(PAF(3),VFR(3),o[0],0,0,0), C1,8); \
    GAPB(o[1]=__builtin_amdgcn_mfma_f32_32x32x16_bf16(PAF(3),VFR(7),o[1],0,0,0), C1,12); \
    }while(0)
  int t=1;
  #undef CMASK
  #define CMASK(P0,P1,t) do{}while(0)
  for(;t+5<NT;t+=2){
    STEP(pB0,pB1,pA0,pA1,t,true,true,true);     WAIT_BAR(3); RESC(); ROT();
    STEP(pA0,pA1,pB0,pB1,t+1,true,true,true);   WAIT_BAR(3); RESC(); ROT();
  }
  #undef CMASK
  #define CMASK(P0,P1,t) do{int jb_=(t)-(NT-4); if(jb_>=0)cmask(P0,P1,jb_,qrel,hi);}while(0)
  #define ENDW(tt) do{ if((tt)+3<NT){WAIT_BAR(3);} else if((tt)+2<NT){WAIT_BAR(1);} else {WAIT_BAR(0);} }while(0)
  for(;t+1<NT;t+=2){
    STEP(pB0,pB1,pA0,pA1,t,(t+3<NT),(t+1<NT),(t+1<NT));       ENDW(t);   RESC(); ROT();
    STEP(pA0,pA1,pB0,pB1,t+1,(t+4<NT),(t+2<NT),(t+2<NT));     ENDW(t+1); RESC(); ROT();
  }
  STEP(pB0,pB1,pA0,pA1,NT-1,false,false,false); RESC();
  { float sacc=pB0[0]+pB0[1]; _Pragma("unroll") for(int r=2;r<16;++r)sacc+=pB0[r]; _Pragma("unroll") for(int r=0;r<16;++r)sacc+=pB1[r]; l_reg+=sacc;
    pw0=(u32x4){PKW(pB0,0),PKW(pB0,2),PKW(pB0,4),PKW(pB0,6)};pw1=(u32x4){PKW(pB0,8),PKW(pB0,10),PKW(pB0,12),PKW(pB0,14)};pw2=(u32x4){PKW(pB1,0),PKW(pB1,2),PKW(pB1,4),PKW(pB1,6)};pw3=(u32x4){PKW(pB1,8),PKW(pB1,10),PKW(pB1,12),PKW(pB1,14)};
    SBAR(); pv(o,vb0+sl_cur,PAF(0),PAF(1),PAF(2),PAF(3)); }
  #undef PKW
  #undef PAF
  #undef VFR
  #undef PIN
  #undef MX3
  #undef GAPA
  #undef GAPB
  #undef EX
  #undef VRD
  #undef KRD
  #undef KRDE
  #undef STEP
  #undef ENDW
  {auto rr=__builtin_amdgcn_permlane32_swap(__float_as_uint(l_reg),__float_as_uint(l_reg),false,false);l_reg=__uint_as_float(rr[0])+__uint_as_float(rr[1]);}
  if(hi==0)wsf[32+r32]=l_reg;asm volatile("s_waitcnt lgkmcnt(0)":::"memory");
  float rli[16];
  #pragma unroll
  for(int r=0;r<16;++r)rli[r]=__builtin_amdgcn_rcpf(wsf[32+crow(r,hi)]);
  int lane_e=lane; asm volatile("":"+v"(lane_e));
  const int r32e=lane_e&31,hie=lane_e>>5;
  unsigned char*Ow=(unsigned char*)O+((rowbase+q0+wid*QBLK)*DM+h*D);
  { unsigned char*stg=(unsigned char*)(shm+LDS_OST)+wid*4096;
    #pragma unroll
    for(int r=0;r<16;++r){const int orow=crow(r,hie); const float sc32=32.f*rli[r];
      #pragma unroll
      for(int d0=0;d0<2;++d0)stg[orow*64+d0*32+r32e]=(unsigned char)__builtin_amdgcn_cvt_pk_fp8_f32(o[d0][r]*sc32,0.f,0,false);}
    asm volatile("s_waitcnt lgkmcnt(0)":::"memory");
    typedef unsigned u32x2_t __attribute__((ext_vector_type(2)));
    #pragma unroll
    for(int i=0;i<4;++i){const int row=i*8+(lane_e>>3),ch=lane_e&7; const u32x2_t v=*(const u32x2_t*)(stg+row*64+ch*8); *(u32x2_t*)(Ow+(long)row*DM+ch*8)=v;} }
  asm volatile("s_waitcnt lgkmcnt(0)\n\ts_barrier":::"memory");
  #undef DMA_K
  #undef DMA_V
  #undef CMASK
  #undef START
  #undef RESC
  #undef ROT
}
constexpr int ATTN_LDS_BYTES=LDS_BYTES;
struct AttnTensors { const bf16* Q; const bf16* K; const bf16* V; bf16* O; };
struct AttnUnit { int bh; int qb; };
struct StaticOrder {
  int vcu;
  __device__ __forceinline__ explicit StaticOrder(int grid,int block):vcu((block%8)*(grid/8)+block/8){}
  __device__ __forceinline__ bool next(int i,AttnUnit&u)const{ if(i>=4)return false; const int s=vcu&7; u.bh=vcu>>3; u.qb=(i==0)?s:(i==1)?15-s:(i==2)?16+s:31-s; return true; }
  __device__ __forceinline__ void a_ready(const AttnUnit&)const{}
  __device__ __forceinline__ void done(const AttnUnit&)const{}
};
template<class Sched,int THRL=8> __device__ __forceinline__ void attn_phase(char*lds,const AttnTensors&T,const Sched&S){
  AttnUnit u;
  for(int i=0;S.next(i,u);++i){ S.a_ready(u); attn_unit<THRL>(u.bh/NHEAD,u.bh%NHEAD,u.qb,T.Q,T.K,T.V,T.O,lds); S.done(u); }
}
#undef SBAR
#undef WAIT_BAR
}

#ifndef MK_DUP
#define MK_DUP 0
#endif
constexpr int NWAVES = 8, NTHREADS = 512;
constexpr int BATCH = 2, T = 8192, D = 1024, H = 16, HD = 64, FF = 2816, FF2 = 5632;
constexpr int M = BATCH * T;
constexpr int FOX_IN = 3088, DSA_IN = 2120;
constexpr float EPS = 1e-6f;
constexpr float LOG2E = 1.4426950408889634f;

constexpr size_t MiB = 1u << 20;
constexpr size_t WS_CTL = 0, CTL_ZERO_BYTES = 32 * 1024;
constexpr size_t WS_MOD = 1 * MiB;
constexpr size_t WS_XS = 2 * MiB;
constexpr int CW_NS = 1024;
constexpr size_t WS_WUP0 = 8 * MiB, WS_WUP1 = 19 * MiB;
constexpr size_t WS_WDN0 = 30 * MiB, WS_WDN1 = 35 * MiB + 512 * 1024;
constexpr size_t WS_WDIN = 41 * MiB;
constexpr size_t WS_WDTAIL = 45 * MiB;
constexpr size_t WS_WDOUT = 45 * MiB + 512 * 1024;
constexpr size_t WS_H = 48 * MiB;
constexpr size_t WS_R = 80 * MiB;
constexpr size_t WS_WFIN = WS_R, WS_WFOUT = WS_R + 6 * MiB;
constexpr size_t WS_Q = WS_R + 8 * MiB, WS_K = WS_R + 40 * MiB, WS_V = WS_R + 72 * MiB;
constexpr size_t WS_LOGF = WS_R + 104 * MiB;
constexpr size_t WS_BETA = WS_R + 105 * MiB;
constexpr size_t WS_KE = WS_R + 106 * MiB;
constexpr size_t WS_O = WS_R + 114 * MiB;
constexpr size_t WS_XB = WS_R + 144 * MiB;
constexpr size_t WS_U = WS_R;
constexpr size_t WS_SA0 = WS_R + 96 * MiB, WS_SG0 = WS_R + 98 * MiB, WS_SA1 = WS_R + 100 * MiB;
constexpr size_t WS_Q1 = WS_R, WS_K1 = WS_R + 32 * MiB, WS_V1 = WS_R + 40 * MiB;
constexpr size_t WS_QI = WS_R + 48 * MiB;
constexpr size_t WS_KI = WS_R + 64 * MiB;
constexpr size_t WS_WI = WS_R + 66 * MiB;
constexpr size_t WS_H8 = WS_R + 84 * MiB;
constexpr size_t WS_O1 = WS_R + 67 * MiB;
constexpr size_t WS_END = 256 * MiB;
static_assert(WS_U + (size_t)M * FF * 2 <= WS_SA0 && WS_SA1 + 2 * MiB <= WS_END, "d_ws map");
constexpr int CW_BAR = 4096;
static_assert((CW_BAR + 3456) * 4 <= 32 * 1024, "control words inside the per-call memset");
constexpr int CW_AQ = 256;
constexpr int CW_DQ = 512;

constexpr int RING_OFF = 0, RING_BYTES = 131072;
constexpr int LDSCTL_OFF = RING_BYTES, MISC_OFF = LDSCTL_OFF + 320;
constexpr int HALO_OFF = 131584;
constexpr int LDS_BYTES = 147456;

#define GAS __attribute__((address_space(1)))
#define LAS __attribute__((address_space(3)))
typedef unsigned short bf16;
typedef unsigned v4u __attribute__((ext_vector_type(4)));
typedef unsigned v2u __attribute__((ext_vector_type(2)));
typedef float f32x4 __attribute__((ext_vector_type(4)));
typedef short bf16x8 __attribute__((ext_vector_type(8)));
typedef GAS unsigned gu32;
#define RLX_AGENT __ATOMIC_RELAXED, __HIP_MEMORY_SCOPE_AGENT
#define LDS_WAIT() asm volatile("s_waitcnt lgkmcnt(0)" ::: "memory")
#define VM_WAIT() asm volatile("s_waitcnt vmcnt(0)" ::: "memory")
__device__ __forceinline__ unsigned f2bf(float f) { unsigned u = __builtin_bit_cast(unsigned, f); return (u + 0x7fffu + ((u >> 16) & 1u)) >> 16; }
__device__ __forceinline__ unsigned pk2(float lo, float hi) { return f2bf(lo) | (f2bf(hi) << 16); }
__device__ __forceinline__ float bf2f(unsigned b) { return __builtin_bit_cast(float, b << 16); }
#define XB_TMO      128
#define XB_XCNT(j)  (256  + 64 * (j))
#define XB_XSUB(j)  (1280 + 64 * (j))
#define XB_XGEN(j)  (2304 + 64 * (j))
#define XB_TOP      3328
#define XB_TOPGEN   3392
#define XCD_BAR_WORDS 3456
#define XB_SPIN_CAP (1u << 18)

__device__ __forceinline__ unsigned xb_ld(unsigned* p)              { return __hip_atomic_load(p, __ATOMIC_RELAXED, __HIP_MEMORY_SCOPE_AGENT); }
__device__ __forceinline__ unsigned xb_add(unsigned* p, unsigned v) { return __hip_atomic_fetch_add(p, v, __ATOMIC_RELAXED, __HIP_MEMORY_SCOPE_AGENT); }
__device__ __forceinline__ unsigned xb_xcc_id() { return (unsigned)__builtin_amdgcn_s_getreg((3 << 11) | 20) & 0xFu; }
#define XB_SPIN(cond, bar) do { unsigned _sp = 0; while (cond) { __builtin_amdgcn_s_sleep(1); \
    if ((++_sp & 255u) == 0u) { if (xb_ld(&(bar)[XB_TMO])) break; if (_sp > XB_SPIN_CAP) { atomicAdd(&(bar)[XB_TMO], 1u); break; } } } } while (0)

struct XcdBarrier {
    unsigned* bar; unsigned x;
    volatile LAS unsigned* st;
};

__device__ __forceinline__ XcdBarrier xcd_barrier_post(unsigned* bar, volatile LAS unsigned* st) {
    XcdBarrier b; b.bar = bar; b.x = xb_xcc_id(); b.st = st;
    if (threadIdx.x == 0) (void)xb_add(&bar[XB_XCNT(b.x)], 1u);
    return b;
}
__device__ __forceinline__ void xcd_barrier_complete(unsigned* bar, unsigned x, unsigned& nloc, unsigned& nx) {
    const unsigned G = gridDim.x * gridDim.y * gridDim.z;
    unsigned sum, cnt, mine, sp = 0u;
    for (;;) {
        sum = 0u; cnt = 0u; mine = 0u;
#pragma unroll
        for (unsigned j = 0; j < 16; ++j) { const unsigned c = xb_ld(&bar[XB_XCNT(j)]); sum += c; cnt += (c > 0u) ? 1u : 0u; mine = (j == x) ? c : mine; }
        if (sum == G) break;
        __builtin_amdgcn_s_sleep(1);
        if ((++sp & 255u) == 0u) { if (xb_ld(&bar[XB_TMO])) break; if (sp > XB_SPIN_CAP) { atomicAdd(&bar[XB_TMO], 1u); break; } }
    }
    nloc = mine > 0u ? mine : 1u; nx = cnt > 0u ? cnt : 1u;
}

__device__ __forceinline__ void xcd_barrier(const XcdBarrier& b) {
    asm volatile("s_waitcnt vmcnt(0)" ::: "memory");
    __syncthreads();
    if (threadIdx.x == 0) {
        unsigned* bar = b.bar;
        __builtin_amdgcn_s_waitcnt(0);
        unsigned nloc = b.st[0], nx = b.st[1];
        if (nloc == 0u) { xcd_barrier_complete(bar, b.x, nloc, nx); b.st[0] = nloc; b.st[1] = nx; }
        const unsigned old = xb_add(&bar[XB_XSUB(b.x)], 1u);
        const unsigned gen = old / nloc;
        if (old + 1u == (gen + 1u) * nloc) {
            __builtin_amdgcn_fence(__ATOMIC_RELEASE, "agent");
            asm volatile("s_waitcnt vmcnt(0)" ::: "memory");
            const unsigned og = xb_add(&bar[XB_TOP], 1u);
            const unsigned tg = og / nx;
            if (og + 1u == (tg + 1u) * nx) xb_add(&bar[XB_TOPGEN], 1u);
            else XB_SPIN(xb_ld(&bar[XB_TOPGEN]) == tg, bar);
            __builtin_amdgcn_fence(__ATOMIC_ACQUIRE, "agent");
            xb_add(&bar[XB_XGEN(b.x)], 1u);
            asm volatile("s_waitcnt vmcnt(0)" ::: "memory");
        } else {
            XB_SPIN(xb_ld(&bar[XB_XGEN(b.x)]) == gen, bar);
            __builtin_amdgcn_fence(__ATOMIC_ACQUIRE, "agent");
            asm volatile("s_waitcnt vmcnt(0)" ::: "memory");
        }
    }
    __syncthreads();
}

__device__ __forceinline__ float wave_sum(float v) {
    v += dppf<0xB1>(v); v += dppf<0x4E>(v); v += dppf<0x141>(v); v += dppf<0x140>(v);
    return xsum32(xsum16(v));
}
__device__ __forceinline__ float wave_max(float v) {
    v = fmaxf(v, dppf<0xB1>(v)); v = fmaxf(v, dppf<0x4E>(v)); v = fmaxf(v, dppf<0x141>(v)); v = fmaxf(v, dppf<0x140>(v));
    return xmax32(xmax16(v));
}
template <int F8S>
__device__ __forceinline__ void p0_transpose_item(const float* W, int ldw, int K, bf16* WT, int k0, int n0, int drow, LAS float* scr, int lane) {
#pragma unroll 8
    for (int i = 0; i < 32; ++i) { const int kk = 2 * i + (lane >> 5); scr[kk * 33 + (lane & 31)] = W[(size_t)(k0 + kk) * ldw + n0 + (lane & 31)]; }
    LDS_WAIT(); asm volatile("" ::: "memory");
    const int c = lane & 7;
#pragma unroll
    for (int j = 0; j < 4; ++j) { const int n = (lane >> 3) + 8 * j; const LAS float* s = scr + (8 * c) * 33 + n;
        if (F8S) { const float sc8 = (float)(1 << F8S); int w0 = 0, w1 = 0;
            w0 = __builtin_amdgcn_cvt_pk_fp8_f32(s[0 * 33] * sc8, s[1 * 33] * sc8, w0, false); w0 = __builtin_amdgcn_cvt_pk_fp8_f32(s[2 * 33] * sc8, s[3 * 33] * sc8, w0, true);
            w1 = __builtin_amdgcn_cvt_pk_fp8_f32(s[4 * 33] * sc8, s[5 * 33] * sc8, w1, false); w1 = __builtin_amdgcn_cvt_pk_fp8_f32(s[6 * 33] * sc8, s[7 * 33] * sc8, w1, true);
            *(GAS v2u*)((unsigned char*)WT + (size_t)(drow + n) * K + k0 + 8 * c) = (v2u){(unsigned)w0, (unsigned)w1}; }
        else { v4u o; o.x = pk2(s[0 * 33], s[1 * 33]); o.y = pk2(s[2 * 33], s[3 * 33]); o.z = pk2(s[4 * 33], s[5 * 33]); o.w = pk2(s[6 * 33], s[7 * 33]);
        *(GAS v4u*)(WT + (size_t)(drow + n) * K + k0 + 8 * c) = o; } }
    LDS_WAIT(); asm volatile("" ::: "memory");
}
template <int HP, int F8S = 0>
__device__ __forceinline__ void p0_matrix(const float* W, int ldw, int K, int ncols, bf16* WT, LAS float* scr, int lane, int gw, int NGW, int& base) {
    const int nblk = ncols / 32, items = (K / 64) * nblk;
    int first = gw - (base % NGW); if (first < 0) first += NGW;
    for (int r = first; r < items; r += NGW) {
        const int kb = r / nblk, nb = r % nblk, n0 = 32 * nb;
        int drow = n0;
        if (HP == 1) { const int tile = n0 >> 8, nl = n0 & 255, wc = nl >> 6, bj = (nl >> 5) & 1; drow = tile * 256 + 128 * bj + 32 * wc; }
        if (HP == 2) { const int isg = n0 >= FF, j = isg ? n0 - FF : n0; drow = (j >> 7) * 256 + (isg ? 128 : 0) + (j & 127); }
        p0_transpose_item<F8S>(W, ldw, K, WT, 64 * kb, n0, drow, scr, lane);
    }
    base += items;
}

struct Ptrs {
    const float *x, *c, *w_ada, *b_ada, *g_mix, *g_ffn, *fox_w_in, *fox_b_f, *fox_g_q, *fox_g_k, *fox_w_out,
                *dsa_w_in, *dsa_g_q, *dsa_g_k, *dsa_g_kidx, *dsa_w_out, *ffn_w_up, *ffn_conv_w, *ffn_conv_b, *ffn_w_down;
    float* out; unsigned char* ws;
};

__device__ __forceinline__ void p0_prologue(const Ptrs& P, LAS unsigned char* lds, int tid, int lane, int wave, int vcu, int G) {
    unsigned char* ws = P.ws;
    LAS float* scr = (LAS float*)(lds + RING_OFF + wave * 16384);
    const int gw = vcu * NWAVES + wave, NGW = G * NWAVES;
    int base = 0;
    p0_matrix<1, 5>(P.fox_w_in, FOX_IN, D, 3 * D, (bf16*)(ws + WS_WFIN), scr, lane, gw, NGW, base);
    p0_matrix<0, 5>(P.fox_w_out, D, D, D, (bf16*)(ws + WS_WFOUT), scr, lane, gw, NGW, base);
    p0_matrix<2, 5>(P.ffn_w_up, FF2, D, FF2, (bf16*)(ws + WS_WUP0), scr, lane, gw, NGW, base);
    p0_matrix<0, 6>(P.ffn_w_down, D, FF, D, (bf16*)(ws + WS_WDN0), scr, lane, gw, NGW, base);
    p0_matrix<1, 5>(P.dsa_w_in, DSA_IN, D, 3 * D / 2, (bf16*)(ws + WS_WDIN), scr, lane, gw, NGW, base);
    p0_matrix<1>(P.dsa_w_in + 3 * D / 2, DSA_IN, D, D / 2, (bf16*)(ws + WS_WDIN + 2 * MiB), scr, lane, gw, NGW, base);
    p0_matrix<0, 5>(P.dsa_w_out, D, D, D, (bf16*)(ws + WS_WDOUT), scr, lane, gw, NGW, base);
    p0_matrix<2, 5>(P.ffn_w_up + (size_t)D * FF2, FF2, D, FF2, (bf16*)(ws + WS_WUP1), scr, lane, gw, NGW, base);
    p0_matrix<0, 6>(P.ffn_w_down + (size_t)FF * D, D, FF, D, (bf16*)(ws + WS_WDN1), scr, lane, gw, NGW, base);
    { bf16* wt = (bf16*)(ws + WS_WDTAIL); const int gt = vcu * NTHREADS + tid, NT_ = G * NTHREADS;
      for (int i = gt; i < 80 * D; i += NT_) { const int n = i / D, k = i % D; wt[i] = (n < 72) ? (bf16)f2bf(P.dsa_w_in[(size_t)k * DSA_IN + 2048 + n]) : (bf16)0; } }
    __syncthreads();
    { LAS float* cact = (LAS float*)(lds + RING_OFF);
      LAS float* part = (LAS float*)(lds + RING_OFF + 8192);
      for (int i = tid; i < 2 * D; i += NTHREADS) { const float v = P.c[i]; cact[i] = v / (1.f + __expf(-v)); }
      __syncthreads();
      float* MOD = (float*)(ws + WS_MOD);
      for (int task = vcu; task < 2 * 96; task += G) {
          const int layer = task / 96, cg = task % 96, col = cg * 64 + lane;
          const float* w = P.w_ada + (size_t)layer * D * 6144 + col;
          float a0 = 0.f, a1 = 0.f;
#pragma unroll 32
          for (int k = wave * 128; k < wave * 128 + 128; ++k) { const float wv = w[(size_t)k * 6144]; a0 += cact[k] * wv; a1 += cact[D + k] * wv; }
          part[(wave * 2 + 0) * 64 + lane] = a0; part[(wave * 2 + 1) * 64 + lane] = a1;
          __syncthreads();
          if (wave < 2) { float s = 0.f;
#pragma unroll
              for (int w8 = 0; w8 < 8; ++w8) s += part[(w8 * 2 + wave) * 64 + lane];
              MOD[((size_t)layer * 2 + wave) * 6144 + col] = s + P.b_ada[layer * 6144 + col]; }
          __syncthreads();
      } }
}

template <bool FGATE, bool XIN16, int OUT8 = 0>
__device__ __forceinline__ void norm_phase(const void* xin, const float* gnorm, const float* modL, int sh_chunk, int sc_chunk, bf16* hout, unsigned char* hout8,
                                           const float* fox_w_in, const float* b_f, float* logf, LAS unsigned char* lds, int tid, int lane, int wave, int vcu, int G) {
    LAS float* wft = (LAS float*)(lds + RING_OFF);
    if (FGATE) {
        for (int i = tid; i < 16 * D; i += NTHREADS) { const int c = i >> 4, hh = i & 15; wft[hh * D + c] = fox_w_in[(size_t)c * FOX_IN + 3 * D + hh]; }
        __syncthreads();
    }
    const int gw = vcu * NWAVES + wave, NGW = G * NWAVES;
    for (int b = 0; b < BATCH; ++b) {
        f32x4 Gv[4], Sv[4];
#pragma unroll
        for (int j = 0; j < 4; ++j) { const int c = 4 * lane + 256 * j;
            const f32x4 g4 = *(const f32x4*)(gnorm + c), sc4 = *(const f32x4*)(modL + (size_t)b * 6144 + sc_chunk * D + c);
            Gv[j] = g4 * (sc4 + 1.0f); Sv[j] = *(const f32x4*)(modL + (size_t)b * 6144 + sh_chunk * D + c); }
        for (int t = gw; t < T; t += NGW) {
            const size_t m = (size_t)b * T + t;
            f32x4 v[4]; float ss = 0.f;
            if (XIN16) { const GAS v2u* xr = (const GAS v2u*)((const bf16*)xin + m * D) + lane;
#pragma unroll
                for (int j = 0; j < 4; ++j) { const v2u r = xr[64 * j]; v[j] = (f32x4){__uint_as_float(r.x << 16), __uint_as_float(r.x & 0xffff0000u), __uint_as_float(r.y << 16), __uint_as_float(r.y & 0xffff0000u)}; }
            } else { const GAS f32x4* xr = (const GAS f32x4*)((const float*)xin + m * D) + lane;
#pragma unroll
                for (int j = 0; j < 4; ++j) v[j] = xr[64 * j]; }
#pragma unroll
            for (int j = 0; j < 4; ++j) ss += (v[j].x * v[j].x + v[j].y * v[j].y) + (v[j].z * v[j].z + v[j].w * v[j].w);
            const float rstd = __builtin_amdgcn_rsqf(wave_sum(ss) * (1.f / D) + EPS);
            GAS unsigned long long* o8 = (GAS unsigned long long*)(hout + m * D) + lane;
#pragma unroll
            for (int j = 0; j < 4; ++j) { v[j] = v[j] * rstd * Gv[j] + Sv[j];
                if (OUT8) { int w8 = 0; w8 = __builtin_amdgcn_cvt_pk_fp8_f32(v[j].x, v[j].y, w8, false); w8 = __builtin_amdgcn_cvt_pk_fp8_f32(v[j].z, v[j].w, w8, true);
                    ((GAS unsigned*)(hout8 + m * D))[lane + 64 * j] = (unsigned)w8; }
                if (OUT8 != 1) o8[64 * j] = (unsigned long long)pk2(v[j].x, v[j].y) | ((unsigned long long)pk2(v[j].z, v[j].w) << 32); }
            if (FGATE) {
                float acc[16];
                typedef float f32x2 __attribute__((ext_vector_type(2)));
#pragma unroll
                for (int hh = 0; hh < 16; ++hh) { f32x2 a2 = (f32x2){0.f, 0.f};
#pragma unroll
                    for (int j = 0; j < 4; ++j) { const f32x4 w4 = *(const LAS f32x4*)(wft + hh * D + 256 * j + 4 * lane);
                        a2 = (f32x2){v[j].x, v[j].y} * (f32x2){w4.x, w4.y} + a2; a2 = (f32x2){v[j].z, v[j].w} * (f32x2){w4.z, w4.w} + a2; }
                    acc[hh] = a2.x + a2.y; if ((hh & 3) == 3) asm volatile("" : "+v"(acc[hh]) :: "memory"); }
                float b8[8], c4[4];
#pragma unroll
                for (int i = 0; i < 8; ++i) { const auto rr = __builtin_amdgcn_permlane32_swap(__builtin_bit_cast(unsigned, acc[i]), __builtin_bit_cast(unsigned, acc[i + 8]), false, false); const unsigned r0 = rr[0], r1 = rr[1];
                    b8[i] = __builtin_bit_cast(float, r0) + __builtin_bit_cast(float, r1); }
#pragma unroll
                for (int i = 0; i < 4; ++i) { const auto rr = __builtin_amdgcn_permlane16_swap(__builtin_bit_cast(unsigned, b8[i]), __builtin_bit_cast(unsigned, b8[i + 4]), false, false); const unsigned r0 = rr[0], r1 = rr[1];
                    c4[i] = __builtin_bit_cast(float, r0) + __builtin_bit_cast(float, r1); }
#pragma unroll
                for (int i = 0; i < 4; ++i) { float t = c4[i]; t += dppf<0xB1>(t); t += dppf<0x4E>(t); t += dppf<0x141>(t); t += dppf<0x140>(t); c4[i] = t; }
                const int j4 = lane & 15; float r = c4[0]; r = (j4 == 1) ? c4[1] : r; r = (j4 == 2) ? c4[2] : r; r = (j4 == 3) ? c4[3] : r;
                const int row16 = lane >> 4, head = (row16 >> 1) * 8 + (row16 & 1) * 4 + j4;
                if (j4 < 4) { const float z = r + b_f[head]; logf[m * 16 + head] = fminf(z, 0.f) - log1pf(__expf(-fabsf(z))); }
            }
        }
    }
    if (FGATE) __syncthreads();
}

__device__ __forceinline__ void fox_scan(const float* logf, float* BETA, unsigned char* KE, int seq, LAS float* red  , int tid, int lane, int wave) {
    const int b = seq >> 4, hh = seq & 15;
    float v[16]; float run = 0.f;
#pragma unroll
    for (int k = 0; k < 16; ++k) { run += logf[((size_t)b * T + 16 * tid + k) * 16 + hh]; v[k] = run; }
    float inc = run;
#pragma unroll
    for (int o = 1; o < 64; o <<= 1) { const float n = __shfl_up(inc, o); if (lane >= o) inc += n; }
    if (lane == 63) red[wave] = inc;
    __syncthreads();
    float pre = inc - run;
#pragma unroll
    for (int w8 = 0; w8 < 8; ++w8) if (w8 < wave) pre += red[w8];
#pragma unroll
    for (int k = 0; k < 16; ++k) {
        const int t = 16 * tid + k; const float be = -(pre + v[k]) * LOG2E;
        BETA[(size_t)seq * T + t] = be;
        const unsigned h0 = f2bf(be); const float r1 = be - bf2f(h0); const unsigned h1 = f2bf(r1); const float r2 = r1 - bf2f(h1); const unsigned h2 = f2bf(r2);
        unsigned char* tile = KE + ((size_t)seq * (T / 64) + (t >> 6)) * 2048 + (t & 63) * 16;
        v4u e; e.x = h0 | (h1 << 16); e.y = h2 | 0x3f800000u; e.z = 0x3f803f80u; e.w = 0u;
        *(GAS v4u*)tile = e; *(GAS v4u*)(tile + 1024) = (v4u){0u, 0u, 0u, 0u};
    }
    __syncthreads();
}

__device__ __forceinline__ void conv_fixup(bf16* U, const float* sideA0, const float* sideG0, const float* sideA1, const float* cw, const float* cb, int pm, int tid) {
    const bool bstart = (pm % (T / 256)) == 0;
    for (int i = tid; i < 2 * (FF / 4); i += NTHREADS) {
        const int r = i / (FF / 4), c = (i % (FF / 4)) * 4;
        const f32x4 a0 = *(const f32x4*)(sideA0 + ((size_t)pm * 2 + r) * FF + c), g0 = *(const f32x4*)(sideG0 + ((size_t)pm * 2 + r) * FF + c);
        const f32x4 z = (f32x4){0.f, 0.f, 0.f, 0.f};
        f32x4 m1, m2;
        if (r == 1) { m1 = *(const f32x4*)(sideA0 + ((size_t)pm * 2) * FF + c); m2 = bstart ? z : *(const f32x4*)(sideA1 + ((size_t)(pm - 1) * 2 + 1) * FF + c); }
        else { m1 = bstart ? z : *(const f32x4*)(sideA1 + ((size_t)(pm - 1) * 2 + 1) * FF + c); m2 = bstart ? z : *(const f32x4*)(sideA1 + ((size_t)(pm - 1) * 2) * FF + c); }
        const f32x4 w0 = *(const f32x4*)(cw + c), w1 = *(const f32x4*)(cw + FF + c), w2 = *(const f32x4*)(cw + 2 * FF + c), bb = *(const f32x4*)(cb + c);
        float uo[4];
#pragma unroll
        for (int e = 0; e < 4; ++e) { const float s = fmaf(w0[e], m2[e], fmaf(w1[e], m1[e], fmaf(w2[e], a0[e], bb[e]))); uo[e] = s * __builtin_amdgcn_rcpf(1.f + __builtin_amdgcn_exp2f(-LOG2E * s)) * g0[e]; }
        { int w8 = 0; w8 = __builtin_amdgcn_cvt_pk_fp8_f32(uo[0], uo[1], w8, false); w8 = __builtin_amdgcn_cvt_pk_fp8_f32(uo[2], uo[3], w8, true);
          *(GAS unsigned*)((unsigned char*)U + ((size_t)pm * 256 + r) * FF + c) = (unsigned)w8; }
    }
    asm volatile("s_waitcnt vmcnt(0)" ::: "memory");
    __syncthreads();
}
namespace dsa {
typedef float f32x16 __attribute__((ext_vector_type(16)));
typedef unsigned long long u64;
constexpr int QT = 16;
constexpr int TOPK = 256;
constexpr int HIST_OFF = 0;
constexpr int SEL_OFF = 135168;
constexpr int ST_OFF = 143360;
constexpr int CAP = 1024;
constexpr float WSCALE = 0.04419417382415922f;

__device__ __forceinline__ void tail_phase(const bf16* Hb, const bf16* WT, const float* g_kidx, bf16* KI, float* WI, int lane, int gw, int NGW) {
    const int n16 = lane & 15, q4 = lane >> 4;
    for (int task = gw; task < M / 16; task += NGW) {
        const int row0 = task * 16;
        f32x4 acc[5];
#pragma unroll
        for (int cb = 0; cb < 5; ++cb) acc[cb] = (f32x4){0.f, 0.f, 0.f, 0.f};
        const bf16* ap = Hb + (size_t)(row0 + n16) * D + 8 * q4;
        const bf16* bp = WT + (size_t)n16 * D + 8 * q4;
#pragma unroll 4
        for (int s = 0; s < 32; ++s) {
            const bf16x8 a = *(const GAS bf16x8*)(ap + 32 * s);
#pragma unroll
            for (int cb = 0; cb < 5; ++cb) { const bf16x8 b = *(const GAS bf16x8*)(bp + (size_t)cb * 16 * D + 32 * s); acc[cb] = __builtin_amdgcn_mfma_f32_16x16x32_bf16(a, b, acc[cb], 0, 0, 0); }
        }
        float gk[4];
#pragma unroll
        for (int cb = 0; cb < 4; ++cb) gk[cb] = g_kidx[16 * cb + n16];
#pragma unroll
        for (int i = 0; i < 4; ++i) {
            const int tok = row0 + 4 * q4 + i;
            float ss = (acc[0][i] * acc[0][i] + acc[1][i] * acc[1][i]) + (acc[2][i] * acc[2][i] + acc[3][i] * acc[3][i]);
            ss += __shfl_xor(ss, 1); ss += __shfl_xor(ss, 2); ss += __shfl_xor(ss, 4); ss += __shfl_xor(ss, 8);
            const float rs = __builtin_amdgcn_rsqf(ss * (1.f / 64.f) + EPS);
#pragma unroll
            for (int cb = 0; cb < 4; ++cb) KI[(size_t)tok * 64 + 16 * cb + n16] = (bf16)f2bf(acc[cb][i] * rs * gk[cb]);
            if (n16 < 8) WI[(size_t)tok * 8 + n16] = acc[4][i] * WSCALE;
        }
    }
}

__device__ __forceinline__ v4u f8x8_to_bf16(unsigned a, unsigned b) {
    typedef float f32x2 __attribute__((ext_vector_type(2)));
    const f32x2 a0 = __builtin_amdgcn_cvt_pk_f32_fp8((int)a, false), a1 = __builtin_amdgcn_cvt_pk_f32_fp8((int)a, true), b0 = __builtin_amdgcn_cvt_pk_f32_fp8((int)b, false), b1 = __builtin_amdgcn_cvt_pk_f32_fp8((int)b, true);
    v4u r; r.x = __builtin_amdgcn_perm(__float_as_uint(a0.y), __float_as_uint(a0.x), 0x07060302u); r.y = __builtin_amdgcn_perm(__float_as_uint(a1.y), __float_as_uint(a1.x), 0x07060302u);
    r.z = __builtin_amdgcn_perm(__float_as_uint(b0.y), __float_as_uint(b0.x), 0x07060302u); r.w = __builtin_amdgcn_perm(__float_as_uint(b1.y), __float_as_uint(b1.x), 0x07060302u); return r;
}
__device__ __forceinline__ u64 make_key(float s, int kidx) {
    const unsigned u = __float_as_uint(s); const unsigned sk = u ^ ((unsigned)((int)u >> 31) | 0x80000000u);
    return ((u64)sk << 13) | (u64)(8191 - kidx);
}
__device__ __forceinline__ float relu_i(float x) { const int b = __float_as_int(x); return __int_as_float(b > 0 ? b : 0); }
__device__ __forceinline__ unsigned skey32(float s) { const unsigned u = __float_as_uint(s); return u ^ ((unsigned)((int)u >> 31) | 0x80000000u); }
template <int MODE, bool L0, int PROBE, bool ALLV, int SMUL>
__device__ __forceinline__ void idx_loop(const bf16x8 (&qa)[4][4], const bf16* KIb, int t0q, int nst, int st_begin, int st_end, int key_l, int hi, LAS unsigned char* lds, const u64 (&Pq)[4][2], unsigned hbase,
                                         bf16x8 (&kb)[4], bf16x8 (&kn)[4], f32x16& acc, int level, int hi_shift, int lo_shift, unsigned mask) {
    for (int st_ = st_begin; st_ < st_end; st_ += 8) {
        const int kidx = 32 * SMUL * st_ + key_l;
        unsigned sks[4][2];
        constexpr bool allvalid = ALLV;
#pragma unroll
        for (int rb = 0; rb < 4; ++rb) {
            f32x16 accN = f32x16{};
            if (rb < 3) {
#pragma unroll
                for (int ks = 0; ks < 4; ++ks) accN = __builtin_amdgcn_mfma_f32_32x32x16_bf16(qa[rb + 1][ks], kb[ks], accN, 0, 0, 0);
            } else {
#pragma unroll
                for (int ks = 0; ks < 4; ++ks) kb[ks] = kn[ks];
                { const int kx = (st_ + 16 < nst) ? kidx + 512 * SMUL : kidx;
#pragma unroll
                  for (int ks = 0; ks < 4; ++ks) kn[ks] = *(const GAS bf16x8*)(KIb + (size_t)(PROBE == 2 ? key_l : kx) * 64 + 16 * ks + 8 * hi); }
#pragma unroll
                for (int ks = 0; ks < 4; ++ks) accN = __builtin_amdgcn_mfma_f32_32x32x16_bf16(qa[0][ks], kb[ks], accN, 0, 0, 0);
            }
            __builtin_amdgcn_sched_barrier(0);
            float sc[2];
            { LAS const f32x4* wp = (LAS const f32x4*)(lds + ST_OFF + 1024 + (4 * rb + 2 * hi) * 32);
              const f32x4 w0 = wp[0], w1 = wp[1], w2 = wp[2], w3 = wp[3];
              float s0 = relu_i(acc[0]) * w0[0];
#pragma unroll
              for (int i = 1; i < 4; ++i) s0 = fmaf(relu_i(acc[i]), w0[i], s0);
#pragma unroll
              for (int i = 0; i < 4; ++i) s0 = fmaf(relu_i(acc[4 + i]), w1[i], s0);
              asm volatile("" : "+v"(s0));
              float s1 = relu_i(acc[8]) * w2[0];
#pragma unroll
              for (int i = 1; i < 4; ++i) s1 = fmaf(relu_i(acc[8 + i]), w2[i], s1);
#pragma unroll
              for (int i = 0; i < 4; ++i) s1 = fmaf(relu_i(acc[12 + i]), w3[i], s1);
              sc[0] = s0; sc[1] = s1; }
#pragma unroll
            for (int e = 0; e < 2; ++e) {
                const int ql = 4 * rb + 2 * hi + e; const int t = t0q + ql;
                const unsigned sk = skey32(sc[e]);
                if (L0 && MODE == 0) {
                    const unsigned skv = allvalid ? sk : ((kidx <= t) ? sk : 0u);
                    const unsigned addr = hbase + (unsigned)(4 * rb + e) * 8192u + ((skv >> 21) << 2);
                    const unsigned vv = (skv & 0x100000u) ? 0x10000u : 1u;
                    if (PROBE == 1) { asm volatile("" :: "v"(addr), "v"(vv)); }
                    else __hip_atomic_fetch_add((LAS unsigned*)(uintptr_t)addr, vv, __ATOMIC_RELAXED, __HIP_MEMORY_SCOPE_WORKGROUP);
                } else if (L0 && (MODE == 1 || MODE == 3)) {
                    sks[rb][e] = sk;
                } else {
                    const bool valid = kidx <= t;
                    const u64 K = ((u64)sk << 13) | (u64)(8191 - kidx);
                    if (MODE == 0) {
                        bool ok = valid;
                        if (level > 0) ok = ok && ((K >> hi_shift) == Pq[rb][e]);
                        if (ok) { const unsigned bin = (unsigned)(K >> lo_shift) & mask;
                            __hip_atomic_fetch_add((LAS unsigned*)(lds + HIST_OFF + ql * 8192) + (bin >> 1), 1u << (16 * (bin & 1)), __ATOMIC_RELAXED, __HIP_MEMORY_SCOPE_WORKGROUP); }
                    } else if (valid) {
                        const u64 pfx = K >> lo_shift;
                        LAS unsigned* st = (LAS unsigned*)(lds + ST_OFF + ql * 32);
                        if (pfx > Pq[rb][e]) {
                            const unsigned slot = __hip_atomic_fetch_add(st + 3, 1u, __ATOMIC_RELAXED, __HIP_MEMORY_SCOPE_WORKGROUP) & 0xffffu;
                            if (slot < (unsigned)TOPK) ((LAS unsigned short*)(lds + SEL_OFF))[ql * TOPK + slot] = (unsigned short)kidx;
                        } else if (pfx == Pq[rb][e]) {
                            const unsigned slot = __hip_atomic_fetch_add(st + 3, 0x10000u, __ATOMIC_RELAXED, __HIP_MEMORY_SCOPE_WORKGROUP) >> 16;
                            if (slot < (unsigned)CAP) ((LAS u64*)(lds + HIST_OFF))[ql * CAP + slot] = K;
                        }
                    }
                }
            }
            if (L0 && (MODE == 1 || MODE == 3) && (rb & 1)) {
                unsigned old[2][2];
#pragma unroll
                for (int r2 = 0; r2 < 2; ++r2)
#pragma unroll
                    for (int e = 0; e < 2; ++e) { const int rbb = rb - 1 + r2, ql = 4 * rbb + 2 * hi + e; const unsigned bin = sks[rbb][e] >> 20, Tb = (unsigned)Pq[rbb][e]; const bool valid = allvalid || (kidx <= t0q + ql);
                        old[r2][e] = 0u;
                        if (valid && bin >= Tb) old[r2][e] = __hip_atomic_fetch_add((LAS unsigned*)(lds + ST_OFF + ql * 32) + 3, (MODE == 1 && bin > Tb) ? 1u : 0x10000u, __ATOMIC_RELAXED, __HIP_MEMORY_SCOPE_WORKGROUP); }
#pragma unroll
                for (int r2 = 0; r2 < 2; ++r2)
#pragma unroll
                    for (int e = 0; e < 2; ++e) { const int rbb = rb - 1 + r2, ql = 4 * rbb + 2 * hi + e; const unsigned bin = sks[rbb][e] >> 20, Tb = (unsigned)Pq[rbb][e]; const bool valid = allvalid || (kidx <= t0q + ql);
                        if (MODE == 1 && valid && bin > Tb) { const unsigned slot = old[r2][e] & 0xffffu; if (slot < (unsigned)TOPK) ((LAS unsigned short*)(lds + SEL_OFF))[ql * TOPK + slot] = (unsigned short)kidx; }
                        else if (valid && (MODE == 3 ? bin >= Tb : bin == Tb)) { const unsigned slot = old[r2][e] >> 16; if (slot < (unsigned)CAP) ((LAS u64*)(lds + HIST_OFF))[ql * CAP + slot] = ((u64)sks[rbb][e] << 13) | (u64)(8191 - kidx); } }
            }
            acc = accN;
        }
    }
}
template <int MODE, bool L0, int PROBE = 0, int SMUL = 1>
__device__ __forceinline__ void idx_pass(const bf16x8 (&qa)[4][4], const bf16* KIb, int t0q, int nst, int wave, int lane_in, LAS unsigned char* lds, int level, int hi_shift, int lo_shift, unsigned mask) {
    int lane = lane_in; asm volatile("" : "+v"(lane));
    const int key_l = lane & 31, hi = lane >> 5;
    u64 Pq[4][2];
#pragma unroll
    for (int rb = 0; rb < 4; ++rb)
#pragma unroll
        for (int e = 0; e < 2; ++e) { const int ql = 4 * rb + 2 * hi + e; LAS const unsigned* st = (LAS const unsigned*)(lds + ST_OFF + ql * 32);
            Pq[rb][e] = (u64)st[0] | ((u64)st[1] << 32); }
    const unsigned hbase = (unsigned)(uintptr_t)(lds + HIST_OFF) + (unsigned)hi * 16384u;
    bf16x8 kb[4], kn[4];
    { const int kc = (wave < nst) ? 32 * SMUL * wave + key_l : key_l;
      const int kc2 = (wave + 8 < nst) ? kc + 256 * SMUL : kc;
#pragma unroll
      for (int ks = 0; ks < 4; ++ks) { kb[ks] = *(const GAS bf16x8*)(KIb + (size_t)kc * 64 + 16 * ks + 8 * hi); kn[ks] = *(const GAS bf16x8*)(KIb + (size_t)(PROBE == 2 ? key_l : kc2) * 64 + 16 * ks + 8 * hi); } }
    f32x16 acc = f32x16{};
#pragma unroll
    for (int ks = 0; ks < 4; ++ks) acc = __builtin_amdgcn_mfma_f32_32x32x16_bf16(qa[0][ks], kb[ks], acc, 0, 0, 0);
    if (SMUL != 1) {
        idx_loop<MODE, L0, PROBE, true, SMUL>(qa, KIb, t0q, nst, wave, nst, key_l, hi, lds, Pq, hbase, kb, kn, acc, level, hi_shift, lo_shift, mask);
        return;
    }
    const int nfull = (t0q + 1) >> 5; int st_split = wave; if (nfull > wave) st_split = wave + ((nfull - wave + 7) >> 3) * 8;
    idx_loop<MODE, L0, PROBE, true, 1>(qa, KIb, t0q, nst, wave, nfull, key_l, hi, lds, Pq, hbase, kb, kn, acc, level, hi_shift, lo_shift, mask);
    idx_loop<MODE, L0, PROBE, false, 1>(qa, KIb, t0q, nst, st_split, nst, key_l, hi, lds, Pq, hbase, kb, kn, acc, level, hi_shift, lo_shift, mask);
}

__device__ __forceinline__ void find_bin(LAS unsigned char* lds, int row, int lane_in, int bits) {
    int lane = lane_in; asm volatile("" : "+v"(lane));
    LAS unsigned* st = (LAS unsigned*)(lds + ST_OFF + row * 32);
    if (st[6] != 0u) return;
    const unsigned need = st[2];
    LAS const unsigned* hrow = (LAS const unsigned*)(lds + HIST_OFF + row * 8192) + 32 * lane;
    v4u hw[8]; unsigned tot = 0;
#pragma unroll
    for (int i = 0; i < 8; ++i) { hw[i] = *(LAS const v4u*)(hrow + 4 * i);
#pragma unroll
        for (int e = 0; e < 4; ++e) tot += (hw[i][e] & 0xffffu) + (hw[i][e] >> 16); }
    unsigned suf = tot;
#pragma unroll
    for (int o = 1; o < 64; o <<= 1) { const unsigned n = (unsigned)__builtin_amdgcn_ds_bpermute(((lane + o) & 63) << 2, (int)suf); if (lane + o < 64) suf += n; }
    const unsigned above = suf - tot;
    if (above < need && need <= suf) {
        unsigned running = above, T = 0, cT = 0; bool found = false;
#pragma unroll
        for (int i = 31; i >= 0; --i) {
            const unsigned w = hw[i >> 2][i & 3], h16 = w >> 16, l16 = w & 0xffffu;
            if (!found) {
                if (running + h16 >= need) { T = 64 * lane + 2 * i + 1; cT = h16; found = true; }
                else { running += h16;
                    if (running + l16 >= need) { T = 64 * lane + 2 * i; cT = l16; found = true; } else running += l16; } }
        }
        const u64 Pold = (u64)st[0] | ((u64)st[1] << 32); const u64 Pn = (Pold << bits) | (u64)T;
        st[0] = (unsigned)Pn; st[1] = (unsigned)(Pn >> 32); st[2] = need - running; st[5] = cT;
    }
}

__device__ __forceinline__ void finish_row(LAS unsigned char* lds, int row, int lane_in, int nbits) {
    int lane = lane_in; asm volatile("" : "+v"(lane));
    LAS unsigned* st = (LAS unsigned*)(lds + ST_OFF + row * 32);
    if (st[6] != 0u) return;
    const unsigned need = st[2]; unsigned nc = st[3] >> 16; if (nc > (unsigned)CAP) nc = CAP;
    unsigned base = st[3] & 0xffffu; if (base > (unsigned)TOPK) base = TOPK;
    LAS const u64* cand = (LAS const u64*)(lds + HIST_OFF) + row * CAP;
    const int nch = (int)((nc + 63u) >> 6);
    const u64 Pfix = ((u64)st[0] | ((u64)st[1] << 32)) << nbits;
    u64 thr = Pfix;
    if (nch <= 4) {
        u64 k[4];
#pragma unroll
        for (int ch = 0; ch < 4; ++ch) { const unsigned i = 64u * ch + lane; k[ch] = (i < nc) ? cand[i] : 0ull; }
        for (int bit = nbits - 1; bit >= 0; --bit) {
            const u64 c = thr | (1ull << bit); unsigned cnt = 0;
#pragma unroll
            for (int ch = 0; ch < 4; ++ch) cnt += (unsigned)__builtin_popcountll(__ballot(k[ch] >= c));
            if (cnt >= need) thr = c;
        }
#pragma unroll
        for (int ch = 0; ch < 4; ++ch) {
            const unsigned i = 64u * ch + lane; const bool s = (i < nc) && (k[ch] >= thr);
            const unsigned long long m = __ballot(s); const unsigned pos = base + (unsigned)__builtin_popcountll(m & ((1ull << lane) - 1ull));
            if (s && pos < (unsigned)TOPK) ((LAS unsigned short*)(lds + SEL_OFF))[row * TOPK + pos] = (unsigned short)(8191u - (unsigned)(k[ch] & 0x1fffull));
            base += (unsigned)__builtin_popcountll(m);
        }
    } else if (nch <= 8) {
        u64 k[8];
#pragma unroll
        for (int ch = 0; ch < 8; ++ch) { const unsigned i = 64u * ch + lane; k[ch] = (i < nc) ? cand[i] : 0ull; }
        for (int bit = nbits - 1; bit >= 0; --bit) {
            const u64 c = thr | (1ull << bit); unsigned cnt = 0;
#pragma unroll
            for (int ch = 0; ch < 8; ++ch) cnt += (unsigned)__builtin_popcountll(__ballot(k[ch] >= c));
            if (cnt >= need) thr = c;
        }
#pragma unroll
        for (int ch = 0; ch < 8; ++ch) {
            const unsigned i = 64u * ch + lane; const bool s = (i < nc) && (k[ch] >= thr);
            const unsigned long long m = __ballot(s); const unsigned pos = base + (unsigned)__builtin_popcountll(m & ((1ull << lane) - 1ull));
            if (s && pos < (unsigned)TOPK) ((LAS unsigned short*)(lds + SEL_OFF))[row * TOPK + pos] = (unsigned short)(8191u - (unsigned)(k[ch] & 0x1fffull));
            base += (unsigned)__builtin_popcountll(m);
        }
    } else if (nch <= 12) {
        u64 k[12];
#pragma unroll
        for (int ch = 0; ch < 12; ++ch) { const unsigned i = 64u * ch + lane; k[ch] = (i < nc) ? cand[i] : 0ull; }
        for (int bit = nbits - 1; bit >= 0; --bit) {
            const u64 c = thr | (1ull << bit); unsigned cnt = 0;
#pragma unroll
            for (int ch = 0; ch < 12; ++ch) cnt += (unsigned)__builtin_popcountll(__ballot(k[ch] >= c));
            if (cnt >= need) thr = c;
        }
#pragma unroll
        for (int ch = 0; ch < 12; ++ch) {
            const unsigned i = 64u * ch + lane; const bool s = (i < nc) && (k[ch] >= thr);
            const unsigned long long m = __ballot(s); const unsigned pos = base + (unsigned)__builtin_popcountll(m & ((1ull << lane) - 1ull));
            if (s && pos < (unsigned)TOPK) ((LAS unsigned short*)(lds + SEL_OFF))[row * TOPK + pos] = (unsigned short)(8191u - (unsigned)(k[ch] & 0x1fffull));
            base += (unsigned)__builtin_popcountll(m);
        }
    } else if (nch <= 16) {
        u64 k[16];
#pragma unroll
        for (int ch = 0; ch < 16; ++ch) { const unsigned i = 64u * ch + lane; k[ch] = (i < nc) ? cand[i] : 0ull; }
        for (int bit = nbits - 1; bit >= 0; --bit) {
            const u64 c = thr | (1ull << bit); unsigned cnt = 0;
#pragma unroll
            for (int ch = 0; ch < 16; ++ch) cnt += (unsigned)__builtin_popcountll(__ballot(k[ch] >= c));
            if (cnt >= need) thr = c;
        }
#pragma unroll
        for (int ch = 0; ch < 16; ++ch) {
            const unsigned i = 64u * ch + lane; const bool s = (i < nc) && (k[ch] >= thr);
            const unsigned long long m = __ballot(s); const unsigned pos = base + (unsigned)__builtin_popcountll(m & ((1ull << lane) - 1ull));
            if (s && pos < (unsigned)TOPK) ((LAS unsigned short*)(lds + SEL_OFF))[row * TOPK + pos] = (unsigned short)(8191u - (unsigned)(k[ch] & 0x1fffull));
            base += (unsigned)__builtin_popcountll(m);
        }
    } else {
        for (int bit = nbits - 1; bit >= 0; --bit) {
            const u64 c = thr | (1ull << bit); unsigned cnt = 0;
            for (int ch = 0; ch < nch; ++ch) { const unsigned i = 64u * ch + lane; const u64 k = (i < nc) ? cand[i] : 0ull; cnt += (unsigned)__builtin_popcountll(__ballot(k >= c)); }
            if (cnt >= need) thr = c;
        }
        for (int ch = 0; ch < nch; ++ch) {
            const unsigned i = 64u * ch + lane; const u64 k = (i < nc) ? cand[i] : 0ull; const bool s = (i < nc) && (k >= thr);
            const unsigned long long m = __ballot(s); const unsigned pos = base + (unsigned)__builtin_popcountll(m & ((1ull << lane) - 1ull));
            if (s && pos < (unsigned)TOPK) ((LAS unsigned short*)(lds + SEL_OFF))[row * TOPK + pos] = (unsigned short)(8191u - (unsigned)(k & 0x1fffull));
            base += (unsigned)__builtin_popcountll(m);
        }
    }
    if (lane == 0) st[3] = base;
}

__device__ __forceinline__ void sparse_attn_row(LAS unsigned char* lds, int row, int b, int t, const bf16* Q1, bf16* O1, const unsigned char* K1, const unsigned char* V1, int wave, int lane_in) {
    int lane = lane_in; asm volatile("" : "+v"(lane));
    const int n16 = lane & 15, q4 = lane >> 4, gl = n16 >> 2;
    LAS const unsigned short* sel = (LAS const unsigned short*)(lds + SEL_OFF) + row * TOPK;
    unsigned cnt = ((LAS const unsigned*)(lds + ST_OFF + row * 32))[3] & 0xffffu; if (cnt > (unsigned)TOPK) cnt = TOPK;
    const bf16* qrow = Q1 + ((size_t)b * T + t) * D; bf16* orow = O1 + ((size_t)b * T + t) * D;
    bf16x8 bq[8];
    { const bf16x8 q0 = *(const GAS bf16x8*)(qrow + n16 * 64 + 16 * q4), q1 = *(const GAS bf16x8*)(qrow + n16 * 64 + 16 * q4 + 8); const bf16x8 z = (bf16x8){0, 0, 0, 0, 0, 0, 0, 0};
#pragma unroll
      for (int s = 0; s < 8; ++s) bq[s] = ((s >> 1) == gl) ? ((s & 1) ? q1 : q0) : z; }
    const float slope = __builtin_amdgcn_exp2f(-0.5f * (float)(n16 + 1)) * LOG2E;
    const unsigned char* Kb = K1 + (size_t)b * T * 256; const unsigned char* Vb = V1 + (size_t)b * T * 256;
    f32x4 sc[16];
    v4u vst[2][8];
    constexpr int KD = 3;
    v4u kfn[KD][4];
#pragma unroll
    for (int d = 0; d < KD; ++d) { const unsigned pos = 16u * d + n16; const unsigned kidx = (pos < cnt) ? (unsigned)sel[pos] : 0u; const unsigned char* kp = Kb + (size_t)kidx * 256 + 16 * q4;
#pragma unroll
      for (int g = 0; g < 4; ++g) kfn[d][g] = *(const GAS v4u*)(kp + 64 * g); }
#pragma unroll
    for (int blk = 0; blk < 16; ++blk) {
        bf16x8 kf[8];
#pragma unroll
        for (int g = 0; g < 4; ++g) { const v4u lo = f8x8_to_bf16(kfn[blk % KD][g].x, kfn[blk % KD][g].y), hi8 = f8x8_to_bf16(kfn[blk % KD][g].z, kfn[blk % KD][g].w); kf[2 * g] = __builtin_bit_cast(bf16x8, lo); kf[2 * g + 1] = __builtin_bit_cast(bf16x8, hi8); }
        if (blk + KD < 16) { const unsigned pos = 16u * (blk + KD) + n16; const unsigned kidx = (pos < cnt) ? (unsigned)sel[pos] : 0u; const unsigned char* kp = Kb + (size_t)kidx * 256 + 16 * q4;
#pragma unroll
            for (int g = 0; g < 4; ++g) kfn[blk % KD][g] = *(const GAS v4u*)(kp + 64 * g); }
        if (blk >= 14) {
            const int d = blk - 14;
#pragma unroll
            for (int i = 0; i < 8; ++i) { const unsigned pos = 32u * d + 4u * i + q4; const unsigned kidx = (pos < cnt) ? (unsigned)sel[pos] : 0u; vst[d][i] = *(const GAS v4u*)(Vb + (size_t)kidx * 256 + 16 * n16); }
        }
        f32x4 a = (f32x4){0.f, 0.f, 0.f, 0.f};
#pragma unroll
        for (int s = 0; s < 8; ++s) a = __builtin_amdgcn_mfma_f32_16x16x32_bf16(kf[s], bq[s], a, 0, 0, 0);
        const unsigned long long i4 = *(LAS const unsigned long long*)(sel + 16 * blk + 4 * q4);
#pragma unroll
        for (int i = 0; i < 4; ++i) { const unsigned p = 16u * blk + 4u * q4 + i; const int ki = (int)((i4 >> (16 * i)) & 0xffffull);
            a[i] = (p < cnt) ? (a[i] - slope * (float)(t - ki)) : -INFINITY; }
        sc[blk] = a;
    }
    float mx = -INFINITY;
#pragma unroll
    for (int blk = 0; blk < 16; ++blk) mx = fmaxf(fmaxf(fmaxf(mx, sc[blk][0]), fmaxf(sc[blk][1], sc[blk][2])), sc[blk][3]);
    mx = xmax32(xmax16(mx));
    float lsum = 0.f;
#pragma unroll
    for (int blk = 0; blk < 16; ++blk)
#pragma unroll
        for (int i = 0; i < 4; ++i) { const float p = __builtin_amdgcn_exp2f(sc[blk][i] - mx); sc[blk][i] = p; lsum += p; }
    lsum = xsum32(xsum16(lsum));
    LAS unsigned char* vbuf = lds + HIST_OFF + wave * 16384;
    f32x4 o[4];
#pragma unroll
    for (int db = 0; db < 4; ++db) o[db] = (f32x4){0.f, 0.f, 0.f, 0.f};
#pragma unroll
    for (int J = 0; J < 8; ++J) {
#pragma unroll
        for (int i = 0; i < 8; ++i) { const int key = 4 * i + q4; LAS unsigned char* dst = vbuf + key * 512 + ((n16 ^ (key & 7)) << 5);
            *(LAS v4u*)dst = f8x8_to_bf16(vst[J & 1][i].x, vst[J & 1][i].y); *(LAS v4u*)(dst + 16) = f8x8_to_bf16(vst[J & 1][i].z, vst[J & 1][i].w); }
        if (J + 2 < 8) {
#pragma unroll
            for (int i = 0; i < 8; ++i) { const unsigned pos = 32u * (J + 2) + 4u * i + q4; const unsigned kidx = (pos < cnt) ? (unsigned)sel[pos] : 0u; vst[J & 1][i] = *(const GAS v4u*)(Vb + (size_t)kidx * 256 + 16 * n16); }
        }
        asm volatile("s_waitcnt lgkmcnt(0)" ::: "memory");
        v4u pb; pb.x = pk2(sc[2 * J][0], sc[2 * J][1]); pb.y = pk2(sc[2 * J][2], sc[2 * J][3]); pb.z = pk2(sc[2 * J + 1][0], sc[2 * J + 1][1]); pb.w = pk2(sc[2 * J + 1][2], sc[2 * J + 1][3]);
#pragma unroll
        for (int g = 0; g < 4; ++g) {
            const v4u pg = (g == gl) ? pb : (v4u){0u, 0u, 0u, 0u};
#pragma unroll
            for (int db = 0; db < 4; ++db) {
                const int qq = n16 >> 2, pp = n16 & 3; const int col = 64 * g + 16 * db + 4 * pp;
                const int r0 = 4 * q4 + qq, r1 = 16 + 4 * q4 + qq;
                const int a0 = r0 * 512 + ((((col >> 4) ^ (r0 & 7)) << 5) | ((col & 15) << 1)), a1 = r1 * 512 + ((((col >> 4) ^ (r1 & 7)) << 5) | ((col & 15) << 1));
                v2u lo, hi2;
                asm volatile("ds_read_b64_tr_b16 %0, %1" : "=v"(lo) : "v"((unsigned)(uintptr_t)(vbuf + a0)) : "memory");
                asm volatile("ds_read_b64_tr_b16 %0, %1" : "=v"(hi2) : "v"((unsigned)(uintptr_t)(vbuf + a1)) : "memory");
                asm volatile("s_waitcnt lgkmcnt(0)" : "+v"(lo), "+v"(hi2) :: "memory");
                const v4u av = (v4u){lo.x, lo.y, hi2.x, hi2.y};
                o[db] = __builtin_amdgcn_mfma_f32_16x16x32_bf16(__builtin_bit_cast(bf16x8, av), __builtin_bit_cast(bf16x8, pg), o[db], 0, 0, 0);
            }
        }
        asm volatile("s_waitcnt lgkmcnt(0)" ::: "memory");
    }
    const float rl = 1.f / lsum;
#pragma unroll
    for (int db = 0; db < 4; ++db) { v2u w; w.x = pk2(o[db][0] * rl, o[db][1] * rl); w.y = pk2(o[db][2] * rl, o[db][3] * rl);
        *(GAS v2u*)(orow + n16 * 64 + 16 * db + 4 * q4) = w; }
}

typedef long i64_t;
__device__ __forceinline__ void canon_sel(LAS unsigned char* lds, LAS unsigned short* sel, unsigned cnt, int wave, int lane) {
    LAS unsigned* bm = (LAS unsigned*)(lds + HIST_OFF + wave * 16384); LAS unsigned* pf = bm + 256;
    *(LAS v4u*)(bm + 4 * lane) = (v4u){0u, 0u, 0u, 0u};
    const v2u e = *(const LAS v2u*)(sel + 4 * lane);
    unsigned idx[4] = {e.x & 0xffffu, e.x >> 16, e.y & 0xffffu, e.y >> 16};
    LDS_WAIT();
#pragma unroll
    for (int i = 0; i < 4; ++i) if ((unsigned)(4 * lane + i) < cnt) __hip_atomic_fetch_or(bm + (idx[i] >> 5), 1u << (idx[i] & 31u), __ATOMIC_RELAXED, __HIP_MEMORY_SCOPE_WORKGROUP);
    LDS_WAIT();
    const v4u w = *(const LAS v4u*)(bm + 4 * lane);
    const unsigned c0 = __builtin_popcount(w.x), c1 = __builtin_popcount(w.y), c2 = __builtin_popcount(w.z), c3 = __builtin_popcount(w.w), tot = c0 + c1 + c2 + c3;
    int sc = (int)tot;
    sc += __builtin_amdgcn_update_dpp(0, sc, 0x111, 0xf, 0xf, false); sc += __builtin_amdgcn_update_dpp(0, sc, 0x112, 0xf, 0xf, false);
    sc += __builtin_amdgcn_update_dpp(0, sc, 0x114, 0xf, 0xf, false); sc += __builtin_amdgcn_update_dpp(0, sc, 0x118, 0xf, 0xf, false);
    sc += __builtin_amdgcn_update_dpp(0, sc, 0x142, 0xa, 0xf, false);
    sc += __builtin_amdgcn_update_dpp(0, sc, 0x143, 0xc, 0xf, false);
    const unsigned ex = (unsigned)sc - tot;
    *(LAS v4u*)(pf + 4 * lane) = (v4u){ex, ex + c0, ex + c0 + c1, ex + c0 + c1 + c2};
    LDS_WAIT();
#pragma unroll
    for (int i = 0; i < 4; ++i) if ((unsigned)(4 * lane + i) < cnt) { const unsigned wd = idx[i] >> 5; const unsigned r = pf[wd] + __builtin_popcount(bm[wd] & ((1u << (idx[i] & 31u)) - 1u)); sel[r] = (unsigned short)idx[i]; }
    LDS_WAIT();
}
__device__ __forceinline__ void sparse_attn_row8(LAS unsigned char* lds, int row, int b, int t, const bf16* Q1, bf16* O1, const unsigned char* K1, const unsigned char* V1, int wave, int lane_in) {
    int lane = lane_in; asm volatile("" : "+v"(lane));
    const int n16 = lane & 15, q4 = lane >> 4, gl = n16 >> 2;
    LAS unsigned short* sel = (LAS unsigned short*)(lds + SEL_OFF) + row * TOPK;
    unsigned cnt = ((LAS const unsigned*)(lds + ST_OFF + row * 32))[3] & 0xffffu; if (cnt > (unsigned)TOPK) cnt = TOPK;
    canon_sel(lds, sel, cnt, wave, lane);
    if (cnt < (unsigned)TOPK) {
        for (unsigned i = cnt + lane; i < (unsigned)TOPK; i += 64u) sel[i] = 0;
        asm volatile("s_waitcnt lgkmcnt(0)" ::: "memory");
    }
    const bf16* qrow = Q1 + ((size_t)b * T + t) * D; bf16* orow = O1 + ((size_t)b * T + t) * D;
    i64_t qs0, qs1;
    { const v4u a = *(const GAS v4u*)(qrow + n16 * 64 + 16 * q4), c = *(const GAS v4u*)(qrow + n16 * 64 + 16 * q4 + 8);
      int w0 = 0, w1 = 0, w2 = 0, w3 = 0;
      w0 = __builtin_amdgcn_cvt_pk_fp8_f32(bf2f(a.x & 0xffffu), bf2f(a.x >> 16), w0, false); w0 = __builtin_amdgcn_cvt_pk_fp8_f32(bf2f(a.y & 0xffffu), bf2f(a.y >> 16), w0, true);
      w1 = __builtin_amdgcn_cvt_pk_fp8_f32(bf2f(a.z & 0xffffu), bf2f(a.z >> 16), w1, false); w1 = __builtin_amdgcn_cvt_pk_fp8_f32(bf2f(a.w & 0xffffu), bf2f(a.w >> 16), w1, true);
      w2 = __builtin_amdgcn_cvt_pk_fp8_f32(bf2f(c.x & 0xffffu), bf2f(c.x >> 16), w2, false); w2 = __builtin_amdgcn_cvt_pk_fp8_f32(bf2f(c.y & 0xffffu), bf2f(c.y >> 16), w2, true);
      w3 = __builtin_amdgcn_cvt_pk_fp8_f32(bf2f(c.z & 0xffffu), bf2f(c.z >> 16), w3, false); w3 = __builtin_amdgcn_cvt_pk_fp8_f32(bf2f(c.w & 0xffffu), bf2f(c.w >> 16), w3, true);
      qs0 = (i64_t)(((u64)(unsigned)w1 << 32) | (u64)(unsigned)w0); qs1 = (i64_t)(((u64)(unsigned)w3 << 32) | (u64)(unsigned)w2); }
    i64_t bq0[4], bq1[4];
#pragma unroll
    for (int g = 0; g < 4; ++g) { bq0[g] = (g == gl) ? qs0 : (i64_t)0; bq1[g] = (g == gl) ? qs1 : (i64_t)0; }
    const float slope = __builtin_amdgcn_exp2f(-0.5f * (float)(n16 + 1)) * LOG2E;
    const unsigned char* Kb = K1 + (size_t)b * T * 256; const unsigned char* Vb = V1 + (size_t)b * T * 256;
    const int vkey = lane >> 1, vpar = lane & 1;
    f32x4 sc[16];
    v4u vst[2][8];
    constexpr int KD = 3;
    v4u kfn[KD][4];
#pragma unroll
    for (int d = 0; d < KD; ++d) { const unsigned kidx = (unsigned)sel[16 * d + n16]; const unsigned char* kp = Kb + (size_t)kidx * 256 + 16 * q4;
#pragma unroll
      for (int g = 0; g < 4; ++g) kfn[d][g] = *(const GAS v4u*)(kp + 64 * g); }
#pragma unroll
    for (int blk = 0; blk < 16; ++blk) {
        f32x4 a = (f32x4){0.f, 0.f, 0.f, 0.f};
#pragma unroll
        for (int g = 0; g < 4; ++g) {
            const v4u ch = kfn[blk % KD][g];
            const i64_t k0 = (i64_t)(((u64)ch.y << 32) | (u64)ch.x), k1 = (i64_t)(((u64)ch.w << 32) | (u64)ch.z);
            a = __builtin_amdgcn_mfma_f32_16x16x32_fp8_fp8(k0, bq0[g], a, 0, 0, 0);
            a = __builtin_amdgcn_mfma_f32_16x16x32_fp8_fp8(k1, bq1[g], a, 0, 0, 0);
        }
        if (blk + KD < 16) { const unsigned kidx = (unsigned)sel[16 * (blk + KD) + n16]; const unsigned char* kp = Kb + (size_t)kidx * 256 + 16 * q4;
#pragma unroll
            for (int g = 0; g < 4; ++g) kfn[blk % KD][g] = *(const GAS v4u*)(kp + 64 * g); }
        if (blk >= 14) { const int d = blk - 14;
#pragma unroll
            for (int k = 0; k < 8; ++k) vst[d][k] = *(const GAS v4u*)(Vb + (size_t)sel[32 * d + 4 * k + q4] * 256 + 16 * n16); }
        const unsigned long long i4 = *(LAS const unsigned long long*)(sel + 16 * blk + 4 * q4);
#pragma unroll
        for (int i = 0; i < 4; ++i) { const unsigned pz = 16u * blk + 4u * q4 + i; const int ki = (int)((i4 >> (16 * i)) & 0xffffull);
            a[i] = (pz < cnt) ? (a[i] - slope * (float)(t - ki)) : -INFINITY; }
        sc[blk] = a;
    }
    float mx = -INFINITY;
#pragma unroll
    for (int blk = 0; blk < 16; ++blk) mx = fmaxf(fmaxf(fmaxf(mx, sc[blk][0]), fmaxf(sc[blk][1], sc[blk][2])), sc[blk][3]);
    mx = xmax32(xmax16(mx));
    float lsum = 0.f;
    mx -= 8.f;
#pragma unroll
    for (int blk = 0; blk < 16; ++blk)
#pragma unroll
        for (int i = 0; i < 4; ++i) { const float pv = __builtin_amdgcn_exp2f(sc[blk][i] - mx); sc[blk][i] = pv; lsum += pv; }
    lsum = xsum32(xsum16(lsum));
    LAS unsigned char* vbuf = lds + HIST_OFF + wave * 16384;
    unsigned vdst[4];
#pragma unroll
    for (int j = 0; j < 4; ++j) vdst[j] = (unsigned)(uintptr_t)vbuf + (unsigned)vkey * 256u + (unsigned)((((2 * j) ^ (vkey & 7)) << 5) | (vpar << 4));
    const int qq = n16 >> 2, pp = n16 & 3; const int r0 = 4 * q4 + qq, r1 = 16 + 4 * q4 + qq;
    f32x4 oe[2], oo[2];
#pragma unroll
    for (int d = 0; d < 2; ++d) { oe[d] = (f32x4){0.f, 0.f, 0.f, 0.f}; oo[d] = (f32x4){0.f, 0.f, 0.f, 0.f}; }
#pragma unroll
    for (int J = 0; J < 8; ++J) {
        LAS unsigned char* slot = vbuf + (J & 1) * 8192;
#pragma unroll
        for (int k = 0; k < 8; ++k) { const int key = 4 * k + q4; *(LAS v4u*)(slot + key * 256 + ((((n16 >> 1) ^ (key & 7)) << 5) | ((n16 & 1) << 4))) = vst[J & 1][k]; }
        if (J + 2 < 8) {
#pragma unroll
            for (int k = 0; k < 8; ++k) vst[J & 1][k] = *(const GAS v4u*)(Vb + (size_t)sel[32 * (J + 2) + 4 * k + q4] * 256 + 16 * n16); }
        asm volatile("s_waitcnt lgkmcnt(0)" ::: "memory");
        int p0 = 0, p1 = 0;
        p0 = __builtin_amdgcn_cvt_pk_fp8_f32(sc[2 * J][0], sc[2 * J][1], p0, false); p0 = __builtin_amdgcn_cvt_pk_fp8_f32(sc[2 * J][2], sc[2 * J][3], p0, true);
        p1 = __builtin_amdgcn_cvt_pk_fp8_f32(sc[2 * J + 1][0], sc[2 * J + 1][1], p1, false); p1 = __builtin_amdgcn_cvt_pk_fp8_f32(sc[2 * J + 1][2], sc[2 * J + 1][3], p1, true);
        const i64_t pb = (i64_t)(((u64)(unsigned)p1 << 32) | (u64)(unsigned)p0);
        v2u trl[8], trh[8];
#pragma unroll
        for (int sg = 0; sg < 8; ++sg) {
            const int a0 = r0 * 256 + (((sg ^ (r0 & 7)) << 5) | (pp << 3)), a1 = r1 * 256 + (((sg ^ (r1 & 7)) << 5) | (pp << 3));
            asm volatile("ds_read_b64_tr_b16 %0, %1" : "=v"(trl[sg]) : "v"((unsigned)(uintptr_t)(slot + a0)) : "memory");
            asm volatile("ds_read_b64_tr_b16 %0, %1" : "=v"(trh[sg]) : "v"((unsigned)(uintptr_t)(slot + a1)) : "memory");
        }
        asm volatile("s_waitcnt lgkmcnt(0)" : "+v"(trl[0]), "+v"(trl[1]), "+v"(trl[2]), "+v"(trl[3]), "+v"(trl[4]), "+v"(trl[5]), "+v"(trl[6]), "+v"(trl[7]),
                                               "+v"(trh[0]), "+v"(trh[1]), "+v"(trh[2]), "+v"(trh[3]), "+v"(trh[4]), "+v"(trh[5]), "+v"(trh[6]), "+v"(trh[7]) :: "memory");
#pragma unroll
        for (int g = 0; g < 4; ++g) {
            const i64_t pg = (g == gl) ? pb : (i64_t)0;
#pragma unroll
            for (int dbp = 0; dbp < 2; ++dbp) {
                const v2u lo = trl[2 * g + dbp], hi2 = trh[2 * g + dbp];
                const unsigned e0 = __builtin_amdgcn_perm(lo.y, lo.x, 0x06040200u), o0 = __builtin_amdgcn_perm(lo.y, lo.x, 0x07050301u);
                const unsigned e1 = __builtin_amdgcn_perm(hi2.y, hi2.x, 0x06040200u), o1 = __builtin_amdgcn_perm(hi2.y, hi2.x, 0x07050301u);
                const i64_t ae = (i64_t)(((u64)e1 << 32) | (u64)e0), ao = (i64_t)(((u64)o1 << 32) | (u64)o0);
                oe[dbp] = __builtin_amdgcn_mfma_f32_16x16x32_fp8_fp8(ae, pg, oe[dbp], 0, 0, 0);
                oo[dbp] = __builtin_amdgcn_mfma_f32_16x16x32_fp8_fp8(ao, pg, oo[dbp], 0, 0, 0);
            }
        }
    }
    (void)vdst;
    const float rl = 32.f / lsum;
#pragma unroll
    for (int dbp = 0; dbp < 2; ++dbp) {
        int w0 = 0, w1 = 0;
        w0 = __builtin_amdgcn_cvt_pk_fp8_f32(oe[dbp][0] * rl, oo[dbp][0] * rl, w0, false); w0 = __builtin_amdgcn_cvt_pk_fp8_f32(oe[dbp][1] * rl, oo[dbp][1] * rl, w0, true);
        w1 = __builtin_amdgcn_cvt_pk_fp8_f32(oe[dbp][2] * rl, oo[dbp][2] * rl, w1, false); w1 = __builtin_amdgcn_cvt_pk_fp8_f32(oe[dbp][3] * rl, oo[dbp][3] * rl, w1, true);
        *(GAS v2u*)((unsigned char*)O1 + ((size_t)b * T + t) * D + n16 * 64 + 32 * dbp + 8 * q4) = (v2u){(unsigned)w0, (unsigned)w1}; }
}

__device__ __forceinline__ void unit(LAS unsigned char* lds, int b, int t0q, const bf16* Q1, bf16* O1, const unsigned char* K1, const unsigned char* V1, const bf16* QI, const bf16* KI, const float* WI, int tid_in, int wave) {
    int tid = tid_in; asm volatile("" : "+v"(tid)); const int lane = tid & 63;
    const int hi = lane >> 5, r32 = lane & 31;
    if (tid < QT * 8) ((LAS float*)(lds + ST_OFF + 1024))[tid] = WI[((size_t)b * T + t0q) * 8 + tid];
    if (tid < QT) { LAS unsigned* st = (LAS unsigned*)(lds + ST_OFF + tid * 32); const int t = t0q + tid;
        unsigned z; asm volatile("v_mov_b32 %0, 0" : "=v"(z));
        st[0] = z; st[1] = z; st[2] = z + (unsigned)TOPK; st[3] = z; st[4] = z; st[5] = z; st[6] = (t + 1 <= TOPK) ? 1u : z; st[7] = z; }
    for (int i = tid; i < 32768 / 4; i += NTHREADS) ((LAS v4u*)(lds + HIST_OFF))[i] = (v4u){0u, 0u, 0u, 0u};
    bf16x8 qa[4][4];
    { const int qlr = 2 * ((r32 >> 2) & 1) + (r32 >> 4), hd = 4 * ((r32 >> 3) & 1) + (r32 & 3);
#pragma unroll
      for (int rb = 0; rb < 4; ++rb) { const bf16* qp = QI + ((size_t)b * T + t0q + 4 * rb + qlr) * 512 + hd * 64 + 8 * hi;
#pragma unroll
          for (int ks = 0; ks < 4; ++ks) qa[rb][ks] = *(const GAS bf16x8*)(qp + 16 * ks); } }
    const int nst = (t0q + QT + 31) >> 5;
    const bf16* KIb = KI + (size_t)b * T * 64;
    bool done = false;
    if (t0q >= 2048) {
        const int nfull_ = (t0q + 1) >> 5, nsamp = (nfull_ + 7) >> 3;
        if (tid < QT) { LAS unsigned* st = (LAS unsigned*)(lds + ST_OFF + tid * 32); const unsigned n = (unsigned)(t0q + tid + 1), ns = 32u * (unsigned)nsamp; st[2] = (512u * ns + n - 1u) / n; }
        __syncthreads();
        idx_pass<0, true, 0, 8>(qa, KIb, t0q, nsamp, wave, lane, lds, 0, 45, 33, 4095u);
        __syncthreads();
        find_bin(lds, 2 * wave, lane, 12); find_bin(lds, 2 * wave + 1, lane, 12);
        __syncthreads();
        idx_pass<3, true>(qa, KIb, t0q, nst, wave, lane, lds, 0, 0, 33, 0u);
        __syncthreads();
        bool bad = false;
#pragma unroll
        for (int r = 0; r < QT; ++r) { const unsigned c = ((LAS const unsigned*)(lds + ST_OFF + r * 32))[3] >> 16; bad = bad || c < (unsigned)TOPK || c > (unsigned)CAP; }
        __syncthreads();
        if (!bad) {
            if (tid < QT) { LAS unsigned* st = (LAS unsigned*)(lds + ST_OFF + tid * 32); st[0] = 0u; st[1] = 0u; st[2] = (unsigned)TOPK; }
            __syncthreads();
            { int lane_c; asm volatile("v_mbcnt_lo_u32_b32 %0, -1, 0\n\tv_mbcnt_hi_u32_b32 %0, -1, %0" : "=v"(lane_c));
              finish_row(lds, 2 * wave, lane_c, 45); finish_row(lds, 2 * wave + 1, lane_c, 45); }
            __syncthreads();
            done = true;
        } else {
            if (tid < QT) { LAS unsigned* st = (LAS unsigned*)(lds + ST_OFF + tid * 32); st[0] = 0u; st[1] = 0u; st[2] = (unsigned)TOPK; st[3] = 0u; st[4] = 0u; st[5] = 0u; }
            for (int i = tid; i < 32768 / 4; i += NTHREADS) ((LAS v4u*)(lds + HIST_OFF))[i] = (v4u){0u, 0u, 0u, 0u};
            __syncthreads();
        }
    }
    int level = 0, lo_shift = 33;
    if (!done) {
    for (;;) {
        const int hi_shift = 45 - 12 * level; lo_shift = (level == 3) ? 0 : 33 - 12 * level; const int bits = (level == 3) ? 9 : 12; const unsigned mask = (1u << bits) - 1u;
        if (level > 0) { for (int i = tid; i < 32768 / 4; i += NTHREADS) ((LAS v4u*)(lds + HIST_OFF))[i] = (v4u){0u, 0u, 0u, 0u}; }
        __syncthreads();
        if (MK_DUP & 512) {
            if (MK_DUP & 1024) idx_pass<0, true, 1>(qa, KIb, t0q, nst, wave, lane, lds, level, hi_shift, lo_shift, mask);
            else if (MK_DUP & 2048) idx_pass<0, true, 2>(qa, KIb, t0q, nst, wave, lane, lds, level, hi_shift, lo_shift, mask);
            else idx_pass<0, true>(qa, KIb, t0q, nst, wave, lane, lds, level, hi_shift, lo_shift, mask);
            __syncthreads();
            for (int i = tid; i < 32768 / 4; i += NTHREADS) ((LAS v4u*)(lds + HIST_OFF))[i] = (v4u){0u, 0u, 0u, 0u};
            __syncthreads();
        }
        if (level == 0) idx_pass<0, true>(qa, KIb, t0q, nst, wave, lane, lds, level, hi_shift, lo_shift, mask);
        else idx_pass<0, false>(qa, KIb, t0q, nst, wave, lane, lds, level, hi_shift, lo_shift, mask);
        __syncthreads();
        find_bin(lds, 2 * wave, lane, bits); find_bin(lds, 2 * wave + 1, lane, bits);
        __syncthreads();
        bool more = false;
        if (level < 3) {
#pragma unroll
            for (int r = 0; r < QT; ++r) { LAS const unsigned* st = (LAS const unsigned*)(lds + ST_OFF + r * 32); more = more || (st[6] == 0u && st[5] > (unsigned)CAP); }
        }
        if (!more) break;
        ++level;
    }
    __syncthreads();
    if (MK_DUP & 4096) { idx_pass<1, true>(qa, KIb, t0q, nst, wave, lane, lds, level, 0, lo_shift, 0u); __syncthreads(); if (tid < QT) ((LAS unsigned*)(lds + ST_OFF + tid * 32))[3] = 0u; __syncthreads(); }
    if (level == 0) idx_pass<1, true>(qa, KIb, t0q, nst, wave, lane, lds, level, 0, lo_shift, 0u);
    else idx_pass<1, false>(qa, KIb, t0q, nst, wave, lane, lds, level, 0, lo_shift, 0u);
    __syncthreads();
    finish_row(lds, 2 * wave, lane, lo_shift); finish_row(lds, 2 * wave + 1, lane, lo_shift);
    __syncthreads();
    }
#pragma unroll 1
    for (int rr = 0; rr < (MK_DUP & 256 ? 4 : 2); ++rr) sparse_attn_row8(lds, 2 * wave + (rr & 1), b, t0q + 2 * wave + (rr & 1), Q1, O1, K1, V1, wave, lane);
    __syncthreads();
}
}
#if defined(__HIP_DEVICE_COMPILE__)
typedef const __attribute__((address_space(4))) Ptrs* KArgs;
__device__ __forceinline__ const Ptrs* get_args() { KArgs p = (KArgs)__builtin_amdgcn_kernarg_segment_ptr(); asm volatile("" : "+s"(p)); return (const Ptrs*)p; }
#else
__device__ __forceinline__ const Ptrs* get_args() { return nullptr; }
#endif
#define DUP(bit, ...) do { if (MK_DUP & (1 << (bit))) { __VA_ARGS__; GRID_BAR(); } } while (0)
__global__ void __launch_bounds__(NTHREADS, 2) hybrid_fwd(Ptrs Pbyval) {
    extern __shared__ __attribute__((aligned(16))) unsigned char lds_raw[];
    LAS unsigned char* lds = (LAS unsigned char*)lds_raw;
    volatile LAS unsigned* MISC = (volatile LAS unsigned*)(lds + MISC_OFF);
    const int tid0 = threadIdx.x; const int wave_s = __builtin_amdgcn_readfirstlane(tid0 >> 6);
#define FRESH_IDS() const Ptrs P = *get_args(); unsigned char* ws = P.ws; gu32* ctl = (gu32*)(ws + WS_CTL); float* MOD = (float*)(ws + WS_MOD); bf16* Hb = (bf16*)(ws + WS_H); (void)ctl; (void)MOD; (void)Hb; int tid; asm volatile("v_mbcnt_lo_u32_b32 %0, -1, 0\n\tv_mbcnt_hi_u32_b32 %0, -1, %0\n\tv_lshl_or_b32 %0, %1, 6, %0" : "=&v"(tid) : "s"(wave_s)); const int lane = tid & 63; const int wave = __builtin_amdgcn_readfirstlane(tid >> 6); (void)lane; (void)wave
    const int G = gridDim.x; const int bx = blockIdx.x; const int vcu = (G % 8 == 0) ? (bx % 8) * (G / 8) + bx / 8 : bx;
    for (int u = tid0; u < (LDS_BYTES - LDSCTL_OFF) / 4; u += NTHREADS) ((LAS unsigned*)(lds + LDSCTL_OFF))[u] = 0u;
    __syncthreads();
    XcdBarrier bar = xcd_barrier_post((unsigned*)((gu32*)(Pbyval.ws + WS_CTL) + CW_BAR), MISC + 8);
#define GRID_BAR() xcd_barrier(bar)

#define PH_PROLOGUE() do { FRESH_IDS(); p0_prologue(P, lds, tid, lane, wave, vcu, G); } while (0)
#define PH_NORM1_L0() do { FRESH_IDS(); norm_phase<true, false, 1>(P.x, P.g_mix, MOD, 0, 1, Hb, (unsigned char*)Hb, P.fox_w_in, P.fox_b_f, (float*)(ws + WS_LOGF), lds, tid, lane, wave, vcu, G); } while (0)
#define PH_NORM1_L1() do { FRESH_IDS(); norm_phase<false, true, 2>((const bf16*)(ws + WS_XB), P.g_mix + D, MOD + (size_t)2 * 6144, 0, 1, Hb, ws + WS_H8, nullptr, nullptr, nullptr, lds, tid, lane, wave, vcu, G); } while (0)
#define PH_NORM2(layer) do { FRESH_IDS(); norm_phase<false, true, 1>((const bf16*)(ws + WS_XB), P.g_ffn + layer * D, MOD + (size_t)layer * 2 * 6144, 3, 4, Hb, (unsigned char*)Hb, nullptr, nullptr, nullptr, lds, tid, lane, wave, vcu, G); } while (0)
#define PH_QKV() do { \
        { FRESH_IDS(); for (int seq = bx; seq < 32; seq += G) fox_scan((const float*)(ws + WS_LOGF), (float*)(ws + WS_BETA), ws + WS_KE, seq, (LAS float*)(lds + RING_OFF), tid, lane, wave); } \
        { FRESH_IDS(); \
            pg8::Gemm g{Hb, (const bf16*)(ws + WS_WFIN), M, 3 * D, D / 2, D / 2, D / 2, 0x7f7f7f7f, 0x7a7a7a7a}; pg8::StaticOrder S; S.init(M, 3 * D, G, bx); \
            pg8::EpiHeads E{}; E.ntens = 3; \
            E.base[0] = (bf16*)(ws + WS_Q); E.tile0[0] = 0; E.ldc[0] = D; E.kind[0] = 1; E.gain[0] = P.fox_g_q; E.scale[0] = attn_body::C2; \
            E.base[1] = (bf16*)(ws + WS_K); E.tile0[1] = 4; E.ldc[1] = D; E.kind[1] = 1; E.gain[1] = P.fox_g_k; E.scale[1] = 1.f; \
            E.base[2] = (bf16*)(ws + WS_V); E.tile0[2] = 8; E.ldc[2] = D; E.kind[2] = 0; E.gain[2] = P.fox_g_k; E.scale[2] = 1.f; \
            E.base[3] = E.base[2]; E.tile0[3] = 1 << 30; E.ldc[3] = D; E.kind[3] = 0; E.gain[3] = P.fox_g_k; E.scale[3] = 1.f; \
            pg8::gemm_phase<pg8::EpiHeads, pg8::StaticOrder, true, true, true>(lds + RING_OFF, g, S, E, tid); } } while (0)
#define PH_FOXATTN(qword) do { FRESH_IDS(); \
            float qkmax; \
            { const float gq = wave_max(fabsf(P.fox_g_q[lane])), gk = wave_max(fabsf(P.fox_g_k[lane])); qkmax = 64.f * attn_body::C2 * gq * gk * 1.02f + 0.5f; } \
            for (;;) { \
                if (tid == 0) MISC[16] = __hip_atomic_fetch_add(ctl + (qword), 1u, RLX_AGENT); \
                __syncthreads(); \
                const int id = (int)MISC[16]; \
                __syncthreads(); \
                if (id >= 32 * 32) break; \
                const int qb = 31 - (id >> 5), bh = id & 31; \
                attn_body::attn_unit<8>(bh >> 4, bh & 15, qb, (const attn_body::bf16*)(ws + WS_Q), (const attn_body::bf16*)(ws + WS_K), (const attn_body::bf16*)(ws + WS_V), \
                                        (attn_body::bf16*)(ws + WS_O), (const attn_body::bf16*)(ws + WS_KE), (const float*)(ws + WS_BETA), qkmax, (char*)lds_raw + RING_OFF, tid); \
            } } while (0)
#define PH_OUTPROJ(layer, OBUF, WBUF) do { FRESH_IDS(); \
            pg8::Gemm g{(const bf16*)(ws + (OBUF)), (const bf16*)(ws + (WBUF)), M, D, D / 2, D / 2, D / 2, 0x7a7a7a7a, 0x7a7a7a7a}; pg8::StaticOrder S; S.init(M, D, G, bx); \
              \
            if (layer == 0) { if (S.nwg <= G) { pg8::EpiResNormStaged<false, 1> E{P.x, ws + WS_XB, MOD + 2 * D, 6144, T, P.g_ffn, MOD, 3, 4, Hb, (unsigned char*)Hb, (float*)(ws + WS_XS), (unsigned*)(ctl + CW_NS), lds + HALO_OFF}; \
                    pg8::gemm_phase<pg8::EpiResNormStaged<false, 1>, pg8::StaticOrder, true, true, true>(lds + RING_OFF, g, S, E, tid); } \
                else { pg8::EpiRes<false, true> E{P.x, ws + WS_XB, MOD + 2 * D, 6144, T}; pg8::gemm_phase<pg8::EpiRes<false, true>, pg8::StaticOrder, true, true, true>(lds + RING_OFF, g, S, E, tid); } } \
            else { if (S.nwg <= G) { pg8::EpiResNormStaged<true, 1> E{ws + WS_XB, ws + WS_XB, MOD + (size_t)2 * 6144 + 2 * D, 6144, T, P.g_ffn + D, MOD + (size_t)2 * 6144, 3, 4, Hb, (unsigned char*)Hb, (float*)(ws + WS_XS) + (size_t)2 * M * 4, (unsigned*)(ctl + CW_NS + 2048), lds + HALO_OFF}; \
                    pg8::gemm_phase<pg8::EpiResNormStaged<true, 1>, pg8::StaticOrder, true, true, true>(lds + RING_OFF, g, S, E, tid); } \
                else { pg8::EpiRes<true, true> E{ws + WS_XB, ws + WS_XB, MOD + (size_t)2 * 6144 + 2 * D, 6144, T}; pg8::gemm_phase<pg8::EpiRes<true, true>, pg8::StaticOrder, true, true, true>(lds + RING_OFF, g, S, E, tid); } } } while (0)
#define PH_UP(layer) do { FRESH_IDS(); \
            pg8::Gemm g{Hb, (const bf16*)(ws + (layer == 0 ? WS_WUP0 : WS_WUP1)), M, FF2, D / 2, D / 2, D / 2, 0x7f7f7f7f, 0x7a7a7a7a}; pg8::StaticOrder S; S.init(M, FF2, G, bx); \
            pg8::EpiConvGate E{(bf16*)(ws + WS_U), P.ffn_conv_w + (size_t)layer * 3 * FF, P.ffn_conv_b + (size_t)layer * FF, (float*)(ws + WS_SA0), (float*)(ws + WS_SG0), (float*)(ws + WS_SA1), (LAS float*)(lds + HALO_OFF), lds + RING_OFF + 3 * 16384  }; \
            pg8::gemm_phase<pg8::EpiConvGate, pg8::StaticOrder, true, true, true>(lds + RING_OFF, g, S, E, tid); } while (0)
#define PH_DOWN(layer) do { FRESH_IDS(); \
            pg8::Gemm g{(const bf16*)(ws + WS_U), (const bf16*)(ws + (layer == 0 ? WS_WDN0 : WS_WDN1)), M, D, FF / 2, FF / 2, FF / 2, 0x7f7f7f7f, 0x79797979}; pg8::StaticOrder S; S.init(M, D, G, bx); \
            { pg8::Unit u0; for (int i_ = 0; S.next(i_, u0); ++i_) conv_fixup((bf16*)(ws + WS_U), (const float*)(ws + WS_SA0), (const float*)(ws + WS_SG0), (const float*)(ws + WS_SA1), P.ffn_conv_w + (size_t)layer * 3 * FF, P.ffn_conv_b + (size_t)layer * FF, u0.pm, tid); } \
            if (layer == 0) { if (S.nwg <= G) { pg8::EpiResNormStaged<true, 2> E{ws + WS_XB, ws + WS_XB, MOD + 5 * D, 6144, T, P.g_mix + D, MOD + (size_t)2 * 6144, 0, 1, Hb, ws + WS_H8, (float*)(ws + WS_XS) + (size_t)M * 4, (unsigned*)(ctl + CW_NS + 1024), lds + HALO_OFF}; \
                    pg8::gemm_phase<pg8::EpiResNormStaged<true, 2>, pg8::StaticOrder, true, true, true>(lds + RING_OFF, g, S, E, tid); } \
                else { pg8::EpiRes<true, true> E{ws + WS_XB, ws + WS_XB, MOD + 5 * D, 6144, T}; pg8::gemm_phase<pg8::EpiRes<true, true>, pg8::StaticOrder, true, true, true>(lds + RING_OFF, g, S, E, tid); } } \
            else { if (S.nwg <= G) { pg8::EpiResStaged<true, false> E{ws + WS_XB, P.out, MOD + (size_t)2 * 6144 + 5 * D, 6144, T}; pg8::gemm_phase<pg8::EpiResStaged<true, false>, pg8::StaticOrder, true, true, true>(lds + RING_OFF, g, S, E, tid); } \
                else { pg8::EpiRes<true, false> E{ws + WS_XB, P.out, MOD + (size_t)2 * 6144 + 5 * D, 6144, T}; pg8::gemm_phase<pg8::EpiRes<true, false>, pg8::StaticOrder, true, true, true>(lds + RING_OFF, g, S, E, tid); } } } while (0)
#define PH_DSAIN() do { FRESH_IDS(); \
              \
            if (G % 16 != 0) dsa::tail_phase(Hb, (const bf16*)(ws + WS_WDTAIL), P.dsa_g_kidx, (bf16*)(ws + WS_KI), (float*)(ws + WS_WI), lane, vcu * NWAVES + wave, G * NWAVES); \
            else if (bx < G / 2) dsa::tail_phase(Hb, (const bf16*)(ws + WS_WDTAIL), P.dsa_g_kidx, (bf16*)(ws + WS_KI), (float*)(ws + WS_WI), lane, bx * NWAVES + wave, (G / 2) * NWAVES); \
              \
            { pg8::Gemm g{(const bf16*)(ws + WS_H8), (const bf16*)(ws + WS_WDIN), M, 3 * D / 2, D / 2, D / 2, D / 2, 0x7f7f7f7f, 0x7a7a7a7a}; pg8::StaticOrder S; S.init(M, 3 * D / 2, G, bx); \
              pg8::EpiHeads E{}; E.ntens = 3; \
              E.base[0] = (bf16*)(ws + WS_Q1); E.tile0[0] = 0; E.ldc[0] = D; E.kind[0] = 1; E.gain[0] = P.dsa_g_q; E.scale[0] = attn_body::C2; \
              E.base[1] = (bf16*)(ws + WS_K1); E.tile0[1] = 4; E.ldc[1] = 256; E.kind[1] = 1; E.gain[1] = P.dsa_g_k; E.scale[1] = 1.f; E.f8[1] = 1; \
              E.base[2] = (bf16*)(ws + WS_V1); E.tile0[2] = 5; E.ldc[2] = 256; E.kind[2] = 0; E.gain[2] = P.dsa_g_k; E.scale[2] = 1.f; E.f8[2] = 1; \
              E.base[3] = E.base[2]; E.tile0[3] = 1 << 30; E.ldc[3] = 256; E.kind[3] = 0; E.gain[3] = P.dsa_g_k; E.scale[3] = 1.f; \
              pg8::gemm_phase<pg8::EpiHeads, pg8::StaticOrder, true, true, true>(lds + RING_OFF, g, S, E, tid); } \
            { FRESH_IDS(); pg8::Gemm g{Hb, (const bf16*)(ws + WS_WDIN + 2 * MiB), M, D / 2, D, D, D, 0, 0}; pg8::StaticOrder S; S.init(M, D / 2, G, (G % 16 == 0) ? (bx + G / 2) % G : bx); \
              pg8::EpiHeads E{}; E.ntens = 1; \
              E.base[0] = (bf16*)(ws + WS_QI); E.tile0[0] = 0; E.ldc[0] = 512; E.kind[0] = 0; E.gain[0] = P.dsa_g_k; E.scale[0] = 1.f; \
              for (int i_ = 1; i_ < 4; ++i_) { E.base[i_] = E.base[0]; E.tile0[i_] = 1 << 30; E.ldc[i_] = 512; E.kind[i_] = 0; E.gain[i_] = P.dsa_g_k; E.scale[i_] = 1.f; } \
              pg8::gemm_phase<pg8::EpiHeads, pg8::StaticOrder, true, true>(lds + RING_OFF, g, S, E, tid); } } while (0)
#define PH_DSAUNITS(qword) do { FRESH_IDS(); \
            int qb_ = (bx & 1), tries_ = 0;      \
            for (;;) { \
                if (tid == 0) MISC[16] = __hip_atomic_fetch_add(ctl + (qword) + 64 * qb_, 1u, RLX_AGENT); \
                __syncthreads(); \
                const int id = (int)MISC[16]; \
                __syncthreads(); \
                if (id >= T / dsa::QT) { if (++tries_ >= 2) break; qb_ ^= 1; continue; } \
                const int b = qb_, t0q = (T / dsa::QT - 1 - id) * dsa::QT; \
                dsa::unit(lds, b, t0q, (const bf16*)(ws + WS_Q1), (bf16*)(ws + WS_O1), (const unsigned char*)(ws + WS_K1), (const unsigned char*)(ws + WS_V1), (const bf16*)(ws + WS_QI), (const bf16*)(ws + WS_KI), (const float*)(ws + WS_WI), tid, wave); \
            } } while (0)

    const bool fusedn = (M / 256) * (D / 256) <= G;
    PH_PROLOGUE(); GRID_BAR();                       DUP(0, PH_PROLOGUE());
    PH_NORM1_L0(); GRID_BAR();                       DUP(1, PH_NORM1_L0());
    PH_QKV(); GRID_BAR();                            DUP(2, PH_QKV());
    PH_FOXATTN(CW_AQ); GRID_BAR();                   DUP(3, PH_FOXATTN(CW_AQ + 64));
    PH_OUTPROJ(0, WS_O, WS_WFOUT); GRID_BAR();       DUP(10, PH_OUTPROJ(0, WS_O, WS_WFOUT));
    if (!fusedn) { PH_NORM2(0); GRID_BAR(); }
    PH_UP(0); GRID_BAR();                            DUP(5, PH_UP(0));
    PH_DOWN(0); GRID_BAR();
    if (!fusedn) { PH_NORM1_L1(); GRID_BAR(); }
    PH_DSAIN(); GRID_BAR();                          DUP(6, PH_DSAIN());
    PH_DSAUNITS(CW_DQ); GRID_BAR();                  DUP(7, PH_DSAUNITS(CW_DQ + 128));
    PH_OUTPROJ(1, WS_O1, WS_WDOUT); GRID_BAR();
    if (!fusedn) { PH_NORM2(1); GRID_BAR(); }
    PH_UP(1); GRID_BAR();
    PH_DOWN(1);
    if (MK_DUP & 512) { GRID_BAR(); PH_DOWN(1); }
}

extern "C" void kernel_launch(void* const* d_in, const int* in_sizes, int n_in, void* d_out, int out_size, void* d_ws, size_t ws_size, hipStream_t stream) {
    static int grid = 0;
    if (grid == 0) {
        if (n_in != 20 || in_sizes[0] != M * D || out_size != M * D || ws_size < WS_END) { fprintf(stderr, "kernel_launch: unexpected problem (n_in %d, in0 %d, out %d, ws %zu); nothing launched\n", n_in, n_in > 0 ? in_sizes[0] : -1, out_size, ws_size); grid = -1; return; }
        int dev = 0, cus = 0, per_cu = 0;
        if (hipGetDevice(&dev) != hipSuccess || hipDeviceGetAttribute(&cus, hipDeviceAttributeMultiprocessorCount, dev) != hipSuccess) { grid = -1; return; }
        if (hipFuncSetAttribute((const void*)hybrid_fwd, hipFuncAttributeMaxDynamicSharedMemorySize, LDS_BYTES) != hipSuccess) { fprintf(stderr, "kernel_launch: hipFuncSetAttribute failed\n"); grid = -1; return; }
        if (hipOccupancyMaxActiveBlocksPerMultiprocessor(&per_cu, (const void*)hybrid_fwd, NTHREADS, LDS_BYTES) != hipSuccess || per_cu < 1)
            fprintf(stderr, "kernel_launch: note: occupancy query reports %d workgroups per CU\n", per_cu);
        (void)hipGetLastError();
        grid = cus;
    }
    if (grid < 0) return;
    if (hipMemsetAsync((char*)d_ws + WS_CTL, 0, CTL_ZERO_BYTES, stream) != hipSuccess) return;
    Ptrs p{};
    p.x = (const float*)d_in[0]; p.c = (const float*)d_in[1]; p.w_ada = (const float*)d_in[2]; p.b_ada = (const float*)d_in[3]; p.g_mix = (const float*)d_in[4]; p.g_ffn = (const float*)d_in[5];
    p.fox_w_in = (const float*)d_in[6]; p.fox_b_f = (const float*)d_in[7]; p.fox_g_q = (const float*)d_in[8]; p.fox_g_k = (const float*)d_in[9]; p.fox_w_out = (const float*)d_in[10];
    p.dsa_w_in = (const float*)d_in[11]; p.dsa_g_q = (const float*)d_in[12]; p.dsa_g_k = (const float*)d_in[13]; p.dsa_g_kidx = (const float*)d_in[14]; p.dsa_w_out = (const float*)d_in[15];
    p.ffn_w_up = (const float*)d_in[16]; p.ffn_conv_w = (const float*)d_in[17]; p.ffn_conv_b = (const float*)d_in[18]; p.ffn_w_down = (const float*)d_in[19];
    p.out = (float*)d_out; p.ws = (unsigned char*)d_ws;
    hipLaunchKernelGGL(hybrid_fwd, dim3(grid), dim3(NTHREADS), LDS_BYTES, stream, p);
}
```

```cpp
#include <hip/hip_runtime.h>
#include <cstdio>
#include <cstdint>
__device__ __forceinline__ float xsum16(float v) { const unsigned a = __builtin_bit_cast(unsigned, v); const auto r = __builtin_amdgcn_permlane16_swap(a, a, false, false); const unsigned r0 = r[0], r1 = r[1]; return __builtin_bit_cast(float, r0) + __builtin_bit_cast(float, r1); }
__device__ __forceinline__ float xsum32(float v) { const unsigned a = __builtin_bit_cast(unsigned, v); const auto r = __builtin_amdgcn_permlane32_swap(a, a, false, false); const unsigned r0 = r[0], r1 = r[1]; return __builtin_bit_cast(float, r0) + __builtin_bit_cast(float, r1); }
__device__ __forceinline__ float xmax16(float v) { const unsigned a = __builtin_bit_cast(unsigned, v); const auto r = __builtin_amdgcn_permlane16_swap(a, a, false, false); const unsigned r0 = r[0], r1 = r[1]; return fmaxf(__builtin_bit_cast(float, r0), __builtin_bit_cast(float, r1)); }
__device__ __forceinline__ float xmax32(float v) { const unsigned a = __builtin_bit_cast(unsigned, v); const auto r = __builtin_amdgcn_permlane32_swap(a, a, false, false); const unsigned r0 = r[0], r1 = r[1]; return fmaxf(__builtin_bit_cast(float, r0), __builtin_bit_cast(float, r1)); }
template <int CTRL> __device__ __forceinline__ float dppf(float v) { return __builtin_bit_cast(float, __builtin_amdgcn_update_dpp(0, __builtin_bit_cast(int, v), CTRL, 0xf, 0xf, true)); }
namespace pg8 {
#define PG8_LAS __attribute__((address_space(3)))
typedef unsigned short bf16_t;
typedef short bf16x8 __attribute__((ext_vector_type(8)));
typedef float f32x4 __attribute__((ext_vector_type(4)));
typedef unsigned u32x4 __attribute__((ext_vector_type(4)));
typedef int pg8_v8i __attribute__((ext_vector_type(8)));
typedef short pg8_bf16x16 __attribute__((ext_vector_type(16)));
constexpr int BM = 256, BK = 64, HALF = 128, HTB = HALF * BK * 2  , STAGE_BYTES = 8 * HTB, NXCD = 8, WGM = 4;

__host__ __device__ __forceinline__ int lds_byte(int r, int c) { const int st = (r >> 4) * 2 + (c >> 5), rr = r & 15, cc = c & 31, ob = rr * 64 + cc * 2; return st * 1024 + (ob ^ (((ob >> 9) & 1) << 5)); }
__host__ __device__ __forceinline__ void stage_rc(int b, int& R, int& C) { const int st = b / 1024, sb = b % 1024, swz = sb ^ (((sb >> 9) & 1) << 5); R = (st >> 1) * 16 + swz / 64; C = (st & 1) * 32 + (swz % 64) / 2; }
__host__ __device__ __forceinline__ int perm32(int rho) { const int n = rho >> 4, i = rho & 15; return 8 * (i >> 2) + 4 * n + (i & 3); }

struct Unit { int pm, pn; };
struct Gemm { const bf16_t* A; const bf16_t* Bt; int M, N, K, lda, ldb; int sa, sb; };

struct StaticOrder {
    int nM, nN, nwg, G, c, wgm, rot;
    __host__ __device__ void init(int M, int N, int G_, int c_, int wgm_ = WGM, int rot_ = 3) { nM = M / BM; nN = N / BM; nwg = nM * nN; G = G_; c = c_; wgm = wgm_; rot = rot_; }
    __host__ __device__ __forceinline__ bool next(int i, Unit& u) const {
        const long L = (long)i * G + c; if (L >= nwg) return false;
        int wgid = (int)L; { const int q = nwg / NXCD, r = nwg % NXCD, xcd = wgid % NXCD, off = wgid / NXCD; wgid = (xcd < r ? xcd * (q + 1) : r * (q + 1) + (xcd - r) * q) + off; }
        const int nig = wgm * nN, gid = wgid / nig, fm = gid * wgm, gsz = (nM - fm) < wgm ? (nM - fm) : wgm;
        u.pm = fm + ((wgid % nig) % gsz); u.pn = ((wgid % nig) / gsz + rot * (int)(L % NXCD)) % nN; return true;
    }
    __device__ __forceinline__ void a_ready(const Unit&) const {}
    __device__ __forceinline__ void done(const Unit&) const {}
};

__device__ __forceinline__ unsigned cvt_pk_bf16(float lo, float hi) { unsigned r; asm volatile("v_cvt_pk_bf16_f32 %0, %1, %2" : "=v"(r) : "v"(lo), "v"(hi)); return r; }
typedef float f32x2 __attribute__((ext_vector_type(2)));
struct EpiBf16 {
    static constexpr bool PERM = true, AFTER_DRAIN = false;
    bf16_t* O; int ldc;
    __device__ __forceinline__ void operator()(const f32x4 (&acc)[2][2][4][2], const Unit& u, int wr, int wc, int fr, int fq) const {
        const int row0 = u.pm * BM + wr * 64 + fr; const int col0 = u.pn * BM + wc * 32 + 8 * fq;
#pragma unroll
        for (int ai = 0; ai < 2; ++ai)
#pragma unroll
            for (int m = 0; m < 4; ++m) { bf16_t* rowp = O + (size_t)(row0 + ai * HALF + m * 16) * ldc + col0;
#pragma unroll
                for (int bj = 0; bj < 2; ++bj) { const f32x4 v0 = acc[ai][bj][m][0], v1 = acc[ai][bj][m][1];
                    u32x4 w; w.x = cvt_pk_bf16(v0[0], v0[1]); w.y = cvt_pk_bf16(v0[2], v0[3]); w.z = cvt_pk_bf16(v1[0], v1[1]); w.w = cvt_pk_bf16(v1[2], v1[3]);
                    *(u32x4*)(rowp + bj * HALF) = w; } }
    }
};
struct EpiHeads {
    static constexpr bool PERM = true, AFTER_DRAIN = false;
    bf16_t* base[4]; int tile0[4]; int ldc[4]; int kind[4]; const float* gain[4]; float scale[4]; int f8[4];
    int ntens;
    __device__ __forceinline__ void operator()(const f32x4 (&acc)[2][2][4][2], const Unit& u, int wr, int wc, int fr, int fq) const {
        bf16_t* O = base[0]; int t0 = tile0[0], ld = ldc[0], kd = kind[0], o8 = f8[0]; const float* gn = gain[0]; float sc = scale[0];
#pragma unroll
        for (int i = 1; i < 4; ++i) if (i < ntens && u.pn >= tile0[i]) { O = base[i]; t0 = tile0[i]; ld = ldc[i]; kd = kind[i]; gn = gain[i]; sc = scale[i]; o8 = f8[i]; }
        const int head = (u.pn - t0) * 4 + wc; const int row0 = u.pm * BM + wr * 64 + fr;
        f32x4 gv[2][2];
#pragma unroll
        for (int bj = 0; bj < 2; ++bj)
#pragma unroll
            for (int n = 0; n < 2; ++n) gv[bj][n] = (kd == 1) ? *(const f32x4*)(gn + 32 * bj + 8 * fq + 4 * n) * sc : (f32x4){sc, sc, sc, sc};
#pragma unroll
        for (int ai = 0; ai < 2; ++ai)
#pragma unroll
            for (int m = 0; m < 4; ++m) {
                float rs = 1.f;
                if (kd == 1) { float ss = 0.f;
#pragma unroll
                    for (int bj = 0; bj < 2; ++bj)
#pragma unroll
                        for (int n = 0; n < 2; ++n) { const f32x4 x = acc[ai][bj][m][n]; ss += (x[0] * x[0] + x[1] * x[1]) + (x[2] * x[2] + x[3] * x[3]); }
                    ss = xsum32(xsum16(ss));
                    rs = __builtin_amdgcn_rsqf(ss * (1.0f / 64.0f) + 1e-6f); }
                if (o8) {
                    unsigned char* rowb = (unsigned char*)O + (size_t)(row0 + ai * HALF + m * 16) * ld + head * 64 + 8 * fq;
#pragma unroll
                    for (int bj = 0; bj < 2; ++bj) { const f32x4 v0 = acc[ai][bj][m][0] * rs * gv[bj][0], v1 = acc[ai][bj][m][1] * rs * gv[bj][1];
                        int w0 = 0, w1 = 0; w0 = __builtin_amdgcn_cvt_pk_fp8_f32(v0[0], v0[1], w0, false); w0 = __builtin_amdgcn_cvt_pk_fp8_f32(v0[2], v0[3], w0, true);
                        w1 = __builtin_amdgcn_cvt_pk_fp8_f32(v1[0], v1[1], w1, false); w1 = __builtin_amdgcn_cvt_pk_fp8_f32(v1[2], v1[3], w1, true);
                        typedef unsigned u32x2 __attribute__((ext_vector_type(2))); *(u32x2*)(rowb + bj * 32) = (u32x2){(unsigned)w0, (unsigned)w1}; }
                } else {
                bf16_t* rowp = O + (size_t)(row0 + ai * HALF + m * 16) * ld + head * 64 + 8 * fq;
#pragma unroll
                for (int bj = 0; bj < 2; ++bj) { const f32x4 v0 = acc[ai][bj][m][0] * rs * gv[bj][0], v1 = acc[ai][bj][m][1] * rs * gv[bj][1];
                    u32x4 w; w.x = cvt_pk_bf16(v0[0], v0[1]); w.y = cvt_pk_bf16(v0[2], v0[3]); w.z = cvt_pk_bf16(v1[0], v1[1]); w.w = cvt_pk_bf16(v1[2], v1[3]);
                    *(u32x4*)(rowp + bj * 32) = w; } } }
    }
};
template <bool BIN16, bool BOUT16>
struct EpiRes {
    static constexpr bool PERM = false, AFTER_DRAIN = false;
    const void* base; void* out; const float* gate; int gate_bstride; int rows_per_batch;
    __device__ __forceinline__ void operator()(const f32x4 (&acc)[2][2][4][2], const Unit& u, int wr, int wc, int fr, int fq) const {
        typedef unsigned u32x2 __attribute__((ext_vector_type(2)));
        const int col0 = u.pn * BM + wc * 32 + 4 * fq; const int b = (u.pm * BM) / rows_per_batch;
        f32x4 gv[2][2];
#pragma unroll
        for (int bj = 0; bj < 2; ++bj)
#pragma unroll
            for (int n = 0; n < 2; ++n) gv[bj][n] = *(const f32x4*)(gate + (size_t)b * gate_bstride + col0 + bj * HALF + n * 16);
#pragma unroll
        for (int ai = 0; ai < 2; ++ai)
#pragma unroll
            for (int m = 0; m < 4; ++m) { const size_t off = (size_t)(u.pm * BM + ai * HALF + wr * 64 + m * 16 + fr) * 1024 + col0;
#pragma unroll
                for (int bj = 0; bj < 2; ++bj)
#pragma unroll
                    for (int n = 0; n < 2; ++n) { const size_t o2 = off + bj * HALF + n * 16; f32x4 bs;
                        if (BIN16) { const u32x2 r = *(const u32x2*)((const bf16_t*)base + o2); bs = (f32x4){__uint_as_float(r.x << 16), __uint_as_float(r.x & 0xffff0000u), __uint_as_float(r.y << 16), __uint_as_float(r.y & 0xffff0000u)}; }
                        else bs = *(const f32x4*)((const float*)base + o2);
                        const f32x4 v = bs + gv[bj][n] * acc[ai][bj][m][n];
                        if (BOUT16) *(u32x2*)((bf16_t*)out + o2) = (u32x2){cvt_pk_bf16(v[0], v[1]), cvt_pk_bf16(v[2], v[3])};
                        else *(f32x4*)((float*)out + o2) = v; }
                if (m & 1) asm volatile("" ::: "memory"); }
    }
};
template <bool BIN16, bool BOUT16>
struct EpiResStaged {
    static constexpr bool PERM = false, AFTER_DRAIN = true;
    const void* base; void* out; const float* gate; int gate_bstride; int rows_per_batch;
    __device__ __forceinline__ void operator()(const f32x4 (&)[2][2][4][2], const Unit&, int, int, int, int) const {}
    __device__ __forceinline__ void fused(const f32x4 (&acc)[2][2][4][2], const Unit& u, int wr, int wc, int fr_in, int fq_in, PG8_LAS unsigned char* img, int wid, int lane_in) const {
        int fr = fr_in, fq = fq_in, lane = lane_in; asm volatile("" : "+v"(fr), "+v"(fq), "+v"(lane));
        const int col0 = u.pn * BM + wc * 32 + 4 * fq; const int b = (u.pm * BM) / rows_per_batch;
        f32x4 gv[2][2];
#pragma unroll
        for (int bj = 0; bj < 2; ++bj)
#pragma unroll
            for (int n = 0; n < 2; ++n) gv[bj][n] = *(const f32x4*)(gate + (size_t)b * gate_bstride + col0 + bj * HALF + n * 16);
#pragma unroll
        for (int ai = 0; ai < 2; ++ai) {
            u32x4 bs16[8]; f32x4 bs32[BIN16 ? 1 : 8][2];
#pragma unroll
            for (int rnd = 0; rnd < 8; ++rnd) { const int q = rnd * 512 + wid * 64 + lane, row = q >> 5, c8 = q & 31; const size_t o = (size_t)(u.pm * BM + ai * HALF + row) * 1024 + u.pn * BM + 8 * c8;
                if constexpr (BIN16) bs16[rnd] = *(const u32x4*)((const bf16_t*)base + o);
                else { bs32[rnd][0] = *(const f32x4*)((const float*)base + o); bs32[rnd][1] = *(const f32x4*)((const float*)base + o + 4); } }
#pragma unroll
            for (int bj = 0; bj < 2; ++bj)
#pragma unroll
                for (int m = 0; m < 4; ++m)
#pragma unroll
                    for (int n = 0; n < 2; ++n) { const int hrow = wr * 64 + m * 16 + fr, chunk = (bj * HALF + wc * 32 + n * 16 + 4 * fq) >> 2;
                        *(PG8_LAS f32x4*)(img + hrow * 1024 + ((chunk ^ ((hrow & 15) << 2)) << 4)) = gv[bj][n] * acc[ai][bj][m][n]; }
            asm volatile("s_waitcnt lgkmcnt(0)" ::: "memory"); __builtin_amdgcn_s_barrier(); asm volatile("" ::: "memory");
#pragma unroll
            for (int rnd = 0; rnd < 8; ++rnd) { const int q = rnd * 512 + wid * 64 + lane, row = q >> 5, c8 = q & 31; const size_t o = (size_t)(u.pm * BM + ai * HALF + row) * 1024 + u.pn * BM + 8 * c8;
                const PG8_LAS unsigned char* ip = img + row * 1024 + (((2 * c8) ^ ((row & 15) << 2)) << 4);
                const f32x4 g0 = *(const PG8_LAS f32x4*)ip, g1 = *(const PG8_LAS f32x4*)(ip + 16);
                f32x4 b0, b1;
                if constexpr (BIN16) { const u32x4 r = bs16[rnd];
                    b0 = (f32x4){__uint_as_float(r.x << 16), __uint_as_float(r.x & 0xffff0000u), __uint_as_float(r.y << 16), __uint_as_float(r.y & 0xffff0000u)};
                    b1 = (f32x4){__uint_as_float(r.z << 16), __uint_as_float(r.z & 0xffff0000u), __uint_as_float(r.w << 16), __uint_as_float(r.w & 0xffff0000u)}; }
                else { b0 = bs32[rnd][0]; b1 = bs32[rnd][1]; }
                const f32x4 v0 = b0 + g0, v1 = b1 + g1;
                if constexpr (BOUT16) *(u32x4*)((bf16_t*)out + o) = (u32x4){cvt_pk_bf16(v0[0], v0[1]), cvt_pk_bf16(v0[2], v0[3]), cvt_pk_bf16(v1[0], v1[1]), cvt_pk_bf16(v1[2], v1[3])};
                else { *(f32x4*)((float*)out + o) = v0; *(f32x4*)((float*)out + o + 4) = v1; } }
            if (ai == 0) { asm volatile("s_waitcnt lgkmcnt(0)" ::: "memory"); __builtin_amdgcn_s_barrier(); asm volatile("" ::: "memory"); }
        }
    }
};
template <bool BIN16, int HMODE>
struct EpiResNormStaged {
    static constexpr bool PERM = false, AFTER_DRAIN = true;
    const void* base; void* out; const float* gate; int gate_bstride; int rows_per_batch;
    const float* gnorm; const float* modL; int sh_chunk, sc_chunk; bf16_t* hout; unsigned char* hout8; float* xslots; unsigned* cnt; PG8_LAS unsigned char* tbl;
    __device__ __forceinline__ void operator()(const f32x4 (&)[2][2][4][2], const Unit&, int, int, int, int) const {}
    __device__ __forceinline__ void fused(const f32x4 (&acc)[2][2][4][2], const Unit& u, int wr, int wc, int fr_in, int fq_in, PG8_LAS unsigned char* img, int wid, int lane_in) const {
        int fr = fr_in, fq = fq_in, lane = lane_in; asm volatile("" : "+v"(fr), "+v"(fq), "+v"(lane));
        const int col0 = u.pn * BM + wc * 32 + 4 * fq; const int b = (u.pm * BM) / rows_per_batch;
        PG8_LAS float* Pt = (PG8_LAS float*)tbl; PG8_LAS float* St = (PG8_LAS float*)(tbl + 1024); PG8_LAS unsigned* flag = (PG8_LAS unsigned*)(tbl + 2048);
        f32x4 gv[2][2];
#pragma unroll
        for (int bj = 0; bj < 2; ++bj)
#pragma unroll
            for (int n = 0; n < 2; ++n) gv[bj][n] = *(const f32x4*)(gate + (size_t)b * gate_bstride + col0 + bj * HALF + n * 16);
        constexpr bool KEEP = BIN16;
        u32x4 wk[KEEP ? 8 : 1];
#pragma unroll
        for (int ai = 0; ai < 2; ++ai) {
            u32x4 bs16[8]; f32x4 bs32[BIN16 ? 1 : 8][2];
#pragma unroll
            for (int rnd = 0; rnd < 8; ++rnd) { const int q = rnd * 512 + wid * 64 + lane, row = q >> 5, c8 = q & 31; const size_t o = (size_t)(u.pm * BM + ai * HALF + row) * 1024 + u.pn * BM + 8 * c8;
                if constexpr (BIN16) bs16[rnd] = *(const u32x4*)((const bf16_t*)base + o);
                else { bs32[rnd][0] = *(const f32x4*)((const float*)base + o); bs32[rnd][1] = *(const f32x4*)((const float*)base + o + 4); } }
#pragma unroll
            for (int bj = 0; bj < 2; ++bj)
#pragma unroll
                for (int m = 0; m < 4; ++m)
#pragma unroll
                    for (int n = 0; n < 2; ++n) { const int hrow = wr * 64 + m * 16 + fr, chunk = (bj * HALF + wc * 32 + n * 16 + 4 * fq) >> 2;
                        *(PG8_LAS f32x4*)(img + hrow * 1024 + ((chunk ^ ((hrow & 15) << 2)) << 4)) = gv[bj][n] * acc[ai][bj][m][n]; }
            asm volatile("s_waitcnt lgkmcnt(0)" ::: "memory"); __builtin_amdgcn_s_barrier(); asm volatile("" ::: "memory");
#pragma unroll
            for (int rnd = 0; rnd < 8; ++rnd) { const int q = rnd * 512 + wid * 64 + lane, row = q >> 5, c8 = q & 31; const size_t o = (size_t)(u.pm * BM + ai * HALF + row) * 1024 + u.pn * BM + 8 * c8;
                const PG8_LAS unsigned char* ip = img + row * 1024 + (((2 * c8) ^ ((row & 15) << 2)) << 4);
                const f32x4 g0 = *(const PG8_LAS f32x4*)ip, g1 = *(const PG8_LAS f32x4*)(ip + 16);
                f32x4 b0, b1;
                if constexpr (BIN16) { const u32x4 r = bs16[rnd];
                    b0 = (f32x4){__uint_as_float(r.x << 16), __uint_as_float(r.x & 0xffff0000u), __uint_as_float(r.y << 16), __uint_as_float(r.y & 0xffff0000u)};
                    b1 = (f32x4){__uint_as_float(r.z << 16), __uint_as_float(r.z & 0xffff0000u), __uint_as_float(r.w << 16), __uint_as_float(r.w & 0xffff0000u)}; }
                else { b0 = bs32[rnd][0]; b1 = bs32[rnd][1]; }
                const f32x4 v0 = b0 + g0, v1 = b1 + g1;
                const u32x4 w = (u32x4){cvt_pk_bf16(v0[0], v0[1]), cvt_pk_bf16(v0[2], v0[3]), cvt_pk_bf16(v1[0], v1[1]), cvt_pk_bf16(v1[2], v1[3])};
                *(u32x4*)((bf16_t*)out + o) = w; if constexpr (KEEP) { if (ai == 1) wk[rnd] = w; }
                float ss = 0.f;
#pragma unroll
                for (int k = 0; k < 4; ++k) { const float lo = __uint_as_float(w[k] << 16), hi = __uint_as_float(w[k] & 0xffff0000u); ss += lo * lo + hi * hi; }
                ss += dppf<0xB1>(ss); ss += dppf<0x4E>(ss); ss += dppf<0x141>(ss); ss += dppf<0x140>(ss); ss = xsum16(ss);
                if (c8 == 0) Pt[ai * HALF + row] = ss; }
            asm volatile("s_waitcnt lgkmcnt(0)" ::: "memory"); __builtin_amdgcn_s_barrier(); asm volatile("" ::: "memory");
        }
        const int c8n = lane & 31; const int gcol = u.pn * BM + 8 * c8n;
        f32x4 G0, G1, S0, S1;
        { const f32x4 g0 = *(const f32x4*)(gnorm + gcol), g1 = *(const f32x4*)(gnorm + gcol + 4);
          const f32x4 c0 = *(const f32x4*)(modL + (size_t)b * 6144 + sc_chunk * 1024 + gcol), c1 = *(const f32x4*)(modL + (size_t)b * 6144 + sc_chunk * 1024 + gcol + 4);
          G0 = g0 * (c0 + 1.0f); G1 = g1 * (c1 + 1.0f); S0 = *(const f32x4*)(modL + (size_t)b * 6144 + sh_chunk * 1024 + gcol); S1 = *(const f32x4*)(modL + (size_t)b * 6144 + sh_chunk * 1024 + gcol + 4); }
        const int trow = wid * 32 + (lane & 31);
        if (lane < 32) __hip_atomic_store(xslots + ((size_t)(u.pm * BM + trow) * 4 + u.pn), Pt[trow], __ATOMIC_RELAXED, __HIP_MEMORY_SCOPE_AGENT);
        asm volatile("s_waitcnt vmcnt(0)" ::: "memory");
        if (lane == 0) __hip_atomic_fetch_add(cnt + 16 * u.pm, 1u, __ATOMIC_RELAXED, __HIP_MEMORY_SCOPE_AGENT);
        if (wid == 0) {
            unsigned sp = 0u;
            while ((unsigned)__builtin_amdgcn_readfirstlane(__hip_atomic_load(cnt + 16 * u.pm, __ATOMIC_RELAXED, __HIP_MEMORY_SCOPE_AGENT)) < 32u) { __builtin_amdgcn_s_sleep(1); if (++sp > (1u << 22)) break; }
            __builtin_amdgcn_fence(__ATOMIC_ACQUIRE, "agent");
            if (lane == 0) flag[0] = sp;
        }
        asm volatile("s_waitcnt vmcnt(0) lgkmcnt(0)" ::: "memory"); __builtin_amdgcn_s_barrier(); asm volatile("" ::: "memory");
        if (lane < 32) { const float* sl = xslots + (size_t)(u.pm * BM + trow) * 4; float t = 0.f;
#pragma unroll
            for (int k = 0; k < 4; ++k) t += __hip_atomic_load(sl + k, __ATOMIC_RELAXED, __HIP_MEMORY_SCOPE_AGENT);
            St[trow] = __builtin_amdgcn_rsqf(t * (1.0f / 1024.0f) + 1e-6f); }
        asm volatile("s_waitcnt lgkmcnt(0)" ::: "memory"); __builtin_amdgcn_s_barrier(); asm volatile("" ::: "memory");
#pragma unroll
        for (int hf = 0; hf < 2; ++hf) {
            u32x4 xr[8];
            if (!KEEP || hf == 0) {
#pragma unroll
                for (int rnd = 0; rnd < 8; ++rnd) { const int q = rnd * 512 + wid * 64 + lane, row = q >> 5; xr[rnd] = *(const u32x4*)((const bf16_t*)out + (size_t)(u.pm * BM + hf * HALF + row) * 1024 + gcol); } }
#pragma unroll
            for (int rnd = 0; rnd < 8; ++rnd) { const int q = rnd * 512 + wid * 64 + lane, row = q >> 5; const size_t o = (size_t)(u.pm * BM + hf * HALF + row) * 1024 + gcol;
                const float rs = St[hf * HALF + row]; u32x4 r; if (KEEP && hf == 1) r = wk[KEEP ? rnd : 0]; else r = xr[rnd];
                const f32x4 x0 = (f32x4){__uint_as_float(r.x << 16), __uint_as_float(r.x & 0xffff0000u), __uint_as_float(r.y << 16), __uint_as_float(r.y & 0xffff0000u)};
                const f32x4 x1 = (f32x4){__uint_as_float(r.z << 16), __uint_as_float(r.z & 0xffff0000u), __uint_as_float(r.w << 16), __uint_as_float(r.w & 0xffff0000u)};
                const f32x4 h0 = x0 * rs * G0 + S0, h1 = x1 * rs * G1 + S1;
                int w0 = 0, w1 = 0; w0 = __builtin_amdgcn_cvt_pk_fp8_f32(h0[0], h0[1], w0, false); w0 = __builtin_amdgcn_cvt_pk_fp8_f32(h0[2], h0[3], w0, true);
                w1 = __builtin_amdgcn_cvt_pk_fp8_f32(h1[0], h1[1], w1, false); w1 = __builtin_amdgcn_cvt_pk_fp8_f32(h1[2], h1[3], w1, true);
                typedef unsigned u32x2 __attribute__((ext_vector_type(2)));
                *(u32x2*)(hout8 + o) = (u32x2){(unsigned)w0, (unsigned)w1};
                if constexpr (HMODE == 2) *(u32x4*)(hout + o) = (u32x4){cvt_pk_bf16(h0[0], h0[1]), cvt_pk_bf16(h0[2], h0[3]), cvt_pk_bf16(h1[0], h1[1]), cvt_pk_bf16(h1[2], h1[3])}; }
        }
    }
};
struct EpiConvGate {
    static constexpr bool PERM = true, AFTER_DRAIN = false;
    bf16_t* U; const float* cw; const float* cb; float* sideA0; float* sideG0; float* sideA1; PG8_LAS float* halo; PG8_LAS unsigned char* stage;
    __device__ __forceinline__ void operator()(const f32x4 (&acc)[2][2][4][2], const Unit& u, int wr, int wc, int fr_in, int fq_in) const {
        constexpr int FFc = 2816;
        int fr = fr_in, fq = fq_in; asm volatile("" : "+v"(fr), "+v"(fq));
        const int colt = u.pn * 128 + wc * 32 + 8 * fq;
        const int lcol = wc * 32 + 8 * fq;
        if (fr >= 14) {
#pragma unroll
            for (int ai = 0; ai < 2; ++ai)
#pragma unroll
                for (int n = 0; n < 2; ++n) *(PG8_LAS f32x4*)(halo + ((ai * 2 + wr) * 2 + (fr - 14)) * 128 + lcol + 4 * n) = acc[ai][0][3][n];
        }
        asm volatile("s_waitcnt lgkmcnt(0)" ::: "memory"); __builtin_amdgcn_s_barrier(); asm volatile("" ::: "memory");
        typedef float f32x2 __attribute__((ext_vector_type(2)));
#define CG_DPP(x, ctrl) __int_as_float(__builtin_amdgcn_update_dpp(0, __float_as_int(x), ctrl, 0xf, 0xf, true))
        const bool lane0 = (fr == 0), lane01 = (fr < 2);
        const int wid8 = wr * 4 + wc, lane64 = fq * 16 + fr;
#pragma unroll
        for (int ai = 0; ai < 2; ++ai) {
#pragma unroll
            for (int n = 0; n < 2; ++n) {
                const f32x4 w0 = *(const f32x4*)(cw + colt + 4 * n), w1 = *(const f32x4*)(cw + FFc + colt + 4 * n), w2 = *(const f32x4*)(cw + 2 * FFc + colt + 4 * n), bb = *(const f32x4*)(cb + colt + 4 * n);
                f32x4 w1b, w0b;
#pragma unroll
                for (int e4 = 0; e4 < 4; ++e4) { w1b[e4] = lane0 ? w1[e4] : 0.f; w0b[e4] = lane01 ? w0[e4] : 0.f; }
                const int pb = (wr == 1) ? (ai * 2) : ((ai == 1) ? 1 : 0); const int hr = (fr >= 14) ? (fr - 14) : 0;
                const f32x4 prv = *(const PG8_LAS f32x4*)(halo + (pb * 2 + hr) * 128 + lcol + 4 * n);
#pragma unroll
                for (int m = 0; m < 4; ++m) {
                    const f32x4 x = acc[ai][0][m][n], gt = acc[ai][1][m][n]; const f32x4 pv = (m == 0) ? prv : acc[ai][0][m - 1][n];
                    f32x4 sv;
#pragma unroll
                    for (int e4 = 0; e4 < 4; ++e4) {
                        float t = fmaf(w2[e4], x[e4], bb[e4]);
                        t = fmaf(CG_DPP(x[e4], 0x111), w1[e4], t);
                        t = fmaf(CG_DPP(pv[e4], 0x121), w1b[e4], t);
                        t = fmaf(CG_DPP(x[e4], 0x112), w0[e4], t);
                        t = fmaf(CG_DPP(pv[e4], 0x122), w0b[e4], t);
                        sv[e4] = t;
                    }
                    f32x4 uo;
#pragma unroll
                    for (int p = 0; p < 2; ++p) {
                        const f32x2 s2 = (f32x2){sv[2 * p], sv[2 * p + 1]}; const f32x2 g2 = (f32x2){gt[2 * p], gt[2 * p + 1]};
                        const f32x2 a2 = s2 * -1.4426950408889634f;
                        const f32x2 d2 = (f32x2){__builtin_amdgcn_exp2f(fminf(a2[0], 60.f)), __builtin_amdgcn_exp2f(fminf(a2[1], 60.f))} + 1.0f;
                        const float r = __builtin_amdgcn_rcpf(d2[0] * d2[1]);
                        const f32x2 inv = (f32x2){d2[1], d2[0]} * r;
                        const f32x2 u2 = (s2 * g2) * inv;
                        uo[2 * p] = u2[0]; uo[2 * p + 1] = u2[1];
                    }
                    const int hrow = wr * 64 + m * 16 + fr, trow = ai * HALF + hrow;
                    int w8 = 0; w8 = __builtin_amdgcn_cvt_pk_fp8_f32(uo[0], uo[1], w8, false); w8 = __builtin_amdgcn_cvt_pk_fp8_f32(uo[2], uo[3], w8, true);
                    { const int cb4 = lcol + 4 * n; *(PG8_LAS unsigned*)(stage + hrow * 128 + ((((cb4 >> 4) ^ ((hrow >> 1) & 7)) << 4) | (cb4 & 15))) = (unsigned)w8; }
                    if (ai == 0 && m == 0) {
                        if (trow < 2) { *(f32x4*)(sideA0 + ((size_t)u.pm * 2 + trow) * FFc + colt + 4 * n) = x; *(f32x4*)(sideG0 + ((size_t)u.pm * 2 + trow) * FFc + colt + 4 * n) = gt; } }
                    if (ai == 1 && m == 3) { if (trow >= 254) *(f32x4*)(sideA1 + ((size_t)u.pm * 2 + (trow - 254)) * FFc + colt + 4 * n) = x; }
                }
            }
            asm volatile("s_waitcnt lgkmcnt(0)" ::: "memory"); __builtin_amdgcn_s_barrier(); asm volatile("" ::: "memory");
#pragma unroll
            for (int rnd = 0; rnd < 2; ++rnd) { const int q = rnd * 512 + wid8 * 64 + lane64, hrow = q >> 3, c = q & 7;
                const u32x4 v = *(const PG8_LAS u32x4*)(stage + hrow * 128 + ((c ^ ((hrow >> 1) & 7)) << 4));
                if (ai == 1 || hrow >= 2) *(u32x4*)((unsigned char*)U + (size_t)(u.pm * BM + ai * HALF + hrow) * FFc + u.pn * 128 + c * 16) = v; }
            if (ai == 0) { asm volatile("s_waitcnt lgkmcnt(0)" ::: "memory"); __builtin_amdgcn_s_barrier(); asm volatile("" ::: "memory"); }
        }
#undef CG_DPP
        asm volatile("s_waitcnt lgkmcnt(0)" ::: "memory"); __builtin_amdgcn_s_barrier(); asm volatile("" ::: "memory");
    }
};
template <class Epi, class Sched, bool ALIGN_EPI = false, bool SP2 = false, bool F8 = false>
__device__ __forceinline__ void gemm_phase(PG8_LAS unsigned char* lds, const Gemm g, const Sched& S, const Epi& E, const int tid) {
    const int wid = __builtin_amdgcn_readfirstlane(tid >> 6), lane = tid & 63, wr = wid >> 2, wc = wid & 3, fr = lane & 15, fq = lane >> 4;
    const int K = g.K, nt = K / BK;
    unsigned voffA[2], voffB[2];
#pragma unroll
    for (int i = 0; i < 2; ++i) { int R, C; stage_rc(tid * 16 + i * 8192, R, C); const int Rb = Epi::PERM ? ((R & ~31) + perm32(R & 31)) : R;
        voffA[i] = (unsigned)(R * g.lda + C) * 2u; voffB[i] = (unsigned)(Rb * g.ldb + C) * 2u; }
    const size_t kstep = (size_t)(BK * 2);
    const size_t hstepA = (size_t)HALF * g.lda * 2, hstepB = (size_t)HALF * g.ldb * 2;
    const size_t tstepA = 2 * hstepA, tstepB = 2 * hstepB;
    const unsigned ldsw = (unsigned)wid * 1024u;
    const int aoff = lds_byte(wr * 64 + fr, fq * 8), boff = lds_byte(wc * 32 + fr, fq * 8);
#define PG8_SA(b, h) (((b) * 2 + (h)) * HTB)
#define PG8_SB(b, h) ((4 + (b) * 2 + (h)) * HTB)
#define PG8_STAGE(bufoff, gbase, voff) do { _Pragma("unroll") for (int _i = 0; _i < 2; ++_i) \
        __builtin_amdgcn_global_load_lds((const unsigned*)((const char*)(gbase) + (voff)[_i]), (PG8_LAS unsigned*)(lds + (bufoff) + ldsw + _i * 8192), 16, 0, 0); } while (0)
#define PG8_LDA(dst, b, h) do { _Pragma("unroll") for (int m = 0; m < 4; ++m) { dst[m].lo = *(const PG8_LAS bf16x8*)(lds + PG8_SA(b, h) + aoff + m * 2048); dst[m].hi = *(const PG8_LAS bf16x8*)(lds + PG8_SA(b, h) + aoff + m * 2048 + 1024); } } while (0)
#define PG8_LDB(dst, b, h) do { _Pragma("unroll") for (int n = 0; n < 2; ++n) { dst[n].lo = *(const PG8_LAS bf16x8*)(lds + PG8_SB(b, h) + boff + n * 2048); dst[n].hi = *(const PG8_LAS bf16x8*)(lds + PG8_SB(b, h) + boff + n * 2048 + 1024); } } while (0)
#define PG8_MMA(ai, bj, At, Bt) do { __builtin_amdgcn_s_setprio(1); _Pragma("unroll") for (int m = 0; m < 4; ++m) _Pragma("unroll") for (int n = 0; n < 2; ++n) { \
        if constexpr (F8) asm volatile("v_mfma_scale_f32_16x16x128_f8f6f4 %0, %1, %2, %0, %3, %4 op_sel_hi:[0,0,0]" : "+v"(acc[ai][bj][m][n]) : "v"(__builtin_bit_cast(pg8_v8i, Bt[n])), "v"(__builtin_bit_cast(pg8_v8i, At[m])), "v"(f8sb), "v"(f8sa));   \
        else { acc[ai][bj][m][n] = __builtin_amdgcn_mfma_f32_16x16x32_bf16(Bt[n].lo, At[m].lo, acc[ai][bj][m][n], 0, 0, 0); acc[ai][bj][m][n] = __builtin_amdgcn_mfma_f32_16x16x32_bf16(Bt[n].hi, At[m].hi, acc[ai][bj][m][n], 0, 0, 0); } } \
        __builtin_amdgcn_s_setprio(0); } while (0)
#define PG8_WAIT_V(n) asm volatile("s_waitcnt vmcnt(" #n ")" ::: "memory")
#define PG8_WAIT_L(n) asm volatile("s_waitcnt lgkmcnt(" #n ")" ::: "memory")
#define PG8_BAR __builtin_amdgcn_s_barrier()
#define PG8_SCHED __builtin_amdgcn_sched_barrier(0)
    Unit cur, nxt; int ui = 0;
    if (!S.next(0, cur)) return;
    f32x4 acc[2][2][4][2];
#pragma unroll
    for (int a = 0; a < 2; ++a)
#pragma unroll
        for (int b = 0; b < 2; ++b)
#pragma unroll
            for (int m = 0; m < 4; ++m)
#pragma unroll
                for (int n = 0; n < 2; ++n) acc[a][b][m][n] = (f32x4){0.f, 0.f, 0.f, 0.f};
    const int f8sa = g.sa, f8sb = g.sb; (void)f8sa; (void)f8sb;
    pg8_bf16x16 At[4], B0[2], B1[2];
    const char* cA = (const char*)g.A + (size_t)cur.pm * tstepA; const char* cB = (const char*)g.Bt + (size_t)cur.pn * tstepB;
    S.a_ready(cur);
    if constexpr (SP2) {
        PG8_STAGE(PG8_SB(0, 0), cB, voffB); PG8_STAGE(PG8_SB(0, 1), cB + hstepB, voffB); PG8_STAGE(PG8_SA(0, 0), cA, voffA); PG8_STAGE(PG8_SA(0, 1), cA + hstepA, voffA);
        if (wr == 1) PG8_BAR;
        PG8_WAIT_V(2); PG8_BAR;
        PG8_STAGE(PG8_SB(1, 0), cB + kstep, voffB); PG8_STAGE(PG8_SA(1, 0), cA + kstep, voffA); PG8_STAGE(PG8_SB(1, 1), cB + hstepB + kstep, voffB);
        PG8_WAIT_V(6); PG8_BAR;
    } else {
        PG8_STAGE(PG8_SB(0, 0), cB, voffB); PG8_STAGE(PG8_SA(0, 0), cA, voffA); PG8_STAGE(PG8_SB(0, 1), cB + hstepB, voffB); PG8_STAGE(PG8_SA(0, 1), cA + hstepA, voffA);
        if (wr == 1) PG8_BAR;
        PG8_WAIT_V(4); PG8_BAR;
        PG8_STAGE(PG8_SB(1, 0), cB + kstep, voffB); PG8_STAGE(PG8_SA(1, 0), cA + kstep, voffA); PG8_STAGE(PG8_SB(1, 1), cB + hstepB + kstep, voffB);
        PG8_WAIT_V(6); PG8_BAR;
    }
    for (;;) {
        const bool has_next = S.next(ui + 1, nxt);
        const char* nA = has_next ? (const char*)g.A + (size_t)nxt.pm * tstepA : cA; const char* nB = has_next ? (const char*)g.Bt + (size_t)nxt.pn * tstepB : cB;
#pragma unroll 1
        for (int t = 0; t < nt; t += 2) {
            const bool last = (t == nt - 2);
            const char* a1 = cA + (size_t)(t + 1) * kstep;
            const char* a2 = last ? nA : cA + (size_t)(t + 2) * kstep; const char* b2 = last ? nB : cB + (size_t)(t + 2) * kstep;
            const char* a3 = a2 + kstep; const char* b3 = b2 + kstep;
            if (last && has_next) S.a_ready(nxt);
            if constexpr (SP2) {
            PG8_LDB(B0, 0, 0); PG8_LDB(B1, 0, 1); PG8_SCHED; PG8_LDA(At, 0, 0); PG8_STAGE(PG8_SA(1, 1), a1 + hstepA, voffA);
            PG8_WAIT_V(8); PG8_WAIT_L(0); PG8_BAR; PG8_MMA(0, 0, At, B0); PG8_MMA(0, 1, At, B1); PG8_BAR; PG8_SCHED;
            PG8_LDA(At, 0, 1); PG8_STAGE(PG8_SB(0, 0), b2, voffB); PG8_STAGE(PG8_SB(0, 1), b2 + hstepB, voffB); PG8_STAGE(PG8_SA(0, 0), a2, voffA);
            PG8_WAIT_V(8); PG8_WAIT_L(0); PG8_BAR; PG8_MMA(1, 0, At, B0); PG8_MMA(1, 1, At, B1); PG8_BAR; PG8_SCHED;
            PG8_LDB(B0, 1, 0); PG8_LDB(B1, 1, 1); PG8_SCHED; PG8_LDA(At, 1, 0); PG8_STAGE(PG8_SA(0, 1), a2 + hstepA, voffA);
            PG8_WAIT_V(8); PG8_WAIT_L(0); PG8_BAR; PG8_MMA(0, 0, At, B0); PG8_MMA(0, 1, At, B1); PG8_BAR; PG8_SCHED;
            PG8_LDA(At, 1, 1); PG8_STAGE(PG8_SB(1, 0), b3, voffB); PG8_STAGE(PG8_SB(1, 1), b3 + hstepB, voffB); PG8_STAGE(PG8_SA(1, 0), a3, voffA);
            PG8_WAIT_V(8); PG8_WAIT_L(0); PG8_BAR; PG8_MMA(1, 0, At, B0); PG8_MMA(1, 1, At, B1); PG8_BAR; PG8_SCHED;
            } else {
            PG8_LDB(B0, 0, 0); PG8_SCHED; PG8_LDA(At, 0, 0); PG8_STAGE(PG8_SA(1, 1), a1 + hstepA, voffA);
            PG8_WAIT_L(8); PG8_BAR; PG8_WAIT_L(0); PG8_MMA(0, 0, At, B0); PG8_BAR; PG8_SCHED;
            PG8_LDB(B1, 0, 1); PG8_STAGE(PG8_SB(0, 0), b2, voffB);
            PG8_BAR; PG8_WAIT_L(0); PG8_MMA(0, 1, At, B1); PG8_BAR;
            PG8_LDA(At, 0, 1); PG8_STAGE(PG8_SA(0, 0), a2, voffA);
            PG8_BAR; PG8_WAIT_L(0); PG8_MMA(1, 0, At, B0); PG8_BAR; PG8_SCHED;
            PG8_STAGE(PG8_SB(0, 1), b2 + hstepB, voffB);
            PG8_WAIT_V(6); PG8_BAR; PG8_MMA(1, 1, At, B1); PG8_BAR;
            PG8_LDB(B0, 1, 0); PG8_SCHED; PG8_LDA(At, 1, 0); PG8_STAGE(PG8_SA(0, 1), a2 + hstepA, voffA);
            PG8_WAIT_L(8); PG8_BAR; PG8_WAIT_L(0); PG8_MMA(0, 0, At, B0); PG8_BAR; PG8_SCHED;
            PG8_LDB(B1, 1, 1); PG8_STAGE(PG8_SB(1, 0), b3, voffB);
            PG8_BAR; PG8_WAIT_L(0); PG8_MMA(0, 1, At, B1); PG8_BAR;
            PG8_LDA(At, 1, 1); PG8_STAGE(PG8_SA(1, 0), a3, voffA);
            PG8_BAR; PG8_WAIT_L(0); PG8_MMA(1, 0, At, B0); PG8_BAR; PG8_SCHED;
            PG8_STAGE(PG8_SB(1, 1), b3 + hstepB, voffB);
            PG8_WAIT_V(6); PG8_BAR; PG8_MMA(1, 1, At, B1); PG8_BAR;
            }
        }
        if constexpr (ALIGN_EPI) { if (wr == 0) PG8_BAR; }
        if constexpr (F8) {
            asm volatile("s_nop 15\n\ts_nop 7" : "+v"(acc[0][0][0][0]), "+v"(acc[0][0][0][1]), "+v"(acc[0][0][1][0]), "+v"(acc[0][0][1][1]), "+v"(acc[0][0][2][0]), "+v"(acc[0][0][2][1]), "+v"(acc[0][0][3][0]), "+v"(acc[0][0][3][1]), "+v"(acc[0][1][0][0]), "+v"(acc[0][1][0][1]), "+v"(acc[0][1][1][0]), "+v"(acc[0][1][1][1]), "+v"(acc[0][1][2][0]), "+v"(acc[0][1][2][1]), "+v"(acc[0][1][3][0]), "+v"(acc[0][1][3][1]) :: "memory");
            asm volatile("" : "+v"(acc[1][0][0][0]), "+v"(acc[1][0][0][1]), "+v"(acc[1][0][1][0]), "+v"(acc[1][0][1][1]), "+v"(acc[1][0][2][0]), "+v"(acc[1][0][2][1]), "+v"(acc[1][0][3][0]), "+v"(acc[1][0][3][1]), "+v"(acc[1][1][0][0]), "+v"(acc[1][1][0][1]), "+v"(acc[1][1][1][0]), "+v"(acc[1][1][1][1]), "+v"(acc[1][1][2][0]), "+v"(acc[1][1][2][1]), "+v"(acc[1][1][3][0]), "+v"(acc[1][1][3][1]) :: "memory"); }
        if constexpr (!Epi::AFTER_DRAIN) { E(acc, cur, wr, wc, fr, fq); S.done(cur); }
        if (!has_next) break;
#pragma unroll
        for (int a = 0; a < 2; ++a)
#pragma unroll
            for (int b = 0; b < 2; ++b)
#pragma unroll
                for (int m = 0; m < 4; ++m)
#pragma unroll
                    for (int n = 0; n < 2; ++n) acc[a][b][m][n] = (f32x4){0.f, 0.f, 0.f, 0.f};
        cur = nxt; cA = nA; cB = nB; ++ui;
        if constexpr (ALIGN_EPI) { if (wr == 1) PG8_BAR; }
    }
    PG8_WAIT_V(0);
    if constexpr (!ALIGN_EPI) { if (wr == 0) PG8_BAR; }
    PG8_BAR;
    if constexpr (Epi::AFTER_DRAIN) { E.fused(acc, cur, wr, wc, fr, fq, lds, wid, lane); S.done(cur); }
#undef PG8_SA
#undef PG8_SB
#undef PG8_STAGE
#undef PG8_LDA
#undef PG8_LDB
#undef PG8_MMA
#undef PG8_WAIT_V
#undef PG8_WAIT_L
#undef PG8_BAR
#undef PG8_SCHED
}
}

#include <hip/hip_bf16.h>
#include <cmath>
namespace attn_body {
using bf16=__hip_bfloat16;
using bf16x8=__attribute__((ext_vector_type(8)))short;
using s16x4=__attribute__((ext_vector_type(4)))short;
using f32x16=__attribute__((ext_vector_type(16)))float;
using u32x4=__attribute__((ext_vector_type(4)))unsigned;
constexpr int BATCH=2,NHEAD=16,SEQ=8192,D=64,DM=NHEAD*D;
constexpr int NW=8,QBLK=32,QB=QBLK*NW,KVBLK=64,NQB=SEQ/QB;
constexpr int ATTN_PITCH=DM, ATTN_UNIT_ROWS=QB;
__device__ __forceinline__ int crow(int r,int hi){return (r&3)+8*(r>>2)+4*hi;}
#define SBAR() __builtin_amdgcn_sched_barrier(0)
__device__ __forceinline__ void cmask(f32x16&p0,f32x16&p1,int jb,int qrel,int hi){
  const float NEG=-INFINITY; int kb=64*jb+4*hi;
  #pragma unroll
  for(int r=0;r<16;++r){int kv=kb+(r&3)+8*(r>>2); if(kv>qrel)p0[r]=NEG; if(kv+32>qrel)p1[r]=NEG;}
}

constexpr int NSLOT=3, SLOTB=8192, KSLOTB=10240;
constexpr int LDS_K=0, LDS_V=NSLOT*KSLOTB, LDS_WS=LDS_V+NSLOT*SLOTB, LDS_OST=LDS_WS+NW*64*4, LDS_BYTES=LDS_OST+NW*4096;
#define KOFF(sl) ((sl)+((sl)>>2))
constexpr float C2=0.125f*1.4426950408889634f;
__device__ __forceinline__ void glds16(const void*gsrc,unsigned lds_dst){unsigned keep;
  asm volatile("s_mov_b32 %0, m0\n\ts_mov_b32 m0, %2\n\ts_nop 0\n\tglobal_load_lds_dwordx4 %1, off\n\ts_mov_b32 m0, %0":"=&s"(keep):"v"(gsrc),"s"(lds_dst):"memory");}
__device__ __forceinline__ void glds4(const void*gsrc,unsigned lds_dst){unsigned keep;
  asm volatile("s_mov_b32 %0, m0\n\ts_mov_b32 m0, %2\n\ts_nop 0\n\tglobal_load_lds_dword %1, off\n\ts_mov_b32 m0, %0":"=&s"(keep):"v"(gsrc),"s"(lds_dst):"memory");}
__device__ __forceinline__ float max3f(float a,float b,float c){float r;asm("v_max3_f32 %0, %1, %2, %3":"=v"(r):"v"(a),"v"(b),"v"(c));return r;}
__device__ __forceinline__ float max2f(float a,float b){float r;asm("v_max_f32_e32 %0, %1, %2":"=v"(r):"v"(a),"v"(b));return r;}
__device__ __forceinline__ float fadd_s(float a,float b){float r;asm("v_add_f32_e32 %0, %1, %2":"=v"(r):"v"(a),"v"(b));return r;}
__device__ __forceinline__ float fsub_s(float a,float b){float r;asm("v_sub_f32_e32 %0, %1, %2":"=v"(r):"v"(a),"v"(b));return r;}
typedef float f32x2_t __attribute__((ext_vector_type(2))); typedef __bf16 bf16x2_t __attribute__((ext_vector_type(2)));
__device__ __forceinline__ unsigned cvtpk_s(float lo,float hi){f32x2_t v={lo,hi};bf16x2_t b=__builtin_convertvector(v,bf16x2_t);return __builtin_bit_cast(unsigned,b);}
#define WAIT_BAR(N) asm volatile("s_waitcnt vmcnt(" #N ") lgkmcnt(0)\n\ts_barrier":::"memory")

__device__ __forceinline__ void qkt(f32x16&p0,f32x16&p1,const char*Kslot,const bf16x8*qr,const bf16x8 qe,int r32,int hi){
  const char*kb=Kslot+hi*1024+r32*16;
  { const bf16x8 e0=*reinterpret_cast<const bf16x8*>(kb+8192); const bf16x8 e1=*reinterpret_cast<const bf16x8*>(kb+8192+512); const f32x16 z=f32x16{};
    p0=__builtin_amdgcn_mfma_f32_32x32x16_bf16(e0,qe,z,0,0,0); p1=__builtin_amdgcn_mfma_f32_32x32x16_bf16(e1,qe,z,0,0,0); }
  #pragma unroll
  for(int d0=0;d0<4;++d0){
    const bf16x8 b0=*reinterpret_cast<const bf16x8*>(kb+d0*2048);
    const bf16x8 b1=*reinterpret_cast<const bf16x8*>(kb+d0*2048+512);
    {p0=__builtin_amdgcn_mfma_f32_32x32x16_bf16(b0,qr[d0],p0,0,0,0);p1=__builtin_amdgcn_mfma_f32_32x32x16_bf16(b1,qr[d0],p1,0,0,0);}}
}
typedef __attribute__((address_space(3))) const char* lds_cptr;
typedef short v4i16_t __attribute__((ext_vector_type(4)));
__device__ __forceinline__ void kload8(bf16x8*kf,lds_cptr kp){
  kf[0]=*(const __attribute__((address_space(3))) bf16x8*)(kp);      kf[1]=*(const __attribute__((address_space(3))) bf16x8*)(kp+512);
  kf[2]=*(const __attribute__((address_space(3))) bf16x8*)(kp+2048); kf[3]=*(const __attribute__((address_space(3))) bf16x8*)(kp+2560);
  kf[4]=*(const __attribute__((address_space(3))) bf16x8*)(kp+4096); kf[5]=*(const __attribute__((address_space(3))) bf16x8*)(kp+4608);
  kf[6]=*(const __attribute__((address_space(3))) bf16x8*)(kp+6144); kf[7]=*(const __attribute__((address_space(3))) bf16x8*)(kp+6656);
  kf[8]=*(const __attribute__((address_space(3))) bf16x8*)(kp+8192); kf[9]=*(const __attribute__((address_space(3))) bf16x8*)(kp+8704);
}
__device__ __forceinline__ void kload2(bf16x8*kf,lds_cptr kp,int j){ kf[2*j]=*(const __attribute__((address_space(3))) bf16x8*)(kp+j*2048); kf[2*j+1]=*(const __attribute__((address_space(3))) bf16x8*)(kp+j*2048+512); }
__device__ __forceinline__ s16x4 vtr(lds_cptr p){ return __builtin_bit_cast(s16x4,__builtin_amdgcn_ds_read_tr16_b64_v4i16((__attribute__((address_space(3))) v4i16_t*)p)); }
__device__ __forceinline__ float rowmax(const f32x16&p0,const f32x16&p1){
  float a=max3f(p0[0],p0[1],p1[0]),b=max3f(p0[2],p0[3],p1[1]);a=max3f(a,p1[2],p1[3]);
  #pragma unroll
  for(int r=4;r<16;r+=4){a=max3f(a,p0[r],p0[r+1]);b=max3f(b,p0[r+2],p0[r+3]);a=max3f(a,p1[r],p1[r+1]);b=max3f(b,p1[r+2],p1[r+3]);}
  const float m=max2f(a,b);
  auto rr=__builtin_amdgcn_permlane32_swap(__float_as_uint(m),__float_as_uint(m),false,false);
  return max2f(__uint_as_float(rr[0]),__uint_as_float(rr[1]));
}
__device__ __forceinline__ void pv(f32x16*o,int vb,bf16x8 pa0,bf16x8 pa1,bf16x8 pa2,bf16x8 pa3){
  #pragma unroll
  for(int d0=0;d0<2;++d0){s16x4 lo[4],hi[4];
    #pragma unroll
    for(int ks=0;ks<4;++ks){
      asm volatile("ds_read_b64_tr_b16 %0,%1 offset:%c2":"=&v"(lo[ks]):"v"(vb),"i"(d0*4096+ks*1024):"memory");
      asm volatile("ds_read_b64_tr_b16 %0,%1 offset:%c2":"=&v"(hi[ks]):"v"(vb),"i"(d0*4096+ks*1024+512):"memory");}
    asm volatile("s_waitcnt lgkmcnt(0)":::"memory");SBAR();
    #define PK(k) (bf16x8){lo[k][0],lo[k][1],lo[k][2],lo[k][3],hi[k][0],hi[k][1],hi[k][2],hi[k][3]}
    o[d0]=__builtin_amdgcn_mfma_f32_32x32x16_bf16(pa0,PK(0),o[d0],0,0,0);
    o[d0]=__builtin_amdgcn_mfma_f32_32x32x16_bf16(pa1,PK(1),o[d0],0,0,0);
    o[d0]=__builtin_amdgcn_mfma_f32_32x32x16_bf16(pa2,PK(2),o[d0],0,0,0);
    o[d0]=__builtin_amdgcn_mfma_f32_32x32x16_bf16(pa3,PK(3),o[d0],0,0,0);
    #undef PK
  }
}

#ifndef ATTN_STORE16
#define ATTN_STORE16(p,v) (*(u32x4*)(p)=(v))
#endif
__device__ __forceinline__ bf16x8 make_qe(float m,int hi){
  const unsigned um=__float_as_uint(m); unsigned h0=(um+0x7fffu+((um>>16)&1u))&0xffff0000u; const float r1=m-__uint_as_float(h0);
  const unsigned u1=__float_as_uint(r1); unsigned h1=(u1+0x7fffu+((u1>>16)&1u))&0xffff0000u; const float r2=r1-__uint_as_float(h1);
  const unsigned u2=__float_as_uint(r2); unsigned h2=(u2+0x7fffu+((u2>>16)&1u))&0xffff0000u;
  u32x4 w; w.x=0x3f803f80u; w.y=0x3f80u|(h0^0x80000000u); w.z=((h1^0x80000000u)>>16)|(h2^0x80000000u); w.w=0u;
  if(hi){w.x=0u;w.y=0u;w.z=0u;} return __builtin_bit_cast(bf16x8,w); }
template<int THRL> __device__ __forceinline__ void attn_unit(int b,int h,int qb,const bf16*Q,const bf16*__restrict__ K,const bf16*__restrict__ V,bf16*O,const bf16*__restrict__ KE,const float*__restrict__ BETA,float qkmax,char*shm,const int tid){
  const int lane=tid&63,r32=lane&31,hi=lane>>5; const int wid=__builtin_amdgcn_readfirstlane(tid>>6);
  const long rowbase=(long)b*SEQ; const int q0=qb*QB;
  const bf16*Qw=Q+(rowbase+q0+wid*QBLK)*DM+h*D;
  const float*bet=BETA+(long)(b*NHEAD+h)*SEQ; const int NTF=(q0+QB)/KVBLK; int t0;
  { const float thr=bet[q0]-37.f-2.f*qkmax; const int l0=lane,l1=lane+64;
    const bool s0=(l0<NTF-4)&&(bet[64*l0+63]<thr), s1=(l1<NTF-4)&&(bet[64*l1+63]<thr);
    const unsigned long long m0=__ballot(s0), m1=__ballot(s1);
    int n0=(~m0)?__builtin_ctzll(~m0):64; if(n0==64) n0+=(~m1)?__builtin_ctzll(~m1):64;
    t0=__builtin_amdgcn_readfirstlane(n0)&~1; }
  const bf16*Kh=K+(rowbase+(long)t0*KVBLK)*DM+h*D,*Vh=V+(rowbase+(long)t0*KVBLK)*DM+h*D;
  const char*KEh=(const char*)KE+((long)(b*NHEAD+h)*(SEQ/KVBLK)+t0)*2048+wid*256+lane*4;
  const unsigned lds0=(unsigned)(uintptr_t)shm;
  float*wsf=(float*)(shm+LDS_WS)+wid*64;
  const bf16*ksrc=Kh+(long)lane*DM+wid*8;
  const bf16*vsrc=Vh+(long)(16*(wid&3)+(lane>>2))*DM+(wid>>2)*32+(lane&3)*8;
  const unsigned kdst=lds0+LDS_K+wid*1024, vdst=lds0+LDS_V+wid*1024, kedst=lds0+LDS_K+8192+wid*256;
  #define DMA_K(t,slot) do{ glds16(ksrc+(long)(t)*KVBLK*DM,(unsigned)__builtin_amdgcn_readfirstlane(kdst+KOFF(slot))); glds4(KEh+(long)(t)*2048,(unsigned)__builtin_amdgcn_readfirstlane(kedst+KOFF(slot))); }while(0)
  #define DMA_V(t,slot) glds16(vsrc+(long)(t)*KVBLK*DM,(unsigned)__builtin_amdgcn_readfirstlane(vdst+(slot)))
  const int vb0=(int)(lds0+LDS_V)+((lane>>4)&1)*32+(lane&3)*8+(4*hi+((lane&15)>>2))*64;
  const char*Kbase=shm+LDS_K; bf16x8 kf[10];
  const lds_cptr shm3=(lds_cptr)shm; const lds_cptr kp0=shm3+LDS_K+hi*1024+r32*16; const lds_cptr vp0=shm3+LDS_V+((lane>>4)&1)*32+(lane&3)*8+(4*hi+((lane&15)>>2))*64;
  const int NT=NTF-t0;
  DMA_K(0,0);DMA_V(0,0);DMA_K(1,SLOTB);
  bf16x8 qr[4];
  #pragma unroll
  for(int d0=0;d0<4;++d0)qr[d0]=*reinterpret_cast<const bf16x8*>(&Qw[(long)r32*DM+d0*16+hi*8]);
  float mhat=bet[q0+wid*QBLK+r32],l_reg=0.f;f32x16 o[2];o[0]=f32x16{};o[1]=f32x16{}; bf16x8 qe=make_qe(mhat,hi);
  const int qrel=wid*QBLK+r32;
  #define CMASK(P0,P1,t) do{int jb_=(t)-(NT-4); if(jb_>=0)cmask(P0,P1,jb_,qrel,hi);}while(0)
  bool resc=false;
  #define START(P0,P1) do{ resc=false; _Pragma("unroll") for(int r=0;r<16;++r)P0[r]=__builtin_amdgcn_exp2f(P0[r]); }while(0)
  #define RESC() do{ if(resc){ asm volatile("s_waitcnt lgkmcnt(0)":::"memory"); \
      _Pragma("unroll") for(int d_=0;d_<2;++d_) _Pragma("unroll") for(int r=0;r<16;++r)o[d_][r]*=wsf[crow(r,hi)]; } }while(0)
  f32x16 pA0,pA1,pB0,pB1;
  int sl_prev=0,sl_cur=0,sl_next=SLOTB;
  #define ROT() do{sl_prev=sl_cur;sl_cur=sl_next;sl_next=(sl_next==(NSLOT-1)*SLOTB)?0:sl_next+SLOTB;}while(0)
  DMA_K(2,2*SLOTB);
  WAIT_BAR(5);
  qkt(pA0,pA1,Kbase,qr,qe,r32,hi);asm volatile("s_nop 15\n\ts_nop 7":"+v"(pA0),"+v"(pA1));CMASK(pA0,pA1,0);
  START(pA0,pA1);
  _Pragma("unroll") for(int r=0;r<16;++r)pA1[r]=__builtin_amdgcn_exp2f(pA1[r]);
  WAIT_BAR(0);
  DMA_K(3,0);DMA_V(1,SLOTB);
  ROT();
  kload8(kf,kp0+KOFF(sl_cur));
  WAIT_BAR(3);
  s16x4 vlo[8],vhi[8]; u32x4 pw0,pw1,pw2,pw3;
  #define PKW(P,B) cvtpk_s(P[B],P[B+1])
  #define PAF(k) __builtin_bit_cast(bf16x8,pw##k)
  #define VFR(i) (bf16x8){vlo[i][0],vlo[i][1],vlo[i][2],vlo[i][3],vhi[i][0],vhi[i][1],vhi[i][2],vhi[i][3]}
  #define PIN(x) asm volatile("":"+v"(x))
  #define MX3(a,b,c) __builtin_fmaxf(__builtin_fmaxf((a),(b)),(c))
  #define GAPA(MF,A0,A1,A2,A3,W0,W1,PW) do{ MF; sacc+=A0; sacc+=A1; sacc+=A2; sacc+=A3; PIN(sacc); W0; W1; PIN(PW); SBAR(); }while(0)
  #define EX(v) __builtin_amdgcn_exp2f(v)
  #define GAPB(MF,X,B) do{ MF; X[B]=EX(X[B]); X[B+1]=EX(X[B+1]); X[B+2]=EX(X[B+2]); X[B+3]=EX(X[B+3]); PIN(X); SBAR(); }while(0)
  #define VRD(i) do{ vlo[i]=vtr(vp_+(((i)>>2)*4096+((i)&3)*1024)); vhi[i]=vtr(vp_+(((i)>>2)*4096+((i)&3)*1024+512)); }while(0)
  #define KRD(G,j) do{ if(G){ kload2(kf,kp0+KOFF(sl_next),j); SBAR(); } }while(0)
  #define KRDE(G) do{ if(G){ kf[8]=*(const __attribute__((address_space(3))) bf16x8*)(kp0+KOFF(sl_next)+8192); kf[9]=*(const __attribute__((address_space(3))) bf16x8*)(kp0+KOFF(sl_next)+8704); SBAR(); } }while(0)
  #define STEP(C0,C1,P0,P1,t,GK,GV,GL) do{ SBAR(); \
    const lds_cptr vp_=vp0+sl_prev; \
    VRD(0); SBAR(); float sacc=(P0[0]+P0[1]); \
    C0=__builtin_amdgcn_mfma_f32_32x32x16_bf16(kf[8],qe,f32x16{},0,0,0); C1=__builtin_amdgcn_mfma_f32_32x32x16_bf16(kf[9],qe,f32x16{},0,0,0); SBAR(); \
    GAPA(C0=__builtin_amdgcn_mfma_f32_32x32x16_bf16(kf[0],qr[0],C0,0,0,0), P0[2],P0[3],P0[4],P0[5],     pw0[0]=PKW(P0,0), pw0[1]=PKW(P0,2), pw0); \
    VRD(4); SBAR(); GAPA(C1=__builtin_amdgcn_mfma_f32_32x32x16_bf16(kf[1],qr[0],C1,0,0,0), P0[6],P0[7],P0[8],P0[9],     pw0[2]=PKW(P0,4), pw0[3]=PKW(P0,6), pw0); \
    VRD(1); SBAR(); GAPA(C0=__builtin_amdgcn_mfma_f32_32x32x16_bf16(kf[2],qr[1],C0,0,0,0),   P0[10],P0[11],P0[12],P0[13], pw1[0]=PKW(P0,8), pw1[1]=PKW(P0,10), pw1); \
    VRD(5); SBAR(); GAPA(C1=__builtin_amdgcn_mfma_f32_32x32x16_bf16(kf[3],qr[1],C1,0,0,0),   P0[14],P0[15],P1[0],P1[1],   pw1[2]=PKW(P0,12),pw1[3]=PKW(P0,14), pw1); \
    VRD(2); SBAR(); GAPA(C0=__builtin_amdgcn_mfma_f32_32x32x16_bf16(kf[4],qr[2],C0,0,0,0),   P1[2],P1[3],P1[4],P1[5],     pw2[0]=PKW(P1,0), pw2[1]=PKW(P1,2), pw2); \
    VRD(6); SBAR(); GAPA(C1=__builtin_amdgcn_mfma_f32_32x32x16_bf16(kf[5],qr[2],C1,0,0,0),   P1[6],P1[7],P1[8],P1[9],     pw2[2]=PKW(P1,4), pw2[3]=PKW(P1,6), pw2); \
    VRD(3); SBAR(); GAPA(C0=__builtin_amdgcn_mfma_f32_32x32x16_bf16(kf[6],qr[3],C0,0,0,0),   P1[10],P1[11],P1[12],P1[13], pw3[0]=PKW(P1,8), pw3[1]=PKW(P1,10), pw3); \
    VRD(7); SBAR(); GAPA(C1=__builtin_amdgcn_mfma_f32_32x32x16_bf16(kf[7],qr[3],C1,0,0,0),   P1[14],P1[15],0.f,0.f,       pw3[2]=PKW(P1,12),pw3[3]=PKW(P1,14), pw3); \
    l_reg+=sacc; \
    if(GK){DMA_K((t)+3,sl_cur);} if(GV){DMA_V((t)+1,sl_next);} \
    CMASK(C0,C1,t); \
    { float a=MX3(C0[0],C0[1],C1[0]),b=MX3(C0[2],C0[3],C1[1]); a=MX3(a,C1[2],C1[3]); \
      _Pragma("unroll") for(int r=4;r<16;r+=4){a=MX3(a,C0[r],C0[r+1]);b=MX3(b,C0[r+2],C0[r+3]);a=MX3(a,C1[r],C1[r+1]);b=MX3(b,C1[r+2],C1[r+3]);} \
      float rm=__builtin_fmaxf(a,b); { auto rr=__builtin_amdgcn_permlane32_swap(__float_as_uint(rm),__float_as_uint(rm),false,false); rm=__builtin_fmaxf(__uint_as_float(rr[0]),__uint_as_float(rr[1])); } \
      resc=false; \
      if(__builtin_expect(__any(rm>(float)THRL),0)){ const float dl=__builtin_fmaxf(rm,0.f); mhat+=dl; \
        _Pragma("unroll") for(int r=0;r<16;++r){C0[r]-=dl;C1[r]-=dl;} \
        qe=make_qe(mhat,hi); \
        const float f=__builtin_amdgcn_exp2f(-dl); l_reg*=f; if(hi==0)wsf[r32]=f; resc=true; } } \
    SBAR(); \
    GAPB(o[0]=__builtin_amdgcn_mfma_f32_32x32x16_bf16(PAF(0),VFR(0),o[0],0,0,0), C0,0); \
    GAPB(o[1]=__builtin_amdgcn_mfma_f32_32x32x16_bf16(PAF(0),VFR(4),o[1],0,0,0), C0,4); \
    KRD(GL,0); GAPB(o[0]=__builtin_amdgcn_mfma_f32_32x32x16_bf16(PAF(1),VFR(1),o[0],0,0,0), C0,8); \
    KRD(GL,1); GAPB(o[1]=__builtin_amdgcn_mfma_f32_32x32x16_bf16(PAF(1),VFR(5),o[1],0,0,0), C0,12); \
    KRD(GL,2); GAPB(o[0]=__builtin_amdgcn_mfma_f32_32x32x16_bf16(PAF(2),VFR(2),o[0],0,0,0), C1,0); \
    KRD(GL,3); GAPB(o[1]=__builtin_amdgcn_mfma_f32_32x32x16_bf16(PAF(2),VFR(6),o[1],0,0,0), C1,4); \
    KRDE(GL); GAPB(o[0]=__builtin_amdgcn_mfma_f32_32x32x16_bf16(PAF(3),VFR(3),o[0],0,0,0), C1,8); \
    GAPB(o[1]=__builtin_amdgcn_mfma_f32_32x32x16_bf16(PAF(3),VFR(7),o[1],0,0,0), C1,12); \
    }while(0)
  int t=1;
  #undef CMASK
  #define CMASK(P0,P1,t) do{}while(0)
  for(;t+5<NT;t+=2){
    STEP(pB0,pB1,pA0,pA1,t,true,true,true);     WAIT_BAR(3); RESC(); ROT();
    STEP(pA0,pA1,pB0,pB1,t+1,true,true,true);   WAIT_BAR(3); RESC(); ROT();
  }
  #undef CMASK
  #define CMASK(P0,P1,t) do{int jb_=(t)-(NT-4); if(jb_>=0)cmask(P0,P1,jb_,qrel,hi);}while(0)
  #define ENDW(tt) do{ if((tt)+3<NT){WAIT_BAR(3);} else if((tt)+2<NT){WAIT_BAR(1);} else {WAIT_BAR(0);} }while(0)
  for(;t+1<NT;t+=2){
    STEP(pB0,pB1,pA0,pA1,t,(t+3<NT),(t+1<NT),(t+1<NT));       ENDW(t);   RESC(); ROT();
    STEP(pA0,pA1,pB0,pB1,t+1,(t+4<NT),(t+2<NT),(t+2<NT));     ENDW(t+1); RESC(); ROT();
  }
  STEP(pB0,pB1,pA0,pA1,NT-1,false,false,false); RESC();
  { float sacc=pB0[0]+pB0[1]; _Pragma("unroll") for(int r=2;r<16;++r)sacc+=pB0[r]; _Pragma("unroll") for(int r=0;r<16;++r)sacc+=pB1[r]; l_reg+=sacc;
    pw0=(u32x4){PKW(pB0,0),PKW(pB0,2),PKW(pB0,4),PKW(pB0,6)};pw1=(u32x4){PKW(pB0,8),PKW(pB0,10),PKW(pB0,12),PKW(pB0,14)};pw2=(u32x4){PKW(pB1,0),PKW(pB1,2),PKW(pB1,4),PKW(pB1,6)};pw3=(u32x4){PKW(pB1,8),PKW(pB1,10),PKW(pB1,12),PKW(pB1,14)};
    SBAR(); pv(o,vb0+sl_cur,PAF(0),PAF(1),PAF(2),PAF(3)); }
  #undef PKW
  #undef PAF
  #undef VFR
  #undef PIN
  #undef MX3
  #undef GAPA
  #undef GAPB
  #undef EX
  #undef VRD
  #undef KRD
  #undef KRDE
  #undef STEP
  #undef ENDW
  {auto rr=__builtin_amdgcn_permlane32_swap(__float_as_uint(l_reg),__float_as_uint(l_reg),false,false);l_reg=__uint_as_float(rr[0])+__uint_as_float(rr[1]);}
  if(hi==0)wsf[32+r32]=l_reg;asm volatile("s_waitcnt lgkmcnt(0)":::"memory");
  float rli[16];
  #pragma unroll
  for(int r=0;r<16;++r)rli[r]=__builtin_amdgcn_rcpf(wsf[32+crow(r,hi)]);
  int lane_e=lane; asm volatile("":"+v"(lane_e));
  const int r32e=lane_e&31,hie=lane_e>>5;
  unsigned char*Ow=(unsigned char*)O+((rowbase+q0+wid*QBLK)*DM+h*D);
  { unsigned char*stg=(unsigned char*)(shm+LDS_OST)+wid*4096;
    #pragma unroll
    for(int r=0;r<16;++r){const int orow=crow(r,hie); const float sc32=32.f*rli[r];
      #pragma unroll
      for(int d0=0;d0<2;++d0)stg[orow*64+d0*32+r32e]=(unsigned char)__builtin_amdgcn_cvt_pk_fp8_f32(o[d0][r]*sc32,0.f,0,false);}
    asm volatile("s_waitcnt lgkmcnt(0)":::"memory");
    typedef unsigned u32x2_t __attribute__((ext_vector_type(2)));
    #pragma unroll
    for(int i=0;i<4;++i){const int row=i*8+(lane_e>>3),ch=lane_e&7; const u32x2_t v=*(const u32x2_t*)(stg+row*64+ch*8); *(u32x2_t*)(Ow+(long)row*DM+ch*8)=v;} }
  asm volatile("s_waitcnt lgkmcnt(0)\n\ts_barrier":::"memory");
  #undef DMA_K
  #undef DMA_V
  #undef CMASK
  #undef START
  #undef RESC
  #undef ROT
}
constexpr int ATTN_LDS_BYTES=LDS_BYTES;
struct AttnTensors { const bf16* Q; const bf16* K; const bf16* V; bf16* O; };
struct AttnUnit { int bh; int qb; };
struct StaticOrder {
  int vcu;
  __device__ __forceinline__ explicit StaticOrder(int grid,int block):vcu((block%8)*(grid/8)+block/8){}
  __device__ __forceinline__ bool next(int i,AttnUnit&u)const{ if(i>=4)return false; const int s=vcu&7; u.bh=vcu>>3; u.qb=(i==0)?s:(i==1)?15-s:(i==2)?16+s:31-s; return true; }
  __device__ __forceinline__ void a_ready(const AttnUnit&)const{}
  __device__ __forceinline__ void done(const AttnUnit&)const{}
};
template<class Sched,int THRL=8> __device__ __forceinline__ void attn_phase(char*lds,const AttnTensors&T,const Sched&S){
  AttnUnit u;
  for(int i=0;S.next(i,u);++i){ S.a_ready(u); attn_unit<THRL>(u.bh/NHEAD,u.bh%NHEAD,u.qb,T.Q,T.K,T.V,T.O,lds); S.done(u); }
}
#undef SBAR
#undef WAIT_BAR
}

#ifndef MK_DUP
#define MK_DUP 0
#endif
#define ORD_QKV 4, 3
#define ORD_UP 4, 3
#define ORD_DIN 4, 3
#define ORD_QI 4, 3
constexpr int NWAVES = 8, NTHREADS = 512;
constexpr int BATCH = 2, T = 8192, D = 1024, H = 16, HD = 64, FF = 2816, FF2 = 5632;
constexpr int M = BATCH * T;
constexpr int FOX_IN = 3088, DSA_IN = 2120;
constexpr float EPS = 1e-6f;
constexpr float LOG2E = 1.4426950408889634f;

constexpr size_t MiB = 1u << 20;
constexpr size_t WS_CTL = 0, CTL_ZERO_BYTES = 32 * 1024;
constexpr size_t WS_MOD = 1 * MiB;
constexpr size_t WS_XS = 2 * MiB;
constexpr int CW_NS = 1024;
constexpr size_t WS_WUP0 = 8 * MiB, WS_WUP1 = 19 * MiB;
constexpr size_t WS_WDN0 = 30 * MiB, WS_WDN1 = 35 * MiB + 512 * 1024;
constexpr size_t WS_WDIN = 41 * MiB;
constexpr size_t WS_WDTAIL = 45 * MiB;
constexpr size_t WS_WDOUT = 45 * MiB + 512 * 1024;
constexpr size_t WS_H = 48 * MiB;
constexpr size_t WS_R = 80 * MiB;
constexpr size_t WS_WFIN = WS_R, WS_WFOUT = WS_R + 6 * MiB;
constexpr size_t WS_Q = WS_R + 8 * MiB, WS_K = WS_R + 40 * MiB, WS_V = WS_R + 72 * MiB;
constexpr size_t WS_LOGF = WS_R + 104 * MiB;
constexpr size_t WS_BETA = WS_R + 105 * MiB;
constexpr size_t WS_KE = WS_R + 106 * MiB;
constexpr size_t WS_O = WS_R + 114 * MiB;
constexpr size_t WS_XB = WS_R + 144 * MiB;
constexpr size_t WS_U = WS_R;
constexpr size_t WS_SA0 = WS_R + 96 * MiB, WS_SG0 = WS_R + 98 * MiB, WS_SA1 = WS_R + 100 * MiB;
constexpr size_t WS_Q1 = WS_R, WS_K1 = WS_R + 32 * MiB, WS_V1 = WS_R + 40 * MiB;
constexpr size_t WS_QI = WS_R + 48 * MiB;
constexpr size_t WS_KI = WS_R + 64 * MiB;
constexpr size_t WS_WI = WS_R + 66 * MiB;
constexpr size_t WS_H8 = WS_R + 84 * MiB;
constexpr size_t WS_O1 = WS_R + 67 * MiB;
constexpr size_t WS_END = 256 * MiB;
static_assert(WS_U + (size_t)M * FF * 2 <= WS_SA0 && WS_SA1 + 2 * MiB <= WS_END, "d_ws map");
constexpr int CW_BAR = 4096;
static_assert((CW_BAR + 3456) * 4 <= 32 * 1024, "control words inside the per-call memset");
constexpr int CW_AQ = 256;
constexpr int CW_DQ = 512;

constexpr int RING_OFF = 0, RING_BYTES = 131072;
constexpr int LDSCTL_OFF = RING_BYTES, MISC_OFF = LDSCTL_OFF + 320;
constexpr int HALO_OFF = 131584;
constexpr int LDS_BYTES = 147456;

#define GAS __attribute__((address_space(1)))
#define LAS __attribute__((address_space(3)))
typedef unsigned short bf16;
typedef unsigned v4u __attribute__((ext_vector_type(4)));
typedef unsigned v2u __attribute__((ext_vector_type(2)));
typedef float f32x4 __attribute__((ext_vector_type(4)));
typedef short bf16x8 __attribute__((ext_vector_type(8)));
typedef GAS unsigned gu32;
#define RLX_AGENT __ATOMIC_RELAXED, __HIP_MEMORY_SCOPE_AGENT
#define LDS_WAIT() asm volatile("s_waitcnt lgkmcnt(0)" ::: "memory")
#define VM_WAIT() asm volatile("s_waitcnt vmcnt(0)" ::: "memory")
__device__ __forceinline__ unsigned f2bf(float f) { unsigned u = __builtin_bit_cast(unsigned, f); return (u + 0x7fffu + ((u >> 16) & 1u)) >> 16; }
__device__ __forceinline__ unsigned pk2(float lo, float hi) { return f2bf(lo) | (f2bf(hi) << 16); }
__device__ __forceinline__ float bf2f(unsigned b) { return __builtin_bit_cast(float, b << 16); }
#define XB_TMO      128
#define XB_XCNT(j)  (256  + 64 * (j))
#define XB_XSUB(j)  (1280 + 64 * (j))
#define XB_XGEN(j)  (2304 + 64 * (j))
#define XB_TOP      3328
#define XB_TOPGEN   3392
#define XCD_BAR_WORDS 3456
#define XB_SPIN_CAP (1u << 18)

__device__ __forceinline__ unsigned xb_ld(unsigned* p)              { return __hip_atomic_load(p, __ATOMIC_RELAXED, __HIP_MEMORY_SCOPE_AGENT); }
__device__ __forceinline__ unsigned xb_add(unsigned* p, unsigned v) { return __hip_atomic_fetch_add(p, v, __ATOMIC_RELAXED, __HIP_MEMORY_SCOPE_AGENT); }
__device__ __forceinline__ unsigned xb_xcc_id() { return (unsigned)__builtin_amdgcn_s_getreg((3 << 11) | 20) & 0xFu; }
#define XB_SPIN(cond, bar) do { unsigned _sp = 0; while (cond) { __builtin_amdgcn_s_sleep(1); \
    if ((++_sp & 255u) == 0u) { if (xb_ld(&(bar)[XB_TMO])) break; if (_sp > XB_SPIN_CAP) { atomicAdd(&(bar)[XB_TMO], 1u); break; } } } } while (0)

struct XcdBarrier {
    unsigned* bar; unsigned x;
    volatile LAS unsigned* st;
};

__device__ __forceinline__ XcdBarrier xcd_barrier_post(unsigned* bar, volatile LAS unsigned* st) {
    XcdBarrier b; b.bar = bar; b.x = xb_xcc_id(); b.st = st;
    if (threadIdx.x == 0) (void)xb_add(&bar[XB_XCNT(b.x)], 1u);
    return b;
}
__device__ __forceinline__ void xcd_barrier_complete(unsigned* bar, unsigned x, unsigned& nloc, unsigned& nx) {
    const unsigned G = gridDim.x * gridDim.y * gridDim.z;
    unsigned sum, cnt, mine, sp = 0u;
    for (;;) {
        sum = 0u; cnt = 0u; mine = 0u;
#pragma unroll
        for (unsigned j = 0; j < 16; ++j) { const unsigned c = xb_ld(&bar[XB_XCNT(j)]); sum += c; cnt += (c > 0u) ? 1u : 0u; mine = (j == x) ? c : mine; }
        if (sum == G) break;
        __builtin_amdgcn_s_sleep(1);
        if ((++sp & 255u) == 0u) { if (xb_ld(&bar[XB_TMO])) break; if (sp > XB_SPIN_CAP) { atomicAdd(&bar[XB_TMO], 1u); break; } }
    }
    nloc = mine > 0u ? mine : 1u; nx = cnt > 0u ? cnt : 1u;
}

__device__ __forceinline__ void xcd_barrier(const XcdBarrier& b) {
    asm volatile("s_waitcnt vmcnt(0)" ::: "memory");
    __syncthreads();
    if (threadIdx.x == 0) {
        unsigned* bar = b.bar;
        __builtin_amdgcn_s_waitcnt(0);
        unsigned nloc = b.st[0], nx = b.st[1];
        if (nloc == 0u) { xcd_barrier_complete(bar, b.x, nloc, nx); b.st[0] = nloc; b.st[1] = nx; }
        const unsigned old = xb_add(&bar[XB_XSUB(b.x)], 1u);
        const unsigned gen = old / nloc;
        if (old + 1u == (gen + 1u) * nloc) {
            __builtin_amdgcn_fence(__ATOMIC_RELEASE, "agent");
            asm volatile("s_waitcnt vmcnt(0)" ::: "memory");
            const unsigned og = xb_add(&bar[XB_TOP], 1u);
            const unsigned tg = og / nx;
            if (og + 1u == (tg + 1u) * nx) xb_add(&bar[XB_TOPGEN], 1u);
            else XB_SPIN(xb_ld(&bar[XB_TOPGEN]) == tg, bar);
            __builtin_amdgcn_fence(__ATOMIC_ACQUIRE, "agent");
            xb_add(&bar[XB_XGEN(b.x)], 1u);
            asm volatile("s_waitcnt vmcnt(0)" ::: "memory");
        } else {
            XB_SPIN(xb_ld(&bar[XB_XGEN(b.x)]) == gen, bar);
            __builtin_amdgcn_fence(__ATOMIC_ACQUIRE, "agent");
            asm volatile("s_waitcnt vmcnt(0)" ::: "memory");
        }
    }
    __syncthreads();
}

__device__ __forceinline__ float wave_sum(float v) {
    v += dppf<0xB1>(v); v += dppf<0x4E>(v); v += dppf<0x141>(v); v += dppf<0x140>(v);
    return xsum32(xsum16(v));
}
__device__ __forceinline__ float wave_max(float v) {
    v = fmaxf(v, dppf<0xB1>(v)); v = fmaxf(v, dppf<0x4E>(v)); v = fmaxf(v, dppf<0x141>(v)); v = fmaxf(v, dppf<0x140>(v));
    return xmax32(xmax16(v));
}
template <int F8S>
__device__ __forceinline__ void p0_transpose_item(const float* W, int ldw, int K, bf16* WT, int k0, int n0, int drow, LAS float* scr, int lane) {
#pragma unroll 8
    for (int i = 0; i < 32; ++i) { const int kk = 2 * i + (lane >> 5); scr[kk * 33 + (lane & 31)] = W[(size_t)(k0 + kk) * ldw + n0 + (lane & 31)]; }
    LDS_WAIT(); asm volatile("" ::: "memory");
    const int c = lane & 7;
#pragma unroll
    for (int j = 0; j < 4; ++j) { const int n = (lane >> 3) + 8 * j; const LAS float* s = scr + (8 * c) * 33 + n;
        if (F8S) { const float sc8 = (float)(1 << F8S); int w0 = 0, w1 = 0;
            w0 = __builtin_amdgcn_cvt_pk_fp8_f32(s[0 * 33] * sc8, s[1 * 33] * sc8, w0, false); w0 = __builtin_amdgcn_cvt_pk_fp8_f32(s[2 * 33] * sc8, s[3 * 33] * sc8, w0, true);
            w1 = __builtin_amdgcn_cvt_pk_fp8_f32(s[4 * 33] * sc8, s[5 * 33] * sc8, w1, false); w1 = __builtin_amdgcn_cvt_pk_fp8_f32(s[6 * 33] * sc8, s[7 * 33] * sc8, w1, true);
            *(GAS v2u*)((unsigned char*)WT + (size_t)(drow + n) * K + k0 + 8 * c) = (v2u){(unsigned)w0, (unsigned)w1}; }
        else { v4u o; o.x = pk2(s[0 * 33], s[1 * 33]); o.y = pk2(s[2 * 33], s[3 * 33]); o.z = pk2(s[4 * 33], s[5 * 33]); o.w = pk2(s[6 * 33], s[7 * 33]);
        *(GAS v4u*)(WT + (size_t)(drow + n) * K + k0 + 8 * c) = o; } }
    LDS_WAIT(); asm volatile("" ::: "memory");
}
template <int HP, int F8S = 0>
__device__ __forceinline__ void p0_matrix(const float* W, int ldw, int K, int ncols, bf16* WT, LAS float* scr, int lane, int gw, int NGW, int& base) {
    const int nblk = ncols / 32, items = (K / 64) * nblk;
    int first = gw - (base % NGW); if (first < 0) first += NGW;
    for (int r = first; r < items; r += NGW) {
        const int kb = r / nblk, nb = r % nblk, n0 = 32 * nb;
        int drow = n0;
        if (HP == 1) { const int tile = n0 >> 8, nl = n0 & 255, wc = nl >> 6, bj = (nl >> 5) & 1; drow = tile * 256 + 128 * bj + 32 * wc; }
        if (HP == 2) { const int isg = n0 >= FF, j = isg ? n0 - FF : n0; drow = (j >> 7) * 256 + (isg ? 128 : 0) + (j & 127); }
        p0_transpose_item<F8S>(W, ldw, K, WT, 64 * kb, n0, drow, scr, lane);
    }
    base += items;
}

struct Ptrs {
    const float *x, *c, *w_ada, *b_ada, *g_mix, *g_ffn, *fox_w_in, *fox_b_f, *fox_g_q, *fox_g_k, *fox_w_out,
                *dsa_w_in, *dsa_g_q, *dsa_g_k, *dsa_g_kidx, *dsa_w_out, *ffn_w_up, *ffn_conv_w, *ffn_conv_b, *ffn_w_down;
    float* out; unsigned char* ws;
};

__device__ __forceinline__ void p0_prologue(const Ptrs& P, LAS unsigned char* lds, int tid, int lane, int wave, int vcu, int G) {
    unsigned char* ws = P.ws;
    LAS float* scr = (LAS float*)(lds + RING_OFF + wave * 16384);
    const int gw = vcu * NWAVES + wave, NGW = G * NWAVES;
    int base = 0;
    p0_matrix<1, 5>(P.fox_w_in, FOX_IN, D, 3 * D, (bf16*)(ws + WS_WFIN), scr, lane, gw, NGW, base);
    p0_matrix<0, 5>(P.fox_w_out, D, D, D, (bf16*)(ws + WS_WFOUT), scr, lane, gw, NGW, base);
    p0_matrix<2, 5>(P.ffn_w_up, FF2, D, FF2, (bf16*)(ws + WS_WUP0), scr, lane, gw, NGW, base);
    p0_matrix<0, 6>(P.ffn_w_down, D, FF, D, (bf16*)(ws + WS_WDN0), scr, lane, gw, NGW, base);
    p0_matrix<1, 5>(P.dsa_w_in, DSA_IN, D, 3 * D / 2, (bf16*)(ws + WS_WDIN), scr, lane, gw, NGW, base);
    p0_matrix<1>(P.dsa_w_in + 3 * D / 2, DSA_IN, D, D / 2, (bf16*)(ws + WS_WDIN + 2 * MiB), scr, lane, gw, NGW, base);
    p0_matrix<0, 5>(P.dsa_w_out, D, D, D, (bf16*)(ws + WS_WDOUT), scr, lane, gw, NGW, base);
    p0_matrix<2, 5>(P.ffn_w_up + (size_t)D * FF2, FF2, D, FF2, (bf16*)(ws + WS_WUP1), scr, lane, gw, NGW, base);
    p0_matrix<0, 6>(P.ffn_w_down + (size_t)FF * D, D, FF, D, (bf16*)(ws + WS_WDN1), scr, lane, gw, NGW, base);
    { bf16* wt = (bf16*)(ws + WS_WDTAIL); const int gt = vcu * NTHREADS + tid, NT_ = G * NTHREADS;
      for (int i = gt; i < 80 * D; i += NT_) { const int n = i / D, k = i % D; wt[i] = (n < 72) ? (bf16)f2bf(P.dsa_w_in[(size_t)k * DSA_IN + 2048 + n]) : (bf16)0; } }
    __syncthreads();
    { LAS float* cact = (LAS float*)(lds + RING_OFF);
      LAS float* part = (LAS float*)(lds + RING_OFF + 8192);
      for (int i = tid; i < 2 * D; i += NTHREADS) { const float v = P.c[i]; cact[i] = v / (1.f + __expf(-v)); }
      __syncthreads();
      float* MOD = (float*)(ws + WS_MOD);
      for (int task = vcu; task < 2 * 96; task += G) {
          const int layer = task / 96, cg = task % 96, col = cg * 64 + lane;
          const float* w = P.w_ada + (size_t)layer * D * 6144 + col;
          float a0 = 0.f, a1 = 0.f;
#pragma unroll 32
          for (int k = wave * 128; k < wave * 128 + 128; ++k) { const float wv = w[(size_t)k * 6144]; a0 += cact[k] * wv; a1 += cact[D + k] * wv; }
          part[(wave * 2 + 0) * 64 + lane] = a0; part[(wave * 2 + 1) * 64 + lane] = a1;
          __syncthreads();
          if (wave < 2) { float s = 0.f;
#pragma unroll
              for (int w8 = 0; w8 < 8; ++w8) s += part[(w8 * 2 + wave) * 64 + lane];
              MOD[((size_t)layer * 2 + wave) * 6144 + col] = s + P.b_ada[layer * 6144 + col]; }
          __syncthreads();
      } }
}

template <bool FGATE, bool XIN16, int OUT8 = 0>
__device__ __forceinline__ void norm_phase(const void* xin, const float* gnorm, const float* modL, int sh_chunk, int sc_chunk, bf16* hout, unsigned char* hout8,
                                           const float* fox_w_in, const float* b_f, float* logf, LAS unsigned char* lds, int tid, int lane, int wave, int vcu, int G) {
    LAS float* wft = (LAS float*)(lds + RING_OFF);
    if (FGATE) {
        for (int i = tid; i < 16 * D; i += NTHREADS) { const int c = i >> 4, hh = i & 15; wft[hh * D + c] = fox_w_in[(size_t)c * FOX_IN + 3 * D + hh]; }
        __syncthreads();
    }
    const int gw = vcu * NWAVES + wave, NGW = G * NWAVES;
    for (int b = 0; b < BATCH; ++b) {
        f32x4 Gv[4], Sv[4];
#pragma unroll
        for (int j = 0; j < 4; ++j) { const int c = 4 * lane + 256 * j;
            const f32x4 g4 = *(const f32x4*)(gnorm + c), sc4 = *(const f32x4*)(modL + (size_t)b * 6144 + sc_chunk * D + c);
            Gv[j] = g4 * (sc4 + 1.0f); Sv[j] = *(const f32x4*)(modL + (size_t)b * 6144 + sh_chunk * D + c); }
        for (int t = gw; t < T; t += NGW) {
            const size_t m = (size_t)b * T + t;
            f32x4 v[4]; float ss = 0.f;
            if (XIN16) { const GAS v2u* xr = (const GAS v2u*)((const bf16*)xin + m * D) + lane;
#pragma unroll
                for (int j = 0; j < 4; ++j) { const v2u r = xr[64 * j]; v[j] = (f32x4){__uint_as_float(r.x << 16), __uint_as_float(r.x & 0xffff0000u), __uint_as_float(r.y << 16), __uint_as_float(r.y & 0xffff0000u)}; }
            } else { const GAS f32x4* xr = (const GAS f32x4*)((const float*)xin + m * D) + lane;
#pragma unroll
                for (int j = 0; j < 4; ++j) v[j] = xr[64 * j]; }
#pragma unroll
            for (int j = 0; j < 4; ++j) ss += (v[j].x * v[j].x + v[j].y * v[j].y) + (v[j].z * v[j].z + v[j].w * v[j].w);
            const float rstd = __builtin_amdgcn_rsqf(wave_sum(ss) * (1.f / D) + EPS);
            GAS unsigned long long* o8 = (GAS unsigned long long*)(hout + m * D) + lane;
#pragma unroll
            for (int j = 0; j < 4; ++j) { v[j] = v[j] * rstd * Gv[j] + Sv[j];
                if (OUT8) { int w8 = 0; w8 = __builtin_amdgcn_cvt_pk_fp8_f32(v[j].x, v[j].y, w8, false); w8 = __builtin_amdgcn_cvt_pk_fp8_f32(v[j].z, v[j].w, w8, true);
                    ((GAS unsigned*)(hout8 + m * D))[lane + 64 * j] = (unsigned)w8; }
                if (OUT8 != 1) o8[64 * j] = (unsigned long long)pk2(v[j].x, v[j].y) | ((unsigned long long)pk2(v[j].z, v[j].w) << 32); }
            if (FGATE) {
                float acc[16];
                typedef float f32x2 __attribute__((ext_vector_type(2)));
#pragma unroll
                for (int hh = 0; hh < 16; ++hh) { f32x2 a2 = (f32x2){0.f, 0.f};
#pragma unroll
                    for (int j = 0; j < 4; ++j) { const f32x4 w4 = *(const LAS f32x4*)(wft + hh * D + 256 * j + 4 * lane);
                        a2 = (f32x2){v[j].x, v[j].y} * (f32x2){w4.x, w4.y} + a2; a2 = (f32x2){v[j].z, v[j].w} * (f32x2){w4.z, w4.w} + a2; }
                    acc[hh] = a2.x + a2.y; if ((hh & 3) == 3) asm volatile("" : "+v"(acc[hh]) :: "memory"); }
                float b8[8], c4[4];
#pragma unroll
                for (int i = 0; i < 8; ++i) { const auto rr = __builtin_amdgcn_permlane32_swap(__builtin_bit_cast(unsigned, acc[i]), __builtin_bit_cast(unsigned, acc[i + 8]), false, false); const unsigned r0 = rr[0], r1 = rr[1];
                    b8[i] = __builtin_bit_cast(float, r0) + __builtin_bit_cast(float, r1); }
#pragma unroll
                for (int i = 0; i < 4; ++i) { const auto rr = __builtin_amdgcn_permlane16_swap(__builtin_bit_cast(unsigned, b8[i]), __builtin_bit_cast(unsigned, b8[i + 4]), false, false); const unsigned r0 = rr[0], r1 = rr[1];
                    c4[i] = __builtin_bit_cast(float, r0) + __builtin_bit_cast(float, r1); }
#pragma unroll
                for (int i = 0; i < 4; ++i) { float t = c4[i]; t += dppf<0xB1>(t); t += dppf<0x4E>(t); t += dppf<0x141>(t); t += dppf<0x140>(t); c4[i] = t; }
                const int j4 = lane & 15; float r = c4[0]; r = (j4 == 1) ? c4[1] : r; r = (j4 == 2) ? c4[2] : r; r = (j4 == 3) ? c4[3] : r;
                const int row16 = lane >> 4, head = (row16 >> 1) * 8 + (row16 & 1) * 4 + j4;
                if (j4 < 4) { const float z = r + b_f[head]; logf[m * 16 + head] = fminf(z, 0.f) - log1pf(__expf(-fabsf(z))); }
            }
        }
    }
    if (FGATE) __syncthreads();
}

__device__ __forceinline__ void fox_scan(const float* logf, float* BETA, unsigned char* KE, int seq, LAS float* red  , int tid, int lane, int wave) {
    const int b = seq >> 4, hh = seq & 15;
    float v[16]; float run = 0.f;
#pragma unroll
    for (int k = 0; k < 16; ++k) { run += logf[((size_t)b * T + 16 * tid + k) * 16 + hh]; v[k] = run; }
    float inc = run;
#pragma unroll
    for (int o = 1; o < 64; o <<= 1) { const float n = __shfl_up(inc, o); if (lane >= o) inc += n; }
    if (lane == 63) red[wave] = inc;
    __syncthreads();
    float pre = inc - run;
#pragma unroll
    for (int w8 = 0; w8 < 8; ++w8) if (w8 < wave) pre += red[w8];
#pragma unroll
    for (int k = 0; k < 16; ++k) {
        const int t = 16 * tid + k; const float be = -(pre + v[k]) * LOG2E;
        BETA[(size_t)seq * T + t] = be;
        const unsigned h0 = f2bf(be); const float r1 = be - bf2f(h0); const unsigned h1 = f2bf(r1); const float r2 = r1 - bf2f(h1); const unsigned h2 = f2bf(r2);
        unsigned char* tile = KE + ((size_t)seq * (T / 64) + (t >> 6)) * 2048 + (t & 63) * 16;
        v4u e; e.x = h0 | (h1 << 16); e.y = h2 | 0x3f800000u; e.z = 0x3f803f80u; e.w = 0u;
        *(GAS v4u*)tile = e; *(GAS v4u*)(tile + 1024) = (v4u){0u, 0u, 0u, 0u};
    }
    __syncthreads();
}

__device__ __forceinline__ void conv_fixup(bf16* U, const float* sideA0, const float* sideG0, const float* sideA1, const float* cw, const float* cb, int pm, int tid) {
    const bool bstart = (pm % (T / 256)) == 0;
    for (int i = tid; i < 2 * (FF / 4); i += NTHREADS) {
        const int r = i / (FF / 4), c = (i % (FF / 4)) * 4;
        const f32x4 a0 = *(const f32x4*)(sideA0 + ((size_t)pm * 2 + r) * FF + c), g0 = *(const f32x4*)(sideG0 + ((size_t)pm * 2 + r) * FF + c);
        const f32x4 z = (f32x4){0.f, 0.f, 0.f, 0.f};
        f32x4 m1, m2;
        if (r == 1) { m1 = *(const f32x4*)(sideA0 + ((size_t)pm * 2) * FF + c); m2 = bstart ? z : *(const f32x4*)(sideA1 + ((size_t)(pm - 1) * 2 + 1) * FF + c); }
        else { m1 = bstart ? z : *(const f32x4*)(sideA1 + ((size_t)(pm - 1) * 2 + 1) * FF + c); m2 = bstart ? z : *(const f32x4*)(sideA1 + ((size_t)(pm - 1) * 2) * FF + c); }
        const f32x4 w0 = *(const f32x4*)(cw + c), w1 = *(const f32x4*)(cw + FF + c), w2 = *(const f32x4*)(cw + 2 * FF + c), bb = *(const f32x4*)(cb + c);
        float uo[4];
#pragma unroll
        for (int e = 0; e < 4; ++e) { const float s = fmaf(w0[e], m2[e], fmaf(w1[e], m1[e], fmaf(w2[e], a0[e], bb[e]))); uo[e] = s * __builtin_amdgcn_rcpf(1.f + __builtin_amdgcn_exp2f(-LOG2E * s)) * g0[e]; }
        { int w8 = 0; w8 = __builtin_amdgcn_cvt_pk_fp8_f32(uo[0], uo[1], w8, false); w8 = __builtin_amdgcn_cvt_pk_fp8_f32(uo[2], uo[3], w8, true);
          *(GAS unsigned*)((unsigned char*)U + ((size_t)pm * 256 + r) * FF + c) = (unsigned)w8; }
    }
    asm volatile("s_waitcnt vmcnt(0)" ::: "memory");
    __syncthreads();
}
namespace dsa {
typedef float f32x16 __attribute__((ext_vector_type(16)));
typedef unsigned long long u64;
constexpr int QT = 16;
constexpr int TOPK = 256;
constexpr int HIST_OFF = 0;
constexpr int SEL_OFF = 135168;
constexpr int ST_OFF = 143360;
constexpr int CAP = 1024;
constexpr float WSCALE = 0.04419417382415922f;

__device__ __forceinline__ void tail_phase(const bf16* Hb, const bf16* WT, const float* g_kidx, bf16* KI, float* WI, int lane, int gw, int NGW) {
    const int n16 = lane & 15, q4 = lane >> 4;
    for (int task = gw; task < M / 16; task += NGW) {
        const int row0 = task * 16;
        f32x4 acc[5];
#pragma unroll
        for (int cb = 0; cb < 5; ++cb) acc[cb] = (f32x4){0.f, 0.f, 0.f, 0.f};
        const bf16* ap = Hb + (size_t)(row0 + n16) * D + 8 * q4;
        const bf16* bp = WT + (size_t)n16 * D + 8 * q4;
#pragma unroll 4
        for (int s = 0; s < 32; ++s) {
            const bf16x8 a = *(const GAS bf16x8*)(ap + 32 * s);
#pragma unroll
            for (int cb = 0; cb < 5; ++cb) { const bf16x8 b = *(const GAS bf16x8*)(bp + (size_t)cb * 16 * D + 32 * s); acc[cb] = __builtin_amdgcn_mfma_f32_16x16x32_bf16(a, b, acc[cb], 0, 0, 0); }
        }
        float gk[4];
#pragma unroll
        for (int cb = 0; cb < 4; ++cb) gk[cb] = g_kidx[16 * cb + n16];
#pragma unroll
        for (int i = 0; i < 4; ++i) {
            const int tok = row0 + 4 * q4 + i;
            float ss = (acc[0][i] * acc[0][i] + acc[1][i] * acc[1][i]) + (acc[2][i] * acc[2][i] + acc[3][i] * acc[3][i]);
            ss += __shfl_xor(ss, 1); ss += __shfl_xor(ss, 2); ss += __shfl_xor(ss, 4); ss += __shfl_xor(ss, 8);
            const float rs = __builtin_amdgcn_rsqf(ss * (1.f / 64.f) + EPS);
#pragma unroll
            for (int cb = 0; cb < 4; ++cb) KI[(size_t)tok * 64 + 16 * cb + n16] = (bf16)f2bf(acc[cb][i] * rs * gk[cb]);
            if (n16 < 8) WI[(size_t)tok * 8 + n16] = acc[4][i] * WSCALE;
        }
    }
}

__device__ __forceinline__ v4u f8x8_to_bf16(unsigned a, unsigned b) {
    typedef float f32x2 __attribute__((ext_vector_type(2)));
    const f32x2 a0 = __builtin_amdgcn_cvt_pk_f32_fp8((int)a, false), a1 = __builtin_amdgcn_cvt_pk_f32_fp8((int)a, true), b0 = __builtin_amdgcn_cvt_pk_f32_fp8((int)b, false), b1 = __builtin_amdgcn_cvt_pk_f32_fp8((int)b, true);
    v4u r; r.x = __builtin_amdgcn_perm(__float_as_uint(a0.y), __float_as_uint(a0.x), 0x07060302u); r.y = __builtin_amdgcn_perm(__float_as_uint(a1.y), __float_as_uint(a1.x), 0x07060302u);
    r.z = __builtin_amdgcn_perm(__float_as_uint(b0.y), __float_as_uint(b0.x), 0x07060302u); r.w = __builtin_amdgcn_perm(__float_as_uint(b1.y), __float_as_uint(b1.x), 0x07060302u); return r;
}
__device__ __forceinline__ u64 make_key(float s, int kidx) {
    const unsigned u = __float_as_uint(s); const unsigned sk = u ^ ((unsigned)((int)u >> 31) | 0x80000000u);
    return ((u64)sk << 13) | (u64)(8191 - kidx);
}
__device__ __forceinline__ float relu_i(float x) { const int b = __float_as_int(x); return __int_as_float(b > 0 ? b : 0); }
__device__ __forceinline__ unsigned skey32(float s) { const unsigned u = __float_as_uint(s); return u ^ ((unsigned)((int)u >> 31) | 0x80000000u); }
template <int MODE, bool L0, int PROBE, bool ALLV, int SMUL>
__device__ __forceinline__ void idx_loop(const bf16x8 (&qa)[4][4], const bf16* KIb, int t0q, int nst, int st_begin, int st_end, int key_l, int hi, LAS unsigned char* lds, const u64 (&Pq)[4][2], unsigned hbase,
                                         bf16x8 (&kb)[4], bf16x8 (&kn)[4], f32x16& acc, int level, int hi_shift, int lo_shift, unsigned mask) {
    for (int st_ = st_begin; st_ < st_end; st_ += 8) {
        const int kidx = 32 * SMUL * st_ + key_l;
        unsigned sks[4][2];
        constexpr bool allvalid = ALLV;
#pragma unroll
        for (int rb = 0; rb < 4; ++rb) {
            f32x16 accN = f32x16{};
            if (rb < 3) {
#pragma unroll
                for (int ks = 0; ks < 4; ++ks) accN = __builtin_amdgcn_mfma_f32_32x32x16_bf16(qa[rb + 1][ks], kb[ks], accN, 0, 0, 0);
            } else {
#pragma unroll
                for (int ks = 0; ks < 4; ++ks) kb[ks] = kn[ks];
                { const int kx = (st_ + 16 < nst) ? kidx + 512 * SMUL : kidx;
#pragma unroll
                  for (int ks = 0; ks < 4; ++ks) kn[ks] = *(const GAS bf16x8*)(KIb + (size_t)(PROBE == 2 ? key_l : kx) * 64 + 16 * ks + 8 * hi); }
#pragma unroll
                for (int ks = 0; ks < 4; ++ks) accN = __builtin_amdgcn_mfma_f32_32x32x16_bf16(qa[0][ks], kb[ks], accN, 0, 0, 0);
            }
            __builtin_amdgcn_sched_barrier(0);
            float sc[2];
            { LAS const f32x4* wp = (LAS const f32x4*)(lds + ST_OFF + 1024 + (4 * rb + 2 * hi) * 32);
              const f32x4 w0 = wp[0], w1 = wp[1], w2 = wp[2], w3 = wp[3];
              float s0 = relu_i(acc[0]) * w0[0];
#pragma unroll
              for (int i = 1; i < 4; ++i) s0 = fmaf(relu_i(acc[i]), w0[i], s0);
#pragma unroll
              for (int i = 0; i < 4; ++i) s0 = fmaf(relu_i(acc[4 + i]), w1[i], s0);
              asm volatile("" : "+v"(s0));
              float s1 = relu_i(acc[8]) * w2[0];
#pragma unroll
              for (int i = 1; i < 4; ++i) s1 = fmaf(relu_i(acc[8 + i]), w2[i], s1);
#pragma unroll
              for (int i = 0; i < 4; ++i) s1 = fmaf(relu_i(acc[12 + i]), w3[i], s1);
              sc[0] = s0; sc[1] = s1; }
#pragma unroll
            for (int e = 0; e < 2; ++e) {
                const int ql = 4 * rb + 2 * hi + e; const int t = t0q + ql;
                const unsigned sk = skey32(sc[e]);
                if (L0 && MODE == 0) {
                    const unsigned skv = allvalid ? sk : ((kidx <= t) ? sk : 0u);
                    const unsigned addr = hbase + (unsigned)(4 * rb + e) * 8192u + ((skv >> 21) << 2);
                    const unsigned vv = (skv & 0x100000u) ? 0x10000u : 1u;
                    if (PROBE == 1) { asm volatile("" :: "v"(addr), "v"(vv)); }
                    else __hip_atomic_fetch_add((LAS unsigned*)(uintptr_t)addr, vv, __ATOMIC_RELAXED, __HIP_MEMORY_SCOPE_WORKGROUP);
                } else if (L0 && (MODE == 1 || MODE == 3)) {
                    sks[rb][e] = sk;
                } else {
                    const bool valid = kidx <= t;
                    const u64 K = ((u64)sk << 13) | (u64)(8191 - kidx);
                    if (MODE == 0) {
                        bool ok = valid;
                        if (level > 0) ok = ok && ((K >> hi_shift) == Pq[rb][e]);
                        if (ok) { const unsigned bin = (unsigned)(K >> lo_shift) & mask;
                            __hip_atomic_fetch_add((LAS unsigned*)(lds + HIST_OFF + ql * 8192) + (bin >> 1), 1u << (16 * (bin & 1)), __ATOMIC_RELAXED, __HIP_MEMORY_SCOPE_WORKGROUP); }
                    } else if (valid) {
                        const u64 pfx = K >> lo_shift;
                        LAS unsigned* st = (LAS unsigned*)(lds + ST_OFF + ql * 32);
                        if (pfx > Pq[rb][e]) {
                            const unsigned slot = __hip_atomic_fetch_add(st + 3, 1u, __ATOMIC_RELAXED, __HIP_MEMORY_SCOPE_WORKGROUP) & 0xffffu;
                            if (slot < (unsigned)TOPK) ((LAS unsigned short*)(lds + SEL_OFF))[ql * TOPK + slot] = (unsigned short)kidx;
                        } else if (pfx == Pq[rb][e]) {
                            const unsigned slot = __hip_atomic_fetch_add(st + 3, 0x10000u, __ATOMIC_RELAXED, __HIP_MEMORY_SCOPE_WORKGROUP) >> 16;
                            if (slot < (unsigned)CAP) ((LAS u64*)(lds + HIST_OFF))[ql * CAP + slot] = K;
                        }
                    }
                }
            }
            if (L0 && (MODE == 1 || MODE == 3) && (rb & 1)) {
                unsigned old[2][2];
#pragma unroll
                for (int r2 = 0; r2 < 2; ++r2)
#pragma unroll
                    for (int e = 0; e < 2; ++e) { const int rbb = rb - 1 + r2, ql = 4 * rbb + 2 * hi + e; const unsigned bin = sks[rbb][e] >> 20, Tb = (unsigned)Pq[rbb][e]; const bool valid = allvalid || (kidx <= t0q + ql);
                        old[r2][e] = 0u;
                        if (valid && bin >= Tb) old[r2][e] = __hip_atomic_fetch_add((LAS unsigned*)(lds + ST_OFF + ql * 32) + 3, (MODE == 1 && bin > Tb) ? 1u : 0x10000u, __ATOMIC_RELAXED, __HIP_MEMORY_SCOPE_WORKGROUP); }
#pragma unroll
                for (int r2 = 0; r2 < 2; ++r2)
#pragma unroll
                    for (int e = 0; e < 2; ++e) { const int rbb = rb - 1 + r2, ql = 4 * rbb + 2 * hi + e; const unsigned bin = sks[rbb][e] >> 20, Tb = (unsigned)Pq[rbb][e]; const bool valid = allvalid || (kidx <= t0q + ql);
                        if (MODE == 1 && valid && bin > Tb) { const unsigned slot = old[r2][e] & 0xffffu; if (slot < (unsigned)TOPK) ((LAS unsigned short*)(lds + SEL_OFF))[ql * TOPK + slot] = (unsigned short)kidx; }
                        else if (valid && (MODE == 3 ? bin >= Tb : bin == Tb)) { const unsigned slot = old[r2][e] >> 16; if (slot < (unsigned)CAP) ((LAS u64*)(lds + HIST_OFF))[ql * CAP + slot] = ((u64)sks[rbb][e] << 13) | (u64)(8191 - kidx); } }
            }
            acc = accN;
        }
    }
}
template <int MODE, bool L0, int PROBE = 0, int SMUL = 1>
__device__ __forceinline__ void idx_pass(const bf16x8 (&qa)[4][4], const bf16* KIb, int t0q, int nst, int wave, int lane_in, LAS unsigned char* lds, int level, int hi_shift, int lo_shift, unsigned mask) {
    int lane = lane_in; asm volatile("" : "+v"(lane));
    const int key_l = lane & 31, hi = lane >> 5;
    u64 Pq[4][2];
#pragma unroll
    for (int rb = 0; rb < 4; ++rb)
#pragma unroll
        for (int e = 0; e < 2; ++e) { const int ql = 4 * rb + 2 * hi + e; LAS const unsigned* st = (LAS const unsigned*)(lds + ST_OFF + ql * 32);
            Pq[rb][e] = (u64)st[0] | ((u64)st[1] << 32); }
    const unsigned hbase = (unsigned)(uintptr_t)(lds + HIST_OFF) + (unsigned)hi * 16384u;
    bf16x8 kb[4], kn[4];
    { const int kc = (wave < nst) ? 32 * SMUL * wave + key_l : key_l;
      const int kc2 = (wave + 8 < nst) ? kc + 256 * SMUL : kc;
#pragma unroll
      for (int ks = 0; ks < 4; ++ks) { kb[ks] = *(const GAS bf16x8*)(KIb + (size_t)kc * 64 + 16 * ks + 8 * hi); kn[ks] = *(const GAS bf16x8*)(KIb + (size_t)(PROBE == 2 ? key_l : kc2) * 64 + 16 * ks + 8 * hi); } }
    f32x16 acc = f32x16{};
#pragma unroll
    for (int ks = 0; ks < 4; ++ks) acc = __builtin_amdgcn_mfma_f32_32x32x16_bf16(qa[0][ks], kb[ks], acc, 0, 0, 0);
    if (SMUL != 1) {
        idx_loop<MODE, L0, PROBE, true, SMUL>(qa, KIb, t0q, nst, wave, nst, key_l, hi, lds, Pq, hbase, kb, kn, acc, level, hi_shift, lo_shift, mask);
        return;
    }
    const int nfull = (t0q + 1) >> 5; int st_split = wave; if (nfull > wave) st_split = wave + ((nfull - wave + 7) >> 3) * 8;
    idx_loop<MODE, L0, PROBE, true, 1>(qa, KIb, t0q, nst, wave, nfull, key_l, hi, lds, Pq, hbase, kb, kn, acc, level, hi_shift, lo_shift, mask);
    idx_loop<MODE, L0, PROBE, false, 1>(qa, KIb, t0q, nst, st_split, nst, key_l, hi, lds, Pq, hbase, kb, kn, acc, level, hi_shift, lo_shift, mask);
}

__device__ __forceinline__ void find_bin(LAS unsigned char* lds, int row, int lane_in, int bits) {
    int lane = lane_in; asm volatile("" : "+v"(lane));
    LAS unsigned* st = (LAS unsigned*)(lds + ST_OFF + row * 32);
    if (st[6] != 0u) return;
    const unsigned need = st[2];
    LAS const unsigned* hrow = (LAS const unsigned*)(lds + HIST_OFF + row * 8192) + 32 * lane;
    v4u hw[8]; unsigned tot = 0;
#pragma unroll
    for (int i = 0; i < 8; ++i) { hw[i] = *(LAS const v4u*)(hrow + 4 * i);
#pragma unroll
        for (int e = 0; e < 4; ++e) tot += (hw[i][e] & 0xffffu) + (hw[i][e] >> 16); }
    unsigned suf = tot;
#pragma unroll
    for (int o = 1; o < 64; o <<= 1) { const unsigned n = (unsigned)__builtin_amdgcn_ds_bpermute(((lane + o) & 63) << 2, (int)suf); if (lane + o < 64) suf += n; }
    const unsigned above = suf - tot;
    if (above < need && need <= suf) {
        unsigned running = above, T = 0, cT = 0; bool found = false;
#pragma unroll
        for (int i = 31; i >= 0; --i) {
            const unsigned w = hw[i >> 2][i & 3], h16 = w >> 16, l16 = w & 0xffffu;
            if (!found) {
                if (running + h16 >= need) { T = 64 * lane + 2 * i + 1; cT = h16; found = true; }
                else { running += h16;
                    if (running + l16 >= need) { T = 64 * lane + 2 * i; cT = l16; found = true; } else running += l16; } }
        }
        const u64 Pold = (u64)st[0] | ((u64)st[1] << 32); const u64 Pn = (Pold << bits) | (u64)T;
        st[0] = (unsigned)Pn; st[1] = (unsigned)(Pn >> 32); st[2] = need - running; st[5] = cT;
    }
}

__device__ __forceinline__ void finish_row(LAS unsigned char* lds, int row, int lane_in, int nbits) {
    int lane = lane_in; asm volatile("" : "+v"(lane));
    LAS unsigned* st = (LAS unsigned*)(lds + ST_OFF + row * 32);
    if (st[6] != 0u) return;
    const unsigned need = st[2]; unsigned nc = st[3] >> 16; if (nc > (unsigned)CAP) nc = CAP;
    unsigned base = st[3] & 0xffffu; if (base > (unsigned)TOPK) base = TOPK;
    LAS const u64* cand = (LAS const u64*)(lds + HIST_OFF) + row * CAP;
    const int nch = (int)((nc + 63u) >> 6);
    const u64 Pfix = ((u64)st[0] | ((u64)st[1] << 32)) << nbits;
    u64 thr = Pfix;
    if (nch <= 4) {
        u64 k[4];
#pragma unroll
        for (int ch = 0; ch < 4; ++ch) { const unsigned i = 64u * ch + lane; k[ch] = (i < nc) ? cand[i] : 0ull; }
        for (int bit = nbits - 1; bit >= 0; --bit) {
            const u64 c = thr | (1ull << bit); unsigned cnt = 0;
#pragma unroll
            for (int ch = 0; ch < 4; ++ch) cnt += (unsigned)__builtin_popcountll(__ballot(k[ch] >= c));
            if (cnt >= need) thr = c;
        }
#pragma unroll
        for (int ch = 0; ch < 4; ++ch) {
            const unsigned i = 64u * ch + lane; const bool s = (i < nc) && (k[ch] >= thr);
            const unsigned long long m = __ballot(s); const unsigned pos = base + (unsigned)__builtin_popcountll(m & ((1ull << lane) - 1ull));
            if (s && pos < (unsigned)TOPK) ((LAS unsigned short*)(lds + SEL_OFF))[row * TOPK + pos] = (unsigned short)(8191u - (unsigned)(k[ch] & 0x1fffull));
            base += (unsigned)__builtin_popcountll(m);
        }
    } else if (nch <= 8) {
        u64 k[8];
#pragma unroll
        for (int ch = 0; ch < 8; ++ch) { const unsigned i = 64u * ch + lane; k[ch] = (i < nc) ? cand[i] : 0ull; }
        for (int bit = nbits - 1; bit >= 0; --bit) {
            const u64 c = thr | (1ull << bit); unsigned cnt = 0;
#pragma unroll
            for (int ch = 0; ch < 8; ++ch) cnt += (unsigned)__builtin_popcountll(__ballot(k[ch] >= c));
            if (cnt >= need) thr = c;
        }
#pragma unroll
        for (int ch = 0; ch < 8; ++ch) {
            const unsigned i = 64u * ch + lane; const bool s = (i < nc) && (k[ch] >= thr);
            const unsigned long long m = __ballot(s); const unsigned pos = base + (unsigned)__builtin_popcountll(m & ((1ull << lane) - 1ull));
            if (s && pos < (unsigned)TOPK) ((LAS unsigned short*)(lds + SEL_OFF))[row * TOPK + pos] = (unsigned short)(8191u - (unsigned)(k[ch] & 0x1fffull));
            base += (unsigned)__builtin_popcountll(m);
        }
    } else if (nch <= 12) {
        u64 k[12];
#pragma unroll
        for (int ch = 0; ch < 12; ++ch) { const unsigned i = 64u * ch + lane; k[ch] = (i < nc) ? cand[i] : 0ull; }
        for (int bit = nbits - 1; bit >= 0; --bit) {
            const u64 c = thr | (1ull << bit); unsigned cnt = 0;
#pragma unroll
            for (int ch = 0; ch < 12; ++ch) cnt += (unsigned)__builtin_popcountll(__ballot(k[ch] >= c));
            if (cnt >= need) thr = c;
        }
#pragma unroll
        for (int ch = 0; ch < 12; ++ch) {
            const unsigned i = 64u * ch + lane; const bool s = (i < nc) && (k[ch] >= thr);
            const unsigned long long m = __ballot(s); const unsigned pos = base + (unsigned)__builtin_popcountll(m & ((1ull << lane) - 1ull));
            if (s && pos < (unsigned)TOPK) ((LAS unsigned short*)(lds + SEL_OFF))[row * TOPK + pos] = (unsigned short)(8191u - (unsigned)(k[ch] & 0x1fffull));
            base += (unsigned)__builtin_popcountll(m);
        }
    } else if (nch <= 16) {
        u64 k[16];
#pragma unroll
        for (int ch = 0; ch < 16; ++ch) { const unsigned i = 64u * ch + lane; k[ch] = (i < nc) ? cand[i] : 0ull; }
        for (int bit = nbits - 1; bit >= 0; --bit) {
            const u64 c = thr | (1ull << bit); unsigned cnt = 0;
#pragma unroll
            for (int ch = 0; ch < 16; ++ch) cnt += (unsigned)__builtin_popcountll(__ballot(k[ch] >= c));
            if (cnt >= need) thr = c;
        }
#pragma unroll
        for (int ch = 0; ch < 16; ++ch) {
            const unsigned i = 64u * ch + lane; const bool s = (i < nc) && (k[ch] >= thr);
            const unsigned long long m = __ballot(s); const unsigned pos = base + (unsigned)__builtin_popcountll(m & ((1ull << lane) - 1ull));
            if (s && pos < (unsigned)TOPK) ((LAS unsigned short*)(lds + SEL_OFF))[row * TOPK + pos] = (unsigned short)(8191u - (unsigned)(k[ch] & 0x1fffull));
            base += (unsigned)__builtin_popcountll(m);
        }
    } else {
        for (int bit = nbits - 1; bit >= 0; --bit) {
            const u64 c = thr | (1ull << bit); unsigned cnt = 0;
            for (int ch = 0; ch < nch; ++ch) { const unsigned i = 64u * ch + lane; const u64 k = (i < nc) ? cand[i] : 0ull; cnt += (unsigned)__builtin_popcountll(__ballot(k >= c)); }
            if (cnt >= need) thr = c;
        }
        for (int ch = 0; ch < nch; ++ch) {
            const unsigned i = 64u * ch + lane; const u64 k = (i < nc) ? cand[i] : 0ull; const bool s = (i < nc) && (k >= thr);
            const unsigned long long m = __ballot(s); const unsigned pos = base + (unsigned)__builtin_popcountll(m & ((1ull << lane) - 1ull));
            if (s && pos < (unsigned)TOPK) ((LAS unsigned short*)(lds + SEL_OFF))[row * TOPK + pos] = (unsigned short)(8191u - (unsigned)(k & 0x1fffull));
            base += (unsigned)__builtin_popcountll(m);
        }
    }
    if (lane == 0) st[3] = base;
}

__device__ __forceinline__ void sparse_attn_row(LAS unsigned char* lds, int row, int b, int t, const bf16* Q1, bf16* O1, const unsigned char* K1, const unsigned char* V1, int wave, int lane_in) {
    int lane = lane_in; asm volatile("" : "+v"(lane));
    const int n16 = lane & 15, q4 = lane >> 4, gl = n16 >> 2;
    LAS const unsigned short* sel = (LAS const unsigned short*)(lds + SEL_OFF) + row * TOPK;
    unsigned cnt = ((LAS const unsigned*)(lds + ST_OFF + row * 32))[3] & 0xffffu; if (cnt > (unsigned)TOPK) cnt = TOPK;
    const bf16* qrow = Q1 + ((size_t)b * T + t) * D; bf16* orow = O1 + ((size_t)b * T + t) * D;
    bf16x8 bq[8];
    { const bf16x8 q0 = *(const GAS bf16x8*)(qrow + n16 * 64 + 16 * q4), q1 = *(const GAS bf16x8*)(qrow + n16 * 64 + 16 * q4 + 8); const bf16x8 z = (bf16x8){0, 0, 0, 0, 0, 0, 0, 0};
#pragma unroll
      for (int s = 0; s < 8; ++s) bq[s] = ((s >> 1) == gl) ? ((s & 1) ? q1 : q0) : z; }
    const float slope = __builtin_amdgcn_exp2f(-0.5f * (float)(n16 + 1)) * LOG2E;
    const unsigned char* Kb = K1 + (size_t)b * T * 256; const unsigned char* Vb = V1 + (size_t)b * T * 256;
    f32x4 sc[16];
    v4u vst[2][8];
    constexpr int KD = 3;
    v4u kfn[KD][4];
#pragma unroll
    for (int d = 0; d < KD; ++d) { const unsigned pos = 16u * d + n16; const unsigned kidx = (pos < cnt) ? (unsigned)sel[pos] : 0u; const unsigned char* kp = Kb + (size_t)kidx * 256 + 16 * q4;
#pragma unroll
      for (int g = 0; g < 4; ++g) kfn[d][g] = *(const GAS v4u*)(kp + 64 * g); }
#pragma unroll
    for (int blk = 0; blk < 16; ++blk) {
        bf16x8 kf[8];
#pragma unroll
        for (int g = 0; g < 4; ++g) { const v4u lo = f8x8_to_bf16(kfn[blk % KD][g].x, kfn[blk % KD][g].y), hi8 = f8x8_to_bf16(kfn[blk % KD][g].z, kfn[blk % KD][g].w); kf[2 * g] = __builtin_bit_cast(bf16x8, lo); kf[2 * g + 1] = __builtin_bit_cast(bf16x8, hi8); }
        if (blk + KD < 16) { const unsigned pos = 16u * (blk + KD) + n16; const unsigned kidx = (pos < cnt) ? (unsigned)sel[pos] : 0u; const unsigned char* kp = Kb + (size_t)kidx * 256 + 16 * q4;
#pragma unroll
            for (int g = 0; g < 4; ++g) kfn[blk % KD][g] = *(const GAS v4u*)(kp + 64 * g); }
        if (blk >= 14) {
            const int d = blk - 14;
#pragma unroll
            for (int i = 0; i < 8; ++i) { const unsigned pos = 32u * d + 4u * i + q4; const unsigned kidx = (pos < cnt) ? (unsigned)sel[pos] : 0u; vst[d][i] = *(const GAS v4u*)(Vb + (size_t)kidx * 256 + 16 * n16); }
        }
        f32x4 a = (f32x4){0.f, 0.f, 0.f, 0.f};
#pragma unroll
        for (int s = 0; s < 8; ++s) a = __builtin_amdgcn_mfma_f32_16x16x32_bf16(kf[s], bq[s], a, 0, 0, 0);
        const unsigned long long i4 = *(LAS const unsigned long long*)(sel + 16 * blk + 4 * q4);
#pragma unroll
        for (int i = 0; i < 4; ++i) { const unsigned p = 16u * blk + 4u * q4 + i; const int ki = (int)((i4 >> (16 * i)) & 0xffffull);
            a[i] = (p < cnt) ? (a[i] - slope * (float)(t - ki)) : -INFINITY; }
        sc[blk] = a;
    }
    float mx = -INFINITY;
#pragma unroll
    for (int blk = 0; blk < 16; ++blk) mx = fmaxf(fmaxf(fmaxf(mx, sc[blk][0]), fmaxf(sc[blk][1], sc[blk][2])), sc[blk][3]);
    mx = xmax32(xmax16(mx));
    float lsum = 0.f;
#pragma unroll
    for (int blk = 0; blk < 16; ++blk)
#pragma unroll
        for (int i = 0; i < 4; ++i) { const float p = __builtin_amdgcn_exp2f(sc[blk][i] - mx); sc[blk][i] = p; lsum += p; }
    lsum = xsum32(xsum16(lsum));
    LAS unsigned char* vbuf = lds + HIST_OFF + wave * 16384;
    f32x4 o[4];
#pragma unroll
    for (int db = 0; db < 4; ++db) o[db] = (f32x4){0.f, 0.f, 0.f, 0.f};
#pragma unroll
    for (int J = 0; J < 8; ++J) {
#pragma unroll
        for (int i = 0; i < 8; ++i) { const int key = 4 * i + q4; LAS unsigned char* dst = vbuf + key * 512 + ((n16 ^ (key & 7)) << 5);
            *(LAS v4u*)dst = f8x8_to_bf16(vst[J & 1][i].x, vst[J & 1][i].y); *(LAS v4u*)(dst + 16) = f8x8_to_bf16(vst[J & 1][i].z, vst[J & 1][i].w); }
        if (J + 2 < 8) {
#pragma unroll
            for (int i = 0; i < 8; ++i) { const unsigned pos = 32u * (J + 2) + 4u * i + q4; const unsigned kidx = (pos < cnt) ? (unsigned)sel[pos] : 0u; vst[J & 1][i] = *(const GAS v4u*)(Vb + (size_t)kidx * 256 + 16 * n16); }
        }
        asm volatile("s_waitcnt lgkmcnt(0)" ::: "memory");
        v4u pb; pb.x = pk2(sc[2 * J][0], sc[2 * J][1]); pb.y = pk2(sc[2 * J][2], sc[2 * J][3]); pb.z = pk2(sc[2 * J + 1][0], sc[2 * J + 1][1]); pb.w = pk2(sc[2 * J + 1][2], sc[2 * J + 1][3]);
#pragma unroll
        for (int g = 0; g < 4; ++g) {
            const v4u pg = (g == gl) ? pb : (v4u){0u, 0u, 0u, 0u};
#pragma unroll
            for (int db = 0; db < 4; ++db) {
                const int qq = n16 >> 2, pp = n16 & 3; const int col = 64 * g + 16 * db + 4 * pp;
                const int r0 = 4 * q4 + qq, r1 = 16 + 4 * q4 + qq;
                const int a0 = r0 * 512 + ((((col >> 4) ^ (r0 & 7)) << 5) | ((col & 15) << 1)), a1 = r1 * 512 + ((((col >> 4) ^ (r1 & 7)) << 5) | ((col & 15) << 1));
                v2u lo, hi2;
                asm volatile("ds_read_b64_tr_b16 %0, %1" : "=v"(lo) : "v"((unsigned)(uintptr_t)(vbuf + a0)) : "memory");
                asm volatile("ds_read_b64_tr_b16 %0, %1" : "=v"(hi2) : "v"((unsigned)(uintptr_t)(vbuf + a1)) : "memory");
                asm volatile("s_waitcnt lgkmcnt(0)" : "+v"(lo), "+v"(hi2) :: "memory");
                const v4u av = (v4u){lo.x, lo.y, hi2.x, hi2.y};
                o[db] = __builtin_amdgcn_mfma_f32_16x16x32_bf16(__builtin_bit_cast(bf16x8, av), __builtin_bit_cast(bf16x8, pg), o[db], 0, 0, 0);
            }
        }
        asm volatile("s_waitcnt lgkmcnt(0)" ::: "memory");
    }
    const float rl = 1.f / lsum;
#pragma unroll
    for (int db = 0; db < 4; ++db) { v2u w; w.x = pk2(o[db][0] * rl, o[db][1] * rl); w.y = pk2(o[db][2] * rl, o[db][3] * rl);
        *(GAS v2u*)(orow + n16 * 64 + 16 * db + 4 * q4) = w; }
}

typedef long i64_t;
__device__ __forceinline__ void canon_sel(LAS unsigned char* lds, LAS unsigned short* sel, unsigned cnt, int wave, int lane) {
    LAS unsigned* bm = (LAS unsigned*)(lds + HIST_OFF + wave * 16384); LAS unsigned* pf = bm + 256;
    *(LAS v4u*)(bm + 4 * lane) = (v4u){0u, 0u, 0u, 0u};
    const v2u e = *(const LAS v2u*)(sel + 4 * lane);
    unsigned idx[4] = {e.x & 0xffffu, e.x >> 16, e.y & 0xffffu, e.y >> 16};
    LDS_WAIT();
#pragma unroll
    for (int i = 0; i < 4; ++i) if ((unsigned)(4 * lane + i) < cnt) __hip_atomic_fetch_or(bm + (idx[i] >> 5), 1u << (idx[i] & 31u), __ATOMIC_RELAXED, __HIP_MEMORY_SCOPE_WORKGROUP);
    LDS_WAIT();
    const v4u w = *(const LAS v4u*)(bm + 4 * lane);
    const unsigned c0 = __builtin_popcount(w.x), c1 = __builtin_popcount(w.y), c2 = __builtin_popcount(w.z), c3 = __builtin_popcount(w.w), tot = c0 + c1 + c2 + c3;
    int sc = (int)tot;
    sc += __builtin_amdgcn_update_dpp(0, sc, 0x111, 0xf, 0xf, false); sc += __builtin_amdgcn_update_dpp(0, sc, 0x112, 0xf, 0xf, false);
    sc += __builtin_amdgcn_update_dpp(0, sc, 0x114, 0xf, 0xf, false); sc += __builtin_amdgcn_update_dpp(0, sc, 0x118, 0xf, 0xf, false);
    sc += __builtin_amdgcn_update_dpp(0, sc, 0x142, 0xa, 0xf, false);
    sc += __builtin_amdgcn_update_dpp(0, sc, 0x143, 0xc, 0xf, false);
    const unsigned ex = (unsigned)sc - tot;
    *(LAS v4u*)(pf + 4 * lane) = (v4u){ex, ex + c0, ex + c0 + c1, ex + c0 + c1 + c2};
    LDS_WAIT();
#pragma unroll
    for (int i = 0; i < 4; ++i) if ((unsigned)(4 * lane + i) < cnt) { const unsigned wd = idx[i] >> 5; const unsigned r = pf[wd] + __builtin_popcount(bm[wd] & ((1u << (idx[i] & 31u)) - 1u)); sel[r] = (unsigned short)idx[i]; }
    LDS_WAIT();
}
__device__ __forceinline__ void sparse_attn_row8(LAS unsigned char* lds, int row, int b, int t, const bf16* Q1, bf16* O1, const unsigned char* K1, const unsigned char* V1, int wave, int lane_in) {
    int lane = lane_in; asm volatile("" : "+v"(lane));
    const int n16 = lane & 15, q4 = lane >> 4, gl = n16 >> 2;
    LAS unsigned short* sel = (LAS unsigned short*)(lds + SEL_OFF) + row * TOPK;
    unsigned cnt = ((LAS const unsigned*)(lds + ST_OFF + row * 32))[3] & 0xffffu; if (cnt > (unsigned)TOPK) cnt = TOPK;
    canon_sel(lds, sel, cnt, wave, lane);
    if (cnt < (unsigned)TOPK) {
        for (unsigned i = cnt + lane; i < (unsigned)TOPK; i += 64u) sel[i] = 0;
        asm volatile("s_waitcnt lgkmcnt(0)" ::: "memory");
    }
    const bf16* qrow = Q1 + ((size_t)b * T + t) * D; bf16* orow = O1 + ((size_t)b * T + t) * D;
    i64_t qs0, qs1;
    { const v4u a = *(const GAS v4u*)(qrow + n16 * 64 + 16 * q4), c = *(const GAS v4u*)(qrow + n16 * 64 + 16 * q4 + 8);
      int w0 = 0, w1 = 0, w2 = 0, w3 = 0;
      w0 = __builtin_amdgcn_cvt_pk_fp8_f32(bf2f(a.x & 0xffffu), bf2f(a.x >> 16), w0, false); w0 = __builtin_amdgcn_cvt_pk_fp8_f32(bf2f(a.y & 0xffffu), bf2f(a.y >> 16), w0, true);
      w1 = __builtin_amdgcn_cvt_pk_fp8_f32(bf2f(a.z & 0xffffu), bf2f(a.z >> 16), w1, false); w1 = __builtin_amdgcn_cvt_pk_fp8_f32(bf2f(a.w & 0xffffu), bf2f(a.w >> 16), w1, true);
      w2 = __builtin_amdgcn_cvt_pk_fp8_f32(bf2f(c.x & 0xffffu), bf2f(c.x >> 16), w2, false); w2 = __builtin_amdgcn_cvt_pk_fp8_f32(bf2f(c.y & 0xffffu), bf2f(c.y >> 16), w2, true);
      w3 = __builtin_amdgcn_cvt_pk_fp8_f32(bf2f(c.z & 0xffffu), bf2f(c.z >> 16), w3, false); w3 = __builtin_amdgcn_cvt_pk_fp8_f32(bf2f(c.w & 0xffffu), bf2f(c.w >> 16), w3, true);
      qs0 = (i64_t)(((u64)(unsigned)w1 << 32) | (u64)(unsigned)w0); qs1 = (i64_t)(((u64)(unsigned)w3 << 32) | (u64)(unsigned)w2); }
    i64_t bq0[4], bq1[4];
#pragma unroll
    for (int g = 0; g < 4; ++g) { bq0[g] = (g == gl) ? qs0 : (i64_t)0; bq1[g] = (g == gl) ? qs1 : (i64_t)0; }
    const float slope = __builtin_amdgcn_exp2f(-0.5f * (float)(n16 + 1)) * LOG2E;
    const unsigned char* Kb = K1 + (size_t)b * T * 256; const unsigned char* Vb = V1 + (size_t)b * T * 256;
    const int vkey = lane >> 1, vpar = lane & 1;
    f32x4 sc[16];
    v4u vst[2][8];
    constexpr int KD = 3;
    v4u kfn[KD][4];
#pragma unroll
    for (int d = 0; d < KD; ++d) { const unsigned kidx = (unsigned)sel[16 * d + n16]; const unsigned char* kp = Kb + (size_t)kidx * 256 + 16 * q4;
#pragma unroll
      for (int g = 0; g < 4; ++g) kfn[d][g] = *(const GAS v4u*)(kp + 64 * g); }
#pragma unroll
    for (int blk = 0; blk < 16; ++blk) {
        f32x4 a = (f32x4){0.f, 0.f, 0.f, 0.f};
#pragma unroll
        for (int g = 0; g < 4; ++g) {
            const v4u ch = kfn[blk % KD][g];
            const i64_t k0 = (i64_t)(((u64)ch.y << 32) | (u64)ch.x), k1 = (i64_t)(((u64)ch.w << 32) | (u64)ch.z);
            a = __builtin_amdgcn_mfma_f32_16x16x32_fp8_fp8(k0, bq0[g], a, 0, 0, 0);
            a = __builtin_amdgcn_mfma_f32_16x16x32_fp8_fp8(k1, bq1[g], a, 0, 0, 0);
        }
        if (blk + KD < 16) { const unsigned kidx = (unsigned)sel[16 * (blk + KD) + n16]; const unsigned char* kp = Kb + (size_t)kidx * 256 + 16 * q4;
#pragma unroll
            for (int g = 0; g < 4; ++g) kfn[blk % KD][g] = *(const GAS v4u*)(kp + 64 * g); }
        if (blk >= 14) { const int d = blk - 14;
#pragma unroll
            for (int k = 0; k < 8; ++k) vst[d][k] = *(const GAS v4u*)(Vb + (size_t)sel[32 * d + 4 * k + q4] * 256 + 16 * n16); }
        const unsigned long long i4 = *(LAS const unsigned long long*)(sel + 16 * blk + 4 * q4);
#pragma unroll
        for (int i = 0; i < 4; ++i) { const unsigned pz = 16u * blk + 4u * q4 + i; const int ki = (int)((i4 >> (16 * i)) & 0xffffull);
            a[i] = (pz < cnt) ? (a[i] - slope * (float)(t - ki)) : -INFINITY; }
        sc[blk] = a;
    }
    float mx = -INFINITY;
#pragma unroll
    for (int blk = 0; blk < 16; ++blk) mx = fmaxf(fmaxf(fmaxf(mx, sc[blk][0]), fmaxf(sc[blk][1], sc[blk][2])), sc[blk][3]);
    mx = xmax32(xmax16(mx));
    float lsum = 0.f;
    mx -= 8.f;
#pragma unroll
    for (int blk = 0; blk < 16; ++blk)
#pragma unroll
        for (int i = 0; i < 4; ++i) { const float pv = __builtin_amdgcn_exp2f(sc[blk][i] - mx); sc[blk][i] = pv; lsum += pv; }
    lsum = xsum32(xsum16(lsum));
    LAS unsigned char* vbuf = lds + HIST_OFF + wave * 16384;
    unsigned vdst[4];
#pragma unroll
    for (int j = 0; j < 4; ++j) vdst[j] = (unsigned)(uintptr_t)vbuf + (unsigned)vkey * 256u + (unsigned)((((2 * j) ^ (vkey & 7)) << 5) | (vpar << 4));
    const int qq = n16 >> 2, pp = n16 & 3; const int r0 = 4 * q4 + qq, r1 = 16 + 4 * q4 + qq;
    f32x4 oe[2], oo[2];
#pragma unroll
    for (int d = 0; d < 2; ++d) { oe[d] = (f32x4){0.f, 0.f, 0.f, 0.f}; oo[d] = (f32x4){0.f, 0.f, 0.f, 0.f}; }
#pragma unroll
    for (int J = 0; J < 8; ++J) {
        LAS unsigned char* slot = vbuf + (J & 1) * 8192;
#pragma unroll
        for (int k = 0; k < 8; ++k) { const int key = 4 * k + q4; *(LAS v4u*)(slot + key * 256 + ((((n16 >> 1) ^ (key & 7)) << 5) | ((n16 & 1) << 4))) = vst[J & 1][k]; }
        if (J + 2 < 8) {
#pragma unroll
            for (int k = 0; k < 8; ++k) vst[J & 1][k] = *(const GAS v4u*)(Vb + (size_t)sel[32 * (J + 2) + 4 * k + q4] * 256 + 16 * n16); }
        asm volatile("s_waitcnt lgkmcnt(0)" ::: "memory");
        int p0 = 0, p1 = 0;
        p0 = __builtin_amdgcn_cvt_pk_fp8_f32(sc[2 * J][0], sc[2 * J][1], p0, false); p0 = __builtin_amdgcn_cvt_pk_fp8_f32(sc[2 * J][2], sc[2 * J][3], p0, true);
        p1 = __builtin_amdgcn_cvt_pk_fp8_f32(sc[2 * J + 1][0], sc[2 * J + 1][1], p1, false); p1 = __builtin_amdgcn_cvt_pk_fp8_f32(sc[2 * J + 1][2], sc[2 * J + 1][3], p1, true);
        const i64_t pb = (i64_t)(((u64)(unsigned)p1 << 32) | (u64)(unsigned)p0);
        v2u trl[8], trh[8];
#pragma unroll
        for (int sg = 0; sg < 8; ++sg) {
            const int a0 = r0 * 256 + (((sg ^ (r0 & 7)) << 5) | (pp << 3)), a1 = r1 * 256 + (((sg ^ (r1 & 7)) << 5) | (pp << 3));
            asm volatile("ds_read_b64_tr_b16 %0, %1" : "=v"(trl[sg]) : "v"((unsigned)(uintptr_t)(slot + a0)) : "memory");
            asm volatile("ds_read_b64_tr_b16 %0, %1" : "=v"(trh[sg]) : "v"((unsigned)(uintptr_t)(slot + a1)) : "memory");
        }
        asm volatile("s_waitcnt lgkmcnt(0)" : "+v"(trl[0]), "+v"(trl[1]), "+v"(trl[2]), "+v"(trl[3]), "+v"(trl[4]), "+v"(trl[5]), "+v"(trl[6]), "+v"(trl[7]),
                                               "+v"(trh[0]), "+v"(trh[1]), "+v"(trh[2]), "+v"(trh[3]), "+v"(trh[4]), "+v"(trh[5]), "+v"(trh[6]), "+v"(trh[7]) :: "memory");
#pragma unroll
        for (int g = 0; g < 4; ++g) {
            const i64_t pg = (g == gl) ? pb : (i64_t)0;
#pragma unroll
            for (int dbp = 0; dbp < 2; ++dbp) {
                const v2u lo = trl[2 * g + dbp], hi2 = trh[2 * g + dbp];
                const unsigned e0 = __builtin_amdgcn_perm(lo.y, lo.x, 0x06040200u), o0 = __builtin_amdgcn_perm(lo.y, lo.x, 0x07050301u);
                const unsigned e1 = __builtin_amdgcn_perm(hi2.y, hi2.x, 0x06040200u), o1 = __builtin_amdgcn_perm(hi2.y, hi2.x, 0x07050301u);
                const i64_t ae = (i64_t)(((u64)e1 << 32) | (u64)e0), ao = (i64_t)(((u64)o1 << 32) | (u64)o0);
                oe[dbp] = __builtin_amdgcn_mfma_f32_16x16x32_fp8_fp8(ae, pg, oe[dbp], 0, 0, 0);
                oo[dbp] = __builtin_amdgcn_mfma_f32_16x16x32_fp8_fp8(ao, pg, oo[dbp], 0, 0, 0);
            }
        }
    }
    (void)vdst;
    const float rl = 32.f / lsum;
#pragma unroll
    for (int dbp = 0; dbp < 2; ++dbp) {
        int w0 = 0, w1 = 0;
        w0 = __builtin_amdgcn_cvt_pk_fp8_f32(oe[dbp][0] * rl, oo[dbp][0] * rl, w0, false); w0 = __builtin_amdgcn_cvt_pk_fp8_f32(oe[dbp][1] * rl, oo[dbp][1] * rl, w0, true);
        w1 = __builtin_amdgcn_cvt_pk_fp8_f32(oe[dbp][2] * rl, oo[dbp][2] * rl, w1, false); w1 = __builtin_amdgcn_cvt_pk_fp8_f32(oe[dbp][3] * rl, oo[dbp][3] * rl, w1, true);
        *(GAS v2u*)((unsigned char*)O1 + ((size_t)b * T + t) * D + n16 * 64 + 32 * dbp + 8 * q4) = (v2u){(unsigned)w0, (unsigned)w1}; }
}

__device__ __forceinline__ void unit(LAS unsigned char* lds, int b, int t0q, const bf16* Q1, bf16* O1, const unsigned char* K1, const unsigned char* V1, const bf16* QI, const bf16* KI, const float* WI, int tid_in, int wave) {
    int tid = tid_in; asm volatile("" : "+v"(tid)); const int lane = tid & 63;
    const int hi = lane >> 5, r32 = lane & 31;
    if (tid < QT * 8) ((LAS float*)(lds + ST_OFF + 1024))[tid] = WI[((size_t)b * T + t0q) * 8 + tid];
    if (tid < QT) { LAS unsigned* st = (LAS unsigned*)(lds + ST_OFF + tid * 32); const int t = t0q + tid;
        unsigned z; asm volatile("v_mov_b32 %0, 0" : "=v"(z));
        st[0] = z; st[1] = z; st[2] = z + (unsigned)TOPK; st[3] = z; st[4] = z; st[5] = z; st[6] = (t + 1 <= TOPK) ? 1u : z; st[7] = z; }
    for (int i = tid; i < 32768 / 4; i += NTHREADS) ((LAS v4u*)(lds + HIST_OFF))[i] = (v4u){0u, 0u, 0u, 0u};
    bf16x8 qa[4][4];
    { const int qlr = 2 * ((r32 >> 2) & 1) + (r32 >> 4), hd = 4 * ((r32 >> 3) & 1) + (r32 & 3);
#pragma unroll
      for (int rb = 0; rb < 4; ++rb) { const bf16* qp = QI + ((size_t)b * T + t0q + 4 * rb + qlr) * 512 + hd * 64 + 8 * hi;
#pragma unroll
          for (int ks = 0; ks < 4; ++ks) qa[rb][ks] = *(const GAS bf16x8*)(qp + 16 * ks); } }
    const int nst = (t0q + QT + 31) >> 5;
    const bf16* KIb = KI + (size_t)b * T * 64;
    bool done = false;
    if (t0q >= 2048) {
        const int nfull_ = (t0q + 1) >> 5, nsamp = (nfull_ + 7) >> 3;
        if (tid < QT) { LAS unsigned* st = (LAS unsigned*)(lds + ST_OFF + tid * 32); const unsigned n = (unsigned)(t0q + tid + 1), ns = 32u * (unsigned)nsamp; st[2] = (512u * ns + n - 1u) / n; }
        __syncthreads();
        idx_pass<0, true, 0, 8>(qa, KIb, t0q, nsamp, wave, lane, lds, 0, 45, 33, 4095u);
        __syncthreads();
        find_bin(lds, 2 * wave, lane, 12); find_bin(lds, 2 * wave + 1, lane, 12);
        __syncthreads();
        idx_pass<3, true>(qa, KIb, t0q, nst, wave, lane, lds, 0, 0, 33, 0u);
        __syncthreads();
        bool bad = false;
#pragma unroll
        for (int r = 0; r < QT; ++r) { const unsigned c = ((LAS const unsigned*)(lds + ST_OFF + r * 32))[3] >> 16; bad = bad || c < (unsigned)TOPK || c > (unsigned)CAP; }
        __syncthreads();
        if (!bad) {
            if (tid < QT) { LAS unsigned* st = (LAS unsigned*)(lds + ST_OFF + tid * 32); st[0] = 0u; st[1] = 0u; st[2] = (unsigned)TOPK; }
            __syncthreads();
            { int lane_c; asm volatile("v_mbcnt_lo_u32_b32 %0, -1, 0\n\tv_mbcnt_hi_u32_b32 %0, -1, %0" : "=v"(lane_c));
              finish_row(lds, 2 * wave, lane_c, 45); finish_row(lds, 2 * wave + 1, lane_c, 45); }
            __syncthreads();
            done = true;
        } else {
            if (tid < QT) { LAS unsigned* st = (LAS unsigned*)(lds + ST_OFF + tid * 32); st[0] = 0u; st[1] = 0u; st[2] = (unsigned)TOPK; st[3] = 0u; st[4] = 0u; st[5] = 0u; }
            for (int i = tid; i < 32768 / 4; i += NTHREADS) ((LAS v4u*)(lds + HIST_OFF))[i] = (v4u){0u, 0u, 0u, 0u};
            __syncthreads();
        }
    }
    int level = 0, lo_shift = 33;
    if (!done) {
    for (;;) {
        const int hi_shift = 45 - 12 * level; lo_shift = (level == 3) ? 0 : 33 - 12 * level; const int bits = (level == 3) ? 9 : 12; const unsigned mask = (1u << bits) - 1u;
        if (level > 0) { for (int i = tid; i < 32768 / 4; i += NTHREADS) ((LAS v4u*)(lds + HIST_OFF))[i] = (v4u){0u, 0u, 0u, 0u}; }
        __syncthreads();
        if (MK_DUP & 512) {
            if (MK_DUP & 1024) idx_pass<0, true, 1>(qa, KIb, t0q, nst, wave, lane, lds, level, hi_shift, lo_shift, mask);
            else if (MK_DUP & 2048) idx_pass<0, true, 2>(qa, KIb, t0q, nst, wave, lane, lds, level, hi_shift, lo_shift, mask);
            else idx_pass<0, true>(qa, KIb, t0q, nst, wave, lane, lds, level, hi_shift, lo_shift, mask);
            __syncthreads();
            for (int i = tid; i < 32768 / 4; i += NTHREADS) ((LAS v4u*)(lds + HIST_OFF))[i] = (v4u){0u, 0u, 0u, 0u};
            __syncthreads();
        }
        if (level == 0) idx_pass<0, true>(qa, KIb, t0q, nst, wave, lane, lds, level, hi_shift, lo_shift, mask);
        else idx_pass<0, false>(qa, KIb, t0q, nst, wave, lane, lds, level, hi_shift, lo_shift, mask);
        __syncthreads();
        find_bin(lds, 2 * wave, lane, bits); find_bin(lds, 2 * wave + 1, lane, bits);
        __syncthreads();
        bool more = false;
        if (level < 3) {
#pragma unroll
            for (int r = 0; r < QT; ++r) { LAS const unsigned* st = (LAS const unsigned*)(lds + ST_OFF + r * 32); more = more || (st[6] == 0u && st[5] > (unsigned)CAP); }
        }
        if (!more) break;
        ++level;
    }
    __syncthreads();
    if (MK_DUP & 4096) { idx_pass<1, true>(qa, KIb, t0q, nst, wave, lane, lds, level, 0, lo_shift, 0u); __syncthreads(); if (tid < QT) ((LAS unsigned*)(lds + ST_OFF + tid * 32))[3] = 0u; __syncthreads(); }
    if (level == 0) idx_pass<1, true>(qa, KIb, t0q, nst, wave, lane, lds, level, 0, lo_shift, 0u);
    else idx_pass<1, false>(qa, KIb, t0q, nst, wave, lane, lds, level, 0, lo_shift, 0u);
    __syncthreads();
    finish_row(lds, 2 * wave, lane, lo_shift); finish_row(lds, 2 * wave + 1, lane, lo_shift);
    __syncthreads();
    }
#pragma unroll 1
    for (int rr = 0; rr < (MK_DUP & 256 ? 4 : 2); ++rr) sparse_attn_row8(lds, 2 * wave + (rr & 1), b, t0q + 2 * wave + (rr & 1), Q1, O1, K1, V1, wave, lane);
    __syncthreads();
}
}
#if defined(__HIP_DEVICE_COMPILE__)
typedef const __attribute__((address_space(4))) Ptrs* KArgs;
__device__ __forceinline__ const Ptrs* get_args() { KArgs p = (KArgs)__builtin_amdgcn_kernarg_segment_ptr(); asm volatile("" : "+s"(p)); return (const Ptrs*)p; }
#else
__device__ __forceinline__ const Ptrs* get_args() { return nullptr; }
#endif
#define DUP(bit, ...) do { if (MK_DUP & (1 << (bit))) { __VA_ARGS__; GRID_BAR(); } } while (0)
__global__ void __launch_bounds__(NTHREADS, 2) hybrid_fwd(Ptrs Pbyval) {
    extern __shared__ __attribute__((aligned(16))) unsigned char lds_raw[];
    LAS unsigned char* lds = (LAS unsigned char*)lds_raw;
    volatile LAS unsigned* MISC = (volatile LAS unsigned*)(lds + MISC_OFF);
    const int tid0 = threadIdx.x; const int wave_s = __builtin_amdgcn_readfirstlane(tid0 >> 6);
#define FRESH_IDS() const Ptrs P = *get_args(); unsigned char* ws = P.ws; gu32* ctl = (gu32*)(ws + WS_CTL); float* MOD = (float*)(ws + WS_MOD); bf16* Hb = (bf16*)(ws + WS_H); (void)ctl; (void)MOD; (void)Hb; int tid; asm volatile("v_mbcnt_lo_u32_b32 %0, -1, 0\n\tv_mbcnt_hi_u32_b32 %0, -1, %0\n\tv_lshl_or_b32 %0, %1, 6, %0" : "=&v"(tid) : "s"(wave_s)); const int lane = tid & 63; const int wave = __builtin_amdgcn_readfirstlane(tid >> 6); (void)lane; (void)wave
    const int G = gridDim.x; const int bx = blockIdx.x; const int vcu = (G % 8 == 0) ? (bx % 8) * (G / 8) + bx / 8 : bx;
    for (int u = tid0; u < (LDS_BYTES - LDSCTL_OFF) / 4; u += NTHREADS) ((LAS unsigned*)(lds + LDSCTL_OFF))[u] = 0u;
    __syncthreads();
    XcdBarrier bar = xcd_barrier_post((unsigned*)((gu32*)(Pbyval.ws + WS_CTL) + CW_BAR), MISC + 8);
#define GRID_BAR() xcd_barrier(bar)

#define PH_PROLOGUE() do { FRESH_IDS(); p0_prologue(P, lds, tid, lane, wave, vcu, G); } while (0)
#define PH_NORM1_L0() do { FRESH_IDS(); norm_phase<true, false, 1>(P.x, P.g_mix, MOD, 0, 1, Hb, (unsigned char*)Hb, P.fox_w_in, P.fox_b_f, (float*)(ws + WS_LOGF), lds, tid, lane, wave, vcu, G); } while (0)
#define PH_NORM1_L1() do { FRESH_IDS(); norm_phase<false, true, 2>((const bf16*)(ws + WS_XB), P.g_mix + D, MOD + (size_t)2 * 6144, 0, 1, Hb, ws + WS_H8, nullptr, nullptr, nullptr, lds, tid, lane, wave, vcu, G); } while (0)
#define PH_NORM2(layer) do { FRESH_IDS(); norm_phase<false, true, 1>((const bf16*)(ws + WS_XB), P.g_ffn + layer * D, MOD + (size_t)layer * 2 * 6144, 3, 4, Hb, (unsigned char*)Hb, nullptr, nullptr, nullptr, lds, tid, lane, wave, vcu, G); } while (0)
#define PH_QKV() do { \
        { FRESH_IDS(); for (int seq = bx; seq < 32; seq += G) fox_scan((const float*)(ws + WS_LOGF), (float*)(ws + WS_BETA), ws + WS_KE, seq, (LAS float*)(lds + RING_OFF), tid, lane, wave); } \
        { FRESH_IDS(); \
            pg8::Gemm g{Hb, (const bf16*)(ws + WS_WFIN), M, 3 * D, D / 2, D / 2, D / 2, 0x7f7f7f7f, 0x7a7a7a7a}; pg8::StaticOrder S; S.init(M, 3 * D, G, bx, ORD_QKV); \
            pg8::EpiHeads E{}; E.ntens = 3; \
            E.base[0] = (bf16*)(ws + WS_Q); E.tile0[0] = 0; E.ldc[0] = D; E.kind[0] = 1; E.gain[0] = P.fox_g_q; E.scale[0] = attn_body::C2; \
            E.base[1] = (bf16*)(ws + WS_K); E.tile0[1] = 4; E.ldc[1] = D; E.kind[1] = 1; E.gain[1] = P.fox_g_k; E.scale[1] = 1.f; \
            E.base[2] = (bf16*)(ws + WS_V); E.tile0[2] = 8; E.ldc[2] = D; E.kind[2] = 0; E.gain[2] = P.fox_g_k; E.scale[2] = 1.f; \
            E.base[3] = E.base[2]; E.tile0[3] = 1 << 30; E.ldc[3] = D; E.kind[3] = 0; E.gain[3] = P.fox_g_k; E.scale[3] = 1.f; \
            pg8::gemm_phase<pg8::EpiHeads, pg8::StaticOrder, true, true, true>(lds + RING_OFF, g, S, E, tid); } } while (0)
#define PH_FOXATTN(qword) do { FRESH_IDS(); \
            float qkmax; \
            { const float gq = wave_max(fabsf(P.fox_g_q[lane])), gk = wave_max(fabsf(P.fox_g_k[lane])); qkmax = 64.f * attn_body::C2 * gq * gk * 1.02f + 0.5f; } \
            for (;;) { \
                if (tid == 0) MISC[16] = __hip_atomic_fetch_add(ctl + (qword), 1u, RLX_AGENT); \
                __syncthreads(); \
                const int id = (int)MISC[16]; \
                __syncthreads(); \
                if (id >= 32 * 32) break; \
                const int qb = 31 - (id >> 5), bh = id & 31; \
                attn_body::attn_unit<8>(bh >> 4, bh & 15, qb, (const attn_body::bf16*)(ws + WS_Q), (const attn_body::bf16*)(ws + WS_K), (const attn_body::bf16*)(ws + WS_V), \
                                        (attn_body::bf16*)(ws + WS_O), (const attn_body::bf16*)(ws + WS_KE), (const float*)(ws + WS_BETA), qkmax, (char*)lds_raw + RING_OFF, tid); \
            } } while (0)
#define PH_OUTPROJ(layer, OBUF, WBUF) do { FRESH_IDS(); \
            pg8::Gemm g{(const bf16*)(ws + (OBUF)), (const bf16*)(ws + (WBUF)), M, D, D / 2, D / 2, D / 2, 0x7a7a7a7a, 0x7a7a7a7a}; pg8::StaticOrder S; S.init(M, D, G, bx); \
              \
            if (layer == 0) { if (S.nwg <= G) { pg8::EpiResNormStaged<false, 1> E{P.x, ws + WS_XB, MOD + 2 * D, 6144, T, P.g_ffn, MOD, 3, 4, Hb, (unsigned char*)Hb, (float*)(ws + WS_XS), (unsigned*)(ctl + CW_NS), lds + HALO_OFF}; \
                    pg8::gemm_phase<pg8::EpiResNormStaged<false, 1>, pg8::StaticOrder, true, true, true>(lds + RING_OFF, g, S, E, tid); } \
                else { pg8::EpiRes<false, true> E{P.x, ws + WS_XB, MOD + 2 * D, 6144, T}; pg8::gemm_phase<pg8::EpiRes<false, true>, pg8::StaticOrder, true, true, true>(lds + RING_OFF, g, S, E, tid); } } \
            else { if (S.nwg <= G) { pg8::EpiResNormStaged<true, 1> E{ws + WS_XB, ws + WS_XB, MOD + (size_t)2 * 6144 + 2 * D, 6144, T, P.g_ffn + D, MOD + (size_t)2 * 6144, 3, 4, Hb, (unsigned char*)Hb, (float*)(ws + WS_XS) + (size_t)2 * M * 4, (unsigned*)(ctl + CW_NS + 2048), lds + HALO_OFF}; \
                    pg8::gemm_phase<pg8::EpiResNormStaged<true, 1>, pg8::StaticOrder, true, true, true>(lds + RING_OFF, g, S, E, tid); } \
                else { pg8::EpiRes<true, true> E{ws + WS_XB, ws + WS_XB, MOD + (size_t)2 * 6144 + 2 * D, 6144, T}; pg8::gemm_phase<pg8::EpiRes<true, true>, pg8::StaticOrder, true, true, true>(lds + RING_OFF, g, S, E, tid); } } } while (0)
#define PH_UP(layer) do { FRESH_IDS(); \
            pg8::Gemm g{Hb, (const bf16*)(ws + (layer == 0 ? WS_WUP0 : WS_WUP1)), M, FF2, D / 2, D / 2, D / 2, 0x7f7f7f7f, 0x7a7a7a7a}; pg8::StaticOrder S; S.init(M, FF2, G, (G % 16 == 0) ? (bx % 8) + 8 * ((((bx / 8) & 1) * (G / 16)) + ((bx / 8) >> 1)) : bx, ORD_UP);   \
            pg8::EpiConvGate E{(bf16*)(ws + WS_U), P.ffn_conv_w + (size_t)layer * 3 * FF, P.ffn_conv_b + (size_t)layer * FF, (float*)(ws + WS_SA0), (float*)(ws + WS_SG0), (float*)(ws + WS_SA1), (LAS float*)(lds + HALO_OFF), lds + RING_OFF + 3 * 16384  }; \
            pg8::gemm_phase<pg8::EpiConvGate, pg8::StaticOrder, true, true, true>(lds + RING_OFF, g, S, E, tid); } while (0)
#define PH_DOWN(layer) do { FRESH_IDS(); \
            pg8::Gemm g{(const bf16*)(ws + WS_U), (const bf16*)(ws + (layer == 0 ? WS_WDN0 : WS_WDN1)), M, D, FF / 2, FF / 2, FF / 2, 0x7f7f7f7f, 0x79797979}; pg8::StaticOrder S; S.init(M, D, G, bx); \
            { pg8::Unit u0; for (int i_ = 0; S.next(i_, u0); ++i_) conv_fixup((bf16*)(ws + WS_U), (const float*)(ws + WS_SA0), (const float*)(ws + WS_SG0), (const float*)(ws + WS_SA1), P.ffn_conv_w + (size_t)layer * 3 * FF, P.ffn_conv_b + (size_t)layer * FF, u0.pm, tid); } \
            if (layer == 0) { if (S.nwg <= G) { pg8::EpiResNormStaged<true, 2> E{ws + WS_XB, ws + WS_XB, MOD + 5 * D, 6144, T, P.g_mix + D, MOD + (size_t)2 * 6144, 0, 1, Hb, ws + WS_H8, (float*)(ws + WS_XS) + (size_t)M * 4, (unsigned*)(ctl + CW_NS + 1024), lds + HALO_OFF}; \
                    pg8::gemm_phase<pg8::EpiResNormStaged<true, 2>, pg8::StaticOrder, true, true, true>(lds + RING_OFF, g, S, E, tid); } \
                else { pg8::EpiRes<true, true> E{ws + WS_XB, ws + WS_XB, MOD + 5 * D, 6144, T}; pg8::gemm_phase<pg8::EpiRes<true, true>, pg8::StaticOrder, true, true, true>(lds + RING_OFF, g, S, E, tid); } } \
            else { if (S.nwg <= G) { pg8::EpiResStaged<true, false> E{ws + WS_XB, P.out, MOD + (size_t)2 * 6144 + 5 * D, 6144, T}; pg8::gemm_phase<pg8::EpiResStaged<true, false>, pg8::StaticOrder, true, true, true>(lds + RING_OFF, g, S, E, tid); } \
                else { pg8::EpiRes<true, false> E{ws + WS_XB, P.out, MOD + (size_t)2 * 6144 + 5 * D, 6144, T}; pg8::gemm_phase<pg8::EpiRes<true, false>, pg8::StaticOrder, true, true, true>(lds + RING_OFF, g, S, E, tid); } } } while (0)
#define PH_DSAIN() do { FRESH_IDS(); \
              \
            if (G % 16 != 0) dsa::tail_phase(Hb, (const bf16*)(ws + WS_WDTAIL), P.dsa_g_kidx, (bf16*)(ws + WS_KI), (float*)(ws + WS_WI), lane, vcu * NWAVES + wave, G * NWAVES); \
            else if (bx < G / 2) dsa::tail_phase(Hb, (const bf16*)(ws + WS_WDTAIL), P.dsa_g_kidx, (bf16*)(ws + WS_KI), (float*)(ws + WS_WI), lane, bx * NWAVES + wave, (G / 2) * NWAVES); \
              \
            { pg8::Gemm g{(const bf16*)(ws + WS_H8), (const bf16*)(ws + WS_WDIN), M, 3 * D / 2, D / 2, D / 2, D / 2, 0x7f7f7f7f, 0x7a7a7a7a}; pg8::StaticOrder S; S.init(M, 3 * D / 2, G, bx, ORD_DIN); \
              pg8::EpiHeads E{}; E.ntens = 3; \
              E.base[0] = (bf16*)(ws + WS_Q1); E.tile0[0] = 0; E.ldc[0] = D; E.kind[0] = 1; E.gain[0] = P.dsa_g_q; E.scale[0] = attn_body::C2; \
              E.base[1] = (bf16*)(ws + WS_K1); E.tile0[1] = 4; E.ldc[1] = 256; E.kind[1] = 1; E.gain[1] = P.dsa_g_k; E.scale[1] = 1.f; E.f8[1] = 1; \
              E.base[2] = (bf16*)(ws + WS_V1); E.tile0[2] = 5; E.ldc[2] = 256; E.kind[2] = 0; E.gain[2] = P.dsa_g_k; E.scale[2] = 1.f; E.f8[2] = 1; \
              E.base[3] = E.base[2]; E.tile0[3] = 1 << 30; E.ldc[3] = 256; E.kind[3] = 0; E.gain[3] = P.dsa_g_k; E.scale[3] = 1.f; \
              pg8::gemm_phase<pg8::EpiHeads, pg8::StaticOrder, true, true, true>(lds + RING_OFF, g, S, E, tid); } \
            { FRESH_IDS(); pg8::Gemm g{Hb, (const bf16*)(ws + WS_WDIN + 2 * MiB), M, D / 2, D, D, D, 0, 0}; pg8::StaticOrder S; S.init(M, D / 2, G, (G % 16 == 0) ? (bx + G / 2) % G : bx, ORD_QI); \
              pg8::EpiHeads E{}; E.ntens = 1; \
              E.base[0] = (bf16*)(ws + WS_QI); E.tile0[0] = 0; E.ldc[0] = 512; E.kind[0] = 0; E.gain[0] = P.dsa_g_k; E.scale[0] = 1.f; \
              for (int i_ = 1; i_ < 4; ++i_) { E.base[i_] = E.base[0]; E.tile0[i_] = 1 << 30; E.ldc[i_] = 512; E.kind[i_] = 0; E.gain[i_] = P.dsa_g_k; E.scale[i_] = 1.f; } \
              pg8::gemm_phase<pg8::EpiHeads, pg8::StaticOrder, true, true>(lds + RING_OFF, g, S, E, tid); } } while (0)
#define PH_DSAUNITS(qword) do { FRESH_IDS(); \
            int qb_ = (bx & 1), tries_ = 0;      \
            for (;;) { \
                if (tid == 0) MISC[16] = __hip_atomic_fetch_add(ctl + (qword) + 64 * qb_, 1u, RLX_AGENT); \
                __syncthreads(); \
                const int id = (int)MISC[16]; \
                __syncthreads(); \
                if (id >= T / dsa::QT) { if (++tries_ >= 2) break; qb_ ^= 1; continue; } \
                const int b = qb_, t0q = (T / dsa::QT - 1 - id) * dsa::QT; \
                dsa::unit(lds, b, t0q, (const bf16*)(ws + WS_Q1), (bf16*)(ws + WS_O1), (const unsigned char*)(ws + WS_K1), (const unsigned char*)(ws + WS_V1), (const bf16*)(ws + WS_QI), (const bf16*)(ws + WS_KI), (const float*)(ws + WS_WI), tid, wave); \
            } } while (0)

    const bool fusedn = (M / 256) * (D / 256) <= G;
    PH_PROLOGUE(); GRID_BAR();                       DUP(0, PH_PROLOGUE());
    PH_NORM1_L0(); GRID_BAR();                       DUP(1, PH_NORM1_L0());
    PH_QKV(); GRID_BAR();                            DUP(2, PH_QKV());
    PH_FOXATTN(CW_AQ); GRID_BAR();                   DUP(3, PH_FOXATTN(CW_AQ + 64));
    PH_OUTPROJ(0, WS_O, WS_WFOUT); GRID_BAR();       DUP(10, PH_OUTPROJ(0, WS_O, WS_WFOUT));
    if (!fusedn) { PH_NORM2(0); GRID_BAR(); }
    PH_UP(0); GRID_BAR();                            DUP(5, PH_UP(0));
    PH_DOWN(0); GRID_BAR();
    if (!fusedn) { PH_NORM1_L1(); GRID_BAR(); }
    PH_DSAIN(); GRID_BAR();                          DUP(6, PH_DSAIN());
    PH_DSAUNITS(CW_DQ); GRID_BAR();                  DUP(7, PH_DSAUNITS(CW_DQ + 128));
    PH_OUTPROJ(1, WS_O1, WS_WDOUT); GRID_BAR();
    if (!fusedn) { PH_NORM2(1); GRID_BAR(); }
    PH_UP(1); GRID_BAR();
    PH_DOWN(1);
    if (MK_DUP & 512) { GRID_BAR(); PH_DOWN(1); }
}

extern "C" void kernel_launch(void* const* d_in, const int* in_sizes, int n_in, void* d_out, int out_size, void* d_ws, size_t ws_size, hipStream_t stream) {
    static int grid = 0;
    if (grid == 0) {
        if (n_in != 20 || in_sizes[0] != M * D || out_size != M * D || ws_size < WS_END) { fprintf(stderr, "kernel_launch: unexpected problem (n_in %d, in0 %d, out %d, ws %zu); nothing launched\n", n_in, n_in > 0 ? in_sizes[0] : -1, out_size, ws_size); grid = -1; return; }
        int dev = 0, cus = 0, per_cu = 0;
        if (hipGetDevice(&dev) != hipSuccess || hipDeviceGetAttribute(&cus, hipDeviceAttributeMultiprocessorCount, dev) != hipSuccess) { grid = -1; return; }
        if (hipFuncSetAttribute((const void*)hybrid_fwd, hipFuncAttributeMaxDynamicSharedMemorySize, LDS_BYTES) != hipSuccess) { fprintf(stderr, "kernel_launch: hipFuncSetAttribute failed\n"); grid = -1; return; }
        if (hipOccupancyMaxActiveBlocksPerMultiprocessor(&per_cu, (const void*)hybrid_fwd, NTHREADS, LDS_BYTES) != hipSuccess || per_cu < 1)
            fprintf(stderr, "kernel_launch: note: occupancy query reports %d workgroups per CU\n", per_cu);
        (void)hipGetLastError();
        grid = cus;
    }
    if (grid < 0) return;
    if (hipMemsetAsync((char*)d_ws + WS_CTL, 0, CTL_ZERO_BYTES, stream) != hipSuccess) return;
    Ptrs p{};
    p.x = (const float*)d_in[0]; p.c = (const float*)d_in[1]; p.w_ada = (const float*)d_in[2]; p.b_ada = (const float*)d_in[3]; p.g_mix = (const float*)d_in[4]; p.g_ffn = (const float*)d_in[5];
    p.fox_w_in = (const float*)d_in[6]; p.fox_b_f = (const float*)d_in[7]; p.fox_g_q = (const float*)d_in[8]; p.fox_g_k = (const float*)d_in[9]; p.fox_w_out = (const float*)d_in[10];
    p.dsa_w_in = (const float*)d_in[11]; p.dsa_g_q = (const float*)d_in[12]; p.dsa_g_k = (const float*)d_in[13]; p.dsa_g_kidx = (const float*)d_in[14]; p.dsa_w_out = (const float*)d_in[15];
    p.ffn_w_up = (const float*)d_in[16]; p.ffn_conv_w = (const float*)d_in[17]; p.ffn_conv_b = (const float*)d_in[18]; p.ffn_w_down = (const float*)d_in[19];
    p.out = (float*)d_out; p.ws = (unsigned char*)d_ws;
    hipLaunchKernelGGL(hybrid_fwd, dim3(grid), dim3(NTHREADS), LDS_BYTES, stream, p);
}
```

```cpp
#include <hip/hip_runtime.h>
#include <cstdio>
#include <cstdint>
__device__ __forceinline__ float xsum16(float v) { const unsigned a = __builtin_bit_cast(unsigned, v); const auto r = __builtin_amdgcn_permlane16_swap(a, a, false, false); const unsigned r0 = r[0], r1 = r[1]; return __builtin_bit_cast(float, r0) + __builtin_bit_cast(float, r1); }
__device__ __forceinline__ float xsum32(float v) { const unsigned a = __builtin_bit_cast(unsigned, v); const auto r = __builtin_amdgcn_permlane32_swap(a, a, false, false); const unsigned r0 = r[0], r1 = r[1]; return __builtin_bit_cast(float, r0) + __builtin_bit_cast(float, r1); }
__device__ __forceinline__ float xmax16(float v) { const unsigned a = __builtin_bit_cast(unsigned, v); const auto r = __builtin_amdgcn_permlane16_swap(a, a, false, false); const unsigned r0 = r[0], r1 = r[1]; return fmaxf(__builtin_bit_cast(float, r0), __builtin_bit_cast(float, r1)); }
__device__ __forceinline__ float xmax32(float v) { const unsigned a = __builtin_bit_cast(unsigned, v); const auto r = __builtin_amdgcn_permlane32_swap(a, a, false, false); const unsigned r0 = r[0], r1 = r[1]; return fmaxf(__builtin_bit_cast(float, r0), __builtin_bit_cast(float, r1)); }
template <int CTRL> __device__ __forceinline__ float dppf(float v) { return __builtin_bit_cast(float, __builtin_amdgcn_update_dpp(0, __builtin_bit_cast(int, v), CTRL, 0xf, 0xf, true)); }
namespace pg8 {
#define PG8_LAS __attribute__((address_space(3)))
typedef unsigned short bf16_t;
typedef short bf16x8 __attribute__((ext_vector_type(8)));
typedef float f32x4 __attribute__((ext_vector_type(4)));
typedef unsigned u32x4 __attribute__((ext_vector_type(4)));
typedef int pg8_v8i __attribute__((ext_vector_type(8)));
typedef short pg8_bf16x16 __attribute__((ext_vector_type(16)));
constexpr int BM = 256, BK = 64, HALF = 128, HTB = HALF * BK * 2  , STAGE_BYTES = 8 * HTB, NXCD = 8, WGM = 4;

__host__ __device__ __forceinline__ int lds_byte(int r, int c) { const int st = (r >> 4) * 2 + (c >> 5), rr = r & 15, cc = c & 31, ob = rr * 64 + cc * 2; return st * 1024 + (ob ^ (((ob >> 9) & 1) << 5)); }
__host__ __device__ __forceinline__ void stage_rc(int b, int& R, int& C) { const int st = b / 1024, sb = b % 1024, swz = sb ^ (((sb >> 9) & 1) << 5); R = (st >> 1) * 16 + swz / 64; C = (st & 1) * 32 + (swz % 64) / 2; }
__host__ __device__ __forceinline__ int perm32(int rho) { const int n = rho >> 4, i = rho & 15; return 8 * (i >> 2) + 4 * n + (i & 3); }

struct Unit { int pm, pn; };
struct Gemm { const bf16_t* A; const bf16_t* Bt; int M, N, K, lda, ldb; int sa, sb; };

struct StaticOrder {
    int nM, nN, nwg, G, c, wgm, rot;
    __host__ __device__ void init(int M, int N, int G_, int c_, int wgm_ = WGM, int rot_ = 3) { nM = M / BM; nN = N / BM; nwg = nM * nN; G = G_; c = c_; wgm = wgm_; rot = rot_; }
    __host__ __device__ __forceinline__ bool next(int i, Unit& u) const {
        const long L = (long)i * G + c; if (L >= nwg) return false;
        int wgid = (int)L; { const int q = nwg / NXCD, r = nwg % NXCD, xcd = wgid % NXCD, off = wgid / NXCD; wgid = (xcd < r ? xcd * (q + 1) : r * (q + 1) + (xcd - r) * q) + off; }
        const int nig = wgm * nN, gid = wgid / nig, fm = gid * wgm, gsz = (nM - fm) < wgm ? (nM - fm) : wgm;
        u.pm = fm + ((wgid % nig) % gsz); u.pn = ((wgid % nig) / gsz + rot * (int)(L % NXCD)) % nN; return true;
    }
    __device__ __forceinline__ void a_ready(const Unit&) const {}
    __device__ __forceinline__ void done(const Unit&) const {}
};

__device__ __forceinline__ unsigned cvt_pk_bf16(float lo, float hi) { unsigned r; asm volatile("v_cvt_pk_bf16_f32 %0, %1, %2" : "=v"(r) : "v"(lo), "v"(hi)); return r; }
typedef float f32x2 __attribute__((ext_vector_type(2)));
struct EpiBf16 {
    static constexpr bool PERM = true, AFTER_DRAIN = false;
    bf16_t* O; int ldc;
    __device__ __forceinline__ void operator()(const f32x4 (&acc)[2][2][4][2], const Unit& u, int wr, int wc, int fr, int fq) const {
        const int row0 = u.pm * BM + wr * 64 + fr; const int col0 = u.pn * BM + wc * 32 + 8 * fq;
#pragma unroll
        for (int ai = 0; ai < 2; ++ai)
#pragma unroll
            for (int m = 0; m < 4; ++m) { bf16_t* rowp = O + (size_t)(row0 + ai * HALF + m * 16) * ldc + col0;
#pragma unroll
                for (int bj = 0; bj < 2; ++bj) { const f32x4 v0 = acc[ai][bj][m][0], v1 = acc[ai][bj][m][1];
                    u32x4 w; w.x = cvt_pk_bf16(v0[0], v0[1]); w.y = cvt_pk_bf16(v0[2], v0[3]); w.z = cvt_pk_bf16(v1[0], v1[1]); w.w = cvt_pk_bf16(v1[2], v1[3]);
                    *(u32x4*)(rowp + bj * HALF) = w; } }
    }
};
struct EpiHeads {
    static constexpr bool PERM = true, AFTER_DRAIN = false;
    bf16_t* base[4]; int tile0[4]; int ldc[4]; int kind[4]; const float* gain[4]; float scale[4]; int f8[4];
    int ntens;
    __device__ __forceinline__ void operator()(const f32x4 (&acc)[2][2][4][2], const Unit& u, int wr, int wc, int fr, int fq) const {
        bf16_t* O = base[0]; int t0 = tile0[0], ld = ldc[0], kd = kind[0], o8 = f8[0]; const float* gn = gain[0]; float sc = scale[0];
#pragma unroll
        for (int i = 1; i < 4; ++i) if (i < ntens && u.pn >= tile0[i]) { O = base[i]; t0 = tile0[i]; ld = ldc[i]; kd = kind[i]; gn = gain[i]; sc = scale[i]; o8 = f8[i]; }
        const int head = (u.pn - t0) * 4 + wc; const int row0 = u.pm * BM + wr * 64 + fr;
        f32x4 gv[2][2];
#pragma unroll
        for (int bj = 0; bj < 2; ++bj)
#pragma unroll
            for (int n = 0; n < 2; ++n) gv[bj][n] = (kd == 1) ? *(const f32x4*)(gn + 32 * bj + 8 * fq + 4 * n) * sc : (f32x4){sc, sc, sc, sc};
#pragma unroll
        for (int ai = 0; ai < 2; ++ai)
#pragma unroll
            for (int m = 0; m < 4; ++m) {
                float rs = 1.f;
                if (kd == 1) { float ss = 0.f;
#pragma unroll
                    for (int bj = 0; bj < 2; ++bj)
#pragma unroll
                        for (int n = 0; n < 2; ++n) { const f32x4 x = acc[ai][bj][m][n]; ss += (x[0] * x[0] + x[1] * x[1]) + (x[2] * x[2] + x[3] * x[3]); }
                    ss = xsum32(xsum16(ss));
                    rs = __builtin_amdgcn_rsqf(ss * (1.0f / 64.0f) + 1e-6f); }
                if (o8) {
                    unsigned char* rowb = (unsigned char*)O + (size_t)(row0 + ai * HALF + m * 16) * ld + head * 64 + 8 * fq;
#pragma unroll
                    for (int bj = 0; bj < 2; ++bj) { const f32x4 v0 = acc[ai][bj][m][0] * rs * gv[bj][0], v1 = acc[ai][bj][m][1] * rs * gv[bj][1];
                        int w0 = 0, w1 = 0; w0 = __builtin_amdgcn_cvt_pk_fp8_f32(v0[0], v0[1], w0, false); w0 = __builtin_amdgcn_cvt_pk_fp8_f32(v0[2], v0[3], w0, true);
                        w1 = __builtin_amdgcn_cvt_pk_fp8_f32(v1[0], v1[1], w1, false); w1 = __builtin_amdgcn_cvt_pk_fp8_f32(v1[2], v1[3], w1, true);
                        typedef unsigned u32x2 __attribute__((ext_vector_type(2))); *(u32x2*)(rowb + bj * 32) = (u32x2){(unsigned)w0, (unsigned)w1}; }
                } else {
                bf16_t* rowp = O + (size_t)(row0 + ai * HALF + m * 16) * ld + head * 64 + 8 * fq;
#pragma unroll
                for (int bj = 0; bj < 2; ++bj) { const f32x4 v0 = acc[ai][bj][m][0] * rs * gv[bj][0], v1 = acc[ai][bj][m][1] * rs * gv[bj][1];
                    u32x4 w; w.x = cvt_pk_bf16(v0[0], v0[1]); w.y = cvt_pk_bf16(v0[2], v0[3]); w.z = cvt_pk_bf16(v1[0], v1[1]); w.w = cvt_pk_bf16(v1[2], v1[3]);
                    *(u32x4*)(rowp + bj * 32) = w; } } }
    }
};
template <bool BIN16, bool BOUT16>
struct EpiRes {
    static constexpr bool PERM = false, AFTER_DRAIN = false;
    const void* base; void* out; const float* gate; int gate_bstride; int rows_per_batch;
    __device__ __forceinline__ void operator()(const f32x4 (&acc)[2][2][4][2], const Unit& u, int wr, int wc, int fr, int fq) const {
        typedef unsigned u32x2 __attribute__((ext_vector_type(2)));
        const int col0 = u.pn * BM + wc * 32 + 4 * fq; const int b = (u.pm * BM) / rows_per_batch;
        f32x4 gv[2][2];
#pragma unroll
        for (int bj = 0; bj < 2; ++bj)
#pragma unroll
            for (int n = 0; n < 2; ++n) gv[bj][n] = *(const f32x4*)(gate + (size_t)b * gate_bstride + col0 + bj * HALF + n * 16);
#pragma unroll
        for (int ai = 0; ai < 2; ++ai)
#pragma unroll
            for (int m = 0; m < 4; ++m) { const size_t off = (size_t)(u.pm * BM + ai * HALF + wr * 64 + m * 16 + fr) * 1024 + col0;
#pragma unroll
                for (int bj = 0; bj < 2; ++bj)
#pragma unroll
                    for (int n = 0; n < 2; ++n) { const size_t o2 = off + bj * HALF + n * 16; f32x4 bs;
                        if (BIN16) { const u32x2 r = *(const u32x2*)((const bf16_t*)base + o2); bs = (f32x4){__uint_as_float(r.x << 16), __uint_as_float(r.x & 0xffff0000u), __uint_as_float(r.y << 16), __uint_as_float(r.y & 0xffff0000u)}; }
                        else bs = *(const f32x4*)((const float*)base + o2);
                        const f32x4 v = bs + gv[bj][n] * acc[ai][bj][m][n];
                        if (BOUT16) *(u32x2*)((bf16_t*)out + o2) = (u32x2){cvt_pk_bf16(v[0], v[1]), cvt_pk_bf16(v[2], v[3])};
                        else *(f32x4*)((float*)out + o2) = v; }
                if (m & 1) asm volatile("" ::: "memory"); }
    }
};
template <bool BIN16, bool BOUT16>
struct EpiResStaged {
    static constexpr bool PERM = false, AFTER_DRAIN = true;
    const void* base; void* out; const float* gate; int gate_bstride; int rows_per_batch;
    __device__ __forceinline__ void operator()(const f32x4 (&)[2][2][4][2], const Unit&, int, int, int, int) const {}
    __device__ __forceinline__ void fused(const f32x4 (&acc)[2][2][4][2], const Unit& u, int wr, int wc, int fr_in, int fq_in, PG8_LAS unsigned char* img, int wid, int lane_in) const {
        int fr = fr_in, fq = fq_in, lane = lane_in; asm volatile("" : "+v"(fr), "+v"(fq), "+v"(lane));
        const int col0 = u.pn * BM + wc * 32 + 4 * fq; const int b = (u.pm * BM) / rows_per_batch;
        f32x4 gv[2][2];
#pragma unroll
        for (int bj = 0; bj < 2; ++bj)
#pragma unroll
            for (int n = 0; n < 2; ++n) gv[bj][n] = *(const f32x4*)(gate + (size_t)b * gate_bstride + col0 + bj * HALF + n * 16);
#pragma unroll
        for (int ai = 0; ai < 2; ++ai) {
            u32x4 bs16[8]; f32x4 bs32[BIN16 ? 1 : 8][2];
#pragma unroll
            for (int rnd = 0; rnd < 8; ++rnd) { const int q = rnd * 512 + wid * 64 + lane, row = q >> 5, c8 = q & 31; const size_t o = (size_t)(u.pm * BM + ai * HALF + row) * 1024 + u.pn * BM + 8 * c8;
                if constexpr (BIN16) bs16[rnd] = *(const u32x4*)((const bf16_t*)base + o);
                else { bs32[rnd][0] = *(const f32x4*)((const float*)base + o); bs32[rnd][1] = *(const f32x4*)((const float*)base + o + 4); } }
#pragma unroll
            for (int bj = 0; bj < 2; ++bj)
#pragma unroll
                for (int m = 0; m < 4; ++m)
#pragma unroll
                    for (int n = 0; n < 2; ++n) { const int hrow = wr * 64 + m * 16 + fr, chunk = (bj * HALF + wc * 32 + n * 16 + 4 * fq) >> 2;
                        *(PG8_LAS f32x4*)(img + hrow * 1024 + ((chunk ^ ((hrow & 15) << 2)) << 4)) = gv[bj][n] * acc[ai][bj][m][n]; }
            asm volatile("s_waitcnt lgkmcnt(0)" ::: "memory"); __builtin_amdgcn_s_barrier(); asm volatile("" ::: "memory");
#pragma unroll
            for (int rnd = 0; rnd < 8; ++rnd) { const int q = rnd * 512 + wid * 64 + lane, row = q >> 5, c8 = q & 31; const size_t o = (size_t)(u.pm * BM + ai * HALF + row) * 1024 + u.pn * BM + 8 * c8;
                const PG8_LAS unsigned char* ip = img + row * 1024 + (((2 * c8) ^ ((row & 15) << 2)) << 4);
                const f32x4 g0 = *(const PG8_LAS f32x4*)ip, g1 = *(const PG8_LAS f32x4*)(ip + 16);
                f32x4 b0, b1;
                if constexpr (BIN16) { const u32x4 r = bs16[rnd];
                    b0 = (f32x4){__uint_as_float(r.x << 16), __uint_as_float(r.x & 0xffff0000u), __uint_as_float(r.y << 16), __uint_as_float(r.y & 0xffff0000u)};
                    b1 = (f32x4){__uint_as_float(r.z << 16), __uint_as_float(r.z & 0xffff0000u), __uint_as_float(r.w << 16), __uint_as_float(r.w & 0xffff0000u)}; }
                else { b0 = bs32[rnd][0]; b1 = bs32[rnd][1]; }
                const f32x4 v0 = b0 + g0, v1 = b1 + g1;
                if constexpr (BOUT16) *(u32x4*)((bf16_t*)out + o) = (u32x4){cvt_pk_bf16(v0[0], v0[1]), cvt_pk_bf16(v0[2], v0[3]), cvt_pk_bf16(v1[0], v1[1]), cvt_pk_bf16(v1[2], v1[3])};
                else { *(f32x4*)((float*)out + o) = v0; *(f32x4*)((float*)out + o + 4) = v1; } }
            if (ai == 0) { asm volatile("s_waitcnt lgkmcnt(0)" ::: "memory"); __builtin_amdgcn_s_barrier(); asm volatile("" ::: "memory"); }
        }
    }
};
template <bool BIN16, int HMODE>
struct EpiResNormStaged {
    static constexpr bool PERM = false, AFTER_DRAIN = true;
    const void* base; void* out; const float* gate; int gate_bstride; int rows_per_batch;
    const float* gnorm; const float* modL; int sh_chunk, sc_chunk; bf16_t* hout; unsigned char* hout8; float* xslots; unsigned* cnt; PG8_LAS unsigned char* tbl;
    __device__ __forceinline__ void operator()(const f32x4 (&)[2][2][4][2], const Unit&, int, int, int, int) const {}
    __device__ __forceinline__ void fused(const f32x4 (&acc)[2][2][4][2], const Unit& u, int wr, int wc, int fr_in, int fq_in, PG8_LAS unsigned char* img, int wid, int lane_in) const {
        int fr = fr_in, fq = fq_in, lane = lane_in; asm volatile("" : "+v"(fr), "+v"(fq), "+v"(lane));
        const int col0 = u.pn * BM + wc * 32 + 4 * fq; const int b = (u.pm * BM) / rows_per_batch;
        PG8_LAS float* Pt = (PG8_LAS float*)tbl; PG8_LAS float* St = (PG8_LAS float*)(tbl + 1024); PG8_LAS unsigned* flag = (PG8_LAS unsigned*)(tbl + 2048);
        f32x4 gv[2][2];
#pragma unroll
        for (int bj = 0; bj < 2; ++bj)
#pragma unroll
            for (int n = 0; n < 2; ++n) gv[bj][n] = *(const f32x4*)(gate + (size_t)b * gate_bstride + col0 + bj * HALF + n * 16);
        constexpr bool KEEP = BIN16;
        u32x4 wk[KEEP ? 8 : 1];
#pragma unroll
        for (int ai = 0; ai < 2; ++ai) {
            u32x4 bs16[8]; f32x4 bs32[BIN16 ? 1 : 8][2];
#pragma unroll
            for (int rnd = 0; rnd < 8; ++rnd) { const int q = rnd * 512 + wid * 64 + lane, row = q >> 5, c8 = q & 31; const size_t o = (size_t)(u.pm * BM + ai * HALF + row) * 1024 + u.pn * BM + 8 * c8;
                if constexpr (BIN16) bs16[rnd] = *(const u32x4*)((const bf16_t*)base + o);
                else { bs32[rnd][0] = *(const f32x4*)((const float*)base + o); bs32[rnd][1] = *(const f32x4*)((const float*)base + o + 4); } }
#pragma unroll
            for (int bj = 0; bj < 2; ++bj)
#pragma unroll
                for (int m = 0; m < 4; ++m)
#pragma unroll
                    for (int n = 0; n < 2; ++n) { const int hrow = wr * 64 + m * 16 + fr, chunk = (bj * HALF + wc * 32 + n * 16 + 4 * fq) >> 2;
                        *(PG8_LAS f32x4*)(img + hrow * 1024 + ((chunk ^ ((hrow & 15) << 2)) << 4)) = gv[bj][n] * acc[ai][bj][m][n]; }
            asm volatile("s_waitcnt lgkmcnt(0)" ::: "memory"); __builtin_amdgcn_s_barrier(); asm volatile("" ::: "memory");
#pragma unroll
            for (int rnd = 0; rnd < 8; ++rnd) { const int q = rnd * 512 + wid * 64 + lane, row = q >> 5, c8 = q & 31; const size_t o = (size_t)(u.pm * BM + ai * HALF + row) * 1024 + u.pn * BM + 8 * c8;
                const PG8_LAS unsigned char* ip = img + row * 1024 + (((2 * c8) ^ ((row & 15) << 2)) << 4);
                const f32x4 g0 = *(const PG8_LAS f32x4*)ip, g1 = *(const PG8_LAS f32x4*)(ip + 16);
                f32x4 b0, b1;
                if constexpr (BIN16) { const u32x4 r = bs16[rnd];
                    b0 = (f32x4){__uint_as_float(r.x << 16), __uint_as_float(r.x & 0xffff0000u), __uint_as_float(r.y << 16), __uint_as_float(r.y & 0xffff0000u)};
                    b1 = (f32x4){__uint_as_float(r.z << 16), __uint_as_float(r.z & 0xffff0000u), __uint_as_float(r.w << 16), __uint_as_float(r.w & 0xffff0000u)}; }
                else { b0 = bs32[rnd][0]; b1 = bs32[rnd][1]; }
                const f32x4 v0 = b0 + g0, v1 = b1 + g1;
                const u32x4 w = (u32x4){cvt_pk_bf16(v0[0], v0[1]), cvt_pk_bf16(v0[2], v0[3]), cvt_pk_bf16(v1[0], v1[1]), cvt_pk_bf16(v1[2], v1[3])};
                *(u32x4*)((bf16_t*)out + o) = w; if constexpr (KEEP) { if (ai == 1) wk[rnd] = w; }
                float ss = 0.f;
#pragma unroll
                for (int k = 0; k < 4; ++k) { const float lo = __uint_as_float(w[k] << 16), hi = __uint_as_float(w[k] & 0xffff0000u); ss += lo * lo + hi * hi; }
                ss += dppf<0xB1>(ss); ss += dppf<0x4E>(ss); ss += dppf<0x141>(ss); ss += dppf<0x140>(ss); ss = xsum16(ss);
                if (c8 == 0) Pt[ai * HALF + row] = ss; }
            asm volatile("s_waitcnt lgkmcnt(0)" ::: "memory"); __builtin_amdgcn_s_barrier(); asm volatile("" ::: "memory");
        }
        const int c8n = lane & 31; const int gcol = u.pn * BM + 8 * c8n;
        f32x4 G0, G1, S0, S1;
        { const f32x4 g0 = *(const f32x4*)(gnorm + gcol), g1 = *(const f32x4*)(gnorm + gcol + 4);
          const f32x4 c0 = *(const f32x4*)(modL + (size_t)b * 6144 + sc_chunk * 1024 + gcol), c1 = *(const f32x4*)(modL + (size_t)b * 6144 + sc_chunk * 1024 + gcol + 4);
          G0 = g0 * (c0 + 1.0f); G1 = g1 * (c1 + 1.0f); S0 = *(const f32x4*)(modL + (size_t)b * 6144 + sh_chunk * 1024 + gcol); S1 = *(const f32x4*)(modL + (size_t)b * 6144 + sh_chunk * 1024 + gcol + 4); }
        const int trow = wid * 32 + (lane & 31);
        if (lane < 32) __hip_atomic_store(xslots + ((size_t)(u.pm * BM + trow) * 4 + u.pn), Pt[trow], __ATOMIC_RELAXED, __HIP_MEMORY_SCOPE_AGENT);
        asm volatile("s_waitcnt vmcnt(0)" ::: "memory");
        if (lane == 0) __hip_atomic_fetch_add(cnt + 16 * u.pm, 1u, __ATOMIC_RELAXED, __HIP_MEMORY_SCOPE_AGENT);
        if (wid == 0) {
            unsigned sp = 0u;
            while ((unsigned)__builtin_amdgcn_readfirstlane(__hip_atomic_load(cnt + 16 * u.pm, __ATOMIC_RELAXED, __HIP_MEMORY_SCOPE_AGENT)) < 32u) { __builtin_amdgcn_s_sleep(1); if (++sp > (1u << 22)) break; }
            __builtin_amdgcn_fence(__ATOMIC_ACQUIRE, "agent");
            if (lane == 0) flag[0] = sp;
        }
        asm volatile("s_waitcnt vmcnt(0) lgkmcnt(0)" ::: "memory"); __builtin_amdgcn_s_barrier(); asm volatile("" ::: "memory");
        if (lane < 32) { const float* sl = xslots + (size_t)(u.pm * BM + trow) * 4; float t = 0.f;
#pragma unroll
            for (int k = 0; k < 4; ++k) t += __hip_atomic_load(sl + k, __ATOMIC_RELAXED, __HIP_MEMORY_SCOPE_AGENT);
            St[trow] = __builtin_amdgcn_rsqf(t * (1.0f / 1024.0f) + 1e-6f); }
        asm volatile("s_waitcnt lgkmcnt(0)" ::: "memory"); __builtin_amdgcn_s_barrier(); asm volatile("" ::: "memory");
#pragma unroll
        for (int hf = 0; hf < 2; ++hf) {
            u32x4 xr[8];
            if (!KEEP || hf == 0) {
#pragma unroll
                for (int rnd = 0; rnd < 8; ++rnd) { const int q = rnd * 512 + wid * 64 + lane, row = q >> 5; xr[rnd] = *(const u32x4*)((const bf16_t*)out + (size_t)(u.pm * BM + hf * HALF + row) * 1024 + gcol); } }
#pragma unroll
            for (int rnd = 0; rnd < 8; ++rnd) { const int q = rnd * 512 + wid * 64 + lane, row = q >> 5; const size_t o = (size_t)(u.pm * BM + hf * HALF + row) * 1024 + gcol;
                const float rs = St[hf * HALF + row]; u32x4 r; if (KEEP && hf == 1) r = wk[KEEP ? rnd : 0]; else r = xr[rnd];
                const f32x4 x0 = (f32x4){__uint_as_float(r.x << 16), __uint_as_float(r.x & 0xffff0000u), __uint_as_float(r.y << 16), __uint_as_float(r.y & 0xffff0000u)};
                const f32x4 x1 = (f32x4){__uint_as_float(r.z << 16), __uint_as_float(r.z & 0xffff0000u), __uint_as_float(r.w << 16), __uint_as_float(r.w & 0xffff0000u)};
                const f32x4 h0 = x0 * rs * G0 + S0, h1 = x1 * rs * G1 + S1;
                int w0 = 0, w1 = 0; w0 = __builtin_amdgcn_cvt_pk_fp8_f32(h0[0], h0[1], w0, false); w0 = __builtin_amdgcn_cvt_pk_fp8_f32(h0[2], h0[3], w0, true);
                w1 = __builtin_amdgcn_cvt_pk_fp8_f32(h1[0], h1[1], w1, false); w1 = __builtin_amdgcn_cvt_pk_fp8_f32(h1[2], h1[3], w1, true);
                typedef unsigned u32x2 __attribute__((ext_vector_type(2)));
                *(u32x2*)(hout8 + o) = (u32x2){(unsigned)w0, (unsigned)w1};
                if constexpr (HMODE == 2) *(u32x4*)(hout + o) = (u32x4){cvt_pk_bf16(h0[0], h0[1]), cvt_pk_bf16(h0[2], h0[3]), cvt_pk_bf16(h1[0], h1[1]), cvt_pk_bf16(h1[2], h1[3])}; }
        }
    }
};
struct EpiConvGate {
    static constexpr bool PERM = true, AFTER_DRAIN = false;
    bf16_t* U; const float* cw; const float* cb; float* sideA0; float* sideG0; float* sideA1; PG8_LAS float* halo; PG8_LAS unsigned char* stage;
    __device__ __forceinline__ void operator()(const f32x4 (&acc)[2][2][4][2], const Unit& u, int wr, int wc, int fr_in, int fq_in) const {
        constexpr int FFc = 2816;
        int fr = fr_in, fq = fq_in; asm volatile("" : "+v"(fr), "+v"(fq));
        const int colt = u.pn * 128 + wc * 32 + 8 * fq;
        const int lcol = wc * 32 + 8 * fq;
        if (fr >= 14) {
#pragma unroll
            for (int ai = 0; ai < 2; ++ai)
#pragma unroll
                for (int n = 0; n < 2; ++n) *(PG8_LAS f32x4*)(halo + ((ai * 2 + wr) * 2 + (fr - 14)) * 128 + lcol + 4 * n) = acc[ai][0][3][n];
        }
        asm volatile("s_waitcnt lgkmcnt(0)" ::: "memory"); __builtin_amdgcn_s_barrier(); asm volatile("" ::: "memory");
        typedef float f32x2 __attribute__((ext_vector_type(2)));
#define CG_DPP(x, ctrl) __int_as_float(__builtin_amdgcn_update_dpp(0, __float_as_int(x), ctrl, 0xf, 0xf, true))
        const bool lane0 = (fr == 0), lane01 = (fr < 2);
        const int wid8 = wr * 4 + wc, lane64 = fq * 16 + fr;
#pragma unroll
        for (int ai = 0; ai < 2; ++ai) {
#pragma unroll
            for (int n = 0; n < 2; ++n) {
                const f32x4 w0 = *(const f32x4*)(cw + colt + 4 * n), w1 = *(const f32x4*)(cw + FFc + colt + 4 * n), w2 = *(const f32x4*)(cw + 2 * FFc + colt + 4 * n), bb = *(const f32x4*)(cb + colt + 4 * n);
                f32x4 w1b, w0b;
#pragma unroll
                for (int e4 = 0; e4 < 4; ++e4) { w1b[e4] = lane0 ? w1[e4] : 0.f; w0b[e4] = lane01 ? w0[e4] : 0.f; }
                const int pb = (wr == 1) ? (ai * 2) : ((ai == 1) ? 1 : 0); const int hr = (fr >= 14) ? (fr - 14) : 0;
                const f32x4 prv = *(const PG8_LAS f32x4*)(halo + (pb * 2 + hr) * 128 + lcol + 4 * n);
#pragma unroll
                for (int m = 0; m < 4; ++m) {
                    const f32x4 x = acc[ai][0][m][n], gt = acc[ai][1][m][n]; const f32x4 pv = (m == 0) ? prv : acc[ai][0][m - 1][n];
                    f32x4 sv;
#pragma unroll
                    for (int e4 = 0; e4 < 4; ++e4) {
                        float t = fmaf(w2[e4], x[e4], bb[e4]);
                        t = fmaf(CG_DPP(x[e4], 0x111), w1[e4], t);
                        t = fmaf(CG_DPP(pv[e4], 0x121), w1b[e4], t);
                        t = fmaf(CG_DPP(x[e4], 0x112), w0[e4], t);
                        t = fmaf(CG_DPP(pv[e4], 0x122), w0b[e4], t);
                        sv[e4] = t;
                    }
                    f32x4 uo;
#pragma unroll
                    for (int p = 0; p < 2; ++p) {
                        const f32x2 s2 = (f32x2){sv[2 * p], sv[2 * p + 1]}; const f32x2 g2 = (f32x2){gt[2 * p], gt[2 * p + 1]};
                        const f32x2 a2 = s2 * -1.4426950408889634f;
                        const f32x2 d2 = (f32x2){__builtin_amdgcn_exp2f(fminf(a2[0], 60.f)), __builtin_amdgcn_exp2f(fminf(a2[1], 60.f))} + 1.0f;
                        const float r = __builtin_amdgcn_rcpf(d2[0] * d2[1]);
                        const f32x2 inv = (f32x2){d2[1], d2[0]} * r;
                        const f32x2 u2 = (s2 * g2) * inv;
                        uo[2 * p] = u2[0]; uo[2 * p + 1] = u2[1];
                    }
                    const int hrow = wr * 64 + m * 16 + fr, trow = ai * HALF + hrow;
                    int w8 = 0; w8 = __builtin_amdgcn_cvt_pk_fp8_f32(uo[0], uo[1], w8, false); w8 = __builtin_amdgcn_cvt_pk_fp8_f32(uo[2], uo[3], w8, true);
                    { const int cb4 = lcol + 4 * n; *(PG8_LAS unsigned*)(stage + hrow * 128 + ((((cb4 >> 4) ^ ((hrow >> 1) & 7)) << 4) | (cb4 & 15))) = (unsigned)w8; }
                    if (ai == 0 && m == 0) {
                        if (trow < 2) { *(f32x4*)(sideA0 + ((size_t)u.pm * 2 + trow) * FFc + colt + 4 * n) = x; *(f32x4*)(sideG0 + ((size_t)u.pm * 2 + trow) * FFc + colt + 4 * n) = gt; } }
                    if (ai == 1 && m == 3) { if (trow >= 254) *(f32x4*)(sideA1 + ((size_t)u.pm * 2 + (trow - 254)) * FFc + colt + 4 * n) = x; }
                }
            }
            asm volatile("s_waitcnt lgkmcnt(0)" ::: "memory"); __builtin_amdgcn_s_barrier(); asm volatile("" ::: "memory");
#pragma unroll
            for (int rnd = 0; rnd < 2; ++rnd) { const int q = rnd * 512 + wid8 * 64 + lane64, hrow = q >> 3, c = q & 7;
                const u32x4 v = *(const PG8_LAS u32x4*)(stage + hrow * 128 + ((c ^ ((hrow >> 1) & 7)) << 4));
                if (ai == 1 || hrow >= 2) *(u32x4*)((unsigned char*)U + (size_t)(u.pm * BM + ai * HALF + hrow) * FFc + u.pn * 128 + c * 16) = v; }
            if (ai == 0) { asm volatile("s_waitcnt lgkmcnt(0)" ::: "memory"); __builtin_amdgcn_s_barrier(); asm volatile("" ::: "memory"); }
        }
#undef CG_DPP
        asm volatile("s_waitcnt lgkmcnt(0)" ::: "memory"); __builtin_amdgcn_s_barrier(); asm volatile("" ::: "memory");
    }
};
template <class Epi, class Sched, bool ALIGN_EPI = false, bool SP2 = false, bool F8 = false>
__device__ __forceinline__ void gemm_phase(PG8_LAS unsigned char* lds, const Gemm g, const Sched& S, const Epi& E, const int tid) {
    const int wid = __builtin_amdgcn_readfirstlane(tid >> 6), lane = tid & 63, wr = wid >> 2, wc = wid & 3, fr = lane & 15, fq = lane >> 4;
    const int K = g.K, nt = K / BK;
    unsigned voffA[2], voffB[2];
#pragma unroll
    for (int i = 0; i < 2; ++i) { int R, C; stage_rc(tid * 16 + i * 8192, R, C); const int Rb = Epi::PERM ? ((R & ~31) + perm32(R & 31)) : R;
        voffA[i] = (unsigned)(R * g.lda + C) * 2u; voffB[i] = (unsigned)(Rb * g.ldb + C) * 2u; }
    const size_t kstep = (size_t)(BK * 2);
    const size_t hstepA = (size_t)HALF * g.lda * 2, hstepB = (size_t)HALF * g.ldb * 2;
    const size_t tstepA = 2 * hstepA, tstepB = 2 * hstepB;
    const unsigned ldsw = (unsigned)wid * 1024u;
    const int aoff = lds_byte(wr * 64 + fr, fq * 8), boff = lds_byte(wc * 32 + fr, fq * 8);
#define PG8_SA(b, h) (((b) * 2 + (h)) * HTB)
#define PG8_SB(b, h) ((4 + (b) * 2 + (h)) * HTB)
#define PG8_STAGE(bufoff, gbase, voff) do { _Pragma("unroll") for (int _i = 0; _i < 2; ++_i) \
        __builtin_amdgcn_global_load_lds((const unsigned*)((const char*)(gbase) + (voff)[_i]), (PG8_LAS unsigned*)(lds + (bufoff) + ldsw + _i * 8192), 16, 0, 0); } while (0)
#define PG8_LDA(dst, b, h) do { _Pragma("unroll") for (int m = 0; m < 4; ++m) { dst[m].lo = *(const PG8_LAS bf16x8*)(lds + PG8_SA(b, h) + aoff + m * 2048); dst[m].hi = *(const PG8_LAS bf16x8*)(lds + PG8_SA(b, h) + aoff + m * 2048 + 1024); } } while (0)
#define PG8_LDB(dst, b, h) do { _Pragma("unroll") for (int n = 0; n < 2; ++n) { dst[n].lo = *(const PG8_LAS bf16x8*)(lds + PG8_SB(b, h) + boff + n * 2048); dst[n].hi = *(const PG8_LAS bf16x8*)(lds + PG8_SB(b, h) + boff + n * 2048 + 1024); } } while (0)
#define PG8_MMA(ai, bj, At, Bt) do { __builtin_amdgcn_s_setprio(1); _Pragma("unroll") for (int m = 0; m < 4; ++m) _Pragma("unroll") for (int n = 0; n < 2; ++n) { \
        if constexpr (F8) asm volatile("v_mfma_scale_f32_16x16x128_f8f6f4 %0, %1, %2, %0, %3, %4 op_sel_hi:[0,0,0]" : "+v"(acc[ai][bj][m][n]) : "v"(__builtin_bit_cast(pg8_v8i, Bt[n])), "v"(__builtin_bit_cast(pg8_v8i, At[m])), "v"(f8sb), "v"(f8sa));   \
        else { acc[ai][bj][m][n] = __builtin_amdgcn_mfma_f32_16x16x32_bf16(Bt[n].lo, At[m].lo, acc[ai][bj][m][n], 0, 0, 0); acc[ai][bj][m][n] = __builtin_amdgcn_mfma_f32_16x16x32_bf16(Bt[n].hi, At[m].hi, acc[ai][bj][m][n], 0, 0, 0); } } \
        __builtin_amdgcn_s_setprio(0); } while (0)
#define PG8_WAIT_V(n) asm volatile("s_waitcnt vmcnt(" #n ")" ::: "memory")
#define PG8_WAIT_L(n) asm volatile("s_waitcnt lgkmcnt(" #n ")" ::: "memory")
#define PG8_BAR __builtin_amdgcn_s_barrier()
#define PG8_SCHED __builtin_amdgcn_sched_barrier(0)
    Unit cur, nxt; int ui = 0;
    if (!S.next(0, cur)) return;
    f32x4 acc[2][2][4][2];
#pragma unroll
    for (int a = 0; a < 2; ++a)
#pragma unroll
        for (int b = 0; b < 2; ++b)
#pragma unroll
            for (int m = 0; m < 4; ++m)
#pragma unroll
                for (int n = 0; n < 2; ++n) acc[a][b][m][n] = (f32x4){0.f, 0.f, 0.f, 0.f};
    const int f8sa = g.sa, f8sb = g.sb; (void)f8sa; (void)f8sb;
    pg8_bf16x16 At[4], B0[2], B1[2];
    const char* cA = (const char*)g.A + (size_t)cur.pm * tstepA; const char* cB = (const char*)g.Bt + (size_t)cur.pn * tstepB;
    S.a_ready(cur);
    if constexpr (SP2) {
        PG8_STAGE(PG8_SB(0, 0), cB, voffB); PG8_STAGE(PG8_SB(0, 1), cB + hstepB, voffB); PG8_STAGE(PG8_SA(0, 0), cA, voffA); PG8_STAGE(PG8_SA(0, 1), cA + hstepA, voffA);
        if (wr == 1) PG8_BAR;
        PG8_WAIT_V(2); PG8_BAR;
        PG8_STAGE(PG8_SB(1, 0), cB + kstep, voffB); PG8_STAGE(PG8_SA(1, 0), cA + kstep, voffA); PG8_STAGE(PG8_SB(1, 1), cB + hstepB + kstep, voffB);
        PG8_WAIT_V(6); PG8_BAR;
    } else {
        PG8_STAGE(PG8_SB(0, 0), cB, voffB); PG8_STAGE(PG8_SA(0, 0), cA, voffA); PG8_STAGE(PG8_SB(0, 1), cB + hstepB, voffB); PG8_STAGE(PG8_SA(0, 1), cA + hstepA, voffA);
        if (wr == 1) PG8_BAR;
        PG8_WAIT_V(4); PG8_BAR;
        PG8_STAGE(PG8_SB(1, 0), cB + kstep, voffB); PG8_STAGE(PG8_SA(1, 0), cA + kstep, voffA); PG8_STAGE(PG8_SB(1, 1), cB + hstepB + kstep, voffB);
        PG8_WAIT_V(6); PG8_BAR;
    }
    for (;;) {
        const bool has_next = S.next(ui + 1, nxt);
        const char* nA = has_next ? (const char*)g.A + (size_t)nxt.pm * tstepA : cA; const char* nB = has_next ? (const char*)g.Bt + (size_t)nxt.pn * tstepB : cB;
#pragma unroll 1
        for (int t = 0; t < nt; t += 2) {
            const bool last = (t == nt - 2);
            const char* a1 = cA + (size_t)(t + 1) * kstep;
            const char* a2 = last ? nA : cA + (size_t)(t + 2) * kstep; const char* b2 = last ? nB : cB + (size_t)(t + 2) * kstep;
            const char* a3 = a2 + kstep; const char* b3 = b2 + kstep;
            if (last && has_next) S.a_ready(nxt);
            if constexpr (SP2) {
            PG8_LDB(B0, 0, 0); PG8_LDB(B1, 0, 1); PG8_SCHED; PG8_LDA(At, 0, 0); PG8_STAGE(PG8_SA(1, 1), a1 + hstepA, voffA);
            PG8_WAIT_V(8); PG8_WAIT_L(0); PG8_BAR; PG8_MMA(0, 0, At, B0); PG8_MMA(0, 1, At, B1); PG8_BAR; PG8_SCHED;
            PG8_LDA(At, 0, 1); PG8_STAGE(PG8_SB(0, 0), b2, voffB); PG8_STAGE(PG8_SB(0, 1), b2 + hstepB, voffB); PG8_STAGE(PG8_SA(0, 0), a2, voffA);
            PG8_WAIT_V(8); PG8_WAIT_L(0); PG8_BAR; PG8_MMA(1, 0, At, B0); PG8_MMA(1, 1, At, B1); PG8_BAR; PG8_SCHED;
            PG8_LDB(B0, 1, 0); PG8_LDB(B1, 1, 1); PG8_SCHED; PG8_LDA(At, 1, 0); PG8_STAGE(PG8_SA(0, 1), a2 + hstepA, voffA);
            PG8_WAIT_V(8); PG8_WAIT_L(0); PG8_BAR; PG8_MMA(0, 0, At, B0); PG8_MMA(0, 1, At, B1); PG8_BAR; PG8_SCHED;
            PG8_LDA(At, 1, 1); PG8_STAGE(PG8_SB(1, 0), b3, voffB); PG8_STAGE(PG8_SB(1, 1), b3 + hstepB, voffB); PG8_STAGE(PG8_SA(1, 0), a3, voffA);
            PG8_WAIT_V(8); PG8_WAIT_L(0); PG8_BAR; PG8_MMA(1, 0, At, B0); PG8_MMA(1, 1, At, B1); PG8_BAR; PG8_SCHED;
            } else {
            PG8_LDB(B0, 0, 0); PG8_SCHED; PG8_LDA(At, 0, 0); PG8_STAGE(PG8_SA(1, 1), a1 + hstepA, voffA);
            PG8_WAIT_L(8); PG8_BAR; PG8_WAIT_L(0); PG8_MMA(0, 0, At, B0); PG8_BAR; PG8_SCHED;
            PG8_LDB(B1, 0, 1); PG8_STAGE(PG8_SB(0, 0), b2, voffB);
            PG8_BAR; PG8_WAIT_L(0); PG8_MMA(0, 1, At, B1); PG8_BAR;
            PG8_LDA(At, 0, 1); PG8_STAGE(PG8_SA(0, 0), a2, voffA);
            PG8_BAR; PG8_WAIT_L(0); PG8_MMA(1, 0, At, B0); PG8_BAR; PG8_SCHED;
            PG8_STAGE(PG8_SB(0, 1), b2 + hstepB, voffB);
            PG8_WAIT_V(6); PG8_BAR; PG8_MMA(1, 1, At, B1); PG8_BAR;
            PG8_LDB(B0, 1, 0); PG8_SCHED; PG8_LDA(At, 1, 0); PG8_STAGE(PG8_SA(0, 1), a2 + hstepA, voffA);
            PG8_WAIT_L(8); PG8_BAR; PG8_WAIT_L(0); PG8_MMA(0, 0, At, B0); PG8_BAR; PG8_SCHED;
            PG8_LDB(B1, 1, 1); PG8_STAGE(PG8_SB(1, 0), b3, voffB);
            PG8_BAR; PG8_WAIT_L(0); PG8_MMA(0, 1, At, B1); PG8_BAR;
            PG8_LDA(At, 1, 1); PG8_STAGE(PG8_SA(1, 0), a3, voffA);
            PG8_BAR; PG8_WAIT_L(0); PG8_MMA(1, 0, At, B0); PG8_BAR; PG8_SCHED;
            PG8_STAGE(PG8_SB(1, 1), b3 + hstepB, voffB);
            PG8_WAIT_V(6); PG8_BAR; PG8_MMA(1, 1, At, B1); PG8_BAR;
            }
        }
        if constexpr (ALIGN_EPI) { if (wr == 0) PG8_BAR; }
        if constexpr (F8) {
            asm volatile("s_nop 15\n\ts_nop 7" : "+v"(acc[0][0][0][0]), "+v"(acc[0][0][0][1]), "+v"(acc[0][0][1][0]), "+v"(acc[0][0][1][1]), "+v"(acc[0][0][2][0]), "+v"(acc[0][0][2][1]), "+v"(acc[0][0][3][0]), "+v"(acc[0][0][3][1]), "+v"(acc[0][1][0][0]), "+v"(acc[0][1][0][1]), "+v"(acc[0][1][1][0]), "+v"(acc[0][1][1][1]), "+v"(acc[0][1][2][0]), "+v"(acc[0][1][2][1]), "+v"(acc[0][1][3][0]), "+v"(acc[0][1][3][1]) :: "memory");
            asm volatile("" : "+v"(acc[1][0][0][0]), "+v"(acc[1][0][0][1]), "+v"(acc[1][0][1][0]), "+v"(acc[1][0][1][1]), "+v"(acc[1][0][2][0]), "+v"(acc[1][0][2][1]), "+v"(acc[1][0][3][0]), "+v"(acc[1][0][3][1]), "+v"(acc[1][1][0][0]), "+v"(acc[1][1][0][1]), "+v"(acc[1][1][1][0]), "+v"(acc[1][1][1][1]), "+v"(acc[1][1][2][0]), "+v"(acc[1][1][2][1]), "+v"(acc[1][1][3][0]), "+v"(acc[1][1][3][1]) :: "memory"); }
        if constexpr (!Epi::AFTER_DRAIN) { E(acc, cur, wr, wc, fr, fq); S.done(cur); }
        if (!has_next) break;
#pragma unroll
        for (int a = 0; a < 2; ++a)
#pragma unroll
            for (int b = 0; b < 2; ++b)
#pragma unroll
                for (int m = 0; m < 4; ++m)
#pragma unroll
                    for (int n = 0; n < 2; ++n) acc[a][b][m][n] = (f32x4){0.f, 0.f, 0.f, 0.f};
        cur = nxt; cA = nA; cB = nB; ++ui;
        if constexpr (ALIGN_EPI) { if (wr == 1) PG8_BAR; }
    }
    PG8_WAIT_V(0);
    if constexpr (!ALIGN_EPI) { if (wr == 0) PG8_BAR; }
    PG8_BAR;
    if constexpr (Epi::AFTER_DRAIN) { E.fused(acc, cur, wr, wc, fr, fq, lds, wid, lane); S.done(cur); }
#undef PG8_SA
#undef PG8_SB
#undef PG8_STAGE
#undef PG8_LDA
#undef PG8_LDB
#undef PG8_MMA
#undef PG8_WAIT_V
#undef PG8_WAIT_L
#undef PG8_BAR
#undef PG8_SCHED
}
}

#include <hip/hip_bf16.h>
#include <cmath>
namespace attn_body {
using bf16=__hip_bfloat16;
using bf16x8=__attribute__((ext_vector_type(8)))short;
using s16x4=__attribute__((ext_vector_type(4)))short;
using f32x16=__attribute__((ext_vector_type(16)))float;
using u32x4=__attribute__((ext_vector_type(4)))unsigned;
constexpr int BATCH=2,NHEAD=16,SEQ=8192,D=64,DM=NHEAD*D;
constexpr int NW=8,QBLK=32,QB=QBLK*NW,KVBLK=64,NQB=SEQ/QB;
constexpr int ATTN_PITCH=DM, ATTN_UNIT_ROWS=QB;
__device__ __forceinline__ int crow(int r,int hi){return (r&3)+8*(r>>2)+4*hi;}
#define SBAR() __builtin_amdgcn_sched_barrier(0)
__device__ __forceinline__ void cmask(f32x16&p0,f32x16&p1,int jb,int qrel,int hi){
  const float NEG=-INFINITY; int kb=64*jb+4*hi;
  #pragma unroll
  for(int r=0;r<16;++r){int kv=kb+(r&3)+8*(r>>2); if(kv>qrel)p0[r]=NEG; if(kv+32>qrel)p1[r]=NEG;}
}

constexpr int NSLOT=3, SLOTB=8192, KSLOTB=10240;
constexpr int LDS_K=0, LDS_V=NSLOT*KSLOTB, LDS_WS=LDS_V+NSLOT*SLOTB, LDS_OST=LDS_WS+NW*64*4, LDS_BYTES=LDS_OST+NW*4096;
#define KOFF(sl) ((sl)+((sl)>>2))
constexpr float C2=0.125f*1.4426950408889634f;
__device__ __forceinline__ void glds16(const void*gsrc,unsigned lds_dst){unsigned keep;
  asm volatile("s_mov_b32 %0, m0\n\ts_mov_b32 m0, %2\n\ts_nop 0\n\tglobal_load_lds_dwordx4 %1, off\n\ts_mov_b32 m0, %0":"=&s"(keep):"v"(gsrc),"s"(lds_dst):"memory");}
__device__ __forceinline__ void glds4(const void*gsrc,unsigned lds_dst){unsigned keep;
  asm volatile("s_mov_b32 %0, m0\n\ts_mov_b32 m0, %2\n\ts_nop 0\n\tglobal_load_lds_dword %1, off\n\ts_mov_b32 m0, %0":"=&s"(keep):"v"(gsrc),"s"(lds_dst):"memory");}
__device__ __forceinline__ float max3f(float a,float b,float c){float r;asm("v_max3_f32 %0, %1, %2, %3":"=v"(r):"v"(a),"v"(b),"v"(c));return r;}
__device__ __forceinline__ float max2f(float a,float b){float r;asm("v_max_f32_e32 %0, %1, %2":"=v"(r):"v"(a),"v"(b));return r;}
__device__ __forceinline__ float fadd_s(float a,float b){float r;asm("v_add_f32_e32 %0, %1, %2":"=v"(r):"v"(a),"v"(b));return r;}
__device__ __forceinline__ float fsub_s(float a,float b){float r;asm("v_sub_f32_e32 %0, %1, %2":"=v"(r):"v"(a),"v"(b));return r;}
typedef float f32x2_t __attribute__((ext_vector_type(2))); typedef __bf16 bf16x2_t __attribute__((ext_vector_type(2)));
__device__ __forceinline__ unsigned cvtpk_s(float lo,float hi){f32x2_t v={lo,hi};bf16x2_t b=__builtin_convertvector(v,bf16x2_t);return __builtin_bit_cast(unsigned,b);}
#define WAIT_BAR(N) asm volatile("s_waitcnt vmcnt(" #N ") lgkmcnt(0)\n\ts_barrier":::"memory")

__device__ __forceinline__ void qkt(f32x16&p0,f32x16&p1,const char*Kslot,const bf16x8*qr,const bf16x8 qe,int r32,int hi){
  const char*kb=Kslot+hi*1024+r32*16;
  { const bf16x8 e0=*reinterpret_cast<const bf16x8*>(kb+8192); const bf16x8 e1=*reinterpret_cast<const bf16x8*>(kb+8192+512); const f32x16 z=f32x16{};
    p0=__builtin_amdgcn_mfma_f32_32x32x16_bf16(e0,qe,z,0,0,0); p1=__builtin_amdgcn_mfma_f32_32x32x16_bf16(e1,qe,z,0,0,0); }
  #pragma unroll
  for(int d0=0;d0<4;++d0){
    const bf16x8 b0=*reinterpret_cast<const bf16x8*>(kb+d0*2048);
    const bf16x8 b1=*reinterpret_cast<const bf16x8*>(kb+d0*2048+512);
    {p0=__builtin_amdgcn_mfma_f32_32x32x16_bf16(b0,qr[d0],p0,0,0,0);p1=__builtin_amdgcn_mfma_f32_32x32x16_bf16(b1,qr[d0],p1,0,0,0);}}
}
typedef __attribute__((address_space(3))) const char* lds_cptr;
typedef short v4i16_t __attribute__((ext_vector_type(4)));
__device__ __forceinline__ void kload8(bf16x8*kf,lds_cptr kp){
  kf[0]=*(const __attribute__((address_space(3))) bf16x8*)(kp);      kf[1]=*(const __attribute__((address_space(3))) bf16x8*)(kp+512);
  kf[2]=*(const __attribute__((address_space(3))) bf16x8*)(kp+2048); kf[3]=*(const __attribute__((address_space(3))) bf16x8*)(kp+2560);
  kf[4]=*(const __attribute__((address_space(3))) bf16x8*)(kp+4096); kf[5]=*(const __attribute__((address_space(3))) bf16x8*)(kp+4608);
  kf[6]=*(const __attribute__((address_space(3))) bf16x8*)(kp+6144); kf[7]=*(const __attribute__((address_space(3))) bf16x8*)(kp+6656);
  kf[8]=*(const __attribute__((address_space(3))) bf16x8*)(kp+8192); kf[9]=*(const __attribute__((address_space(3))) bf16x8*)(kp+8704);
}
__device__ __forceinline__ void kload2(bf16x8*kf,lds_cptr kp,int j){ kf[2*j]=*(const __attribute__((address_space(3))) bf16x8*)(kp+j*2048); kf[2*j+1]=*(const __attribute__((address_space(3))) bf16x8*)(kp+j*2048+512); }
__device__ __forceinline__ s16x4 vtr(lds_cptr p){ return __builtin_bit_cast(s16x4,__builtin_amdgcn_ds_read_tr16_b64_v4i16((__attribute__((address_space(3))) v4i16_t*)p)); }
__device__ __forceinline__ float rowmax(const f32x16&p0,const f32x16&p1){
  float a=max3f(p0[0],p0[1],p1[0]),b=max3f(p0[2],p0[3],p1[1]);a=max3f(a,p1[2],p1[3]);
  #pragma unroll
  for(int r=4;r<16;r+=4){a=max3f(a,p0[r],p0[r+1]);b=max3f(b,p0[r+2],p0[r+3]);a=max3f(a,p1[r],p1[r+1]);b=max3f(b,p1[r+2],p1[r+3]);}
  const float m=max2f(a,b);
  auto rr=__builtin_amdgcn_permlane32_swap(__float_as_uint(m),__float_as_uint(m),false,false);
  return max2f(__uint_as_float(rr[0]),__uint_as_float(rr[1]));
}
__device__ __forceinline__ void pv(f32x16*o,int vb,bf16x8 pa0,bf16x8 pa1,bf16x8 pa2,bf16x8 pa3){
  #pragma unroll
  for(int d0=0;d0<2;++d0){s16x4 lo[4],hi[4];
    #pragma unroll
    for(int ks=0;ks<4;++ks){
      asm volatile("ds_read_b64_tr_b16 %0,%1 offset:%c2":"=&v"(lo[ks]):"v"(vb),"i"(d0*4096+ks*1024):"memory");
      asm volatile("ds_read_b64_tr_b16 %0,%1 offset:%c2":"=&v"(hi[ks]):"v"(vb),"i"(d0*4096+ks*1024+512):"memory");}
    asm volatile("s_waitcnt lgkmcnt(0)":::"memory");SBAR();
    #define PK(k) (bf16x8){lo[k][0],lo[k][1],lo[k][2],lo[k][3],hi[k][0],hi[k][1],hi[k][2],hi[k][3]}
    o[d0]=__builtin_amdgcn_mfma_f32_32x32x16_bf16(pa0,PK(0),o[d0],0,0,0);
    o[d0]=__builtin_amdgcn_mfma_f32_32x32x16_bf16(pa1,PK(1),o[d0],0,0,0);
    o[d0]=__builtin_amdgcn_mfma_f32_32x32x16_bf16(pa2,PK(2),o[d0],0,0,0);
    o[d0]=__builtin_amdgcn_mfma_f32_32x32x16_bf16(pa3,PK(3),o[d0],0,0,0);
    #undef PK
  }
}

#ifndef ATTN_STORE16
#define ATTN_STORE16(p,v) (*(u32x4*)(p)=(v))
#endif
__device__ __forceinline__ bf16x8 make_qe(float m,int hi){
  const unsigned um=__float_as_uint(m); unsigned h0=(um+0x7fffu+((um>>16)&1u))&0xffff0000u; const float r1=m-__uint_as_float(h0);
  const unsigned u1=__float_as_uint(r1); unsigned h1=(u1+0x7fffu+((u1>>16)&1u))&0xffff0000u; const float r2=r1-__uint_as_float(h1);
  const unsigned u2=__float_as_uint(r2); unsigned h2=(u2+0x7fffu+((u2>>16)&1u))&0xffff0000u;
  u32x4 w; w.x=0x3f803f80u; w.y=0x3f80u|(h0^0x80000000u); w.z=((h1^0x80000000u)>>16)|(h2^0x80000000u); w.w=0u;
  if(hi){w.x=0u;w.y=0u;w.z=0u;} return __builtin_bit_cast(bf16x8,w); }
template<int THRL> __device__ __forceinline__ void attn_unit(int b,int h,int qb,const bf16*Q,const bf16*__restrict__ K,const bf16*__restrict__ V,bf16*O,const bf16*__restrict__ KE,const float*__restrict__ BETA,float qkmax,char*shm,const int tid){
  const int lane=tid&63,r32=lane&31,hi=lane>>5; const int wid=__builtin_amdgcn_readfirstlane(tid>>6);
  const long rowbase=(long)b*SEQ; const int q0=qb*QB;
  const bf16*Qw=Q+(rowbase+q0+wid*QBLK)*DM+h*D;
  const float*bet=BETA+(long)(b*NHEAD+h)*SEQ; const int NTF=(q0+QB)/KVBLK; int t0;
  { const float thr=bet[q0]-37.f-2.f*qkmax; const int l0=lane,l1=lane+64;
    const bool s0=(l0<NTF-4)&&(bet[64*l0+63]<thr), s1=(l1<NTF-4)&&(bet[64*l1+63]<thr);
    const unsigned long long m0=__ballot(s0), m1=__ballot(s1);
    int n0=(~m0)?__builtin_ctzll(~m0):64; if(n0==64) n0+=(~m1)?__builtin_ctzll(~m1):64;
    t0=__builtin_amdgcn_readfirstlane(n0)&~1; }
  const bf16*Kh=K+(rowbase+(long)t0*KVBLK)*DM+h*D,*Vh=V+(rowbase+(long)t0*KVBLK)*DM+h*D;
  const char*KEh=(const char*)KE+((long)(b*NHEAD+h)*(SEQ/KVBLK)+t0)*2048+wid*256+lane*4;
  const unsigned lds0=(unsigned)(uintptr_t)shm;
  float*wsf=(float*)(shm+LDS_WS)+wid*64;
  const bf16*ksrc=Kh+(long)lane*DM+wid*8;
  const bf16*vsrc=Vh+(long)(16*(wid&3)+(lane>>2))*DM+(wid>>2)*32+(lane&3)*8;
  const unsigned kdst=lds0+LDS_K+wid*1024, vdst=lds0+LDS_V+wid*1024, kedst=lds0+LDS_K+8192+wid*256;
  #define DMA_K(t,slot) do{ glds16(ksrc+(long)(t)*KVBLK*DM,(unsigned)__builtin_amdgcn_readfirstlane(kdst+KOFF(slot))); glds4(KEh+(long)(t)*2048,(unsigned)__builtin_amdgcn_readfirstlane(kedst+KOFF(slot))); }while(0)
  #define DMA_V(t,slot) glds16(vsrc+(long)(t)*KVBLK*DM,(unsigned)__builtin_amdgcn_readfirstlane(vdst+(slot)))
  const int vb0=(int)(lds0+LDS_V)+((lane>>4)&1)*32+(lane&3)*8+(4*hi+((lane&15)>>2))*64;
  const char*Kbase=shm+LDS_K; bf16x8 kf[10];
  const lds_cptr shm3=(lds_cptr)shm; const lds_cptr kp0=shm3+LDS_K+hi*1024+r32*16; const lds_cptr vp0=shm3+LDS_V+((lane>>4)&1)*32+(lane&3)*8+(4*hi+((lane&15)>>2))*64;
  const int NT=NTF-t0;
  DMA_K(0,0);DMA_V(0,0);DMA_K(1,SLOTB);
  bf16x8 qr[4];
  #pragma unroll
  for(int d0=0;d0<4;++d0)qr[d0]=*reinterpret_cast<const bf16x8*>(&Qw[(long)r32*DM+d0*16+hi*8]);
  float mhat=bet[q0+wid*QBLK+r32],l_reg=0.f;f32x16 o[2];o[0]=f32x16{};o[1]=f32x16{}; bf16x8 qe=make_qe(mhat,hi);
  const int qrel=wid*QBLK+r32;
  #define CMASK(P0,P1,t) do{int jb_=(t)-(NT-4); if(jb_>=0)cmask(P0,P1,jb_,qrel,hi);}while(0)
  bool resc=false;
  #define START(P0,P1) do{ resc=false; _Pragma("unroll") for(int r=0;r<16;++r)P0[r]=__builtin_amdgcn_exp2f(P0[r]); }while(0)
  #define RESC() do{ if(resc){ asm volatile("s_waitcnt lgkmcnt(0)":::"memory"); \
      _Pragma("unroll") for(int d_=0;d_<2;++d_) _Pragma("unroll") for(int r=0;r<16;++r)o[d_][r]*=wsf[crow(r,hi)]; } }while(0)
  f32x16 pA0,pA1,pB0,pB1;
  int sl_prev=0,sl_cur=0,sl_next=SLOTB;
  #define ROT() do{sl_prev=sl_cur;sl_cur=sl_next;sl_next=(sl_next==(NSLOT-1)*SLOTB)?0:sl_next+SLOTB;}while(0)
  DMA_K(2,2*SLOTB);
  WAIT_BAR(5);
  qkt(pA0,pA1,Kbase,qr,qe,r32,hi);asm volatile("s_nop 15\n\ts_nop 7":"+v"(pA0),"+v"(pA1));CMASK(pA0,pA1,0);
  START(pA0,pA1);
  _Pragma("unroll") for(int r=0;r<16;++r)pA1[r]=__builtin_amdgcn_exp2f(pA1[r]);
  WAIT_BAR(0);
  DMA_K(3,0);DMA_V(1,SLOTB);
  ROT();
  kload8(kf,kp0+KOFF(sl_cur));
  WAIT_BAR(3);
  s16x4 vlo[8],vhi[8]; u32x4 pw0,pw1,pw2,pw3;
  #define PKW(P,B) cvtpk_s(P[B],P[B+1])
  #define PAF(k) __builtin_bit_cast(bf16x8,pw##k)
  #define VFR(i) (bf16x8){vlo[i][0],vlo[i][1],vlo[i][2],vlo[i][3],vhi[i][0],vhi[i][1],vhi[i][2],vhi[i][3]}
  #define PIN(x) asm volatile("":"+v"(x))
  #define MX3(a,b,c) __builtin_fmaxf(__builtin_fmaxf((a),(b)),(c))
  #define GAPA(MF,A0,A1,A2,A3,W0,W1,PW) do{ MF; sacc+=A0; sacc+=A1; sacc+=A2; sacc+=A3; PIN(sacc); W0; W1; PIN(PW); SBAR(); }while(0)
  #define EX(v) __builtin_amdgcn_exp2f(v)
  #define GAPB(MF,X,B) do{ MF; X[B]=EX(X[B]); X[B+1]=EX(X[B+1]); X[B+2]=EX(X[B+2]); X[B+3]=EX(X[B+3]); PIN(X); SBAR(); }while(0)
  #define VRD(i) do{ vlo[i]=vtr(vp_+(((i)>>2)*4096+((i)&3)*1024)); vhi[i]=vtr(vp_+(((i)>>2)*4096+((i)&3)*1024+512)); }while(0)
  #define KRD(G,j) do{ if(G){ kload2(kf,kp0+KOFF(sl_next),j); SBAR(); } }while(0)
  #define KRDE(G) do{ if(G){ kf[8]=*(const __attribute__((address_space(3))) bf16x8*)(kp0+KOFF(sl_next)+8192); kf[9]=*(const __attribute__((address_space(3))) bf16x8*)(kp0+KOFF(sl_next)+8704); SBAR(); } }while(0)
  #define STEP(C0,C1,P0,P1,t,GK,GV,GL) do{ SBAR(); \
    const lds_cptr vp_=vp0+sl_prev; \
    VRD(0); SBAR(); float sacc=(P0[0]+P0[1]); \
    C0=__builtin_amdgcn_mfma_f32_32x32x16_bf16(kf[8],qe,f32x16{},0,0,0); C1=__builtin_amdgcn_mfma_f32_32x32x16_bf16(kf[9],qe,f32x16{},0,0,0); SBAR(); \
    GAPA(C0=__builtin_amdgcn_mfma_f32_32x32x16_bf16(kf[0],qr[0],C0,0,0,0), P0[2],P0[3],P0[4],P0[5],     pw0[0]=PKW(P0,0), pw0[1]=PKW(P0,2), pw0); \
    VRD(4); SBAR(); GAPA(C1=__builtin_amdgcn_mfma_f32_32x32x16_bf16(kf[1],qr[0],C1,0,0,0), P0[6],P0[7],P0[8],P0[9],     pw0[2]=PKW(P0,4), pw0[3]=PKW(P0,6), pw0); \
    VRD(1); SBAR(); GAPA(C0=__builtin_amdgcn_mfma_f32_32x32x16_bf16(kf[2],qr[1],C0,0,0,0),   P0[10],P0[11],P0[12],P0[13], pw1[0]=PKW(P0,8), pw1[1]=PKW(P0,10), pw1); \
    VRD(5); SBAR(); GAPA(C1=__builtin_amdgcn_mfma_f32_32x32x16_bf16(kf[3],qr[1],C1,0,0,0),   P0[14],P0[15],P1[0],P1[1],   pw1[2]=PKW(P0,12),pw1[3]=PKW(P0,14), pw1); \
    VRD(2); SBAR(); GAPA(C0=__builtin_amdgcn_mfma_f32_32x32x16_bf16(kf[4],qr[2],C0,0,0,0),   P1[2],P1[3],P1[4],P1[5],     pw2[0]=PKW(P1,0), pw2[1]=PKW(P1,2), pw2); \
    VRD(6); SBAR(); GAPA(C1=__builtin_amdgcn_mfma_f32_32x32x16_bf16(kf[5],qr[2],C1,0,0,0),   P1[6],P1[7],P1[8],P1[9],     pw2[2]=PKW(P1,4), pw2[3]=PKW(P1,6), pw2); \
    VRD(3); SBAR(); GAPA(C0=__builtin_amdgcn_mfma_f32_32x32x16_bf16(kf[6],qr[3],C0,0,0,0),   P1[10],P1[11],P1[12],P1[13], pw3[0]=PKW(P1,8), pw3[1]=PKW(P1,10), pw3); \
    VRD(7); SBAR(); GAPA(C1=__builtin_amdgcn_mfma_f32_32x32x16_bf16(kf[7],qr[3],C1,0,0,0),   P1[14],P1[15],0.f,0.f,       pw3[2]=PKW(P1,12),pw3[3]=PKW(P1,14), pw3); \
    l_reg+=sacc; \
    if(GK){DMA_K((t)+3,sl_cur);} if(GV){DMA_V((t)+1,sl_next);} \
    CMASK(C0,C1,t); \
    { float a=MX3(C0[0],C0[1],C1[0]),b=MX3(C0[2],C0[3],C1[1]); a=MX3(a,C1[2],C1[3]); \
      _Pragma("unroll") for(int r=4;r<16;r+=4){a=MX3(a,C0[r],C0[r+1]);b=MX3(b,C0[r+2],C0[r+3]);a=MX3(a,C1[r],C1[r+1]);b=MX3(b,C1[r+2],C1[r+3]);} \
      float rm=__builtin_fmaxf(a,b); { auto rr=__builtin_amdgcn_permlane32_swap(__float_as_uint(rm),__float_as_uint(rm),false,false); rm=__builtin_fmaxf(__uint_as_float(rr[0]),__uint_as_float(rr[1])); } \
      resc=false; \
      if(__builtin_expect(__any(rm>(float)THRL),0)){ const float dl=__builtin_fmaxf(rm,0.f); mhat+=dl; \
        _Pragma("unroll") for(int r=0;r<16;++r){C0[r]-=dl;C1[r]-=dl;} \
        qe=make_qe(mhat,hi); \
        const float f=__builtin_amdgcn_exp2f(-dl); l_reg*=f; if(hi==0)wsf[r32]=f; resc=true; } } \
    SBAR(); \
    GAPB(o[0]=__builtin_amdgcn_mfma_f32_32x32x16_bf16(PAF(0),VFR(0),o[0],0,0,0), C0,0); \
    GAPB(o[1]=__builtin_amdgcn_mfma_f32_32x32x16_bf16(PAF(0),VFR(4),o[1],0,0,0), C0,4); \
    KRD(GL,0); GAPB(o[0]=__builtin_amdgcn_mfma_f32_32x32x16_bf16(PAF(1),VFR(1),o[0],0,0,0), C0,8); \
    KRD(GL,1); GAPB(o[1]=__builtin_amdgcn_mfma_f32_32x32x16_bf16(PAF(1),VFR(5),o[1],0,0,0), C0,12); \
    KRD(GL,2); GAPB(o[0]=__builtin_amdgcn_mfma_f32_32x32x16_bf16(PAF(2),VFR(2),o[0],0,0,0), C1,0); \
    KRD(GL,3); GAPB(o[1]=__builtin_amdgcn_mfma_f32_32x32x16_bf16(PAF(2),VFR(6),o[1],0,0,0), C1,4); \
    KRDE(GL); GAPB(o[0]=__builtin_amdgcn_mfma_f32_32x32x16_bf16(PAF(3),VFR(3),o[0],0,0,0), C1,8); \
    GAPB(o[1]=__builtin_amdgcn_mfma_f32_32x32x16_bf16(PAF(3),VFR(7),o[1],0,0,0), C1,12); \
    }while(0)
  int t=1;
  #undef CMASK
  #define CMASK(P0,P1,t) do{}while(0)
  for(;t+5<NT;t+=2){
    STEP(pB0,pB1,pA0,pA1,t,true,true,true);     WAIT_BAR(3); RESC(); ROT();
    STEP(pA0,pA1,pB0,pB1,t+1,true,true,true);   WAIT_BAR(3); RESC(); ROT();
  }
  #undef CMASK
  #define CMASK(P0,P1,t) do{int jb_=(t)-(NT-4); if(jb_>=0)cmask(P0,P1,jb_,qrel,hi);}while(0)
  #define ENDW(tt) do{ if((tt)+3<NT){WAIT_BAR(3);} else if((tt)+2<NT){WAIT_BAR(1);} else {WAIT_BAR(0);} }while(0)
  for(;t+1<NT;t+=2){
    STEP(pB0,pB1,pA0,pA1,t,(t+3<NT),(t+1<NT),(t+1<NT));       ENDW(t);   RESC(); ROT();
    STEP(pA0,pA1,pB0,pB1,t+1,(t+4<NT),(t+2<NT),(t+2<NT));     ENDW(t+1); RESC(); ROT();
  }
  STEP(pB0,pB1,pA0,pA1,NT-1,false,false,false); RESC();
  { float sacc=pB0[0]+pB0[1]; _Pragma("unroll") for(int r=2;r<16;++r)sacc+=pB0[r]; _Pragma("unroll") for(int r=0;r<16;++r)sacc+=pB1[r]; l_reg+=sacc;
    pw0=(u32x4){PKW(pB0,0),PKW(pB0,2),PKW(pB0,4),PKW(pB0,6)};pw1=(u32x4){PKW(pB0,8),PKW(pB0,10),PKW(pB0,12),PKW(pB0,14)};pw2=(u32x4){PKW(pB1,0),PKW(pB1,2),PKW(pB1,4),PKW(pB1,6)};pw3=(u32x4){PKW(pB1,8),PKW(pB1,10),PKW(pB1,12),PKW(pB1,14)};
    SBAR(); pv(o,vb0+sl_cur,PAF(0),PAF(1),PAF(2),PAF(3)); }
  #undef PKW
  #undef PAF
  #undef VFR
  #undef PIN
  #undef MX3
  #undef GAPA
  #undef GAPB
  #undef EX
  #undef VRD
  #undef KRD
  #undef KRDE
  #undef STEP
  #undef ENDW
  {auto rr=__builtin_amdgcn_permlane32_swap(__float_as_uint(l_reg),__float_as_uint(l_reg),false,false);l_reg=__uint_as_float(rr[0])+__uint_as_float(rr[1]);}
  if(hi==0)wsf[32+r32]=l_reg;asm volatile("s_waitcnt lgkmcnt(0)":::"memory");
  float rli[16];
  #pragma unroll
  for(int r=0;r<16;++r)rli[r]=__builtin_amdgcn_rcpf(wsf[32+crow(r,hi)]);
  int lane_e=lane; asm volatile("":"+v"(lane_e));
  const int r32e=lane_e&31,hie=lane_e>>5;
  unsigned char*Ow=(unsigned char*)O+((rowbase+q0+wid*QBLK)*DM+h*D);
  { unsigned char*stg=(unsigned char*)(shm+LDS_OST)+wid*4096;
    #pragma unroll
    for(int r=0;r<16;++r){const int orow=crow(r,hie); const float sc32=32.f*rli[r];
      #pragma unroll
      for(int d0=0;d0<2;++d0)stg[orow*64+d0*32+r32e]=(unsigned char)__builtin_amdgcn_cvt_pk_fp8_f32(o[d0][r]*sc32,0.f,0,false);}
    asm volatile("s_waitcnt lgkmcnt(0)":::"memory");
    typedef unsigned u32x2_t __attribute__((ext_vector_type(2)));
    #pragma unroll
    for(int i=0;i<4;++i){const int row=i*8+(lane_e>>3),ch=lane_e&7; const u32x2_t v=*(const u32x2_t*)(stg+row*64+ch*8); *(u32x2_t*)(Ow+(long)row*DM+ch*8)=v;} }
  asm volatile("s_waitcnt lgkmcnt(0)\n\ts_barrier":::"memory");
  #undef DMA_K
  #undef DMA_V
  #undef CMASK
  #undef START
  #undef RESC
  #undef ROT
}
constexpr int ATTN_LDS_BYTES=LDS_BYTES;
struct AttnTensors { const bf16* Q; const bf16* K; const bf16* V; bf16* O; };
struct AttnUnit { int bh; int qb; };
struct StaticOrder {
  int vcu;
  __device__ __forceinline__ explicit StaticOrder(int grid,int block):vcu((block%8)*(grid/8)+block/8){}
  __device__ __forceinline__ bool next(int i,AttnUnit&u)const{ if(i>=4)return false; const int s=vcu&7; u.bh=vcu>>3; u.qb=(i==0)?s:(i==1)?15-s:(i==2)?16+s:31-s; return true; }
  __device__ __forceinline__ void a_ready(const AttnUnit&)const{}
  __device__ __forceinline__ void done(const AttnUnit&)const{}
};
template<class Sched,int THRL=8> __device__ __forceinline__ void attn_phase(char*lds,const AttnTensors&T,const Sched&S){
  AttnUnit u;
  for(int i=0;S.next(i,u);++i){ S.a_ready(u); attn_unit<THRL>(u.bh/NHEAD,u.bh%NHEAD,u.qb,T.Q,T.K,T.V,T.O,lds); S.done(u); }
}
#undef SBAR
#undef WAIT_BAR
}

#ifndef MK_DUP
#define MK_DUP 0
#endif
#define ORD_QKV 4, 3
#define ORD_UP 4, 3
#define ORD_DIN 4, 3
#define ORD_QI 4, 3
constexpr int NWAVES = 8, NTHREADS = 512;
constexpr int BATCH = 2, T = 8192, D = 1024, H = 16, HD = 64, FF = 2816, FF2 = 5632;
constexpr int M = BATCH * T;
constexpr int FOX_IN = 3088, DSA_IN = 2120;
constexpr float EPS = 1e-6f;
constexpr float LOG2E = 1.4426950408889634f;

constexpr size_t MiB = 1u << 20;
constexpr size_t WS_CTL = 0, CTL_ZERO_BYTES = 32 * 1024;
constexpr size_t WS_MOD = 1 * MiB;
constexpr size_t WS_XS = 2 * MiB;
constexpr int CW_NS = 1024;
constexpr size_t WS_WUP0 = 8 * MiB, WS_WUP1 = 19 * MiB;
constexpr size_t WS_WDN0 = 30 * MiB, WS_WDN1 = 35 * MiB + 512 * 1024;
constexpr size_t WS_WDIN = 41 * MiB;
constexpr size_t WS_WDTAIL = 45 * MiB;
constexpr size_t WS_WDOUT = 45 * MiB + 512 * 1024;
constexpr size_t WS_H = 48 * MiB;
constexpr size_t WS_R = 80 * MiB;
constexpr size_t WS_WFIN = WS_R, WS_WFOUT = WS_R + 6 * MiB;
constexpr size_t WS_Q = WS_R + 8 * MiB, WS_K = WS_R + 40 * MiB, WS_V = WS_R + 72 * MiB;
constexpr size_t WS_LOGF = WS_R + 104 * MiB;
constexpr size_t WS_BETA = WS_R + 105 * MiB;
constexpr size_t WS_KE = WS_R + 106 * MiB;
constexpr size_t WS_O = WS_R + 114 * MiB;
constexpr size_t WS_XB = WS_R + 144 * MiB;
constexpr size_t WS_U = WS_R;
constexpr size_t WS_SA0 = WS_R + 96 * MiB, WS_SG0 = WS_R + 98 * MiB, WS_SA1 = WS_R + 100 * MiB;
constexpr size_t WS_Q1 = WS_R, WS_K1 = WS_R + 32 * MiB, WS_V1 = WS_R + 40 * MiB;
constexpr size_t WS_QI = WS_R + 48 * MiB;
constexpr size_t WS_KI = WS_R + 64 * MiB;
constexpr size_t WS_WI = WS_R + 66 * MiB;
constexpr size_t WS_H8 = WS_R + 84 * MiB;
constexpr size_t WS_O1 = WS_R + 67 * MiB;
constexpr size_t WS_END = 256 * MiB;
static_assert(WS_U + (size_t)M * FF * 2 <= WS_SA0 && WS_SA1 + 2 * MiB <= WS_END, "d_ws map");
constexpr int CW_BAR = 4096;
static_assert((CW_BAR + 3456) * 4 <= 32 * 1024, "control words inside the per-call memset");
constexpr int CW_AQ = 256;
constexpr int CW_DQ = 512;

constexpr int RING_OFF = 0, RING_BYTES = 131072;
constexpr int LDSCTL_OFF = RING_BYTES, MISC_OFF = LDSCTL_OFF + 320;
constexpr int HALO_OFF = 131584;
constexpr int LDS_BYTES = 147456;

#define GAS __attribute__((address_space(1)))
#define LAS __attribute__((address_space(3)))
typedef unsigned short bf16;
typedef unsigned v4u __attribute__((ext_vector_type(4)));
typedef unsigned v2u __attribute__((ext_vector_type(2)));
typedef float f32x4 __attribute__((ext_vector_type(4)));
typedef short bf16x8 __attribute__((ext_vector_type(8)));
typedef GAS unsigned gu32;
#define RLX_AGENT __ATOMIC_RELAXED, __HIP_MEMORY_SCOPE_AGENT
#define LDS_WAIT() asm volatile("s_waitcnt lgkmcnt(0)" ::: "memory")
#define VM_WAIT() asm volatile("s_waitcnt vmcnt(0)" ::: "memory")
__device__ __forceinline__ unsigned f2bf(float f) { unsigned u = __builtin_bit_cast(unsigned, f); return (u + 0x7fffu + ((u >> 16) & 1u)) >> 16; }
__device__ __forceinline__ unsigned pk2(float lo, float hi) { return f2bf(lo) | (f2bf(hi) << 16); }
__device__ __forceinline__ float bf2f(unsigned b) { return __builtin_bit_cast(float, b << 16); }
#define XB_TMO      128
#define XB_XCNT(j)  (256  + 64 * (j))
#define XB_XSUB(j)  (1280 + 64 * (j))
#define XB_XGEN(j)  (2304 + 64 * (j))
#define XB_TOP      3328
#define XB_TOPGEN   3392
#define XCD_BAR_WORDS 3456
#define XB_SPIN_CAP (1u << 18)

__device__ __forceinline__ unsigned xb_ld(unsigned* p)              { return __hip_atomic_load(p, __ATOMIC_RELAXED, __HIP_MEMORY_SCOPE_AGENT); }
__device__ __forceinline__ unsigned xb_add(unsigned* p, unsigned v) { return __hip_atomic_fetch_add(p, v, __ATOMIC_RELAXED, __HIP_MEMORY_SCOPE_AGENT); }
__device__ __forceinline__ unsigned xb_xcc_id() { return (unsigned)__builtin_amdgcn_s_getreg((3 << 11) | 20) & 0xFu; }
#define XB_SPIN(cond, bar) do { unsigned _sp = 0; while (cond) { __builtin_amdgcn_s_sleep(1); \
    if ((++_sp & 255u) == 0u) { if (xb_ld(&(bar)[XB_TMO])) break; if (_sp > XB_SPIN_CAP) { atomicAdd(&(bar)[XB_TMO], 1u); break; } } } } while (0)

struct XcdBarrier {
    unsigned* bar; unsigned x;
    volatile LAS unsigned* st;
};

__device__ __forceinline__ XcdBarrier xcd_barrier_post(unsigned* bar, volatile LAS unsigned* st) {
    XcdBarrier b; b.bar = bar; b.x = xb_xcc_id(); b.st = st;
    if (threadIdx.x == 0) (void)xb_add(&bar[XB_XCNT(b.x)], 1u);
    return b;
}
__device__ __forceinline__ void xcd_barrier_complete(unsigned* bar, unsigned x, unsigned& nloc, unsigned& nx) {
    const unsigned G = gridDim.x * gridDim.y * gridDim.z;
    unsigned sum, cnt, mine, sp = 0u;
    for (;;) {
        sum = 0u; cnt = 0u; mine = 0u;
#pragma unroll
        for (unsigned j = 0; j < 16; ++j) { const unsigned c = xb_ld(&bar[XB_XCNT(j)]); sum += c; cnt += (c > 0u) ? 1u : 0u; mine = (j == x) ? c : mine; }
        if (sum == G) break;
        __builtin_amdgcn_s_sleep(1);
        if ((++sp & 255u) == 0u) { if (xb_ld(&bar[XB_TMO])) break; if (sp > XB_SPIN_CAP) { atomicAdd(&bar[XB_TMO], 1u); break; } }
    }
    nloc = mine > 0u ? mine : 1u; nx = cnt > 0u ? cnt : 1u;
}

__device__ __forceinline__ void xcd_barrier(const XcdBarrier& b) {
    asm volatile("s_waitcnt vmcnt(0)" ::: "memory");
    __syncthreads();
    if (threadIdx.x == 0) {
        unsigned* bar = b.bar;
        __builtin_amdgcn_s_waitcnt(0);
        unsigned nloc = b.st[0], nx = b.st[1];
        if (nloc == 0u) { xcd_barrier_complete(bar, b.x, nloc, nx); b.st[0] = nloc; b.st[1] = nx; }
        const unsigned old = xb_add(&bar[XB_XSUB(b.x)], 1u);
        const unsigned gen = old / nloc;
        if (old + 1u == (gen + 1u) * nloc) {
            __builtin_amdgcn_fence(__ATOMIC_RELEASE, "agent");
            asm volatile("s_waitcnt vmcnt(0)" ::: "memory");
            const unsigned og = xb_add(&bar[XB_TOP], 1u);
            const unsigned tg = og / nx;
            if (og + 1u == (tg + 1u) * nx) xb_add(&bar[XB_TOPGEN], 1u);
            else XB_SPIN(xb_ld(&bar[XB_TOPGEN]) == tg, bar);
            __builtin_amdgcn_fence(__ATOMIC_ACQUIRE, "agent");
            xb_add(&bar[XB_XGEN(b.x)], 1u);
            asm volatile("s_waitcnt vmcnt(0)" ::: "memory");
        } else {
            XB_SPIN(xb_ld(&bar[XB_XGEN(b.x)]) == gen, bar);
            __builtin_amdgcn_fence(__ATOMIC_ACQUIRE, "agent");
            asm volatile("s_waitcnt vmcnt(0)" ::: "memory");
        }
    }
    __syncthreads();
}

__device__ __forceinline__ float wave_sum(float v) {
    v += dppf<0xB1>(v); v += dppf<0x4E>(v); v += dppf<0x141>(v); v += dppf<0x140>(v);
    return xsum32(xsum16(v));
}
__device__ __forceinline__ float wave_max(float v) {
    v = fmaxf(v, dppf<0xB1>(v)); v = fmaxf(v, dppf<0x4E>(v)); v = fmaxf(v, dppf<0x141>(v)); v = fmaxf(v, dppf<0x140>(v));
    return xmax32(xmax16(v));
}
template <int F8S>
__device__ __forceinline__ void p0_transpose_item(const float* W, int ldw, int K, bf16* WT, int k0, int n0, int drow, LAS float* scr, int lane) {
#pragma unroll 8
    for (int i = 0; i < 32; ++i) { const int kk = 2 * i + (lane >> 5); scr[kk * 33 + (lane & 31)] = W[(size_t)(k0 + kk) * ldw + n0 + (lane & 31)]; }
    LDS_WAIT(); asm volatile("" ::: "memory");
    const int c = lane & 7;
#pragma unroll
    for (int j = 0; j < 4; ++j) { const int n = (lane >> 3) + 8 * j; const LAS float* s = scr + (8 * c) * 33 + n;
        if (F8S) { const float sc8 = (float)(1 << F8S); int w0 = 0, w1 = 0;
            w0 = __builtin_amdgcn_cvt_pk_fp8_f32(s[0 * 33] * sc8, s[1 * 33] * sc8, w0, false); w0 = __builtin_amdgcn_cvt_pk_fp8_f32(s[2 * 33] * sc8, s[3 * 33] * sc8, w0, true);
            w1 = __builtin_amdgcn_cvt_pk_fp8_f32(s[4 * 33] * sc8, s[5 * 33] * sc8, w1, false); w1 = __builtin_amdgcn_cvt_pk_fp8_f32(s[6 * 33] * sc8, s[7 * 33] * sc8, w1, true);
            *(GAS v2u*)((unsigned char*)WT + (size_t)(drow + n) * K + k0 + 8 * c) = (v2u){(unsigned)w0, (unsigned)w1}; }
        else { v4u o; o.x = pk2(s[0 * 33], s[1 * 33]); o.y = pk2(s[2 * 33], s[3 * 33]); o.z = pk2(s[4 * 33], s[5 * 33]); o.w = pk2(s[6 * 33], s[7 * 33]);
        *(GAS v4u*)(WT + (size_t)(drow + n) * K + k0 + 8 * c) = o; } }
    LDS_WAIT(); asm volatile("" ::: "memory");
}
template <int HP, int F8S = 0>
__device__ __forceinline__ void p0_matrix(const float* W, int ldw, int K, int ncols, bf16* WT, LAS float* scr, int lane, int gw, int NGW, int& base) {
    const int nblk = ncols / 32, items = (K / 64) * nblk;
    int first = gw - (base % NGW); if (first < 0) first += NGW;
    for (int r = first; r < items; r += NGW) {
        const int kb = r / nblk, nb = r % nblk, n0 = 32 * nb;
        int drow = n0;
        if (HP == 1) { const int tile = n0 >> 8, nl = n0 & 255, wc = nl >> 6, bj = (nl >> 5) & 1; drow = tile * 256 + 128 * bj + 32 * wc; }
        if (HP == 2) { const int isg = n0 >= FF, j = isg ? n0 - FF : n0; drow = (j >> 7) * 256 + (isg ? 128 : 0) + (j & 127); }
        p0_transpose_item<F8S>(W, ldw, K, WT, 64 * kb, n0, drow, scr, lane);
    }
    base += items;
}

struct Ptrs {
    const float *x, *c, *w_ada, *b_ada, *g_mix, *g_ffn, *fox_w_in, *fox_b_f, *fox_g_q, *fox_g_k, *fox_w_out,
                *dsa_w_in, *dsa_g_q, *dsa_g_k, *dsa_g_kidx, *dsa_w_out, *ffn_w_up, *ffn_conv_w, *ffn_conv_b, *ffn_w_down;
    float* out; unsigned char* ws;
};

__device__ __forceinline__ void p0_prologue(const Ptrs& P, LAS unsigned char* lds, int tid, int lane, int wave, int vcu, int G) {
    unsigned char* ws = P.ws;
    LAS float* scr = (LAS float*)(lds + RING_OFF + wave * 16384);
    const int gw = vcu * NWAVES + wave, NGW = G * NWAVES;
    int base = 0;
    p0_matrix<1, 5>(P.fox_w_in, FOX_IN, D, 3 * D, (bf16*)(ws + WS_WFIN), scr, lane, gw, NGW, base);
    p0_matrix<0, 5>(P.fox_w_out, D, D, D, (bf16*)(ws + WS_WFOUT), scr, lane, gw, NGW, base);
    p0_matrix<2, 5>(P.ffn_w_up, FF2, D, FF2, (bf16*)(ws + WS_WUP0), scr, lane, gw, NGW, base);
    p0_matrix<0, 6>(P.ffn_w_down, D, FF, D, (bf16*)(ws + WS_WDN0), scr, lane, gw, NGW, base);
    p0_matrix<1, 5>(P.dsa_w_in, DSA_IN, D, 3 * D / 2, (bf16*)(ws + WS_WDIN), scr, lane, gw, NGW, base);
    p0_matrix<1>(P.dsa_w_in + 3 * D / 2, DSA_IN, D, D / 2, (bf16*)(ws + WS_WDIN + 2 * MiB), scr, lane, gw, NGW, base);
    p0_matrix<0, 5>(P.dsa_w_out, D, D, D, (bf16*)(ws + WS_WDOUT), scr, lane, gw, NGW, base);
    p0_matrix<2, 5>(P.ffn_w_up + (size_t)D * FF2, FF2, D, FF2, (bf16*)(ws + WS_WUP1), scr, lane, gw, NGW, base);
    p0_matrix<0, 6>(P.ffn_w_down + (size_t)FF * D, D, FF, D, (bf16*)(ws + WS_WDN1), scr, lane, gw, NGW, base);
    { bf16* wt = (bf16*)(ws + WS_WDTAIL); const int gt = vcu * NTHREADS + tid, NT_ = G * NTHREADS;
      for (int i = gt; i < 80 * D; i += NT_) { const int n = i / D, k = i % D; wt[i] = (n < 72) ? (bf16)f2bf(P.dsa_w_in[(size_t)k * DSA_IN + 2048 + n]) : (bf16)0; } }
    __syncthreads();
    { LAS float* cact = (LAS float*)(lds + RING_OFF);
      LAS float* part = (LAS float*)(lds + RING_OFF + 8192);
      for (int i = tid; i < 2 * D; i += NTHREADS) { const float v = P.c[i]; cact[i] = v / (1.f + __expf(-v)); }
      __syncthreads();
      float* MOD = (float*)(ws + WS_MOD);
      for (int task = vcu; task < 2 * 96; task += G) {
          const int layer = task / 96, cg = task % 96, col = cg * 64 + lane;
          const float* w = P.w_ada + (size_t)layer * D * 6144 + col;
          float a0 = 0.f, a1 = 0.f;
#pragma unroll 32
          for (int k = wave * 128; k < wave * 128 + 128; ++k) { const float wv = w[(size_t)k * 6144]; a0 += cact[k] * wv; a1 += cact[D + k] * wv; }
          part[(wave * 2 + 0) * 64 + lane] = a0; part[(wave * 2 + 1) * 64 + lane] = a1;
          __syncthreads();
          if (wave < 2) { float s = 0.f;
#pragma unroll
              for (int w8 = 0; w8 < 8; ++w8) s += part[(w8 * 2 + wave) * 64 + lane];
              MOD[((size_t)layer * 2 + wave) * 6144 + col] = s + P.b_ada[layer * 6144 + col]; }
          __syncthreads();
      } }
}

template <bool FGATE, bool XIN16, int OUT8 = 0>
__device__ __forceinline__ void norm_phase(const void* xin, const float* gnorm, const float* modL, int sh_chunk, int sc_chunk, bf16* hout, unsigned char* hout8,
                                           const float* fox_w_in, const float* b_f, float* logf, LAS unsigned char* lds, int tid, int lane, int wave, int vcu, int G) {
    LAS float* wft = (LAS float*)(lds + RING_OFF);
    if (FGATE) {
        for (int i = tid; i < 16 * D; i += NTHREADS) { const int c = i >> 4, hh = i & 15; wft[hh * D + c] = fox_w_in[(size_t)c * FOX_IN + 3 * D + hh]; }
        __syncthreads();
    }
    const int gw = vcu * NWAVES + wave, NGW = G * NWAVES;
    for (int b = 0; b < BATCH; ++b) {
        f32x4 Gv[4], Sv[4];
#pragma unroll
        for (int j = 0; j < 4; ++j) { const int c = 4 * lane + 256 * j;
            const f32x4 g4 = *(const f32x4*)(gnorm + c), sc4 = *(const f32x4*)(modL + (size_t)b * 6144 + sc_chunk * D + c);
            Gv[j] = g4 * (sc4 + 1.0f); Sv[j] = *(const f32x4*)(modL + (size_t)b * 6144 + sh_chunk * D + c); }
        for (int t = gw; t < T; t += NGW) {
            const size_t m = (size_t)b * T + t;
            f32x4 v[4]; float ss = 0.f;
            if (XIN16) { const GAS v2u* xr = (const GAS v2u*)((const bf16*)xin + m * D) + lane;
#pragma unroll
                for (int j = 0; j < 4; ++j) { const v2u r = xr[64 * j]; v[j] = (f32x4){__uint_as_float(r.x << 16), __uint_as_float(r.x & 0xffff0000u), __uint_as_float(r.y << 16), __uint_as_float(r.y & 0xffff0000u)}; }
            } else { const GAS f32x4* xr = (const GAS f32x4*)((const float*)xin + m * D) + lane;
#pragma unroll
                for (int j = 0; j < 4; ++j) v[j] = xr[64 * j]; }
#pragma unroll
            for (int j = 0; j < 4; ++j) ss += (v[j].x * v[j].x + v[j].y * v[j].y) + (v[j].z * v[j].z + v[j].w * v[j].w);
            const float rstd = __builtin_amdgcn_rsqf(wave_sum(ss) * (1.f / D) + EPS);
            GAS unsigned long long* o8 = (GAS unsigned long long*)(hout + m * D) + lane;
#pragma unroll
            for (int j = 0; j < 4; ++j) { v[j] = v[j] * rstd * Gv[j] + Sv[j];
                if (OUT8) { int w8 = 0; w8 = __builtin_amdgcn_cvt_pk_fp8_f32(v[j].x, v[j].y, w8, false); w8 = __builtin_amdgcn_cvt_pk_fp8_f32(v[j].z, v[j].w, w8, true);
                    ((GAS unsigned*)(hout8 + m * D))[lane + 64 * j] = (unsigned)w8; }
                if (OUT8 != 1) o8[64 * j] = (unsigned long long)pk2(v[j].x, v[j].y) | ((unsigned long long)pk2(v[j].z, v[j].w) << 32); }
            if (FGATE) {
                float acc[16];
                typedef float f32x2 __attribute__((ext_vector_type(2)));
#pragma unroll
                for (int hh = 0; hh < 16; ++hh) { f32x2 a2 = (f32x2){0.f, 0.f};
#pragma unroll
                    for (int j = 0; j < 4; ++j) { const f32x4 w4 = *(const LAS f32x4*)(wft + hh * D + 256 * j + 4 * lane);
                        a2 = (f32x2){v[j].x, v[j].y} * (f32x2){w4.x, w4.y} + a2; a2 = (f32x2){v[j].z, v[j].w} * (f32x2){w4.z, w4.w} + a2; }
                    acc[hh] = a2.x + a2.y; if ((hh & 3) == 3) asm volatile("" : "+v"(acc[hh]) :: "memory"); }
                float b8[8], c4[4];
#pragma unroll
                for (int i = 0; i < 8; ++i) { const auto rr = __builtin_amdgcn_permlane32_swap(__builtin_bit_cast(unsigned, acc[i]), __builtin_bit_cast(unsigned, acc[i + 8]), false, false); const unsigned r0 = rr[0], r1 = rr[1];
                    b8[i] = __builtin_bit_cast(float, r0) + __builtin_bit_cast(float, r1); }
#pragma unroll
                for (int i = 0; i < 4; ++i) { const auto rr = __builtin_amdgcn_permlane16_swap(__builtin_bit_cast(unsigned, b8[i]), __builtin_bit_cast(unsigned, b8[i + 4]), false, false); const unsigned r0 = rr[0], r1 = rr[1];
                    c4[i] = __builtin_bit_cast(float, r0) + __builtin_bit_cast(float, r1); }
#pragma unroll
                for (int i = 0; i < 4; ++i) { float t = c4[i]; t += dppf<0xB1>(t); t += dppf<0x4E>(t); t += dppf<0x141>(t); t += dppf<0x140>(t); c4[i] = t; }
                const int j4 = lane & 15; float r = c4[0]; r = (j4 == 1) ? c4[1] : r; r = (j4 == 2) ? c4[2] : r; r = (j4 == 3) ? c4[3] : r;
                const int row16 = lane >> 4, head = (row16 >> 1) * 8 + (row16 & 1) * 4 + j4;
                if (j4 < 4) { const float z = r + b_f[head]; logf[m * 16 + head] = fminf(z, 0.f) - log1pf(__expf(-fabsf(z))); }
            }
        }
    }
    if (FGATE) __syncthreads();
}

__device__ __forceinline__ void fox_scan(const float* logf, float* BETA, unsigned char* KE, int seq, LAS float* red  , int tid, int lane, int wave) {
    const int b = seq >> 4, hh = seq & 15;
    float v[16]; float run = 0.f;
#pragma unroll
    for (int k = 0; k < 16; ++k) { run += logf[((size_t)b * T + 16 * tid + k) * 16 + hh]; v[k] = run; }
    float inc = run;
#pragma unroll
    for (int o = 1; o < 64; o <<= 1) { const float n = __shfl_up(inc, o); if (lane >= o) inc += n; }
    if (lane == 63) red[wave] = inc;
    __syncthreads();
    float pre = inc - run;
#pragma unroll
    for (int w8 = 0; w8 < 8; ++w8) if (w8 < wave) pre += red[w8];
#pragma unroll
    for (int k = 0; k < 16; ++k) {
        const int t = 16 * tid + k; const float be = -(pre + v[k]) * LOG2E;
        BETA[(size_t)seq * T + t] = be;
        const unsigned h0 = f2bf(be); const float r1 = be - bf2f(h0); const unsigned h1 = f2bf(r1); const float r2 = r1 - bf2f(h1); const unsigned h2 = f2bf(r2);
        unsigned char* tile = KE + ((size_t)seq * (T / 64) + (t >> 6)) * 2048 + (t & 63) * 16;
        v4u e; e.x = h0 | (h1 << 16); e.y = h2 | 0x3f800000u; e.z = 0x3f803f80u; e.w = 0u;
        *(GAS v4u*)tile = e; *(GAS v4u*)(tile + 1024) = (v4u){0u, 0u, 0u, 0u};
    }
    __syncthreads();
}

__device__ __forceinline__ void conv_fixup(bf16* U, const float* sideA0, const float* sideG0, const float* sideA1, const float* cw, const float* cb, int pm, int tid) {
    const bool bstart = (pm % (T / 256)) == 0;
    for (int i = tid; i < 2 * (FF / 4); i += NTHREADS) {
        const int r = i / (FF / 4), c = (i % (FF / 4)) * 4;
        const f32x4 a0 = *(const f32x4*)(sideA0 + ((size_t)pm * 2 + r) * FF + c), g0 = *(const f32x4*)(sideG0 + ((size_t)pm * 2 + r) * FF + c);
        const f32x4 z = (f32x4){0.f, 0.f, 0.f, 0.f};
        f32x4 m1, m2;
        if (r == 1) { m1 = *(const f32x4*)(sideA0 + ((size_t)pm * 2) * FF + c); m2 = bstart ? z : *(const f32x4*)(sideA1 + ((size_t)(pm - 1) * 2 + 1) * FF + c); }
        else { m1 = bstart ? z : *(const f32x4*)(sideA1 + ((size_t)(pm - 1) * 2 + 1) * FF + c); m2 = bstart ? z : *(const f32x4*)(sideA1 + ((size_t)(pm - 1) * 2) * FF + c); }
        const f32x4 w0 = *(const f32x4*)(cw + c), w1 = *(const f32x4*)(cw + FF + c), w2 = *(const f32x4*)(cw + 2 * FF + c), bb = *(const f32x4*)(cb + c);
        float uo[4];
#pragma unroll
        for (int e = 0; e < 4; ++e) { const float s = fmaf(w0[e], m2[e], fmaf(w1[e], m1[e], fmaf(w2[e], a0[e], bb[e]))); uo[e] = s * __builtin_amdgcn_rcpf(1.f + __builtin_amdgcn_exp2f(-LOG2E * s)) * g0[e]; }
        { int w8 = 0; w8 = __builtin_amdgcn_cvt_pk_fp8_f32(uo[0], uo[1], w8, false); w8 = __builtin_amdgcn_cvt_pk_fp8_f32(uo[2], uo[3], w8, true);
          *(GAS unsigned*)((unsigned char*)U + ((size_t)pm * 256 + r) * FF + c) = (unsigned)w8; }
    }
    asm volatile("s_waitcnt vmcnt(0)" ::: "memory");
    __syncthreads();
}
namespace dsa {
typedef float f32x16 __attribute__((ext_vector_type(16)));
typedef unsigned long long u64;
constexpr int QT = 16;
constexpr int TOPK = 256;
constexpr int HIST_OFF = 0;
constexpr int SEL_OFF = 135168;
constexpr int ST_OFF = 143360;
constexpr int CAP = 1024;
constexpr float WSCALE = 0.04419417382415922f;

__device__ __forceinline__ void tail_phase(const bf16* Hb, const bf16* WT, const float* g_kidx, bf16* KI, float* WI, int lane, int gw, int NGW) {
    const int n16 = lane & 15, q4 = lane >> 4;
    for (int task = gw; task < M / 16; task += NGW) {
        const int row0 = task * 16;
        f32x4 acc[5];
#pragma unroll
        for (int cb = 0; cb < 5; ++cb) acc[cb] = (f32x4){0.f, 0.f, 0.f, 0.f};
        const bf16* ap = Hb + (size_t)(row0 + n16) * D + 8 * q4;
        const bf16* bp = WT + (size_t)n16 * D + 8 * q4;
#pragma unroll 4
        for (int s = 0; s < 32; ++s) {
            const bf16x8 a = *(const GAS bf16x8*)(ap + 32 * s);
#pragma unroll
            for (int cb = 0; cb < 5; ++cb) { const bf16x8 b = *(const GAS bf16x8*)(bp + (size_t)cb * 16 * D + 32 * s); acc[cb] = __builtin_amdgcn_mfma_f32_16x16x32_bf16(a, b, acc[cb], 0, 0, 0); }
        }
        float gk[4];
#pragma unroll
        for (int cb = 0; cb < 4; ++cb) gk[cb] = g_kidx[16 * cb + n16];
#pragma unroll
        for (int i = 0; i < 4; ++i) {
            const int tok = row0 + 4 * q4 + i;
            float ss = (acc[0][i] * acc[0][i] + acc[1][i] * acc[1][i]) + (acc[2][i] * acc[2][i] + acc[3][i] * acc[3][i]);
            ss += __shfl_xor(ss, 1); ss += __shfl_xor(ss, 2); ss += __shfl_xor(ss, 4); ss += __shfl_xor(ss, 8);
            const float rs = __builtin_amdgcn_rsqf(ss * (1.f / 64.f) + EPS);
#pragma unroll
            for (int cb = 0; cb < 4; ++cb) KI[(size_t)tok * 64 + 16 * cb + n16] = (bf16)f2bf(acc[cb][i] * rs * gk[cb]);
            if (n16 < 8) WI[(size_t)tok * 8 + n16] = acc[4][i] * WSCALE;
        }
    }
}

__device__ __forceinline__ v4u f8x8_to_bf16(unsigned a, unsigned b) {
    typedef float f32x2 __attribute__((ext_vector_type(2)));
    const f32x2 a0 = __builtin_amdgcn_cvt_pk_f32_fp8((int)a, false), a1 = __builtin_amdgcn_cvt_pk_f32_fp8((int)a, true), b0 = __builtin_amdgcn_cvt_pk_f32_fp8((int)b, false), b1 = __builtin_amdgcn_cvt_pk_f32_fp8((int)b, true);
    v4u r; r.x = __builtin_amdgcn_perm(__float_as_uint(a0.y), __float_as_uint(a0.x), 0x07060302u); r.y = __builtin_amdgcn_perm(__float_as_uint(a1.y), __float_as_uint(a1.x), 0x07060302u);
    r.z = __builtin_amdgcn_perm(__float_as_uint(b0.y), __float_as_uint(b0.x), 0x07060302u); r.w = __builtin_amdgcn_perm(__float_as_uint(b1.y), __float_as_uint(b1.x), 0x07060302u); return r;
}
__device__ __forceinline__ u64 make_key(float s, int kidx) {
    const unsigned u = __float_as_uint(s); const unsigned sk = u ^ ((unsigned)((int)u >> 31) | 0x80000000u);
    return ((u64)sk << 13) | (u64)(8191 - kidx);
}
__device__ __forceinline__ float relu_i(float x) { const int b = __float_as_int(x); return __int_as_float(b > 0 ? b : 0); }
__device__ __forceinline__ unsigned skey32(float s) { const unsigned u = __float_as_uint(s); return u ^ ((unsigned)((int)u >> 31) | 0x80000000u); }
template <int MODE, bool L0, int PROBE, bool ALLV, int SMUL>
__device__ __forceinline__ void idx_loop(const bf16x8 (&qa)[4][4], const bf16* KIb, int t0q, int nst, int st_begin, int st_end, int key_l, int hi, LAS unsigned char* lds, const u64 (&Pq)[4][2], unsigned hbase,
                                         bf16x8 (&kb)[4], bf16x8 (&kn)[4], f32x16& acc, int level, int hi_shift, int lo_shift, unsigned mask) {
    for (int st_ = st_begin; st_ < st_end; st_ += 8) {
        const int kidx = 32 * SMUL * st_ + key_l;
        unsigned sks[4][2];
        constexpr bool allvalid = ALLV;
#pragma unroll
        for (int rb = 0; rb < 4; ++rb) {
            f32x16 accN = f32x16{};
            if (rb < 3) {
#pragma unroll
                for (int ks = 0; ks < 4; ++ks) accN = __builtin_amdgcn_mfma_f32_32x32x16_bf16(qa[rb + 1][ks], kb[ks], accN, 0, 0, 0);
            } else {
#pragma unroll
                for (int ks = 0; ks < 4; ++ks) kb[ks] = kn[ks];
                { const int kx = (st_ + 16 < nst) ? kidx + 512 * SMUL : kidx;
#pragma unroll
                  for (int ks = 0; ks < 4; ++ks) kn[ks] = *(const GAS bf16x8*)(KIb + (size_t)(PROBE == 2 ? key_l : kx) * 64 + 16 * ks + 8 * hi); }
#pragma unroll
                for (int ks = 0; ks < 4; ++ks) accN = __builtin_amdgcn_mfma_f32_32x32x16_bf16(qa[0][ks], kb[ks], accN, 0, 0, 0);
            }
            __builtin_amdgcn_sched_barrier(0);
            float sc[2];
            { LAS const f32x4* wp = (LAS const f32x4*)(lds + ST_OFF + 1024 + (4 * rb + 2 * hi) * 32);
              const f32x4 w0 = wp[0], w1 = wp[1], w2 = wp[2], w3 = wp[3];
              float s0 = relu_i(acc[0]) * w0[0];
#pragma unroll
              for (int i = 1; i < 4; ++i) s0 = fmaf(relu_i(acc[i]), w0[i], s0);
#pragma unroll
              for (int i = 0; i < 4; ++i) s0 = fmaf(relu_i(acc[4 + i]), w1[i], s0);
              asm volatile("" : "+v"(s0));
              float s1 = relu_i(acc[8]) * w2[0];
#pragma unroll
              for (int i = 1; i < 4; ++i) s1 = fmaf(relu_i(acc[8 + i]), w2[i], s1);
#pragma unroll
              for (int i = 0; i < 4; ++i) s1 = fmaf(relu_i(acc[12 + i]), w3[i], s1);
              sc[0] = s0; sc[1] = s1; }
#pragma unroll
            for (int e = 0; e < 2; ++e) {
                const int ql = 4 * rb + 2 * hi + e; const int t = t0q + ql;
                const unsigned sk = skey32(sc[e]);
                if (L0 && MODE == 0) {
                    const unsigned skv = allvalid ? sk : ((kidx <= t) ? sk : 0u);
                    const unsigned addr = hbase + (unsigned)(4 * rb + e) * 8192u + ((skv >> 21) << 2);
                    const unsigned vv = (skv & 0x100000u) ? 0x10000u : 1u;
                    if (PROBE == 1) { asm volatile("" :: "v"(addr), "v"(vv)); }
                    else __hip_atomic_fetch_add((LAS unsigned*)(uintptr_t)addr, vv, __ATOMIC_RELAXED, __HIP_MEMORY_SCOPE_WORKGROUP);
                } else if (L0 && (MODE == 1 || MODE == 3)) {
                    sks[rb][e] = sk;
                } else {
                    const bool valid = kidx <= t;
                    const u64 K = ((u64)sk << 13) | (u64)(8191 - kidx);
                    if (MODE == 0) {
                        bool ok = valid;
                        if (level > 0) ok = ok && ((K >> hi_shift) == Pq[rb][e]);
                        if (ok) { const unsigned bin = (unsigned)(K >> lo_shift) & mask;
                            __hip_atomic_fetch_add((LAS unsigned*)(lds + HIST_OFF + ql * 8192) + (bin >> 1), 1u << (16 * (bin & 1)), __ATOMIC_RELAXED, __HIP_MEMORY_SCOPE_WORKGROUP); }
                    } else if (valid) {
                        const u64 pfx = K >> lo_shift;
                        LAS unsigned* st = (LAS unsigned*)(lds + ST_OFF + ql * 32);
                        if (pfx > Pq[rb][e]) {
                            const unsigned slot = __hip_atomic_fetch_add(st + 3, 1u, __ATOMIC_RELAXED, __HIP_MEMORY_SCOPE_WORKGROUP) & 0xffffu;
                            if (slot < (unsigned)TOPK) ((LAS unsigned short*)(lds + SEL_OFF))[ql * TOPK + slot] = (unsigned short)kidx;
                        } else if (pfx == Pq[rb][e]) {
                            const unsigned slot = __hip_atomic_fetch_add(st + 3, 0x10000u, __ATOMIC_RELAXED, __HIP_MEMORY_SCOPE_WORKGROUP) >> 16;
                            if (slot < (unsigned)CAP) ((LAS u64*)(lds + HIST_OFF))[ql * CAP + slot] = K;
                        }
                    }
                }
            }
            if (L0 && (MODE == 1 || MODE == 3) && (rb & 1)) {
                unsigned old[2][2];
#pragma unroll
                for (int r2 = 0; r2 < 2; ++r2)
#pragma unroll
                    for (int e = 0; e < 2; ++e) { const int rbb = rb - 1 + r2, ql = 4 * rbb + 2 * hi + e; const unsigned bin = sks[rbb][e] >> 20, Tb = (unsigned)Pq[rbb][e]; const bool valid = allvalid || (kidx <= t0q + ql);
                        old[r2][e] = 0u;
                        if (valid && bin >= Tb) old[r2][e] = __hip_atomic_fetch_add((LAS unsigned*)(lds + ST_OFF + ql * 32) + 3, (MODE == 1 && bin > Tb) ? 1u : 0x10000u, __ATOMIC_RELAXED, __HIP_MEMORY_SCOPE_WORKGROUP); }
#pragma unroll
                for (int r2 = 0; r2 < 2; ++r2)
#pragma unroll
                    for (int e = 0; e < 2; ++e) { const int rbb = rb - 1 + r2, ql = 4 * rbb + 2 * hi + e; const unsigned bin = sks[rbb][e] >> 20, Tb = (unsigned)Pq[rbb][e]; const bool valid = allvalid || (kidx <= t0q + ql);
                        if (MODE == 1 && valid && bin > Tb) { const unsigned slot = old[r2][e] & 0xffffu; if (slot < (unsigned)TOPK) ((LAS unsigned short*)(lds + SEL_OFF))[ql * TOPK + slot] = (unsigned short)kidx; }
                        else if (valid && (MODE == 3 ? bin >= Tb : bin == Tb)) { const unsigned slot = old[r2][e] >> 16; if (slot < (unsigned)CAP) ((LAS u64*)(lds + HIST_OFF))[ql * CAP + slot] = ((u64)sks[rbb][e] << 13) | (u64)(8191 - kidx); } }
            }
            acc = accN;
        }
    }
}
template <int MODE, bool L0, int PROBE = 0, int SMUL = 1>
__device__ __forceinline__ void idx_pass(const bf16x8 (&qa)[4][4], const bf16* KIb, int t0q, int nst, int wave, int lane_in, LAS unsigned char* lds, int level, int hi_shift, int lo_shift, unsigned mask) {
    int lane = lane_in; asm volatile("" : "+v"(lane));
    const int key_l = lane & 31, hi = lane >> 5;
    u64 Pq[4][2];
#pragma unroll
    for (int rb = 0; rb < 4; ++rb)
#pragma unroll
        for (int e = 0; e < 2; ++e) { const int ql = 4 * rb + 2 * hi + e; LAS const unsigned* st = (LAS const unsigned*)(lds + ST_OFF + ql * 32);
            Pq[rb][e] = (u64)st[0] | ((u64)st[1] << 32); }
    const unsigned hbase = (unsigned)(uintptr_t)(lds + HIST_OFF) + (unsigned)hi * 16384u;
    bf16x8 kb[4], kn[4];
    { const int kc = (wave < nst) ? 32 * SMUL * wave + key_l : key_l;
      const int kc2 = (wave + 8 < nst) ? kc + 256 * SMUL : kc;
#pragma unroll
      for (int ks = 0; ks < 4; ++ks) { kb[ks] = *(const GAS bf16x8*)(KIb + (size_t)kc * 64 + 16 * ks + 8 * hi); kn[ks] = *(const GAS bf16x8*)(KIb + (size_t)(PROBE == 2 ? key_l : kc2) * 64 + 16 * ks + 8 * hi); } }
    f32x16 acc = f32x16{};
#pragma unroll
    for (int ks = 0; ks < 4; ++ks) acc = __builtin_amdgcn_mfma_f32_32x32x16_bf16(qa[0][ks], kb[ks], acc, 0, 0, 0);
    if (SMUL != 1) {
        idx_loop<MODE, L0, PROBE, true, SMUL>(qa, KIb, t0q, nst, wave, nst, key_l, hi, lds, Pq, hbase, kb, kn, acc, level, hi_shift, lo_shift, mask);
        return;
    }
    const int nfull = (t0q + 1) >> 5; int st_split = wave; if (nfull > wave) st_split = wave + ((nfull - wave + 7) >> 3) * 8;
    idx_loop<MODE, L0, PROBE, true, 1>(qa, KIb, t0q, nst, wave, nfull, key_l, hi, lds, Pq, hbase, kb, kn, acc, level, hi_shift, lo_shift, mask);
    idx_loop<MODE, L0, PROBE, false, 1>(qa, KIb, t0q, nst, st_split, nst, key_l, hi, lds, Pq, hbase, kb, kn, acc, level, hi_shift, lo_shift, mask);
}

__device__ __forceinline__ void find_bin(LAS unsigned char* lds, int row, int lane_in, int bits) {
    int lane = lane_in; asm volatile("" : "+v"(lane));
    LAS unsigned* st = (LAS unsigned*)(lds + ST_OFF + row * 32);
    if (st[6] != 0u) return;
    const unsigned need = st[2];
    LAS const unsigned* hrow = (LAS const unsigned*)(lds + HIST_OFF + row * 8192) + 32 * lane;
    v4u hw[8]; unsigned tot = 0;
#pragma unroll
    for (int i = 0; i < 8; ++i) { hw[i] = *(LAS const v4u*)(hrow + 4 * i);
#pragma unroll
        for (int e = 0; e < 4; ++e) tot += (hw[i][e] & 0xffffu) + (hw[i][e] >> 16); }
    unsigned suf = tot;
#pragma unroll
    for (int o = 1; o < 64; o <<= 1) { const unsigned n = (unsigned)__builtin_amdgcn_ds_bpermute(((lane + o) & 63) << 2, (int)suf); if (lane + o < 64) suf += n; }
    const unsigned above = suf - tot;
    if (above < need && need <= suf) {
        unsigned running = above, T = 0, cT = 0; bool found = false;
#pragma unroll
        for (int i = 31; i >= 0; --i) {
            const unsigned w = hw[i >> 2][i & 3], h16 = w >> 16, l16 = w & 0xffffu;
            if (!found) {
                if (running + h16 >= need) { T = 64 * lane + 2 * i + 1; cT = h16; found = true; }
                else { running += h16;
                    if (running + l16 >= need) { T = 64 * lane + 2 * i; cT = l16; found = true; } else running += l16; } }
        }
        const u64 Pold = (u64)st[0] | ((u64)st[1] << 32); const u64 Pn = (Pold << bits) | (u64)T;
        st[0] = (unsigned)Pn; st[1] = (unsigned)(Pn >> 32); st[2] = need - running; st[5] = cT;
    }
}

template <int NCH>
__device__ __forceinline__ unsigned finish_regs(LAS unsigned char* lds, int row, int lane, int nbits, LAS const u64* cand, unsigned nc, unsigned need, unsigned base, u64 Pfix) {
    u64 k[NCH];
#pragma unroll
    for (int ch = 0; ch < NCH; ++ch) { const unsigned i = 64u * ch + lane; k[ch] = (i < nc) ? cand[i] : 0ull; }
    u64 thr = Pfix;
    if (nbits == 45) {
        unsigned hi[NCH];
#pragma unroll
        for (int ch = 0; ch < NCH; ++ch) hi[ch] = (unsigned)(k[ch] >> 13);
        unsigned t = 0u, cge = 0xffffffffu;
        for (int bit = 31; bit >= 0; --bit) {
            const unsigned c = t | (1u << bit); unsigned cnt = 0;
#pragma unroll
            for (int ch = 0; ch < NCH; ++ch) cnt += (unsigned)__builtin_popcountll(__ballot(hi[ch] >= c));
            if (cnt >= need) { t = c; cge = cnt; }
        }
        thr = (u64)t << 13;
        if (cge != need) {
            for (int bit = 12; bit >= 0; --bit) {
                const u64 c = thr | (1ull << bit); unsigned cnt = 0;
#pragma unroll
                for (int ch = 0; ch < NCH; ++ch) cnt += (unsigned)__builtin_popcountll(__ballot(k[ch] >= c));
                if (cnt >= need) thr = c;
            }
        }
    } else {
        for (int bit = nbits - 1; bit >= 0; --bit) {
            const u64 c = thr | (1ull << bit); unsigned cnt = 0;
#pragma unroll
            for (int ch = 0; ch < NCH; ++ch) cnt += (unsigned)__builtin_popcountll(__ballot(k[ch] >= c));
            if (cnt >= need) thr = c;
        }
    }
#pragma unroll
    for (int ch = 0; ch < NCH; ++ch) {
        const unsigned i = 64u * ch + lane; const bool s = (i < nc) && (k[ch] >= thr);
        const unsigned long long m = __ballot(s); const unsigned pos = base + (unsigned)__builtin_popcountll(m & ((1ull << lane) - 1ull));
        if (s && pos < (unsigned)TOPK) ((LAS unsigned short*)(lds + SEL_OFF))[row * TOPK + pos] = (unsigned short)(8191u - (unsigned)(k[ch] & 0x1fffull));
        base += (unsigned)__builtin_popcountll(m);
    }
    return base;
}
__device__ __forceinline__ void finish_row(LAS unsigned char* lds, int row, int lane_in, int nbits) {
    int lane = lane_in; asm volatile("" : "+v"(lane));
    LAS unsigned* st = (LAS unsigned*)(lds + ST_OFF + row * 32);
    if (st[6] != 0u) return;
    const unsigned need = st[2]; unsigned nc = st[3] >> 16; if (nc > (unsigned)CAP) nc = CAP;
    unsigned base = st[3] & 0xffffu; if (base > (unsigned)TOPK) base = TOPK;
    LAS const u64* cand = (LAS const u64*)(lds + HIST_OFF) + row * CAP;
    const int nch = (int)((nc + 63u) >> 6);
    const u64 Pfix = ((u64)st[0] | ((u64)st[1] << 32)) << nbits;
    u64 thr = Pfix;
    if (nch <= 4) base = finish_regs<4>(lds, row, lane, nbits, cand, nc, need, base, Pfix);
    else if (nch <= 8) base = finish_regs<8>(lds, row, lane, nbits, cand, nc, need, base, Pfix);
    else if (nch <= 12) base = finish_regs<12>(lds, row, lane, nbits, cand, nc, need, base, Pfix);
    else if (nch <= 16) base = finish_regs<16>(lds, row, lane, nbits, cand, nc, need, base, Pfix);
    else {
        for (int bit = nbits - 1; bit >= 0; --bit) {
            const u64 c = thr | (1ull << bit); unsigned cnt = 0;
            for (int ch = 0; ch < nch; ++ch) { const unsigned i = 64u * ch + lane; const u64 k = (i < nc) ? cand[i] : 0ull; cnt += (unsigned)__builtin_popcountll(__ballot(k >= c)); }
            if (cnt >= need) thr = c;
        }
        for (int ch = 0; ch < nch; ++ch) {
            const unsigned i = 64u * ch + lane; const u64 k = (i < nc) ? cand[i] : 0ull; const bool s = (i < nc) && (k >= thr);
            const unsigned long long m = __ballot(s); const unsigned pos = base + (unsigned)__builtin_popcountll(m & ((1ull << lane) - 1ull));
            if (s && pos < (unsigned)TOPK) ((LAS unsigned short*)(lds + SEL_OFF))[row * TOPK + pos] = (unsigned short)(8191u - (unsigned)(k & 0x1fffull));
            base += (unsigned)__builtin_popcountll(m);
        }
    }
    if (lane == 0) st[3] = base;
}

__device__ __forceinline__ void sparse_attn_row(LAS unsigned char* lds, int row, int b, int t, const bf16* Q1, bf16* O1, const unsigned char* K1, const unsigned char* V1, int wave, int lane_in) {
    int lane = lane_in; asm volatile("" : "+v"(lane));
    const int n16 = lane & 15, q4 = lane >> 4, gl = n16 >> 2;
    LAS const unsigned short* sel = (LAS const unsigned short*)(lds + SEL_OFF) + row * TOPK;
    unsigned cnt = ((LAS const unsigned*)(lds + ST_OFF + row * 32))[3] & 0xffffu; if (cnt > (unsigned)TOPK) cnt = TOPK;
    const bf16* qrow = Q1 + ((size_t)b * T + t) * D; bf16* orow = O1 + ((size_t)b * T + t) * D;
    bf16x8 bq[8];
    { const bf16x8 q0 = *(const GAS bf16x8*)(qrow + n16 * 64 + 16 * q4), q1 = *(const GAS bf16x8*)(qrow + n16 * 64 + 16 * q4 + 8); const bf16x8 z = (bf16x8){0, 0, 0, 0, 0, 0, 0, 0};
#pragma unroll
      for (int s = 0; s < 8; ++s) bq[s] = ((s >> 1) == gl) ? ((s & 1) ? q1 : q0) : z; }
    const float slope = __builtin_amdgcn_exp2f(-0.5f * (float)(n16 + 1)) * LOG2E;
    const unsigned char* Kb = K1 + (size_t)b * T * 256; const unsigned char* Vb = V1 + (size_t)b * T * 256;
    f32x4 sc[16];
    v4u vst[2][8];
    constexpr int KD = 3;
    v4u kfn[KD][4];
#pragma unroll
    for (int d = 0; d < KD; ++d) { const unsigned pos = 16u * d + n16; const unsigned kidx = (pos < cnt) ? (unsigned)sel[pos] : 0u; const unsigned char* kp = Kb + (size_t)kidx * 256 + 16 * q4;
#pragma unroll
      for (int g = 0; g < 4; ++g) kfn[d][g] = *(const GAS v4u*)(kp + 64 * g); }
#pragma unroll
    for (int blk = 0; blk < 16; ++blk) {
        bf16x8 kf[8];
#pragma unroll
        for (int g = 0; g < 4; ++g) { const v4u lo = f8x8_to_bf16(kfn[blk % KD][g].x, kfn[blk % KD][g].y), hi8 = f8x8_to_bf16(kfn[blk % KD][g].z, kfn[blk % KD][g].w); kf[2 * g] = __builtin_bit_cast(bf16x8, lo); kf[2 * g + 1] = __builtin_bit_cast(bf16x8, hi8); }
        if (blk + KD < 16) { const unsigned pos = 16u * (blk + KD) + n16; const unsigned kidx = (pos < cnt) ? (unsigned)sel[pos] : 0u; const unsigned char* kp = Kb + (size_t)kidx * 256 + 16 * q4;
#pragma unroll
            for (int g = 0; g < 4; ++g) kfn[blk % KD][g] = *(const GAS v4u*)(kp + 64 * g); }
        if (blk >= 14) {
            const int d = blk - 14;
#pragma unroll
            for (int i = 0; i < 8; ++i) { const unsigned pos = 32u * d + 4u * i + q4; const unsigned kidx = (pos < cnt) ? (unsigned)sel[pos] : 0u; vst[d][i] = *(const GAS v4u*)(Vb + (size_t)kidx * 256 + 16 * n16); }
        }
        f32x4 a = (f32x4){0.f, 0.f, 0.f, 0.f};
#pragma unroll
        for (int s = 0; s < 8; ++s) a = __builtin_amdgcn_mfma_f32_16x16x32_bf16(kf[s], bq[s], a, 0, 0, 0);
        const unsigned long long i4 = *(LAS const unsigned long long*)(sel + 16 * blk + 4 * q4);
#pragma unroll
        for (int i = 0; i < 4; ++i) { const unsigned p = 16u * blk + 4u * q4 + i; const int ki = (int)((i4 >> (16 * i)) & 0xffffull);
            a[i] = (p < cnt) ? (a[i] - slope * (float)(t - ki)) : -INFINITY; }
        sc[blk] = a;
    }
    float mx = -INFINITY;
#pragma unroll
    for (int blk = 0; blk < 16; ++blk) mx = fmaxf(fmaxf(fmaxf(mx, sc[blk][0]), fmaxf(sc[blk][1], sc[blk][2])), sc[blk][3]);
    mx = xmax32(xmax16(mx));
    float lsum = 0.f;
#pragma unroll
    for (int blk = 0; blk < 16; ++blk)
#pragma unroll
        for (int i = 0; i < 4; ++i) { const float p = __builtin_amdgcn_exp2f(sc[blk][i] - mx); sc[blk][i] = p; lsum += p; }
    lsum = xsum32(xsum16(lsum));
    LAS unsigned char* vbuf = lds + HIST_OFF + wave * 16384;
    f32x4 o[4];
#pragma unroll
    for (int db = 0; db < 4; ++db) o[db] = (f32x4){0.f, 0.f, 0.f, 0.f};
#pragma unroll
    for (int J = 0; J < 8; ++J) {
#pragma unroll
        for (int i = 0; i < 8; ++i) { const int key = 4 * i + q4; LAS unsigned char* dst = vbuf + key * 512 + ((n16 ^ (key & 7)) << 5);
            *(LAS v4u*)dst = f8x8_to_bf16(vst[J & 1][i].x, vst[J & 1][i].y); *(LAS v4u*)(dst + 16) = f8x8_to_bf16(vst[J & 1][i].z, vst[J & 1][i].w); }
        if (J + 2 < 8) {
#pragma unroll
            for (int i = 0; i < 8; ++i) { const unsigned pos = 32u * (J + 2) + 4u * i + q4; const unsigned kidx = (pos < cnt) ? (unsigned)sel[pos] : 0u; vst[J & 1][i] = *(const GAS v4u*)(Vb + (size_t)kidx * 256 + 16 * n16); }
        }
        asm volatile("s_waitcnt lgkmcnt(0)" ::: "memory");
        v4u pb; pb.x = pk2(sc[2 * J][0], sc[2 * J][1]); pb.y = pk2(sc[2 * J][2], sc[2 * J][3]); pb.z = pk2(sc[2 * J + 1][0], sc[2 * J + 1][1]); pb.w = pk2(sc[2 * J + 1][2], sc[2 * J + 1][3]);
#pragma unroll
        for (int g = 0; g < 4; ++g) {
            const v4u pg = (g == gl) ? pb : (v4u){0u, 0u, 0u, 0u};
#pragma unroll
            for (int db = 0; db < 4; ++db) {
                const int qq = n16 >> 2, pp = n16 & 3; const int col = 64 * g + 16 * db + 4 * pp;
                const int r0 = 4 * q4 + qq, r1 = 16 + 4 * q4 + qq;
                const int a0 = r0 * 512 + ((((col >> 4) ^ (r0 & 7)) << 5) | ((col & 15) << 1)), a1 = r1 * 512 + ((((col >> 4) ^ (r1 & 7)) << 5) | ((col & 15) << 1));
                v2u lo, hi2;
                asm volatile("ds_read_b64_tr_b16 %0, %1" : "=v"(lo) : "v"((unsigned)(uintptr_t)(vbuf + a0)) : "memory");
                asm volatile("ds_read_b64_tr_b16 %0, %1" : "=v"(hi2) : "v"((unsigned)(uintptr_t)(vbuf + a1)) : "memory");
                asm volatile("s_waitcnt lgkmcnt(0)" : "+v"(lo), "+v"(hi2) :: "memory");
                const v4u av = (v4u){lo.x, lo.y, hi2.x, hi2.y};
                o[db] = __builtin_amdgcn_mfma_f32_16x16x32_bf16(__builtin_bit_cast(bf16x8, av), __builtin_bit_cast(bf16x8, pg), o[db], 0, 0, 0);
            }
        }
        asm volatile("s_waitcnt lgkmcnt(0)" ::: "memory");
    }
    const float rl = 1.f / lsum;
#pragma unroll
    for (int db = 0; db < 4; ++db) { v2u w; w.x = pk2(o[db][0] * rl, o[db][1] * rl); w.y = pk2(o[db][2] * rl, o[db][3] * rl);
        *(GAS v2u*)(orow + n16 * 64 + 16 * db + 4 * q4) = w; }
}

typedef long i64_t;
__device__ __forceinline__ void canon_sel(LAS unsigned char* lds, LAS unsigned short* sel, unsigned cnt, int wave, int lane) {
    LAS unsigned* bm = (LAS unsigned*)(lds + HIST_OFF + wave * 16384); LAS unsigned* pf = bm + 256;
    *(LAS v4u*)(bm + 4 * lane) = (v4u){0u, 0u, 0u, 0u};
    const v2u e = *(const LAS v2u*)(sel + 4 * lane);
    unsigned idx[4] = {e.x & 0xffffu, e.x >> 16, e.y & 0xffffu, e.y >> 16};
    LDS_WAIT();
#pragma unroll
    for (int i = 0; i < 4; ++i) if ((unsigned)(4 * lane + i) < cnt) __hip_atomic_fetch_or(bm + (idx[i] >> 5), 1u << (idx[i] & 31u), __ATOMIC_RELAXED, __HIP_MEMORY_SCOPE_WORKGROUP);
    LDS_WAIT();
    const v4u w = *(const LAS v4u*)(bm + 4 * lane);
    const unsigned c0 = __builtin_popcount(w.x), c1 = __builtin_popcount(w.y), c2 = __builtin_popcount(w.z), c3 = __builtin_popcount(w.w), tot = c0 + c1 + c2 + c3;
    int sc = (int)tot;
    sc += __builtin_amdgcn_update_dpp(0, sc, 0x111, 0xf, 0xf, false); sc += __builtin_amdgcn_update_dpp(0, sc, 0x112, 0xf, 0xf, false);
    sc += __builtin_amdgcn_update_dpp(0, sc, 0x114, 0xf, 0xf, false); sc += __builtin_amdgcn_update_dpp(0, sc, 0x118, 0xf, 0xf, false);
    sc += __builtin_amdgcn_update_dpp(0, sc, 0x142, 0xa, 0xf, false);
    sc += __builtin_amdgcn_update_dpp(0, sc, 0x143, 0xc, 0xf, false);
    const unsigned ex = (unsigned)sc - tot;
    *(LAS v4u*)(pf + 4 * lane) = (v4u){ex, ex + c0, ex + c0 + c1, ex + c0 + c1 + c2};
    LDS_WAIT();
#pragma unroll
    for (int i = 0; i < 4; ++i) if ((unsigned)(4 * lane + i) < cnt) { const unsigned wd = idx[i] >> 5; const unsigned r = pf[wd] + __builtin_popcount(bm[wd] & ((1u << (idx[i] & 31u)) - 1u)); sel[r] = (unsigned short)idx[i]; }
    LDS_WAIT();
}
__device__ __forceinline__ void sparse_attn_row8(LAS unsigned char* lds, int row, int b, int t, const bf16* Q1, bf16* O1, const unsigned char* K1, const unsigned char* V1, int wave, int lane_in) {
    int lane = lane_in; asm volatile("" : "+v"(lane));
    const int n16 = lane & 15, q4 = lane >> 4, gl = n16 >> 2;
    LAS unsigned short* sel = (LAS unsigned short*)(lds + SEL_OFF) + row * TOPK;
    unsigned cnt = ((LAS const unsigned*)(lds + ST_OFF + row * 32))[3] & 0xffffu; if (cnt > (unsigned)TOPK) cnt = TOPK;
    canon_sel(lds, sel, cnt, wave, lane);
    if (cnt < (unsigned)TOPK) {
        for (unsigned i = cnt + lane; i < (unsigned)TOPK; i += 64u) sel[i] = 0;
        asm volatile("s_waitcnt lgkmcnt(0)" ::: "memory");
    }
    const bf16* qrow = Q1 + ((size_t)b * T + t) * D; bf16* orow = O1 + ((size_t)b * T + t) * D;
    i64_t qs0, qs1;
    { const v4u a = *(const GAS v4u*)(qrow + n16 * 64 + 16 * q4), c = *(const GAS v4u*)(qrow + n16 * 64 + 16 * q4 + 8);
      int w0 = 0, w1 = 0, w2 = 0, w3 = 0;
      w0 = __builtin_amdgcn_cvt_pk_fp8_f32(bf2f(a.x & 0xffffu), bf2f(a.x >> 16), w0, false); w0 = __builtin_amdgcn_cvt_pk_fp8_f32(bf2f(a.y & 0xffffu), bf2f(a.y >> 16), w0, true);
      w1 = __builtin_amdgcn_cvt_pk_fp8_f32(bf2f(a.z & 0xffffu), bf2f(a.z >> 16), w1, false); w1 = __builtin_amdgcn_cvt_pk_fp8_f32(bf2f(a.w & 0xffffu), bf2f(a.w >> 16), w1, true);
      w2 = __builtin_amdgcn_cvt_pk_fp8_f32(bf2f(c.x & 0xffffu), bf2f(c.x >> 16), w2, false); w2 = __builtin_amdgcn_cvt_pk_fp8_f32(bf2f(c.y & 0xffffu), bf2f(c.y >> 16), w2, true);
      w3 = __builtin_amdgcn_cvt_pk_fp8_f32(bf2f(c.z & 0xffffu), bf2f(c.z >> 16), w3, false); w3 = __builtin_amdgcn_cvt_pk_fp8_f32(bf2f(c.w & 0xffffu), bf2f(c.w >> 16), w3, true);
      qs0 = (i64_t)(((u64)(unsigned)w1 << 32) | (u64)(unsigned)w0); qs1 = (i64_t)(((u64)(unsigned)w3 << 32) | (u64)(unsigned)w2); }
    i64_t bq0[4], bq1[4];
#pragma unroll
    for (int g = 0; g < 4; ++g) { bq0[g] = (g == gl) ? qs0 : (i64_t)0; bq1[g] = (g == gl) ? qs1 : (i64_t)0; }
    const float slope = __builtin_amdgcn_exp2f(-0.5f * (float)(n16 + 1)) * LOG2E;
    const unsigned char* Kb = K1 + (size_t)b * T * 256; const unsigned char* Vb = V1 + (size_t)b * T * 256;
    const int vkey = lane >> 1, vpar = lane & 1;
    f32x4 sc[16];
    v4u vst[2][8];
    constexpr int KD = 3;
    v4u kfn[KD][4];
#pragma unroll
    for (int d = 0; d < KD; ++d) { const unsigned kidx = (unsigned)sel[16 * d + n16]; const unsigned char* kp = Kb + (size_t)kidx * 256 + 16 * q4;
#pragma unroll
      for (int g = 0; g < 4; ++g) kfn[d][g] = *(const GAS v4u*)(kp + 64 * g); }
#pragma unroll
    for (int blk = 0; blk < 16; ++blk) {
        f32x4 a = (f32x4){0.f, 0.f, 0.f, 0.f};
#pragma unroll
        for (int g = 0; g < 4; ++g) {
            const v4u ch = kfn[blk % KD][g];
            const i64_t k0 = (i64_t)(((u64)ch.y << 32) | (u64)ch.x), k1 = (i64_t)(((u64)ch.w << 32) | (u64)ch.z);
            a = __builtin_amdgcn_mfma_f32_16x16x32_fp8_fp8(k0, bq0[g], a, 0, 0, 0);
            a = __builtin_amdgcn_mfma_f32_16x16x32_fp8_fp8(k1, bq1[g], a, 0, 0, 0);
        }
        if (blk + KD < 16) { const unsigned kidx = (unsigned)sel[16 * (blk + KD) + n16]; const unsigned char* kp = Kb + (size_t)kidx * 256 + 16 * q4;
#pragma unroll
            for (int g = 0; g < 4; ++g) kfn[blk % KD][g] = *(const GAS v4u*)(kp + 64 * g); }
        if (blk >= 14) { const int d = blk - 14;
#pragma unroll
            for (int k = 0; k < 8; ++k) vst[d][k] = *(const GAS v4u*)(Vb + (size_t)sel[32 * d + 4 * k + q4] * 256 + 16 * n16); }
        const unsigned long long i4 = *(LAS const unsigned long long*)(sel + 16 * blk + 4 * q4);
#pragma unroll
        for (int i = 0; i < 4; ++i) { const unsigned pz = 16u * blk + 4u * q4 + i; const int ki = (int)((i4 >> (16 * i)) & 0xffffull);
            a[i] = (pz < cnt) ? (a[i] - slope * (float)(t - ki)) : -INFINITY; }
        sc[blk] = a;
    }
    float mx = -INFINITY;
#pragma unroll
    for (int blk = 0; blk < 16; ++blk) mx = fmaxf(fmaxf(fmaxf(mx, sc[blk][0]), fmaxf(sc[blk][1], sc[blk][2])), sc[blk][3]);
    mx = xmax32(xmax16(mx));
    float lsum = 0.f;
    mx -= 8.f;
#pragma unroll
    for (int blk = 0; blk < 16; ++blk)
#pragma unroll
        for (int i = 0; i < 4; ++i) { const float pv = __builtin_amdgcn_exp2f(sc[blk][i] - mx); sc[blk][i] = pv; lsum += pv; }
    lsum = xsum32(xsum16(lsum));
    LAS unsigned char* vbuf = lds + HIST_OFF + wave * 16384;
    unsigned vdst[4];
#pragma unroll
    for (int j = 0; j < 4; ++j) vdst[j] = (unsigned)(uintptr_t)vbuf + (unsigned)vkey * 256u + (unsigned)((((2 * j) ^ (vkey & 7)) << 5) | (vpar << 4));
    const int qq = n16 >> 2, pp = n16 & 3; const int r0 = 4 * q4 + qq, r1 = 16 + 4 * q4 + qq;
    f32x4 oe[2], oo[2];
#pragma unroll
    for (int d = 0; d < 2; ++d) { oe[d] = (f32x4){0.f, 0.f, 0.f, 0.f}; oo[d] = (f32x4){0.f, 0.f, 0.f, 0.f}; }
#pragma unroll
    for (int J = 0; J < 8; ++J) {
        LAS unsigned char* slot = vbuf + (J & 1) * 8192;
#pragma unroll
        for (int k = 0; k < 8; ++k) { const int key = 4 * k + q4; *(LAS v4u*)(slot + key * 256 + ((((n16 >> 1) ^ (key & 7)) << 5) | ((n16 & 1) << 4))) = vst[J & 1][k]; }
        if (J + 2 < 8) {
#pragma unroll
            for (int k = 0; k < 8; ++k) vst[J & 1][k] = *(const GAS v4u*)(Vb + (size_t)sel[32 * (J + 2) + 4 * k + q4] * 256 + 16 * n16); }
        asm volatile("s_waitcnt lgkmcnt(0)" ::: "memory");
        int p0 = 0, p1 = 0;
        p0 = __builtin_amdgcn_cvt_pk_fp8_f32(sc[2 * J][0], sc[2 * J][1], p0, false); p0 = __builtin_amdgcn_cvt_pk_fp8_f32(sc[2 * J][2], sc[2 * J][3], p0, true);
        p1 = __builtin_amdgcn_cvt_pk_fp8_f32(sc[2 * J + 1][0], sc[2 * J + 1][1], p1, false); p1 = __builtin_amdgcn_cvt_pk_fp8_f32(sc[2 * J + 1][2], sc[2 * J + 1][3], p1, true);
        const i64_t pb = (i64_t)(((u64)(unsigned)p1 << 32) | (u64)(unsigned)p0);
        v2u trl[8], trh[8];
#pragma unroll
        for (int sg = 0; sg < 8; ++sg) {
            const int a0 = r0 * 256 + (((sg ^ (r0 & 7)) << 5) | (pp << 3)), a1 = r1 * 256 + (((sg ^ (r1 & 7)) << 5) | (pp << 3));
            asm volatile("ds_read_b64_tr_b16 %0, %1" : "=v"(trl[sg]) : "v"((unsigned)(uintptr_t)(slot + a0)) : "memory");
            asm volatile("ds_read_b64_tr_b16 %0, %1" : "=v"(trh[sg]) : "v"((unsigned)(uintptr_t)(slot + a1)) : "memory");
        }
        asm volatile("s_waitcnt lgkmcnt(0)" : "+v"(trl[0]), "+v"(trl[1]), "+v"(trl[2]), "+v"(trl[3]), "+v"(trl[4]), "+v"(trl[5]), "+v"(trl[6]), "+v"(trl[7]),
                                               "+v"(trh[0]), "+v"(trh[1]), "+v"(trh[2]), "+v"(trh[3]), "+v"(trh[4]), "+v"(trh[5]), "+v"(trh[6]), "+v"(trh[7]) :: "memory");
#pragma unroll
        for (int g = 0; g < 4; ++g) {
            const i64_t pg = (g == gl) ? pb : (i64_t)0;
#pragma unroll
            for (int dbp = 0; dbp < 2; ++dbp) {
                const v2u lo = trl[2 * g + dbp], hi2 = trh[2 * g + dbp];
                const unsigned e0 = __builtin_amdgcn_perm(lo.y, lo.x, 0x06040200u), o0 = __builtin_amdgcn_perm(lo.y, lo.x, 0x07050301u);
                const unsigned e1 = __builtin_amdgcn_perm(hi2.y, hi2.x, 0x06040200u), o1 = __builtin_amdgcn_perm(hi2.y, hi2.x, 0x07050301u);
                const i64_t ae = (i64_t)(((u64)e1 << 32) | (u64)e0), ao = (i64_t)(((u64)o1 << 32) | (u64)o0);
                oe[dbp] = __builtin_amdgcn_mfma_f32_16x16x32_fp8_fp8(ae, pg, oe[dbp], 0, 0, 0);
                oo[dbp] = __builtin_amdgcn_mfma_f32_16x16x32_fp8_fp8(ao, pg, oo[dbp], 0, 0, 0);
            }
        }
    }
    (void)vdst;
    const float rl = 32.f / lsum;
#pragma unroll
    for (int dbp = 0; dbp < 2; ++dbp) {
        int w0 = 0, w1 = 0;
        w0 = __builtin_amdgcn_cvt_pk_fp8_f32(oe[dbp][0] * rl, oo[dbp][0] * rl, w0, false); w0 = __builtin_amdgcn_cvt_pk_fp8_f32(oe[dbp][1] * rl, oo[dbp][1] * rl, w0, true);
        w1 = __builtin_amdgcn_cvt_pk_fp8_f32(oe[dbp][2] * rl, oo[dbp][2] * rl, w1, false); w1 = __builtin_amdgcn_cvt_pk_fp8_f32(oe[dbp][3] * rl, oo[dbp][3] * rl, w1, true);
        *(GAS v2u*)((unsigned char*)O1 + ((size_t)b * T + t) * D + n16 * 64 + 32 * dbp + 8 * q4) = (v2u){(unsigned)w0, (unsigned)w1}; }
}

__device__ __forceinline__ void unit(LAS unsigned char* lds, int b, int t0q, const bf16* Q1, bf16* O1, const unsigned char* K1, const unsigned char* V1, const bf16* QI, const bf16* KI, const float* WI, int tid_in, int wave) {
    int tid = tid_in; asm volatile("" : "+v"(tid)); const int lane = tid & 63;
    const int hi = lane >> 5, r32 = lane & 31;
    if (tid < QT * 8) ((LAS float*)(lds + ST_OFF + 1024))[tid] = WI[((size_t)b * T + t0q) * 8 + tid];
    if (tid < QT) { LAS unsigned* st = (LAS unsigned*)(lds + ST_OFF + tid * 32); const int t = t0q + tid;
        unsigned z; asm volatile("v_mov_b32 %0, 0" : "=v"(z));
        st[0] = z; st[1] = z; st[2] = z + (unsigned)TOPK; st[3] = z; st[4] = z; st[5] = z; st[6] = (t + 1 <= TOPK) ? 1u : z; st[7] = z; }
    for (int i = tid; i < 32768 / 4; i += NTHREADS) ((LAS v4u*)(lds + HIST_OFF))[i] = (v4u){0u, 0u, 0u, 0u};
    bf16x8 qa[4][4];
    { const int qlr = 2 * ((r32 >> 2) & 1) + (r32 >> 4), hd = 4 * ((r32 >> 3) & 1) + (r32 & 3);
#pragma unroll
      for (int rb = 0; rb < 4; ++rb) { const bf16* qp = QI + ((size_t)b * T + t0q + 4 * rb + qlr) * 512 + hd * 64 + 8 * hi;
#pragma unroll
          for (int ks = 0; ks < 4; ++ks) qa[rb][ks] = *(const GAS bf16x8*)(qp + 16 * ks); } }
    const int nst = (t0q + QT + 31) >> 5;
    const bf16* KIb = KI + (size_t)b * T * 64;
    bool done = false;
    if (t0q >= 2048) {
        const int nfull_ = (t0q + 1) >> 5, nsamp = (nfull_ + 7) >> 3;
        if (tid < QT) { LAS unsigned* st = (LAS unsigned*)(lds + ST_OFF + tid * 32); const unsigned n = (unsigned)(t0q + tid + 1), ns = 32u * (unsigned)nsamp; st[2] = (512u * ns + n - 1u) / n; }
        __syncthreads();
        idx_pass<0, true, 0, 8>(qa, KIb, t0q, nsamp, wave, lane, lds, 0, 45, 33, 4095u);
        __syncthreads();
        find_bin(lds, 2 * wave, lane, 12); find_bin(lds, 2 * wave + 1, lane, 12);
        __syncthreads();
        idx_pass<3, true>(qa, KIb, t0q, nst, wave, lane, lds, 0, 0, 33, 0u);
        __syncthreads();
        bool bad = false;
#pragma unroll
        for (int r = 0; r < QT; ++r) { const unsigned c = ((LAS const unsigned*)(lds + ST_OFF + r * 32))[3] >> 16; bad = bad || c < (unsigned)TOPK || c > (unsigned)CAP; }
        __syncthreads();
        if (!bad) {
            if (tid < QT) { LAS unsigned* st = (LAS unsigned*)(lds + ST_OFF + tid * 32); st[0] = 0u; st[1] = 0u; st[2] = (unsigned)TOPK; }
            __syncthreads();
            { int lane_c; asm volatile("v_mbcnt_lo_u32_b32 %0, -1, 0\n\tv_mbcnt_hi_u32_b32 %0, -1, %0" : "=v"(lane_c));
              finish_row(lds, 2 * wave, lane_c, 45); finish_row(lds, 2 * wave + 1, lane_c, 45); }
            __syncthreads();
            done = true;
        } else {
            if (tid < QT) { LAS unsigned* st = (LAS unsigned*)(lds + ST_OFF + tid * 32); st[0] = 0u; st[1] = 0u; st[2] = (unsigned)TOPK; st[3] = 0u; st[4] = 0u; st[5] = 0u; }
            for (int i = tid; i < 32768 / 4; i += NTHREADS) ((LAS v4u*)(lds + HIST_OFF))[i] = (v4u){0u, 0u, 0u, 0u};
            __syncthreads();
        }
    }
    int level = 0, lo_shift = 33;
    if (!done) {
    for (;;) {
        const int hi_shift = 45 - 12 * level; lo_shift = (level == 3) ? 0 : 33 - 12 * level; const int bits = (level == 3) ? 9 : 12; const unsigned mask = (1u << bits) - 1u;
        if (level > 0) { for (int i = tid; i < 32768 / 4; i += NTHREADS) ((LAS v4u*)(lds + HIST_OFF))[i] = (v4u){0u, 0u, 0u, 0u}; }
        __syncthreads();
        if (MK_DUP & 512) {
            if (MK_DUP & 1024) idx_pass<0, true, 1>(qa, KIb, t0q, nst, wave, lane, lds, level, hi_shift, lo_shift, mask);
            else if (MK_DUP & 2048) idx_pass<0, true, 2>(qa, KIb, t0q, nst, wave, lane, lds, level, hi_shift, lo_shift, mask);
            else idx_pass<0, true>(qa, KIb, t0q, nst, wave, lane, lds, level, hi_shift, lo_shift, mask);
            __syncthreads();
            for (int i = tid; i < 32768 / 4; i += NTHREADS) ((LAS v4u*)(lds + HIST_OFF))[i] = (v4u){0u, 0u, 0u, 0u};
            __syncthreads();
        }
        if (level == 0) idx_pass<0, true>(qa, KIb, t0q, nst, wave, lane, lds, level, hi_shift, lo_shift, mask);
        else idx_pass<0, false>(qa, KIb, t0q, nst, wave, lane, lds, level, hi_shift, lo_shift, mask);
        __syncthreads();
        find_bin(lds, 2 * wave, lane, bits); find_bin(lds, 2 * wave + 1, lane, bits);
        __syncthreads();
        bool more = false;
        if (level < 3) {
#pragma unroll
            for (int r = 0; r < QT; ++r) { LAS const unsigned* st = (LAS const unsigned*)(lds + ST_OFF + r * 32); more = more || (st[6] == 0u && st[5] > (unsigned)CAP); }
        }
        if (!more) break;
        ++level;
    }
    __syncthreads();
    if (MK_DUP & 4096) { idx_pass<1, true>(qa, KIb, t0q, nst, wave, lane, lds, level, 0, lo_shift, 0u); __syncthreads(); if (tid < QT) ((LAS unsigned*)(lds + ST_OFF + tid * 32))[3] = 0u; __syncthreads(); }
    if (level == 0) idx_pass<1, true>(qa, KIb, t0q, nst, wave, lane, lds, level, 0, lo_shift, 0u);
    else idx_pass<1, false>(qa, KIb, t0q, nst, wave, lane, lds, level, 0, lo_shift, 0u);
    __syncthreads();
    finish_row(lds, 2 * wave, lane, lo_shift); finish_row(lds, 2 * wave + 1, lane, lo_shift);
    __syncthreads();
    }
#pragma unroll 1
    for (int rr = 0; rr < (MK_DUP & 256 ? 4 : 2); ++rr) sparse_attn_row8(lds, 2 * wave + (rr & 1), b, t0q + 2 * wave + (rr & 1), Q1, O1, K1, V1, wave, lane);
    __syncthreads();
}
}
#if defined(__HIP_DEVICE_COMPILE__)
typedef const __attribute__((address_space(4))) Ptrs* KArgs;
__device__ __forceinline__ const Ptrs* get_args() { KArgs p = (KArgs)__builtin_amdgcn_kernarg_segment_ptr(); asm volatile("" : "+s"(p)); return (const Ptrs*)p; }
#else
__device__ __forceinline__ const Ptrs* get_args() { return nullptr; }
#endif
#define DUP(bit, ...) do { if (MK_DUP & (1 << (bit))) { __VA_ARGS__; GRID_BAR(); } } while (0)
__global__ void __launch_bounds__(NTHREADS, 2) hybrid_fwd(Ptrs Pbyval) {
    extern __shared__ __attribute__((aligned(16))) unsigned char lds_raw[];
    LAS unsigned char* lds = (LAS unsigned char*)lds_raw;
    volatile LAS unsigned* MISC = (volatile LAS unsigned*)(lds + MISC_OFF);
    const int tid0 = threadIdx.x; const int wave_s = __builtin_amdgcn_readfirstlane(tid0 >> 6);
#define FRESH_IDS() const Ptrs P = *get_args(); unsigned char* ws = P.ws; gu32* ctl = (gu32*)(ws + WS_CTL); float* MOD = (float*)(ws + WS_MOD); bf16* Hb = (bf16*)(ws + WS_H); (void)ctl; (void)MOD; (void)Hb; int tid; asm volatile("v_mbcnt_lo_u32_b32 %0, -1, 0\n\tv_mbcnt_hi_u32_b32 %0, -1, %0\n\tv_lshl_or_b32 %0, %1, 6, %0" : "=&v"(tid) : "s"(wave_s)); const int lane = tid & 63; const int wave = __builtin_amdgcn_readfirstlane(tid >> 6); (void)lane; (void)wave
    const int G = gridDim.x; const int bx = blockIdx.x; const int vcu = (G % 8 == 0) ? (bx % 8) * (G / 8) + bx / 8 : bx;
    for (int u = tid0; u < (LDS_BYTES - LDSCTL_OFF) / 4; u += NTHREADS) ((LAS unsigned*)(lds + LDSCTL_OFF))[u] = 0u;
    __syncthreads();
    XcdBarrier bar = xcd_barrier_post((unsigned*)((gu32*)(Pbyval.ws + WS_CTL) + CW_BAR), MISC + 8);
#define GRID_BAR() xcd_barrier(bar)

#define PH_PROLOGUE() do { FRESH_IDS(); p0_prologue(P, lds, tid, lane, wave, vcu, G); } while (0)
#define PH_NORM1_L0() do { FRESH_IDS(); norm_phase<true, false, 1>(P.x, P.g_mix, MOD, 0, 1, Hb, (unsigned char*)Hb, P.fox_w_in, P.fox_b_f, (float*)(ws + WS_LOGF), lds, tid, lane, wave, vcu, G); } while (0)
#define PH_NORM1_L1() do { FRESH_IDS(); norm_phase<false, true, 2>((const bf16*)(ws + WS_XB), P.g_mix + D, MOD + (size_t)2 * 6144, 0, 1, Hb, ws + WS_H8, nullptr, nullptr, nullptr, lds, tid, lane, wave, vcu, G); } while (0)
#define PH_NORM2(layer) do { FRESH_IDS(); norm_phase<false, true, 1>((const bf16*)(ws + WS_XB), P.g_ffn + layer * D, MOD + (size_t)layer * 2 * 6144, 3, 4, Hb, (unsigned char*)Hb, nullptr, nullptr, nullptr, lds, tid, lane, wave, vcu, G); } while (0)
#define PH_QKV() do { \
        { FRESH_IDS(); for (int seq = bx; seq < 32; seq += G) fox_scan((const float*)(ws + WS_LOGF), (float*)(ws + WS_BETA), ws + WS_KE, seq, (LAS float*)(lds + RING_OFF), tid, lane, wave); } \
        { FRESH_IDS(); \
            pg8::Gemm g{Hb, (const bf16*)(ws + WS_WFIN), M, 3 * D, D / 2, D / 2, D / 2, 0x7f7f7f7f, 0x7a7a7a7a}; pg8::StaticOrder S; S.init(M, 3 * D, G, bx, ORD_QKV); \
            pg8::EpiHeads E{}; E.ntens = 3; \
            E.base[0] = (bf16*)(ws + WS_Q); E.tile0[0] = 0; E.ldc[0] = D; E.kind[0] = 1; E.gain[0] = P.fox_g_q; E.scale[0] = attn_body::C2; \
            E.base[1] = (bf16*)(ws + WS_K); E.tile0[1] = 4; E.ldc[1] = D; E.kind[1] = 1; E.gain[1] = P.fox_g_k; E.scale[1] = 1.f; \
            E.base[2] = (bf16*)(ws + WS_V); E.tile0[2] = 8; E.ldc[2] = D; E.kind[2] = 0; E.gain[2] = P.fox_g_k; E.scale[2] = 1.f; \
            E.base[3] = E.base[2]; E.tile0[3] = 1 << 30; E.ldc[3] = D; E.kind[3] = 0; E.gain[3] = P.fox_g_k; E.scale[3] = 1.f; \
            pg8::gemm_phase<pg8::EpiHeads, pg8::StaticOrder, true, true, true>(lds + RING_OFF, g, S, E, tid); } } while (0)
#define PH_FOXATTN(qword) do { FRESH_IDS(); \
            float qkmax; \
            { const float gq = wave_max(fabsf(P.fox_g_q[lane])), gk = wave_max(fabsf(P.fox_g_k[lane])); qkmax = 64.f * attn_body::C2 * gq * gk * 1.02f + 0.5f; } \
            for (;;) { \
                if (tid == 0) MISC[16] = __hip_atomic_fetch_add(ctl + (qword), 1u, RLX_AGENT); \
                __syncthreads(); \
                const int id = (int)MISC[16]; \
                __syncthreads(); \
                if (id >= 32 * 32) break; \
                const int qb = 31 - (id >> 5), bh = id & 31; \
                attn_body::attn_unit<8>(bh >> 4, bh & 15, qb, (const attn_body::bf16*)(ws + WS_Q), (const attn_body::bf16*)(ws + WS_K), (const attn_body::bf16*)(ws + WS_V), \
                                        (attn_body::bf16*)(ws + WS_O), (const attn_body::bf16*)(ws + WS_KE), (const float*)(ws + WS_BETA), qkmax, (char*)lds_raw + RING_OFF, tid); \
            } } while (0)
#define PH_OUTPROJ(layer, OBUF, WBUF) do { FRESH_IDS(); \
            pg8::Gemm g{(const bf16*)(ws + (OBUF)), (const bf16*)(ws + (WBUF)), M, D, D / 2, D / 2, D / 2, 0x7a7a7a7a, 0x7a7a7a7a}; pg8::StaticOrder S; S.init(M, D, G, bx); \
              \
            if (layer == 0) { if (S.nwg <= G) { pg8::EpiResNormStaged<false, 1> E{P.x, ws + WS_XB, MOD + 2 * D, 6144, T, P.g_ffn, MOD, 3, 4, Hb, (unsigned char*)Hb, (float*)(ws + WS_XS), (unsigned*)(ctl + CW_NS), lds + HALO_OFF}; \
                    pg8::gemm_phase<pg8::EpiResNormStaged<false, 1>, pg8::StaticOrder, true, true, true>(lds + RING_OFF, g, S, E, tid); } \
                else { pg8::EpiRes<false, true> E{P.x, ws + WS_XB, MOD + 2 * D, 6144, T}; pg8::gemm_phase<pg8::EpiRes<false, true>, pg8::StaticOrder, true, true, true>(lds + RING_OFF, g, S, E, tid); } } \
            else { if (S.nwg <= G) { pg8::EpiResNormStaged<true, 1> E{ws + WS_XB, ws + WS_XB, MOD + (size_t)2 * 6144 + 2 * D, 6144, T, P.g_ffn + D, MOD + (size_t)2 * 6144, 3, 4, Hb, (unsigned char*)Hb, (float*)(ws + WS_XS) + (size_t)2 * M * 4, (unsigned*)(ctl + CW_NS + 2048), lds + HALO_OFF}; \
                    pg8::gemm_phase<pg8::EpiResNormStaged<true, 1>, pg8::StaticOrder, true, true, true>(lds + RING_OFF, g, S, E, tid); } \
                else { pg8::EpiRes<true, true> E{ws + WS_XB, ws + WS_XB, MOD + (size_t)2 * 6144 + 2 * D, 6144, T}; pg8::gemm_phase<pg8::EpiRes<true, true>, pg8::StaticOrder, true, true, true>(lds + RING_OFF, g, S, E, tid); } } } while (0)
#define PH_UP(layer) do { FRESH_IDS(); \
            pg8::Gemm g{Hb, (const bf16*)(ws + (layer == 0 ? WS_WUP0 : WS_WUP1)), M, FF2, D / 2, D / 2, D / 2, 0x7f7f7f7f, 0x7a7a7a7a}; pg8::StaticOrder S; S.init(M, FF2, G, (G % 16 == 0) ? (bx % 8) + 8 * ((((bx / 8) & 1) * (G / 16)) + ((bx / 8) >> 1)) : bx, ORD_UP);   \
            pg8::EpiConvGate E{(bf16*)(ws + WS_U), P.ffn_conv_w + (size_t)layer * 3 * FF, P.ffn_conv_b + (size_t)layer * FF, (float*)(ws + WS_SA0), (float*)(ws + WS_SG0), (float*)(ws + WS_SA1), (LAS float*)(lds + HALO_OFF), lds + RING_OFF + 3 * 16384  }; \
            pg8::gemm_phase<pg8::EpiConvGate, pg8::StaticOrder, true, true, true>(lds + RING_OFF, g, S, E, tid); } while (0)
#define PH_DOWN(layer) do { FRESH_IDS(); \
            pg8::Gemm g{(const bf16*)(ws + WS_U), (const bf16*)(ws + (layer == 0 ? WS_WDN0 : WS_WDN1)), M, D, FF / 2, FF / 2, FF / 2, 0x7f7f7f7f, 0x79797979}; pg8::StaticOrder S; S.init(M, D, G, bx); \
            { pg8::Unit u0; for (int i_ = 0; S.next(i_, u0); ++i_) conv_fixup((bf16*)(ws + WS_U), (const float*)(ws + WS_SA0), (const float*)(ws + WS_SG0), (const float*)(ws + WS_SA1), P.ffn_conv_w + (size_t)layer * 3 * FF, P.ffn_conv_b + (size_t)layer * FF, u0.pm, tid); } \
            if (layer == 0) { if (S.nwg <= G) { pg8::EpiResNormStaged<true, 2> E{ws + WS_XB, ws + WS_XB, MOD + 5 * D, 6144, T, P.g_mix + D, MOD + (size_t)2 * 6144, 0, 1, Hb, ws + WS_H8, (float*)(ws + WS_XS) + (size_t)M * 4, (unsigned*)(ctl + CW_NS + 1024), lds + HALO_OFF}; \
                    pg8::gemm_phase<pg8::EpiResNormStaged<true, 2>, pg8::StaticOrder, true, true, true>(lds + RING_OFF, g, S, E, tid); } \
                else { pg8::EpiRes<true, true> E{ws + WS_XB, ws + WS_XB, MOD + 5 * D, 6144, T}; pg8::gemm_phase<pg8::EpiRes<true, true>, pg8::StaticOrder, true, true, true>(lds + RING_OFF, g, S, E, tid); } } \
            else { if (S.nwg <= G) { pg8::EpiResStaged<true, false> E{ws + WS_XB, P.out, MOD + (size_t)2 * 6144 + 5 * D, 6144, T}; pg8::gemm_phase<pg8::EpiResStaged<true, false>, pg8::StaticOrder, true, true, true>(lds + RING_OFF, g, S, E, tid); } \
                else { pg8::EpiRes<true, false> E{ws + WS_XB, P.out, MOD + (size_t)2 * 6144 + 5 * D, 6144, T}; pg8::gemm_phase<pg8::EpiRes<true, false>, pg8::StaticOrder, true, true, true>(lds + RING_OFF, g, S, E, tid); } } } while (0)
#define PH_DSAIN() do { FRESH_IDS(); \
              \
            if (G % 16 != 0) dsa::tail_phase(Hb, (const bf16*)(ws + WS_WDTAIL), P.dsa_g_kidx, (bf16*)(ws + WS_KI), (float*)(ws + WS_WI), lane, vcu * NWAVES + wave, G * NWAVES); \
            else if (bx < G / 2) dsa::tail_phase(Hb, (const bf16*)(ws + WS_WDTAIL), P.dsa_g_kidx, (bf16*)(ws + WS_KI), (float*)(ws + WS_WI), lane, bx * NWAVES + wave, (G / 2) * NWAVES); \
              \
            { pg8::Gemm g{(const bf16*)(ws + WS_H8), (const bf16*)(ws + WS_WDIN), M, 3 * D / 2, D / 2, D / 2, D / 2, 0x7f7f7f7f, 0x7a7a7a7a}; pg8::StaticOrder S; S.init(M, 3 * D / 2, G, bx, ORD_DIN); \
              pg8::EpiHeads E{}; E.ntens = 3; \
              E.base[0] = (bf16*)(ws + WS_Q1); E.tile0[0] = 0; E.ldc[0] = D; E.kind[0] = 1; E.gain[0] = P.dsa_g_q; E.scale[0] = attn_body::C2; \
              E.base[1] = (bf16*)(ws + WS_K1); E.tile0[1] = 4; E.ldc[1] = 256; E.kind[1] = 1; E.gain[1] = P.dsa_g_k; E.scale[1] = 1.f; E.f8[1] = 1; \
              E.base[2] = (bf16*)(ws + WS_V1); E.tile0[2] = 5; E.ldc[2] = 256; E.kind[2] = 0; E.gain[2] = P.dsa_g_k; E.scale[2] = 1.f; E.f8[2] = 1; \
              E.base[3] = E.base[2]; E.tile0[3] = 1 << 30; E.ldc[3] = 256; E.kind[3] = 0; E.gain[3] = P.dsa_g_k; E.scale[3] = 1.f; \
              pg8::gemm_phase<pg8::EpiHeads, pg8::StaticOrder, true, true, true>(lds + RING_OFF, g, S, E, tid); } \
            { FRESH_IDS(); pg8::Gemm g{Hb, (const bf16*)(ws + WS_WDIN + 2 * MiB), M, D / 2, D, D, D, 0, 0}; pg8::StaticOrder S; S.init(M, D / 2, G, (G % 16 == 0) ? (bx + G / 2) % G : bx, ORD_QI); \
              pg8::EpiHeads E{}; E.ntens = 1; \
              E.base[0] = (bf16*)(ws + WS_QI); E.tile0[0] = 0; E.ldc[0] = 512; E.kind[0] = 0; E.gain[0] = P.dsa_g_k; E.scale[0] = 1.f; \
              for (int i_ = 1; i_ < 4; ++i_) { E.base[i_] = E.base[0]; E.tile0[i_] = 1 << 30; E.ldc[i_] = 512; E.kind[i_] = 0; E.gain[i_] = P.dsa_g_k; E.scale[i_] = 1.f; } \
              pg8::gemm_phase<pg8::EpiHeads, pg8::StaticOrder, true, true>(lds + RING_OFF, g, S, E, tid); } } while (0)
#define PH_DSAUNITS(qword) do { FRESH_IDS(); \
            int qb_ = (bx & 1), tries_ = 0;      \
            for (;;) { \
                if (tid == 0) MISC[16] = __hip_atomic_fetch_add(ctl + (qword) + 64 * qb_, 1u, RLX_AGENT); \
                __syncthreads(); \
                const int id = (int)MISC[16]; \
                __syncthreads(); \
                if (id >= T / dsa::QT) { if (++tries_ >= 2) break; qb_ ^= 1; continue; } \
                const int b = qb_, t0q = (T / dsa::QT - 1 - id) * dsa::QT; \
                dsa::unit(lds, b, t0q, (const bf16*)(ws + WS_Q1), (bf16*)(ws + WS_O1), (const unsigned char*)(ws + WS_K1), (const unsigned char*)(ws + WS_V1), (const bf16*)(ws + WS_QI), (const bf16*)(ws + WS_KI), (const float*)(ws + WS_WI), tid, wave); \
            } } while (0)

    const bool fusedn = (M / 256) * (D / 256) <= G;
    PH_PROLOGUE(); GRID_BAR();                       DUP(0, PH_PROLOGUE());
    PH_NORM1_L0(); GRID_BAR();                       DUP(1, PH_NORM1_L0());
    PH_QKV(); GRID_BAR();                            DUP(2, PH_QKV());
    PH_FOXATTN(CW_AQ); GRID_BAR();                   DUP(3, PH_FOXATTN(CW_AQ + 64));
    PH_OUTPROJ(0, WS_O, WS_WFOUT); GRID_BAR();       DUP(10, PH_OUTPROJ(0, WS_O, WS_WFOUT));
    if (!fusedn) { PH_NORM2(0); GRID_BAR(); }
    PH_UP(0); GRID_BAR();                            DUP(5, PH_UP(0));
    PH_DOWN(0); GRID_BAR();
    if (!fusedn) { PH_NORM1_L1(); GRID_BAR(); }
    PH_DSAIN(); GRID_BAR();                          DUP(6, PH_DSAIN());
    PH_DSAUNITS(CW_DQ); GRID_BAR();                  DUP(7, PH_DSAUNITS(CW_DQ + 128));
    PH_OUTPROJ(1, WS_O1, WS_WDOUT); GRID_BAR();
    if (!fusedn) { PH_NORM2(1); GRID_BAR(); }
    PH_UP(1); GRID_BAR();
    PH_DOWN(1);
    if (MK_DUP & 512) { GRID_BAR(); PH_DOWN(1); }
}

extern "C" void kernel_launch(void* const* d_in, const int* in_sizes, int n_in, void* d_out, int out_size, void* d_ws, size_t ws_size, hipStream_t stream) {
    static int grid = 0;
    if (grid == 0) {
        if (n_in != 20 || in_sizes[0] != M * D || out_size != M * D || ws_size < WS_END) { fprintf(stderr, "kernel_launch: unexpected problem (n_in %d, in0 %d, out %d, ws %zu); nothing launched\n", n_in, n_in > 0 ? in_sizes[0] : -1, out_size, ws_size); grid = -1; return; }
        int dev = 0, cus = 0, per_cu = 0;
        if (hipGetDevice(&dev) != hipSuccess || hipDeviceGetAttribute(&cus, hipDeviceAttributeMultiprocessorCount, dev) != hipSuccess) { grid = -1; return; }
        if (hipFuncSetAttribute((const void*)hybrid_fwd, hipFuncAttributeMaxDynamicSharedMemorySize, LDS_BYTES) != hipSuccess) { fprintf(stderr, "kernel_launch: hipFuncSetAttribute failed\n"); grid = -1; return; }
        if (hipOccupancyMaxActiveBlocksPerMultiprocessor(&per_cu, (const void*)hybrid_fwd, NTHREADS, LDS_BYTES) != hipSuccess || per_cu < 1)
            fprintf(stderr, "kernel_launch: note: occupancy query reports %d workgroups per CU\n", per_cu);
        (void)hipGetLastError();
        grid = cus;
    }
    if (grid < 0) return;
    if (hipMemsetAsync((char*)d_ws + WS_CTL, 0, CTL_ZERO_BYTES, stream) != hipSuccess) return;
    Ptrs p{};
    p.x = (const float*)d_in[0]; p.c = (const float*)d_in[1]; p.w_ada = (const float*)d_in[2]; p.b_ada = (const float*)d_in[3]; p.g_mix = (const float*)d_in[4]; p.g_ffn = (const float*)d_in[5];
    p.fox_w_in = (const float*)d_in[6]; p.fox_b_f = (const float*)d_in[7]; p.fox_g_q = (const float*)d_in[8]; p.fox_g_k = (const float*)d_in[9]; p.fox_w_out = (const float*)d_in[10];
    p.dsa_w_in = (const float*)d_in[11]; p.dsa_g_q = (const float*)d_in[12]; p.dsa_g_k = (const float*)d_in[13]; p.dsa_g_kidx = (const float*)d_in[14]; p.dsa_w_out = (const float*)d_in[15];
    p.ffn_w_up = (const float*)d_in[16]; p.ffn_conv_w = (const float*)d_in[17]; p.ffn_conv_b = (const float*)d_in[18]; p.ffn_w_down = (const float*)d_in[19];
    p.out = (float*)d_out; p.ws = (unsigned char*)d_ws;
    hipLaunchKernelGGL(hybrid_fwd, dim3(grid), dim3(NTHREADS), LDS_BYTES, stream, p);
}
```

```cpp
#include <hip/hip_runtime.h>
#include <cstdio>
#include <cstdint>
__device__ __forceinline__ float xsum16(float v) { const unsigned a = __builtin_bit_cast(unsigned, v); const auto r = __builtin_amdgcn_permlane16_swap(a, a, false, false); const unsigned r0 = r[0], r1 = r[1]; return __builtin_bit_cast(float, r0) + __builtin_bit_cast(float, r1); }
__device__ __forceinline__ float xsum32(float v) { const unsigned a = __builtin_bit_cast(unsigned, v); const auto r = __builtin_amdgcn_permlane32_swap(a, a, false, false); const unsigned r0 = r[0], r1 = r[1]; return __builtin_bit_cast(float, r0) + __builtin_bit_cast(float, r1); }
__device__ __forceinline__ float xmax16(float v) { const unsigned a = __builtin_bit_cast(unsigned, v); const auto r = __builtin_amdgcn_permlane16_swap(a, a, false, false); const unsigned r0 = r[0], r1 = r[1]; return fmaxf(__builtin_bit_cast(float, r0), __builtin_bit_cast(float, r1)); }
__device__ __forceinline__ float xmax32(float v) { const unsigned a = __builtin_bit_cast(unsigned, v); const auto r = __builtin_amdgcn_permlane32_swap(a, a, false, false); const unsigned r0 = r[0], r1 = r[1]; return fmaxf(__builtin_bit_cast(float, r0), __builtin_bit_cast(float, r1)); }
template <int CTRL> __device__ __forceinline__ float dppf(float v) { return __builtin_bit_cast(float, __builtin_amdgcn_update_dpp(0, __builtin_bit_cast(int, v), CTRL, 0xf, 0xf, true)); }
namespace pg8 {
#define PG8_LAS __attribute__((address_space(3)))
typedef unsigned short bf16_t;
typedef short bf16x8 __attribute__((ext_vector_type(8)));
typedef float f32x4 __attribute__((ext_vector_type(4)));
typedef unsigned u32x4 __attribute__((ext_vector_type(4)));
typedef int pg8_v8i __attribute__((ext_vector_type(8)));
typedef short pg8_bf16x16 __attribute__((ext_vector_type(16)));
constexpr int BM = 256, BK = 64, HALF = 128, HTB = HALF * BK * 2  , STAGE_BYTES = 8 * HTB, NXCD = 8, WGM = 4;

__host__ __device__ __forceinline__ int lds_byte(int r, int c) { const int st = (r >> 4) * 2 + (c >> 5), rr = r & 15, cc = c & 31, ob = rr * 64 + cc * 2; return st * 1024 + (ob ^ (((ob >> 9) & 1) << 5)); }
__host__ __device__ __forceinline__ void stage_rc(int b, int& R, int& C) { const int st = b / 1024, sb = b % 1024, swz = sb ^ (((sb >> 9) & 1) << 5); R = (st >> 1) * 16 + swz / 64; C = (st & 1) * 32 + (swz % 64) / 2; }
__host__ __device__ __forceinline__ int perm32(int rho) { const int n = rho >> 4, i = rho & 15; return 8 * (i >> 2) + 4 * n + (i & 3); }

struct Unit { int pm, pn; };
struct Gemm { const bf16_t* A; const bf16_t* Bt; int M, N, K, lda, ldb; int sa, sb; };

struct StaticOrder {
    int nM, nN, nwg, G, c, wgm, rot;
    __host__ __device__ void init(int M, int N, int G_, int c_, int wgm_ = WGM, int rot_ = 3) { nM = M / BM; nN = N / BM; nwg = nM * nN; G = G_; c = c_; wgm = wgm_; rot = rot_; }
    __host__ __device__ __forceinline__ bool next(int i, Unit& u) const {
        const long L = (long)i * G + c; if (L >= nwg) return false;
        int wgid = (int)L; { const int q = nwg / NXCD, r = nwg % NXCD, xcd = wgid % NXCD, off = wgid / NXCD; wgid = (xcd < r ? xcd * (q + 1) : r * (q + 1) + (xcd - r) * q) + off; }
        const int nig = wgm * nN, gid = wgid / nig, fm = gid * wgm, gsz = (nM - fm) < wgm ? (nM - fm) : wgm;
        u.pm = fm + ((wgid % nig) % gsz); u.pn = ((wgid % nig) / gsz + rot * (int)(L % NXCD)) % nN; return true;
    }
    __device__ __forceinline__ void a_ready(const Unit&) const {}
    __device__ __forceinline__ void done(const Unit&) const {}
};

__device__ __forceinline__ unsigned cvt_pk_bf16(float lo, float hi) { unsigned r; asm volatile("v_cvt_pk_bf16_f32 %0, %1, %2" : "=v"(r) : "v"(lo), "v"(hi)); return r; }
typedef float f32x2 __attribute__((ext_vector_type(2)));
struct EpiBf16 {
    static constexpr bool PERM = true, AFTER_DRAIN = false;
    bf16_t* O; int ldc;
    __device__ __forceinline__ void operator()(const f32x4 (&acc)[2][2][4][2], const Unit& u, int wr, int wc, int fr, int fq) const {
        const int row0 = u.pm * BM + wr * 64 + fr; const int col0 = u.pn * BM + wc * 32 + 8 * fq;
#pragma unroll
        for (int ai = 0; ai < 2; ++ai)
#pragma unroll
            for (int m = 0; m < 4; ++m) { bf16_t* rowp = O + (size_t)(row0 + ai * HALF + m * 16) * ldc + col0;
#pragma unroll
                for (int bj = 0; bj < 2; ++bj) { const f32x4 v0 = acc[ai][bj][m][0], v1 = acc[ai][bj][m][1];
                    u32x4 w; w.x = cvt_pk_bf16(v0[0], v0[1]); w.y = cvt_pk_bf16(v0[2], v0[3]); w.z = cvt_pk_bf16(v1[0], v1[1]); w.w = cvt_pk_bf16(v1[2], v1[3]);
                    *(u32x4*)(rowp + bj * HALF) = w; } }
    }
};
struct EpiHeads {
    static constexpr bool PERM = true, AFTER_DRAIN = false;
    bf16_t* base[4]; int tile0[4]; int ldc[4]; int kind[4]; const float* gain[4]; float scale[4]; int f8[4];
    int ntens;
    __device__ __forceinline__ void operator()(const f32x4 (&acc)[2][2][4][2], const Unit& u, int wr, int wc, int fr, int fq) const {
        bf16_t* O = base[0]; int t0 = tile0[0], ld = ldc[0], kd = kind[0], o8 = f8[0]; const float* gn = gain[0]; float sc = scale[0];
#pragma unroll
        for (int i = 1; i < 4; ++i) if (i < ntens && u.pn >= tile0[i]) { O = base[i]; t0 = tile0[i]; ld = ldc[i]; kd = kind[i]; gn = gain[i]; sc = scale[i]; o8 = f8[i]; }
        const int head = (u.pn - t0) * 4 + wc; const int row0 = u.pm * BM + wr * 64 + fr;
        f32x4 gv[2][2];
#pragma unroll
        for (int bj = 0; bj < 2; ++bj)
#pragma unroll
            for (int n = 0; n < 2; ++n) gv[bj][n] = (kd == 1) ? *(const f32x4*)(gn + 32 * bj + 8 * fq + 4 * n) * sc : (f32x4){sc, sc, sc, sc};
#pragma unroll
        for (int ai = 0; ai < 2; ++ai)
#pragma unroll
            for (int m = 0; m < 4; ++m) {
                float rs = 1.f;
                if (kd == 1) { float ss = 0.f;
#pragma unroll
                    for (int bj = 0; bj < 2; ++bj)
#pragma unroll
                        for (int n = 0; n < 2; ++n) { const f32x4 x = acc[ai][bj][m][n]; ss += (x[0] * x[0] + x[1] * x[1]) + (x[2] * x[2] + x[3] * x[3]); }
                    ss = xsum32(xsum16(ss));
                    rs = __builtin_amdgcn_rsqf(ss * (1.0f / 64.0f) + 1e-6f); }
                if (o8) {
                    unsigned char* rowb = (unsigned char*)O + (size_t)(row0 + ai * HALF + m * 16) * ld + head * 64 + 8 * fq;
#pragma unroll
                    for (int bj = 0; bj < 2; ++bj) { const f32x4 v0 = acc[ai][bj][m][0] * rs * gv[bj][0], v1 = acc[ai][bj][m][1] * rs * gv[bj][1];
                        int w0 = 0, w1 = 0; w0 = __builtin_amdgcn_cvt_pk_fp8_f32(v0[0], v0[1], w0, false); w0 = __builtin_amdgcn_cvt_pk_fp8_f32(v0[2], v0[3], w0, true);
                        w1 = __builtin_amdgcn_cvt_pk_fp8_f32(v1[0], v1[1], w1, false); w1 = __builtin_amdgcn_cvt_pk_fp8_f32(v1[2], v1[3], w1, true);
                        typedef unsigned u32x2 __attribute__((ext_vector_type(2))); *(u32x2*)(rowb + bj * 32) = (u32x2){(unsigned)w0, (unsigned)w1}; }
                } else {
                bf16_t* rowp = O + (size_t)(row0 + ai * HALF + m * 16) * ld + head * 64 + 8 * fq;
#pragma unroll
                for (int bj = 0; bj < 2; ++bj) { const f32x4 v0 = acc[ai][bj][m][0] * rs * gv[bj][0], v1 = acc[ai][bj][m][1] * rs * gv[bj][1];
                    u32x4 w; w.x = cvt_pk_bf16(v0[0], v0[1]); w.y = cvt_pk_bf16(v0[2], v0[3]); w.z = cvt_pk_bf16(v1[0], v1[1]); w.w = cvt_pk_bf16(v1[2], v1[3]);
                    *(u32x4*)(rowp + bj * 32) = w; } } }
    }
};
template <bool BIN16, bool BOUT16>
struct EpiRes {
    static constexpr bool PERM = false, AFTER_DRAIN = false;
    const void* base; void* out; const float* gate; int gate_bstride; int rows_per_batch;
    __device__ __forceinline__ void operator()(const f32x4 (&acc)[2][2][4][2], const Unit& u, int wr, int wc, int fr, int fq) const {
        typedef unsigned u32x2 __attribute__((ext_vector_type(2)));
        const int col0 = u.pn * BM + wc * 32 + 4 * fq; const int b = (u.pm * BM) / rows_per_batch;
        f32x4 gv[2][2];
#pragma unroll
        for (int bj = 0; bj < 2; ++bj)
#pragma unroll
            for (int n = 0; n < 2; ++n) gv[bj][n] = *(const f32x4*)(gate + (size_t)b * gate_bstride + col0 + bj * HALF + n * 16);
#pragma unroll
        for (int ai = 0; ai < 2; ++ai)
#pragma unroll
            for (int m = 0; m < 4; ++m) { const size_t off = (size_t)(u.pm * BM + ai * HALF + wr * 64 + m * 16 + fr) * 1024 + col0;
#pragma unroll
                for (int bj = 0; bj < 2; ++bj)
#pragma unroll
                    for (int n = 0; n < 2; ++n) { const size_t o2 = off + bj * HALF + n * 16; f32x4 bs;
                        if (BIN16) { const u32x2 r = *(const u32x2*)((const bf16_t*)base + o2); bs = (f32x4){__uint_as_float(r.x << 16), __uint_as_float(r.x & 0xffff0000u), __uint_as_float(r.y << 16), __uint_as_float(r.y & 0xffff0000u)}; }
                        else bs = *(const f32x4*)((const float*)base + o2);
                        const f32x4 v = bs + gv[bj][n] * acc[ai][bj][m][n];
                        if (BOUT16) *(u32x2*)((bf16_t*)out + o2) = (u32x2){cvt_pk_bf16(v[0], v[1]), cvt_pk_bf16(v[2], v[3])};
                        else *(f32x4*)((float*)out + o2) = v; }
                if (m & 1) asm volatile("" ::: "memory"); }
    }
};
template <bool BIN16, bool BOUT16>
struct EpiResStaged {
    static constexpr bool PERM = false, AFTER_DRAIN = true;
    const void* base; void* out; const float* gate; int gate_bstride; int rows_per_batch;
    __device__ __forceinline__ void operator()(const f32x4 (&)[2][2][4][2], const Unit&, int, int, int, int) const {}
    __device__ __forceinline__ void fused(const f32x4 (&acc)[2][2][4][2], const Unit& u, int wr, int wc, int fr_in, int fq_in, PG8_LAS unsigned char* img, int wid, int lane_in) const {
        int fr = fr_in, fq = fq_in, lane = lane_in; asm volatile("" : "+v"(fr), "+v"(fq), "+v"(lane));
        const int col0 = u.pn * BM + wc * 32 + 4 * fq; const int b = (u.pm * BM) / rows_per_batch;
        f32x4 gv[2][2];
#pragma unroll
        for (int bj = 0; bj < 2; ++bj)
#pragma unroll
            for (int n = 0; n < 2; ++n) gv[bj][n] = *(const f32x4*)(gate + (size_t)b * gate_bstride + col0 + bj * HALF + n * 16);
#pragma unroll
        for (int ai = 0; ai < 2; ++ai) {
            u32x4 bs16[8]; f32x4 bs32[BIN16 ? 1 : 8][2];
#pragma unroll
            for (int rnd = 0; rnd < 8; ++rnd) { const int q = rnd * 512 + wid * 64 + lane, row = q >> 5, c8 = q & 31; const size_t o = (size_t)(u.pm * BM + ai * HALF + row) * 1024 + u.pn * BM + 8 * c8;
                if constexpr (BIN16) bs16[rnd] = *(const u32x4*)((const bf16_t*)base + o);
                else { bs32[rnd][0] = *(const f32x4*)((const float*)base + o); bs32[rnd][1] = *(const f32x4*)((const float*)base + o + 4); } }
#pragma unroll
            for (int bj = 0; bj < 2; ++bj)
#pragma unroll
                for (int m = 0; m < 4; ++m)
#pragma unroll
                    for (int n = 0; n < 2; ++n) { const int hrow = wr * 64 + m * 16 + fr, chunk = (bj * HALF + wc * 32 + n * 16 + 4 * fq) >> 2;
                        *(PG8_LAS f32x4*)(img + hrow * 1024 + ((chunk ^ ((hrow & 15) << 2)) << 4)) = gv[bj][n] * acc[ai][bj][m][n]; }
            asm volatile("s_waitcnt lgkmcnt(0)" ::: "memory"); __builtin_amdgcn_s_barrier(); asm volatile("" ::: "memory");
#pragma unroll
            for (int rnd = 0; rnd < 8; ++rnd) { const int q = rnd * 512 + wid * 64 + lane, row = q >> 5, c8 = q & 31; const size_t o = (size_t)(u.pm * BM + ai * HALF + row) * 1024 + u.pn * BM + 8 * c8;
                const PG8_LAS unsigned char* ip = img + row * 1024 + (((2 * c8) ^ ((row & 15) << 2)) << 4);
                const f32x4 g0 = *(const PG8_LAS f32x4*)ip, g1 = *(const PG8_LAS f32x4*)(ip + 16);
                f32x4 b0, b1;
                if constexpr (BIN16) { const u32x4 r = bs16[rnd];
                    b0 = (f32x4){__uint_as_float(r.x << 16), __uint_as_float(r.x & 0xffff0000u), __uint_as_float(r.y << 16), __uint_as_float(r.y & 0xffff0000u)};
                    b1 = (f32x4){__uint_as_float(r.z << 16), __uint_as_float(r.z & 0xffff0000u), __uint_as_float(r.w << 16), __uint_as_float(r.w & 0xffff0000u)}; }
                else { b0 = bs32[rnd][0]; b1 = bs32[rnd][1]; }
                const f32x4 v0 = b0 + g0, v1 = b1 + g1;
                if constexpr (BOUT16) *(u32x4*)((bf16_t*)out + o) = (u32x4){cvt_pk_bf16(v0[0], v0[1]), cvt_pk_bf16(v0[2], v0[3]), cvt_pk_bf16(v1[0], v1[1]), cvt_pk_bf16(v1[2], v1[3])};
                else { *(f32x4*)((float*)out + o) = v0; *(f32x4*)((float*)out + o + 4) = v1; } }
            if (ai == 0) { asm volatile("s_waitcnt lgkmcnt(0)" ::: "memory"); __builtin_amdgcn_s_barrier(); asm volatile("" ::: "memory"); }
        }
    }
};
template <bool BIN16, int HMODE>
struct EpiResNormStaged {
    static constexpr bool PERM = false, AFTER_DRAIN = true;
    const void* base; void* out; const float* gate; int gate_bstride; int rows_per_batch;
    const float* gnorm; const float* modL; int sh_chunk, sc_chunk; bf16_t* hout; unsigned char* hout8; float* xslots; unsigned* cnt; PG8_LAS unsigned char* tbl;
    __device__ __forceinline__ void operator()(const f32x4 (&)[2][2][4][2], const Unit&, int, int, int, int) const {}
    __device__ __forceinline__ void fused(const f32x4 (&acc)[2][2][4][2], const Unit& u, int wr, int wc, int fr_in, int fq_in, PG8_LAS unsigned char* img, int wid, int lane_in) const {
        int fr = fr_in, fq = fq_in, lane = lane_in; asm volatile("" : "+v"(fr), "+v"(fq), "+v"(lane));
        const int col0 = u.pn * BM + wc * 32 + 4 * fq; const int b = (u.pm * BM) / rows_per_batch;
        PG8_LAS float* Pt = (PG8_LAS float*)tbl; PG8_LAS float* St = (PG8_LAS float*)(tbl + 1024); PG8_LAS unsigned* flag = (PG8_LAS unsigned*)(tbl + 2048);
        f32x4 gv[2][2];
#pragma unroll
        for (int bj = 0; bj < 2; ++bj)
#pragma unroll
            for (int n = 0; n < 2; ++n) gv[bj][n] = *(const f32x4*)(gate + (size_t)b * gate_bstride + col0 + bj * HALF + n * 16);
        constexpr bool KEEP = BIN16;
        u32x4 wk[KEEP ? 8 : 1];
#pragma unroll
        for (int ai = 0; ai < 2; ++ai) {
            u32x4 bs16[8]; f32x4 bs32[BIN16 ? 1 : 8][2];
#pragma unroll
            for (int rnd = 0; rnd < 8; ++rnd) { const int q = rnd * 512 + wid * 64 + lane, row = q >> 5, c8 = q & 31; const size_t o = (size_t)(u.pm * BM + ai * HALF + row) * 1024 + u.pn * BM + 8 * c8;
                if constexpr (BIN16) bs16[rnd] = *(const u32x4*)((const bf16_t*)base + o);
                else { bs32[rnd][0] = *(const f32x4*)((const float*)base + o); bs32[rnd][1] = *(const f32x4*)((const float*)base + o + 4); } }
#pragma unroll
            for (int bj = 0; bj < 2; ++bj)
#pragma unroll
                for (int m = 0; m < 4; ++m)
#pragma unroll
                    for (int n = 0; n < 2; ++n) { const int hrow = wr * 64 + m * 16 + fr, chunk = (bj * HALF + wc * 32 + n * 16 + 4 * fq) >> 2;
                        *(PG8_LAS f32x4*)(img + hrow * 1024 + ((chunk ^ ((hrow & 15) << 2)) << 4)) = gv[bj][n] * acc[ai][bj][m][n]; }
            asm volatile("s_waitcnt lgkmcnt(0)" ::: "memory"); __builtin_amdgcn_s_barrier(); asm volatile("" ::: "memory");
#pragma unroll
            for (int rnd = 0; rnd < 8; ++rnd) { const int q = rnd * 512 + wid * 64 + lane, row = q >> 5, c8 = q & 31; const size_t o = (size_t)(u.pm * BM + ai * HALF + row) * 1024 + u.pn * BM + 8 * c8;
                const PG8_LAS unsigned char* ip = img + row * 1024 + (((2 * c8) ^ ((row & 15) << 2)) << 4);
                const f32x4 g0 = *(const PG8_LAS f32x4*)ip, g1 = *(const PG8_LAS f32x4*)(ip + 16);
                f32x4 b0, b1;
                if constexpr (BIN16) { const u32x4 r = bs16[rnd];
                    b0 = (f32x4){__uint_as_float(r.x << 16), __uint_as_float(r.x & 0xffff0000u), __uint_as_float(r.y << 16), __uint_as_float(r.y & 0xffff0000u)};
                    b1 = (f32x4){__uint_as_float(r.z << 16), __uint_as_float(r.z & 0xffff0000u), __uint_as_float(r.w << 16), __uint_as_float(r.w & 0xffff0000u)}; }
                else { b0 = bs32[rnd][0]; b1 = bs32[rnd][1]; }
                const f32x4 v0 = b0 + g0, v1 = b1 + g1;
                const u32x4 w = (u32x4){cvt_pk_bf16(v0[0], v0[1]), cvt_pk_bf16(v0[2], v0[3]), cvt_pk_bf16(v1[0], v1[1]), cvt_pk_bf16(v1[2], v1[3])};
                *(u32x4*)((bf16_t*)out + o) = w; if constexpr (KEEP) { if (ai == 1) wk[rnd] = w; }
                float ss = 0.f;
#pragma unroll
                for (int k = 0; k < 4; ++k) { const float lo = __uint_as_float(w[k] << 16), hi = __uint_as_float(w[k] & 0xffff0000u); ss += lo * lo + hi * hi; }
                ss += dppf<0xB1>(ss); ss += dppf<0x4E>(ss); ss += dppf<0x141>(ss); ss += dppf<0x140>(ss); ss = xsum16(ss);
                if (c8 == 0) Pt[ai * HALF + row] = ss; }
            asm volatile("s_waitcnt lgkmcnt(0)" ::: "memory"); __builtin_amdgcn_s_barrier(); asm volatile("" ::: "memory");
        }
        const int c8n = lane & 31; const int gcol = u.pn * BM + 8 * c8n;
        f32x4 G0, G1, S0, S1;
        { const f32x4 g0 = *(const f32x4*)(gnorm + gcol), g1 = *(const f32x4*)(gnorm + gcol + 4);
          const f32x4 c0 = *(const f32x4*)(modL + (size_t)b * 6144 + sc_chunk * 1024 + gcol), c1 = *(const f32x4*)(modL + (size_t)b * 6144 + sc_chunk * 1024 + gcol + 4);
          G0 = g0 * (c0 + 1.0f); G1 = g1 * (c1 + 1.0f); S0 = *(const f32x4*)(modL + (size_t)b * 6144 + sh_chunk * 1024 + gcol); S1 = *(const f32x4*)(modL + (size_t)b * 6144 + sh_chunk * 1024 + gcol + 4); }
        const int trow = wid * 32 + (lane & 31);
        if (lane < 32) __hip_atomic_store(xslots + ((size_t)(u.pm * BM + trow) * 4 + u.pn), Pt[trow], __ATOMIC_RELAXED, __HIP_MEMORY_SCOPE_AGENT);
        asm volatile("s_waitcnt vmcnt(0)" ::: "memory");
        if (lane == 0) __hip_atomic_fetch_add(cnt + 16 * u.pm, 1u, __ATOMIC_RELAXED, __HIP_MEMORY_SCOPE_AGENT);
        if (wid == 0) {
            unsigned sp = 0u;
            while ((unsigned)__builtin_amdgcn_readfirstlane(__hip_atomic_load(cnt + 16 * u.pm, __ATOMIC_RELAXED, __HIP_MEMORY_SCOPE_AGENT)) < 32u) { __builtin_amdgcn_s_sleep(1); if (++sp > (1u << 22)) break; }
            __builtin_amdgcn_fence(__ATOMIC_ACQUIRE, "agent");
            if (lane == 0) flag[0] = sp;
        }
        asm volatile("s_waitcnt vmcnt(0) lgkmcnt(0)" ::: "memory"); __builtin_amdgcn_s_barrier(); asm volatile("" ::: "memory");
        if (lane < 32) { const float* sl = xslots + (size_t)(u.pm * BM + trow) * 4; float t = 0.f;
#pragma unroll
            for (int k = 0; k < 4; ++k) t += __hip_atomic_load(sl + k, __ATOMIC_RELAXED, __HIP_MEMORY_SCOPE_AGENT);
            St[trow] = __builtin_amdgcn_rsqf(t * (1.0f / 1024.0f) + 1e-6f); }
        asm volatile("s_waitcnt lgkmcnt(0)" ::: "memory"); __builtin_amdgcn_s_barrier(); asm volatile("" ::: "memory");
#pragma unroll
        for (int hf = 0; hf < 2; ++hf) {
            u32x4 xr[8];
            if (!KEEP || hf == 0) {
#pragma unroll
                for (int rnd = 0; rnd < 8; ++rnd) { const int q = rnd * 512 + wid * 64 + lane, row = q >> 5; xr[rnd] = *(const u32x4*)((const bf16_t*)out + (size_t)(u.pm * BM + hf * HALF + row) * 1024 + gcol); } }
#pragma unroll
            for (int rnd = 0; rnd < 8; ++rnd) { const int q = rnd * 512 + wid * 64 + lane, row = q >> 5; const size_t o = (size_t)(u.pm * BM + hf * HALF + row) * 1024 + gcol;
                const float rs = St[hf * HALF + row]; u32x4 r; if (KEEP && hf == 1) r = wk[KEEP ? rnd : 0]; else r = xr[rnd];
                const f32x4 x0 = (f32x4){__uint_as_float(r.x << 16), __uint_as_float(r.x & 0xffff0000u), __uint_as_float(r.y << 16), __uint_as_float(r.y & 0xffff0000u)};
                const f32x4 x1 = (f32x4){__uint_as_float(r.z << 16), __uint_as_float(r.z & 0xffff0000u), __uint_as_float(r.w << 16), __uint_as_float(r.w & 0xffff0000u)};
                const f32x4 h0 = x0 * rs * G0 + S0, h1 = x1 * rs * G1 + S1;
                int w0 = 0, w1 = 0; w0 = __builtin_amdgcn_cvt_pk_fp8_f32(h0[0], h0[1], w0, false); w0 = __builtin_amdgcn_cvt_pk_fp8_f32(h0[2], h0[3], w0, true);
                w1 = __builtin_amdgcn_cvt_pk_fp8_f32(h1[0], h1[1], w1, false); w1 = __builtin_amdgcn_cvt_pk_fp8_f32(h1[2], h1[3], w1, true);
                typedef unsigned u32x2 __attribute__((ext_vector_type(2)));
                *(u32x2*)(hout8 + o) = (u32x2){(unsigned)w0, (unsigned)w1};
                if constexpr (HMODE == 2) *(u32x4*)(hout + o) = (u32x4){cvt_pk_bf16(h0[0], h0[1]), cvt_pk_bf16(h0[2], h0[3]), cvt_pk_bf16(h1[0], h1[1]), cvt_pk_bf16(h1[2], h1[3])}; }
        }
    }
};
struct EpiConvGate {
    static constexpr bool PERM = true, AFTER_DRAIN = false;
    bf16_t* U; const float* cw; const float* cb; float* sideA0; float* sideG0; float* sideA1; PG8_LAS float* halo; PG8_LAS unsigned char* stage;
    __device__ __forceinline__ void operator()(const f32x4 (&acc)[2][2][4][2], const Unit& u, int wr, int wc, int fr_in, int fq_in) const {
        constexpr int FFc = 2816;
        int fr = fr_in, fq = fq_in; asm volatile("" : "+v"(fr), "+v"(fq));
        const int colt = u.pn * 128 + wc * 32 + 8 * fq;
        const int lcol = wc * 32 + 8 * fq;
        if (fr >= 14) {
#pragma unroll
            for (int ai = 0; ai < 2; ++ai)
#pragma unroll
                for (int n = 0; n < 2; ++n) *(PG8_LAS f32x4*)(halo + ((ai * 2 + wr) * 2 + (fr - 14)) * 128 + lcol + 4 * n) = acc[ai][0][3][n];
        }
        asm volatile("s_waitcnt lgkmcnt(0)" ::: "memory"); __builtin_amdgcn_s_barrier(); asm volatile("" ::: "memory");
        typedef float f32x2 __attribute__((ext_vector_type(2)));
#define CG_DPP(x, ctrl) __int_as_float(__builtin_amdgcn_update_dpp(0, __float_as_int(x), ctrl, 0xf, 0xf, true))
        const bool lane0 = (fr == 0), lane01 = (fr < 2);
        const int wid8 = wr * 4 + wc, lane64 = fq * 16 + fr;
#pragma unroll
        for (int ai = 0; ai < 2; ++ai) {
#pragma unroll
            for (int n = 0; n < 2; ++n) {
                const f32x4 w0 = *(const f32x4*)(cw + colt + 4 * n), w1 = *(const f32x4*)(cw + FFc + colt + 4 * n), w2 = *(const f32x4*)(cw + 2 * FFc + colt + 4 * n), bb = *(const f32x4*)(cb + colt + 4 * n);
                f32x4 w1b, w0b;
#pragma unroll
                for (int e4 = 0; e4 < 4; ++e4) { w1b[e4] = lane0 ? w1[e4] : 0.f; w0b[e4] = lane01 ? w0[e4] : 0.f; }
                const int pb = (wr == 1) ? (ai * 2) : ((ai == 1) ? 1 : 0); const int hr = (fr >= 14) ? (fr - 14) : 0;
                const f32x4 prv = *(const PG8_LAS f32x4*)(halo + (pb * 2 + hr) * 128 + lcol + 4 * n);
#pragma unroll
                for (int m = 0; m < 4; ++m) {
                    const f32x4 x = acc[ai][0][m][n], gt = acc[ai][1][m][n]; const f32x4 pv = (m == 0) ? prv : acc[ai][0][m - 1][n];
                    f32x4 sv;
#pragma unroll
                    for (int e4 = 0; e4 < 4; ++e4) {
                        float t = fmaf(w2[e4], x[e4], bb[e4]);
                        t = fmaf(CG_DPP(x[e4], 0x111), w1[e4], t);
                        t = fmaf(CG_DPP(pv[e4], 0x121), w1b[e4], t);
                        t = fmaf(CG_DPP(x[e4], 0x112), w0[e4], t);
                        t = fmaf(CG_DPP(pv[e4], 0x122), w0b[e4], t);
                        sv[e4] = t;
                    }
                    f32x4 uo;
#pragma unroll
                    for (int p = 0; p < 2; ++p) {
                        const f32x2 s2 = (f32x2){sv[2 * p], sv[2 * p + 1]}; const f32x2 g2 = (f32x2){gt[2 * p], gt[2 * p + 1]};
                        const f32x2 a2 = s2 * -1.4426950408889634f;
                        const f32x2 d2 = (f32x2){__builtin_amdgcn_exp2f(fminf(a2[0], 60.f)), __builtin_amdgcn_exp2f(fminf(a2[1], 60.f))} + 1.0f;
                        const float r = __builtin_amdgcn_rcpf(d2[0] * d2[1]);
                        const f32x2 inv = (f32x2){d2[1], d2[0]} * r;
                        const f32x2 u2 = (s2 * g2) * inv;
                        uo[2 * p] = u2[0]; uo[2 * p + 1] = u2[1];
                    }
                    const int hrow = wr * 64 + m * 16 + fr, trow = ai * HALF + hrow;
                    int w8 = 0; w8 = __builtin_amdgcn_cvt_pk_fp8_f32(uo[0], uo[1], w8, false); w8 = __builtin_amdgcn_cvt_pk_fp8_f32(uo[2], uo[3], w8, true);
                    { const int cb4 = lcol + 4 * n; *(PG8_LAS unsigned*)(stage + hrow * 128 + ((((cb4 >> 4) ^ ((hrow >> 1) & 7)) << 4) | (cb4 & 15))) = (unsigned)w8; }
                    if (ai == 0 && m == 0) {
                        if (trow < 2) { *(f32x4*)(sideA0 + ((size_t)u.pm * 2 + trow) * FFc + colt + 4 * n) = x; *(f32x4*)(sideG0 + ((size_t)u.pm * 2 + trow) * FFc + colt + 4 * n) = gt; } }
                    if (ai == 1 && m == 3) { if (trow >= 254) *(f32x4*)(sideA1 + ((size_t)u.pm * 2 + (trow - 254)) * FFc + colt + 4 * n) = x; }
                }
            }
            asm volatile("s_waitcnt lgkmcnt(0)" ::: "memory"); __builtin_amdgcn_s_barrier(); asm volatile("" ::: "memory");
#pragma unroll
            for (int rnd = 0; rnd < 2; ++rnd) { const int q = rnd * 512 + wid8 * 64 + lane64, hrow = q >> 3, c = q & 7;
                const u32x4 v = *(const PG8_LAS u32x4*)(stage + hrow * 128 + ((c ^ ((hrow >> 1) & 7)) << 4));
                if (ai == 1 || hrow >= 2) *(u32x4*)((unsigned char*)U + (size_t)(u.pm * BM + ai * HALF + hrow) * FFc + u.pn * 128 + c * 16) = v; }
            if (ai == 0) { asm volatile("s_waitcnt lgkmcnt(0)" ::: "memory"); __builtin_amdgcn_s_barrier(); asm volatile("" ::: "memory"); }
        }
#undef CG_DPP
        asm volatile("s_waitcnt lgkmcnt(0)" ::: "memory"); __builtin_amdgcn_s_barrier(); asm volatile("" ::: "memory");
    }
};
template <class Epi, class Sched, bool ALIGN_EPI = false, bool SP2 = false, bool F8 = false>
__device__ __forceinline__ void gemm_phase(PG8_LAS unsigned char* lds, const Gemm g, const Sched& S, const Epi& E, const int tid) {
    const int wid = __builtin_amdgcn_readfirstlane(tid >> 6), lane = tid & 63, wr = wid >> 2, wc = wid & 3, fr = lane & 15, fq = lane >> 4;
    const int K = g.K, nt = K / BK;
    unsigned voffA[2], voffB[2];
#pragma unroll
    for (int i = 0; i < 2; ++i) { int R, C; stage_rc(tid * 16 + i * 8192, R, C); const int Rb = Epi::PERM ? ((R & ~31) + perm32(R & 31)) : R;
        voffA[i] = (unsigned)(R * g.lda + C) * 2u; voffB[i] = (unsigned)(Rb * g.ldb + C) * 2u; }
    const size_t kstep = (size_t)(BK * 2);
    const size_t hstepA = (size_t)HALF * g.lda * 2, hstepB = (size_t)HALF * g.ldb * 2;
    const size_t tstepA = 2 * hstepA, tstepB = 2 * hstepB;
    const unsigned ldsw = (unsigned)wid * 1024u;
    const int aoff = lds_byte(wr * 64 + fr, fq * 8), boff = lds_byte(wc * 32 + fr, fq * 8);
#define PG8_SA(b, h) (((b) * 2 + (h)) * HTB)
#define PG8_SB(b, h) ((4 + (b) * 2 + (h)) * HTB)
#define PG8_STAGE(bufoff, gbase, voff) do { _Pragma("unroll") for (int _i = 0; _i < 2; ++_i) \
        __builtin_amdgcn_global_load_lds((const unsigned*)((const char*)(gbase) + (voff)[_i]), (PG8_LAS unsigned*)(lds + (bufoff) + ldsw + _i * 8192), 16, 0, 0); } while (0)
#define PG8_LDA(dst, b, h) do { _Pragma("unroll") for (int m = 0; m < 4; ++m) { dst[m].lo = *(const PG8_LAS bf16x8*)(lds + PG8_SA(b, h) + aoff + m * 2048); dst[m].hi = *(const PG8_LAS bf16x8*)(lds + PG8_SA(b, h) + aoff + m * 2048 + 1024); } } while (0)
#define PG8_LDB(dst, b, h) do { _Pragma("unroll") for (int n = 0; n < 2; ++n) { dst[n].lo = *(const PG8_LAS bf16x8*)(lds + PG8_SB(b, h) + boff + n * 2048); dst[n].hi = *(const PG8_LAS bf16x8*)(lds + PG8_SB(b, h) + boff + n * 2048 + 1024); } } while (0)
#define PG8_MMA(ai, bj, At, Bt) do { __builtin_amdgcn_s_setprio(1); _Pragma("unroll") for (int m = 0; m < 4; ++m) _Pragma("unroll") for (int n = 0; n < 2; ++n) { \
        if constexpr (F8) asm volatile("v_mfma_scale_f32_16x16x128_f8f6f4 %0, %1, %2, %0, %3, %4 op_sel_hi:[0,0,0]" : "+v"(acc[ai][bj][m][n]) : "v"(__builtin_bit_cast(pg8_v8i, Bt[n])), "v"(__builtin_bit_cast(pg8_v8i, At[m])), "v"(f8sb), "v"(f8sa));   \
        else { acc[ai][bj][m][n] = __builtin_amdgcn_mfma_f32_16x16x32_bf16(Bt[n].lo, At[m].lo, acc[ai][bj][m][n], 0, 0, 0); acc[ai][bj][m][n] = __builtin_amdgcn_mfma_f32_16x16x32_bf16(Bt[n].hi, At[m].hi, acc[ai][bj][m][n], 0, 0, 0); } } \
        __builtin_amdgcn_s_setprio(0); } while (0)
#define PG8_WAIT_V(n) asm volatile("s_waitcnt vmcnt(" #n ")" ::: "memory")
#define PG8_WAIT_L(n) asm volatile("s_waitcnt lgkmcnt(" #n ")" ::: "memory")
#define PG8_BAR __builtin_amdgcn_s_barrier()
#define PG8_SCHED __builtin_amdgcn_sched_barrier(0)
    Unit cur, nxt; int ui = 0;
    if (!S.next(0, cur)) return;
    f32x4 acc[2][2][4][2];
#pragma unroll
    for (int a = 0; a < 2; ++a)
#pragma unroll
        for (int b = 0; b < 2; ++b)
#pragma unroll
            for (int m = 0; m < 4; ++m)
#pragma unroll
                for (int n = 0; n < 2; ++n) acc[a][b][m][n] = (f32x4){0.f, 0.f, 0.f, 0.f};
    const int f8sa = g.sa, f8sb = g.sb; (void)f8sa; (void)f8sb;
    pg8_bf16x16 At[4], B0[2], B1[2];
    const char* cA = (const char*)g.A + (size_t)cur.pm * tstepA; const char* cB = (const char*)g.Bt + (size_t)cur.pn * tstepB;
    S.a_ready(cur);
    if constexpr (SP2) {
        PG8_STAGE(PG8_SB(0, 0), cB, voffB); PG8_STAGE(PG8_SB(0, 1), cB + hstepB, voffB); PG8_STAGE(PG8_SA(0, 0), cA, voffA); PG8_STAGE(PG8_SA(0, 1), cA + hstepA, voffA);
        if (wr == 1) PG8_BAR;
        PG8_WAIT_V(2); PG8_BAR;
        PG8_STAGE(PG8_SB(1, 0), cB + kstep, voffB); PG8_STAGE(PG8_SA(1, 0), cA + kstep, voffA); PG8_STAGE(PG8_SB(1, 1), cB + hstepB + kstep, voffB);
        PG8_WAIT_V(6); PG8_BAR;
    } else {
        PG8_STAGE(PG8_SB(0, 0), cB, voffB); PG8_STAGE(PG8_SA(0, 0), cA, voffA); PG8_STAGE(PG8_SB(0, 1), cB + hstepB, voffB); PG8_STAGE(PG8_SA(0, 1), cA + hstepA, voffA);
        if (wr == 1) PG8_BAR;
        PG8_WAIT_V(4); PG8_BAR;
        PG8_STAGE(PG8_SB(1, 0), cB + kstep, voffB); PG8_STAGE(PG8_SA(1, 0), cA + kstep, voffA); PG8_STAGE(PG8_SB(1, 1), cB + hstepB + kstep, voffB);
        PG8_WAIT_V(6); PG8_BAR;
    }
    for (;;) {
        const bool has_next = S.next(ui + 1, nxt);
        const char* nA = has_next ? (const char*)g.A + (size_t)nxt.pm * tstepA : cA; const char* nB = has_next ? (const char*)g.Bt + (size_t)nxt.pn * tstepB : cB;
#pragma unroll 1
        for (int t = 0; t < nt; t += 2) {
            const bool last = (t == nt - 2);
            const char* a1 = cA + (size_t)(t + 1) * kstep;
            const char* a2 = last ? nA : cA + (size_t)(t + 2) * kstep; const char* b2 = last ? nB : cB + (size_t)(t + 2) * kstep;
            const char* a3 = a2 + kstep; const char* b3 = b2 + kstep;
            if (last && has_next) S.a_ready(nxt);
            if constexpr (SP2) {
            PG8_LDB(B0, 0, 0); PG8_LDB(B1, 0, 1); PG8_SCHED; PG8_LDA(At, 0, 0); PG8_STAGE(PG8_SA(1, 1), a1 + hstepA, voffA);
            PG8_WAIT_V(8); PG8_WAIT_L(0); PG8_BAR; PG8_MMA(0, 0, At, B0); PG8_MMA(0, 1, At, B1); PG8_BAR; PG8_SCHED;
            PG8_LDA(At, 0, 1); PG8_STAGE(PG8_SB(0, 0), b2, voffB); PG8_STAGE(PG8_SB(0, 1), b2 + hstepB, voffB); PG8_STAGE(PG8_SA(0, 0), a2, voffA);
            PG8_WAIT_V(8); PG8_WAIT_L(0); PG8_BAR; PG8_MMA(1, 0, At, B0); PG8_MMA(1, 1, At, B1); PG8_BAR; PG8_SCHED;
            PG8_LDB(B0, 1, 0); PG8_LDB(B1, 1, 1); PG8_SCHED; PG8_LDA(At, 1, 0); PG8_STAGE(PG8_SA(0, 1), a2 + hstepA, voffA);
            PG8_WAIT_V(8); PG8_WAIT_L(0); PG8_BAR; PG8_MMA(0, 0, At, B0); PG8_MMA(0, 1, At, B1); PG8_BAR; PG8_SCHED;
            PG8_LDA(At, 1, 1); PG8_STAGE(PG8_SB(1, 0), b3, voffB); PG8_STAGE(PG8_SB(1, 1), b3 + hstepB, voffB); PG8_STAGE(PG8_SA(1, 0), a3, voffA);
            PG8_WAIT_V(8); PG8_WAIT_L(0); PG8_BAR; PG8_MMA(1, 0, At, B0); PG8_MMA(1, 1, At, B1); PG8_BAR; PG8_SCHED;
            } else {
            PG8_LDB(B0, 0, 0); PG8_SCHED; PG8_LDA(At, 0, 0); PG8_STAGE(PG8_SA(1, 1), a1 + hstepA, voffA);
            PG8_WAIT_L(8); PG8_BAR; PG8_WAIT_L(0); PG8_MMA(0, 0, At, B0); PG8_BAR; PG8_SCHED;
            PG8_LDB(B1, 0, 1); PG8_STAGE(PG8_SB(0, 0), b2, voffB);
            PG8_BAR; PG8_WAIT_L(0); PG8_MMA(0, 1, At, B1); PG8_BAR;
            PG8_LDA(At, 0, 1); PG8_STAGE(PG8_SA(0, 0), a2, voffA);
            PG8_BAR; PG8_WAIT_L(0); PG8_MMA(1, 0, At, B0); PG8_BAR; PG8_SCHED;
            PG8_STAGE(PG8_SB(0, 1), b2 + hstepB, voffB);
            PG8_WAIT_V(6); PG8_BAR; PG8_MMA(1, 1, At, B1); PG8_BAR;
            PG8_LDB(B0, 1, 0); PG8_SCHED; PG8_LDA(At, 1, 0); PG8_STAGE(PG8_SA(0, 1), a2 + hstepA, voffA);
            PG8_WAIT_L(8); PG8_BAR; PG8_WAIT_L(0); PG8_MMA(0, 0, At, B0); PG8_BAR; PG8_SCHED;
            PG8_LDB(B1, 1, 1); PG8_STAGE(PG8_SB(1, 0), b3, voffB);
            PG8_BAR; PG8_WAIT_L(0); PG8_MMA(0, 1, At, B1); PG8_BAR;
            PG8_LDA(At, 1, 1); PG8_STAGE(PG8_SA(1, 0), a3, voffA);
            PG8_BAR; PG8_WAIT_L(0); PG8_MMA(1, 0, At, B0); PG8_BAR; PG8_SCHED;
            PG8_STAGE(PG8_SB(1, 1), b3 + hstepB, voffB);
            PG8_WAIT_V(6); PG8_BAR; PG8_MMA(1, 1, At, B1); PG8_BAR;
            }
        }
        if constexpr (ALIGN_EPI) { if (wr == 0) PG8_BAR; }
        if constexpr (F8) {
            asm volatile("s_nop 15\n\ts_nop 7" : "+v"(acc[0][0][0][0]), "+v"(acc[0][0][0][1]), "+v"(acc[0][0][1][0]), "+v"(acc[0][0][1][1]), "+v"(acc[0][0][2][0]), "+v"(acc[0][0][2][1]), "+v"(acc[0][0][3][0]), "+v"(acc[0][0][3][1]), "+v"(acc[0][1][0][0]), "+v"(acc[0][1][0][1]), "+v"(acc[0][1][1][0]), "+v"(acc[0][1][1][1]), "+v"(acc[0][1][2][0]), "+v"(acc[0][1][2][1]), "+v"(acc[0][1][3][0]), "+v"(acc[0][1][3][1]) :: "memory");
            asm volatile("" : "+v"(acc[1][0][0][0]), "+v"(acc[1][0][0][1]), "+v"(acc[1][0][1][0]), "+v"(acc[1][0][1][1]), "+v"(acc[1][0][2][0]), "+v"(acc[1][0][2][1]), "+v"(acc[1][0][3][0]), "+v"(acc[1][0][3][1]), "+v"(acc[1][1][0][0]), "+v"(acc[1][1][0][1]), "+v"(acc[1][1][1][0]), "+v"(acc[1][1][1][1]), "+v"(acc[1][1][2][0]), "+v"(acc[1][1][2][1]), "+v"(acc[1][1][3][0]), "+v"(acc[1][1][3][1]) :: "memory"); }
        if constexpr (!Epi::AFTER_DRAIN) { E(acc, cur, wr, wc, fr, fq); S.done(cur); }
        if (!has_next) break;
#pragma unroll
        for (int a = 0; a < 2; ++a)
#pragma unroll
            for (int b = 0; b < 2; ++b)
#pragma unroll
                for (int m = 0; m < 4; ++m)
#pragma unroll
                    for (int n = 0; n < 2; ++n) acc[a][b][m][n] = (f32x4){0.f, 0.f, 0.f, 0.f};
        cur = nxt; cA = nA; cB = nB; ++ui;
        if constexpr (ALIGN_EPI) { if (wr == 1) PG8_BAR; }
    }
    PG8_WAIT_V(0);
    if constexpr (!ALIGN_EPI) { if (wr == 0) PG8_BAR; }
    PG8_BAR;
    if constexpr (Epi::AFTER_DRAIN) { E.fused(acc, cur, wr, wc, fr, fq, lds, wid, lane); S.done(cur); }
#undef PG8_SA
#undef PG8_SB
#undef PG8_STAGE
#undef PG8_LDA
#undef PG8_LDB
#undef PG8_MMA
#undef PG8_WAIT_V
#undef PG8_WAIT_L
#undef PG8_BAR
#undef PG8_SCHED
}
}

#include <hip/hip_bf16.h>
#include <cmath>
namespace attn_body {
using bf16=__hip_bfloat16;
using bf16x8=__attribute__((ext_vector_type(8)))short;
using s16x4=__attribute__((ext_vector_type(4)))short;
using f32x16=__attribute__((ext_vector_type(16)))float;
using u32x4=__attribute__((ext_vector_type(4)))unsigned;
constexpr int BATCH=2,NHEAD=16,SEQ=8192,D=64,DM=NHEAD*D;
constexpr int NW=8,QBLK=32,QB=QBLK*NW,KVBLK=64,NQB=SEQ/QB;
constexpr int ATTN_PITCH=DM, ATTN_UNIT_ROWS=QB;
__device__ __forceinline__ int crow(int r,int hi){return (r&3)+8*(r>>2)+4*hi;}
#define SBAR() __builtin_amdgcn_sched_barrier(0)
__device__ __forceinline__ void cmask(f32x16&p0,f32x16&p1,int jb,int qrel,int hi){
  const float NEG=-INFINITY; int kb=64*jb+4*hi;
  #pragma unroll
  for(int r=0;r<16;++r){int kv=kb+(r&3)+8*(r>>2); if(kv>qrel)p0[r]=NEG; if(kv+32>qrel)p1[r]=NEG;}
}

constexpr int NSLOT=3, SLOTB=8192, KSLOTB=10240;
constexpr int LDS_K=0, LDS_V=NSLOT*KSLOTB, LDS_WS=LDS_V+NSLOT*SLOTB, LDS_OST=LDS_WS+NW*64*4, LDS_BYTES=LDS_OST+NW*4096;
#define KOFF(sl) ((sl)+((sl)>>2))
constexpr float C2=0.125f*1.4426950408889634f;
__device__ __forceinline__ void glds16(const void*gsrc,unsigned lds_dst){unsigned keep;
  asm volatile("s_mov_b32 %0, m0\n\ts_mov_b32 m0, %2\n\ts_nop 0\n\tglobal_load_lds_dwordx4 %1, off\n\ts_mov_b32 m0, %0":"=&s"(keep):"v"(gsrc),"s"(lds_dst):"memory");}
__device__ __forceinline__ void glds4(const void*gsrc,unsigned lds_dst){unsigned keep;
  asm volatile("s_mov_b32 %0, m0\n\ts_mov_b32 m0, %2\n\ts_nop 0\n\tglobal_load_lds_dword %1, off\n\ts_mov_b32 m0, %0":"=&s"(keep):"v"(gsrc),"s"(lds_dst):"memory");}
__device__ __forceinline__ float max3f(float a,float b,float c){float r;asm("v_max3_f32 %0, %1, %2, %3":"=v"(r):"v"(a),"v"(b),"v"(c));return r;}
__device__ __forceinline__ float max2f(float a,float b){float r;asm("v_max_f32_e32 %0, %1, %2":"=v"(r):"v"(a),"v"(b));return r;}
__device__ __forceinline__ float fadd_s(float a,float b){float r;asm("v_add_f32_e32 %0, %1, %2":"=v"(r):"v"(a),"v"(b));return r;}
__device__ __forceinline__ float fsub_s(float a,float b){float r;asm("v_sub_f32_e32 %0, %1, %2":"=v"(r):"v"(a),"v"(b));return r;}
typedef float f32x2_t __attribute__((ext_vector_type(2))); typedef __bf16 bf16x2_t __attribute__((ext_vector_type(2)));
__device__ __forceinline__ unsigned cvtpk_s(float lo,float hi){f32x2_t v={lo,hi};bf16x2_t b=__builtin_convertvector(v,bf16x2_t);return __builtin_bit_cast(unsigned,b);}
#define WAIT_BAR(N) asm volatile("s_waitcnt vmcnt(" #N ") lgkmcnt(0)\n\ts_barrier":::"memory")

__device__ __forceinline__ void qkt(f32x16&p0,f32x16&p1,const char*Kslot,const bf16x8*qr,const bf16x8 qe,int r32,int hi){
  const char*kb=Kslot+hi*1024+r32*16;
  { const bf16x8 e0=*reinterpret_cast<const bf16x8*>(kb+8192); const bf16x8 e1=*reinterpret_cast<const bf16x8*>(kb+8192+512); const f32x16 z=f32x16{};
    p0=__builtin_amdgcn_mfma_f32_32x32x16_bf16(e0,qe,z,0,0,0); p1=__builtin_amdgcn_mfma_f32_32x32x16_bf16(e1,qe,z,0,0,0); }
  #pragma unroll
  for(int d0=0;d0<4;++d0){
    const bf16x8 b0=*reinterpret_cast<const bf16x8*>(kb+d0*2048);
    const bf16x8 b1=*reinterpret_cast<const bf16x8*>(kb+d0*2048+512);
    {p0=__builtin_amdgcn_mfma_f32_32x32x16_bf16(b0,qr[d0],p0,0,0,0);p1=__builtin_amdgcn_mfma_f32_32x32x16_bf16(b1,qr[d0],p1,0,0,0);}}
}
typedef __attribute__((address_space(3))) const char* lds_cptr;
typedef short v4i16_t __attribute__((ext_vector_type(4)));
__device__ __forceinline__ void kload8(bf16x8*kf,lds_cptr kp){
  kf[0]=*(const __attribute__((address_space(3))) bf16x8*)(kp);      kf[1]=*(const __attribute__((address_space(3))) bf16x8*)(kp+512);
  kf[2]=*(const __attribute__((address_space(3))) bf16x8*)(kp+2048); kf[3]=*(const __attribute__((address_space(3))) bf16x8*)(kp+2560);
  kf[4]=*(const __attribute__((address_space(3))) bf16x8*)(kp+4096); kf[5]=*(const __attribute__((address_space(3))) bf16x8*)(kp+4608);
  kf[6]=*(const __attribute__((address_space(3))) bf16x8*)(kp+6144); kf[7]=*(const __attribute__((address_space(3))) bf16x8*)(kp+6656);
  kf[8]=*(const __attribute__((address_space(3))) bf16x8*)(kp+8192); kf[9]=*(const __attribute__((address_space(3))) bf16x8*)(kp+8704);
}
__device__ __forceinline__ void kload2(bf16x8*kf,lds_cptr kp,int j){ kf[2*j]=*(const __attribute__((address_space(3))) bf16x8*)(kp+j*2048); kf[2*j+1]=*(const __attribute__((address_space(3))) bf16x8*)(kp+j*2048+512); }
__device__ __forceinline__ s16x4 vtr(lds_cptr p){ return __builtin_bit_cast(s16x4,__builtin_amdgcn_ds_read_tr16_b64_v4i16((__attribute__((address_space(3))) v4i16_t*)p)); }
__device__ __forceinline__ float rowmax(const f32x16&p0,const f32x16&p1){
  float a=max3f(p0[0],p0[1],p1[0]),b=max3f(p0[2],p0[3],p1[1]);a=max3f(a,p1[2],p1[3]);
  #pragma unroll
  for(int r=4;r<16;r+=4){a=max3f(a,p0[r],p0[r+1]);b=max3f(b,p0[r+2],p0[r+3]);a=max3f(a,p1[r],p1[r+1]);b=max3f(b,p1[r+2],p1[r+3]);}
  const float m=max2f(a,b);
  auto rr=__builtin_amdgcn_permlane32_swap(__float_as_uint(m),__float_as_uint(m),false,false);
  return max2f(__uint_as_float(rr[0]),__uint_as_float(rr[1]));
}
__device__ __forceinline__ void pv(f32x16*o,int vb,bf16x8 pa0,bf16x8 pa1,bf16x8 pa2,bf16x8 pa3){
  #pragma unroll
  for(int d0=0;d0<2;++d0){s16x4 lo[4],hi[4];
    #pragma unroll
    for(int ks=0;ks<4;++ks){
      asm volatile("ds_read_b64_tr_b16 %0,%1 offset:%c2":"=&v"(lo[ks]):"v"(vb),"i"(d0*4096+ks*1024):"memory");
      asm volatile("ds_read_b64_tr_b16 %0,%1 offset:%c2":"=&v"(hi[ks]):"v"(vb),"i"(d0*4096+ks*1024+512):"memory");}
    asm volatile("s_waitcnt lgkmcnt(0)":::"memory");SBAR();
    #define PK(k) (bf16x8){lo[k][0],lo[k][1],lo[k][2],lo[k][3],hi[k][0],hi[k][1],hi[k][2],hi[k][3]}
    o[d0]=__builtin_amdgcn_mfma_f32_32x32x16_bf16(pa0,PK(0),o[d0],0,0,0);
    o[d0]=__builtin_amdgcn_mfma_f32_32x32x16_bf16(pa1,PK(1),o[d0],0,0,0);
    o[d0]=__builtin_amdgcn_mfma_f32_32x32x16_bf16(pa2,PK(2),o[d0],0,0,0);
    o[d0]=__builtin_amdgcn_mfma_f32_32x32x16_bf16(pa3,PK(3),o[d0],0,0,0);
    #undef PK
  }
}

#ifndef ATTN_STORE16
#define ATTN_STORE16(p,v) (*(u32x4*)(p)=(v))
#endif
__device__ __forceinline__ bf16x8 make_qe(float m,int hi){
  const unsigned um=__float_as_uint(m); unsigned h0=(um+0x7fffu+((um>>16)&1u))&0xffff0000u; const float r1=m-__uint_as_float(h0);
  const unsigned u1=__float_as_uint(r1); unsigned h1=(u1+0x7fffu+((u1>>16)&1u))&0xffff0000u; const float r2=r1-__uint_as_float(h1);
  const unsigned u2=__float_as_uint(r2); unsigned h2=(u2+0x7fffu+((u2>>16)&1u))&0xffff0000u;
  u32x4 w; w.x=0x3f803f80u; w.y=0x3f80u|(h0^0x80000000u); w.z=((h1^0x80000000u)>>16)|(h2^0x80000000u); w.w=0u;
  if(hi){w.x=0u;w.y=0u;w.z=0u;} return __builtin_bit_cast(bf16x8,w); }
template<int THRL> __device__ __forceinline__ void attn_unit(int b,int h,int qb,const bf16*Q,const bf16*__restrict__ K,const bf16*__restrict__ V,bf16*O,const bf16*__restrict__ KE,const float*__restrict__ BETA,float qkmax,char*shm,const int tid){
  const int lane=tid&63,r32=lane&31,hi=lane>>5; const int wid=__builtin_amdgcn_readfirstlane(tid>>6);
  const long rowbase=(long)b*SEQ; const int q0=qb*QB;
  const bf16*Qw=Q+(rowbase+q0+wid*QBLK)*DM+h*D;
  const float*bet=BETA+(long)(b*NHEAD+h)*SEQ; const int NTF=(q0+QB)/KVBLK; int t0;
  { const float thr=bet[q0]-37.f-2.f*qkmax; const int l0=lane,l1=lane+64;
    const bool s0=(l0<NTF-4)&&(bet[64*l0+63]<thr), s1=(l1<NTF-4)&&(bet[64*l1+63]<thr);
    const unsigned long long m0=__ballot(s0), m1=__ballot(s1);
    int n0=(~m0)?__builtin_ctzll(~m0):64; if(n0==64) n0+=(~m1)?__builtin_ctzll(~m1):64;
    t0=__builtin_amdgcn_readfirstlane(n0)&~1; }
  const bf16*Kh=K+(rowbase+(long)t0*KVBLK)*DM+h*D,*Vh=V+(rowbase+(long)t0*KVBLK)*DM+h*D;
  const char*KEh=(const char*)KE+((long)(b*NHEAD+h)*(SEQ/KVBLK)+t0)*2048+wid*256+lane*4;
  const unsigned lds0=(unsigned)(uintptr_t)shm;
  float*wsf=(float*)(shm+LDS_WS)+wid*64;
  const bf16*ksrc=Kh+(long)lane*DM+wid*8;
  const bf16*vsrc=Vh+(long)(16*(wid&3)+(lane>>2))*DM+(wid>>2)*32+(lane&3)*8;
  const unsigned kdst=lds0+LDS_K+wid*1024, vdst=lds0+LDS_V+wid*1024, kedst=lds0+LDS_K+8192+wid*256;
  #define DMA_K(t,slot) do{ glds16(ksrc+(long)(t)*KVBLK*DM,(unsigned)__builtin_amdgcn_readfirstlane(kdst+KOFF(slot))); glds4(KEh+(long)(t)*2048,(unsigned)__builtin_amdgcn_readfirstlane(kedst+KOFF(slot))); }while(0)
  #define DMA_V(t,slot) glds16(vsrc+(long)(t)*KVBLK*DM,(unsigned)__builtin_amdgcn_readfirstlane(vdst+(slot)))
  const int vb0=(int)(lds0+LDS_V)+((lane>>4)&1)*32+(lane&3)*8+(4*hi+((lane&15)>>2))*64;
  const char*Kbase=shm+LDS_K; bf16x8 kf[10];
  const lds_cptr shm3=(lds_cptr)shm; const lds_cptr kp0=shm3+LDS_K+hi*1024+r32*16; const lds_cptr vp0=shm3+LDS_V+((lane>>4)&1)*32+(lane&3)*8+(4*hi+((lane&15)>>2))*64;
  const int NT=NTF-t0;
  DMA_K(0,0);DMA_V(0,0);DMA_K(1,SLOTB);
  bf16x8 qr[4];
  #pragma unroll
  for(int d0=0;d0<4;++d0)qr[d0]=*reinterpret_cast<const bf16x8*>(&Qw[(long)r32*DM+d0*16+hi*8]);
  float mhat=bet[q0+wid*QBLK+r32],l_reg=0.f;f32x16 o[2];o[0]=f32x16{};o[1]=f32x16{}; bf16x8 qe=make_qe(mhat,hi);
  const int qrel=wid*QBLK+r32;
  #define CMASK(P0,P1,t) do{int jb_=(t)-(NT-4); if(jb_>=0)cmask(P0,P1,jb_,qrel,hi);}while(0)
  bool resc=false;
  #define START(P0,P1) do{ resc=false; _Pragma("unroll") for(int r=0;r<16;++r)P0[r]=__builtin_amdgcn_exp2f(P0[r]); }while(0)
  #define RESC() do{ if(resc){ asm volatile("s_waitcnt lgkmcnt(0)":::"memory"); \
      _Pragma("unroll") for(int d_=0;d_<2;++d_) _Pragma("unroll") for(int r=0;r<16;++r)o[d_][r]*=wsf[crow(r,hi)]; } }while(0)
  f32x16 pA0,pA1,pB0,pB1;
  int sl_prev=0,sl_cur=0,sl_next=SLOTB;
  #define ROT() do{sl_prev=sl_cur;sl_cur=sl_next;sl_next=(sl_next==(NSLOT-1)*SLOTB)?0:sl_next+SLOTB;}while(0)
  DMA_K(2,2*SLOTB);
  WAIT_BAR(5);
  qkt(pA0,pA1,Kbase,qr,qe,r32,hi);asm volatile("s_nop 15\n\ts_nop 7":"+v"(pA0),"+v"(pA1));CMASK(pA0,pA1,0);
  START(pA0,pA1);
  _Pragma("unroll") for(int r=0;r<16;++r)pA1[r]=__builtin_amdgcn_exp2f(pA1[r]);
  WAIT_BAR(0);
  DMA_K(3,0);DMA_V(1,SLOTB);
  ROT();
  kload8(kf,kp0+KOFF(sl_cur));
  WAIT_BAR(3);
  s16x4 vlo[8],vhi[8]; u32x4 pw0,pw1,pw2,pw3;
  #define PKW(P,B) cvtpk_s(P[B],P[B+1])
  #define PAF(k) __builtin_bit_cast(bf16x8,pw##k)
  #define VFR(i) (bf16x8){vlo[i][0],vlo[i][1],vlo[i][2],vlo[i][3],vhi[i][0],vhi[i][1],vhi[i][2],vhi[i][3]}
  #define PIN(x) asm volatile("":"+v"(x))
  #define MX3(a,b,c) __builtin_fmaxf(__builtin_fmaxf((a),(b)),(c))
  #define GAPA(MF,A0,A1,A2,A3,W0,W1,PW) do{ MF; sacc+=A0; sacc+=A1; sacc+=A2; sacc+=A3; PIN(sacc); W0; W1; PIN(PW); SBAR(); }while(0)
  #define EX(v) __builtin_amdgcn_exp2f(v)
  #define GAPB(MF,X,B) do{ MF; X[B]=EX(X[B]); X[B+1]=EX(X[B+1]); X[B+2]=EX(X[B+2]); X[B+3]=EX(X[B+3]); PIN(X); SBAR(); }while(0)
  #define VRD(i) do{ vlo[i]=vtr(vp_+(((i)>>2)*4096+((i)&3)*1024)); vhi[i]=vtr(vp_+(((i)>>2)*4096+((i)&3)*1024+512)); }while(0)
  #define KRD(G,j) do{ if(G){ kload2(kf,kp0+KOFF(sl_next),j); SBAR(); } }while(0)
  #define KRDE(G) do{ if(G){ kf[8]=*(const __attribute__((address_space(3))) bf16x8*)(kp0+KOFF(sl_next)+8192); kf[9]=*(const __attribute__((address_space(3))) bf16x8*)(kp0+KOFF(sl_next)+8704); SBAR(); } }while(0)
  #define STEP(C0,C1,P0,P1,t,GK,GV,GL) do{ SBAR(); \
    const lds_cptr vp_=vp0+sl_prev; \
    VRD(0); SBAR(); float sacc=(P0[0]+P0[1]); \
    C0=__builtin_amdgcn_mfma_f32_32x32x16_bf16(kf[8],qe,f32x16{},0,0,0); C1=__builtin_amdgcn_mfma_f32_32x32x16_bf16(kf[9],qe,f32x16{},0,0,0); SBAR(); \
    GAPA(C0=__builtin_amdgcn_mfma_f32_32x32x16_bf16(kf[0],qr[0],C0,0,0,0), P0[2],P0[3],P0[4],P0[5],     pw0[0]=PKW(P0,0), pw0[1]=PKW(P0,2), pw0); \
    VRD(4); SBAR(); GAPA(C1=__builtin_amdgcn_mfma_f32_32x32x16_bf16(kf[1],qr[0],C1,0,0,0), P0[6],P0[7],P0[8],P0[9],     pw0[2]=PKW(P0,4), pw0[3]=PKW(P0,6), pw0); \
    VRD(1); SBAR(); GAPA(C0=__builtin_amdgcn_mfma_f32_32x32x16_bf16(kf[2],qr[1],C0,0,0,0),   P0[10],P0[11],P0[12],P0[13], pw1[0]=PKW(P0,8), pw1[1]=PKW(P0,10), pw1); \
    VRD(5); SBAR(); GAPA(C1=__builtin_amdgcn_mfma_f32_32x32x16_bf16(kf[3],qr[1],C1,0,0,0),   P0[14],P0[15],P1[0],P1[1],   pw1[2]=PKW(P0,12),pw1[3]=PKW(P0,14), pw1); \
    VRD(2); SBAR(); GAPA(C0=__builtin_amdgcn_mfma_f32_32x32x16_bf16(kf[4],qr[2],C0,0,0,0),   P1[2],P1[3],P1[4],P1[5],     pw2[0]=PKW(P1,0), pw2[1]=PKW(P1,2), pw2); \
    VRD(6); SBAR(); GAPA(C1=__builtin_amdgcn_mfma_f32_32x32x16_bf16(kf[5],qr[2],C1,0,0,0),   P1[6],P1[7],P1[8],P1[9],     pw2[2]=PKW(P1,4), pw2[3]=PKW(P1,6), pw2); \
    VRD(3); SBAR(); GAPA(C0=__builtin_amdgcn_mfma_f32_32x32x16_bf16(kf[6],qr[3],C0,0,0,0),   P1[10],P1[11],P1[12],P1[13], pw3[0]=PKW(P1,8), pw3[1]=PKW(P1,10), pw3); \
    VRD(7); SBAR(); GAPA(C1=__builtin_amdgcn_mfma_f32_32x32x16_bf16(kf[7],qr[3],C1,0,0,0),   P1[14],P1[15],0.f,0.f,       pw3[2]=PKW(P1,12),pw3[3]=PKW(P1,14), pw3); \
    l_reg+=sacc; \
    if(GK){DMA_K((t)+3,sl_cur);} if(GV){DMA_V((t)+1,sl_next);} \
    CMASK(C0,C1,t); \
    { float a=MX3(C0[0],C0[1],C1[0]),b=MX3(C0[2],C0[3],C1[1]); a=MX3(a,C1[2],C1[3]); \
      _Pragma("unroll") for(int r=4;r<16;r+=4){a=MX3(a,C0[r],C0[r+1]);b=MX3(b,C0[r+2],C0[r+3]);a=MX3(a,C1[r],C1[r+1]);b=MX3(b,C1[r+2],C1[r+3]);} \
      float rm=__builtin_fmaxf(a,b); { auto rr=__builtin_amdgcn_permlane32_swap(__float_as_uint(rm),__float_as_uint(rm),false,false); rm=__builtin_fmaxf(__uint_as_float(rr[0]),__uint_as_float(rr[1])); } \
      resc=false; \
      if(__builtin_expect(__any(rm>(float)THRL),0)){ const float dl=__builtin_fmaxf(rm,0.f); mhat+=dl; \
        _Pragma("unroll") for(int r=0;r<16;++r){C0[r]-=dl;C1[r]-=dl;} \
        qe=make_qe(mhat,hi); \
        const float f=__builtin_amdgcn_exp2f(-dl); l_reg*=f; if(hi==0)wsf[r32]=f; resc=true; } } \
    SBAR(); \
    GAPB(o[0]=__builtin_amdgcn_mfma_f32_32x32x16_bf16(PAF(0),VFR(0),o[0],0,0,0), C0,0); \
    GAPB(o[1]=__builtin_amdgcn_mfma_f32_32x32x16_bf16(PAF(0),VFR(4),o[1],0,0,0), C0,4); \
    KRD(GL,0); GAPB(o[0]=__builtin_amdgcn_mfma_f32_32x32x16_bf16(PAF(1),VFR(1),o[0],0,0,0), C0,8); \
    KRD(GL,1); GAPB(o[1]=__builtin_amdgcn_mfma_f32_32x32x16_bf16(PAF(1),VFR(5),o[1],0,0,0), C0,12); \
    KRD(GL,2); GAPB(o[0]=__builtin_amdgcn_mfma_f32_32x32x16_bf16(PAF(2),VFR(2),o[0],0,0,0), C1,0); \
    KRD(GL,3); GAPB(o[1]=__builtin_amdgcn_mfma_f32_32x32x16_bf16(PAF(2),VFR(6),o[1],0,0,0), C1,4); \
    KRDE(GL); GAPB(o[0]=__builtin_amdgcn_mfma_f32_32x32x16_bf16(PAF(3),VFR(3),o[0],0,0,0), C1,8); \
    GAPB(o[1]=__builtin_amdgcn_mfma_f32_32x32x16_bf16(PAF(3),VFR(7),o[1],0,0,0), C1,12); \
    }while(0)
  int t=1;
  #undef CMASK
  #define CMASK(P0,P1,t) do{}while(0)
  for(;t+5<NT;t+=2){
    STEP(pB0,pB1,pA0,pA1,t,true,true,true);     WAIT_BAR(3); RESC(); ROT();
    STEP(pA0,pA1,pB0,pB1,t+1,true,true,true);   WAIT_BAR(3); RESC(); ROT();
  }
  #undef CMASK
  #define CMASK(P0,P1,t) do{int jb_=(t)-(NT-4); if(jb_>=0)cmask(P0,P1,jb_,qrel,hi);}while(0)
  #define ENDW(tt) do{ if((tt)+3<NT){WAIT_BAR(3);} else if((tt)+2<NT){WAIT_BAR(1);} else {WAIT_BAR(0);} }while(0)
  for(;t+1<NT;t+=2){
    STEP(pB0,pB1,pA0,pA1,t,(t+3<NT),(t+1<NT),(t+1<NT));       ENDW(t);   RESC(); ROT();
    STEP(pA0,pA1,pB0,pB1,t+1,(t+4<NT),(t+2<NT),(t+2<NT));     ENDW(t+1); RESC(); ROT();
  }
  STEP(pB0,pB1,pA0,pA1,NT-1,false,false,false); RESC();
  { float sacc=pB0[0]+pB0[1]; _Pragma("unroll") for(int r=2;r<16;++r)sacc+=pB0[r]; _Pragma("unroll") for(int r=0;r<16;++r)sacc+=pB1[r]; l_reg+=sacc;
    pw0=(u32x4){PKW(pB0,0),PKW(pB0,2),PKW(pB0,4),PKW(pB0,6)};pw1=(u32x4){PKW(pB0,8),PKW(pB0,10),PKW(pB0,12),PKW(pB0,14)};pw2=(u32x4){PKW(pB1,0),PKW(pB1,2),PKW(pB1,4),PKW(pB1,6)};pw3=(u32x4){PKW(pB1,8),PKW(pB1,10),PKW(pB1,12),PKW(pB1,14)};
    SBAR(); pv(o,vb0+sl_cur,PAF(0),PAF(1),PAF(2),PAF(3)); }
  #undef PKW
  #undef PAF
  #undef VFR
  #undef PIN
  #undef MX3
  #undef GAPA
  #undef GAPB
  #undef EX
  #undef VRD
  #undef KRD
  #undef KRDE
  #undef STEP
  #undef ENDW
  {auto rr=__builtin_amdgcn_permlane32_swap(__float_as_uint(l_reg),__float_as_uint(l_reg),false,false);l_reg=__uint_as_float(rr[0])+__uint_as_float(rr[1]);}
  if(hi==0)wsf[32+r32]=l_reg;asm volatile("s_waitcnt lgkmcnt(0)":::"memory");
  float rli[16];
  #pragma unroll
  for(int r=0;r<16;++r)rli[r]=__builtin_amdgcn_rcpf(wsf[32+crow(r,hi)]);
  int lane_e=lane; asm volatile("":"+v"(lane_e));
  const int r32e=lane_e&31,hie=lane_e>>5;
  unsigned char*Ow=(unsigned char*)O+((rowbase+q0+wid*QBLK)*DM+h*D);
  { unsigned char*stg=(unsigned char*)(shm+LDS_OST)+wid*4096;
    #pragma unroll
    for(int r=0;r<16;++r){const int orow=crow(r,hie); const float sc32=32.f*rli[r];
      #pragma unroll
      for(int d0=0;d0<2;++d0)stg[orow*64+d0*32+r32e]=(unsigned char)__builtin_amdgcn_cvt_pk_fp8_f32(o[d0][r]*sc32,0.f,0,false);}
    asm volatile("s_waitcnt lgkmcnt(0)":::"memory");
    typedef unsigned u32x2_t __attribute__((ext_vector_type(2)));
    #pragma unroll
    for(int i=0;i<4;++i){const int row=i*8+(lane_e>>3),ch=lane_e&7; const u32x2_t v=*(const u32x2_t*)(stg+row*64+ch*8); *(u32x2_t*)(Ow+(long)row*DM+ch*8)=v;} }
  asm volatile("s_waitcnt lgkmcnt(0)\n\ts_barrier":::"memory");
  #undef DMA_K
  #undef DMA_V
  #undef CMASK
  #undef START
  #undef RESC
  #undef ROT
}
constexpr int ATTN_LDS_BYTES=LDS_BYTES;
struct AttnTensors { const bf16* Q; const bf16* K; const bf16* V; bf16* O; };
struct AttnUnit { int bh; int qb; };
struct StaticOrder {
  int vcu;
  __device__ __forceinline__ explicit StaticOrder(int grid,int block):vcu((block%8)*(grid/8)+block/8){}
  __device__ __forceinline__ bool next(int i,AttnUnit&u)const{ if(i>=4)return false; const int s=vcu&7; u.bh=vcu>>3; u.qb=(i==0)?s:(i==1)?15-s:(i==2)?16+s:31-s; return true; }
  __device__ __forceinline__ void a_ready(const AttnUnit&)const{}
  __device__ __forceinline__ void done(const AttnUnit&)const{}
};
template<class Sched,int THRL=8> __device__ __forceinline__ void attn_phase(char*lds,const AttnTensors&T,const Sched&S){
  AttnUnit u;
  for(int i=0;S.next(i,u);++i){ S.a_ready(u); attn_unit<THRL>(u.bh/NHEAD,u.bh%NHEAD,u.qb,T.Q,T.K,T.V,T.O,lds); S.done(u); }
}
#undef SBAR
#undef WAIT_BAR
}

#ifndef MK_DUP
#define MK_DUP 0
#endif
#define ORD_QKV 4, 3
#define ORD_UP 4, 3
#define ORD_DIN 4, 3
#define ORD_QI 4, 3
constexpr int NWAVES = 8, NTHREADS = 512;
constexpr int BATCH = 2, T = 8192, D = 1024, H = 16, HD = 64, FF = 2816, FF2 = 5632;
constexpr int M = BATCH * T;
constexpr int FOX_IN = 3088, DSA_IN = 2120;
constexpr float EPS = 1e-6f;
constexpr float LOG2E = 1.4426950408889634f;

constexpr size_t MiB = 1u << 20;
constexpr size_t WS_CTL = 0, CTL_ZERO_BYTES = 32 * 1024;
constexpr size_t WS_MOD = 1 * MiB;
constexpr size_t WS_XS = 2 * MiB;
constexpr int CW_NS = 1024;
constexpr size_t WS_WUP0 = 8 * MiB, WS_WUP1 = 19 * MiB;
constexpr size_t WS_WDN0 = 30 * MiB, WS_WDN1 = 35 * MiB + 512 * 1024;
constexpr size_t WS_WDIN = 41 * MiB;
constexpr size_t WS_WDTAIL = 45 * MiB;
constexpr size_t WS_WDOUT = 45 * MiB + 512 * 1024;
constexpr size_t WS_H = 48 * MiB;
constexpr size_t WS_R = 80 * MiB;
constexpr size_t WS_WFIN = WS_R, WS_WFOUT = WS_R + 6 * MiB;
constexpr size_t WS_Q = WS_R + 8 * MiB, WS_K = WS_R + 40 * MiB, WS_V = WS_R + 72 * MiB;
constexpr size_t WS_LOGF = WS_R + 104 * MiB;
constexpr size_t WS_BETA = WS_R + 105 * MiB;
constexpr size_t WS_KE = WS_R + 106 * MiB;
constexpr size_t WS_O = WS_R + 114 * MiB;
constexpr size_t WS_XB = WS_R + 144 * MiB;
constexpr size_t WS_U = WS_R;
constexpr size_t WS_SA0 = WS_R + 96 * MiB, WS_SG0 = WS_R + 98 * MiB, WS_SA1 = WS_R + 100 * MiB;
constexpr size_t WS_Q1 = WS_R, WS_K1 = WS_R + 32 * MiB, WS_V1 = WS_R + 40 * MiB;
constexpr size_t WS_QI = WS_R + 48 * MiB;
constexpr size_t WS_KI = WS_R + 64 * MiB;
constexpr size_t WS_WI = WS_R + 66 * MiB;
constexpr size_t WS_H8 = WS_R + 84 * MiB;
constexpr size_t WS_O1 = WS_R + 67 * MiB;
constexpr size_t WS_END = 256 * MiB;
static_assert(WS_U + (size_t)M * FF * 2 <= WS_SA0 && WS_SA1 + 2 * MiB <= WS_END, "d_ws map");
constexpr int CW_BAR = 4096;
static_assert((CW_BAR + 3456) * 4 <= 32 * 1024, "control words inside the per-call memset");
constexpr int CW_AQ = 256;
constexpr int CW_DQ = 512;

constexpr int RING_OFF = 0, RING_BYTES = 131072;
constexpr int LDSCTL_OFF = RING_BYTES, MISC_OFF = LDSCTL_OFF + 320;
constexpr int HALO_OFF = 131584;
constexpr int LDS_BYTES = 147456;

#define GAS __attribute__((address_space(1)))
#define LAS __attribute__((address_space(3)))
typedef unsigned short bf16;
typedef unsigned v4u __attribute__((ext_vector_type(4)));
typedef unsigned v2u __attribute__((ext_vector_type(2)));
typedef float f32x4 __attribute__((ext_vector_type(4)));
typedef short bf16x8 __attribute__((ext_vector_type(8)));
typedef GAS unsigned gu32;
#define RLX_AGENT __ATOMIC_RELAXED, __HIP_MEMORY_SCOPE_AGENT
#define LDS_WAIT() asm volatile("s_waitcnt lgkmcnt(0)" ::: "memory")
#define VM_WAIT() asm volatile("s_waitcnt vmcnt(0)" ::: "memory")
__device__ __forceinline__ unsigned f2bf(float f) { unsigned u = __builtin_bit_cast(unsigned, f); return (u + 0x7fffu + ((u >> 16) & 1u)) >> 16; }
__device__ __forceinline__ unsigned pk2(float lo, float hi) { return f2bf(lo) | (f2bf(hi) << 16); }
__device__ __forceinline__ float bf2f(unsigned b) { return __builtin_bit_cast(float, b << 16); }
#define XB_TMO      128
#define XB_XCNT(j)  (256  + 64 * (j))
#define XB_XSUB(j)  (1280 + 64 * (j))
#define XB_XGEN(j)  (2304 + 64 * (j))
#define XB_TOP      3328
#define XB_TOPGEN   3392
#define XCD_BAR_WORDS 3456
#define XB_SPIN_CAP (1u << 18)

__device__ __forceinline__ unsigned xb_ld(unsigned* p)              { return __hip_atomic_load(p, __ATOMIC_RELAXED, __HIP_MEMORY_SCOPE_AGENT); }
__device__ __forceinline__ unsigned xb_add(unsigned* p, unsigned v) { return __hip_atomic_fetch_add(p, v, __ATOMIC_RELAXED, __HIP_MEMORY_SCOPE_AGENT); }
__device__ __forceinline__ unsigned xb_xcc_id() { return (unsigned)__builtin_amdgcn_s_getreg((3 << 11) | 20) & 0xFu; }
#define XB_SPIN(cond, bar) do { unsigned _sp = 0; while (cond) { __builtin_amdgcn_s_sleep(1); \
    if ((++_sp & 255u) == 0u) { if (xb_ld(&(bar)[XB_TMO])) break; if (_sp > XB_SPIN_CAP) { atomicAdd(&(bar)[XB_TMO], 1u); break; } } } } while (0)

struct XcdBarrier {
    unsigned* bar; unsigned x;
    volatile LAS unsigned* st;
};

__device__ __forceinline__ XcdBarrier xcd_barrier_post(unsigned* bar, volatile LAS unsigned* st) {
    XcdBarrier b; b.bar = bar; b.x = xb_xcc_id(); b.st = st;
    if (threadIdx.x == 0) (void)xb_add(&bar[XB_XCNT(b.x)], 1u);
    return b;
}
__device__ __forceinline__ void xcd_barrier_complete(unsigned* bar, unsigned x, unsigned& nloc, unsigned& nx) {
    const unsigned G = gridDim.x * gridDim.y * gridDim.z;
    unsigned sum, cnt, mine, sp = 0u;
    for (;;) {
        sum = 0u; cnt = 0u; mine = 0u;
#pragma unroll
        for (unsigned j = 0; j < 16; ++j) { const unsigned c = xb_ld(&bar[XB_XCNT(j)]); sum += c; cnt += (c > 0u) ? 1u : 0u; mine = (j == x) ? c : mine; }
        if (sum == G) break;
        __builtin_amdgcn_s_sleep(1);
        if ((++sp & 255u) == 0u) { if (xb_ld(&bar[XB_TMO])) break; if (sp > XB_SPIN_CAP) { atomicAdd(&bar[XB_TMO], 1u); break; } }
    }
    nloc = mine > 0u ? mine : 1u; nx = cnt > 0u ? cnt : 1u;
}

__device__ __forceinline__ void xcd_barrier(const XcdBarrier& b) {
    asm volatile("s_waitcnt vmcnt(0)" ::: "memory");
    __syncthreads();
    if (threadIdx.x == 0) {
        unsigned* bar = b.bar;
        __builtin_amdgcn_s_waitcnt(0);
        unsigned nloc = b.st[0], nx = b.st[1];
        if (nloc == 0u) { xcd_barrier_complete(bar, b.x, nloc, nx); b.st[0] = nloc; b.st[1] = nx; }
        const unsigned old = xb_add(&bar[XB_XSUB(b.x)], 1u);
        const unsigned gen = old / nloc;
        if (old + 1u == (gen + 1u) * nloc) {
            __builtin_amdgcn_fence(__ATOMIC_RELEASE, "agent");
            asm volatile("s_waitcnt vmcnt(0)" ::: "memory");
            const unsigned og = xb_add(&bar[XB_TOP], 1u);
            const unsigned tg = og / nx;
            if (og + 1u == (tg + 1u) * nx) xb_add(&bar[XB_TOPGEN], 1u);
            else XB_SPIN(xb_ld(&bar[XB_TOPGEN]) == tg, bar);
            __builtin_amdgcn_fence(__ATOMIC_ACQUIRE, "agent");
            xb_add(&bar[XB_XGEN(b.x)], 1u);
            asm volatile("s_waitcnt vmcnt(0)" ::: "memory");
        } else {
            XB_SPIN(xb_ld(&bar[XB_XGEN(b.x)]) == gen, bar);
            __builtin_amdgcn_fence(__ATOMIC_ACQUIRE, "agent");
            asm volatile("s_waitcnt vmcnt(0)" ::: "memory");
        }
    }
    __syncthreads();
}

__device__ __forceinline__ float wave_sum(float v) {
    v += dppf<0xB1>(v); v += dppf<0x4E>(v); v += dppf<0x141>(v); v += dppf<0x140>(v);
    return xsum32(xsum16(v));
}
__device__ __forceinline__ float wave_max(float v) {
    v = fmaxf(v, dppf<0xB1>(v)); v = fmaxf(v, dppf<0x4E>(v)); v = fmaxf(v, dppf<0x141>(v)); v = fmaxf(v, dppf<0x140>(v));
    return xmax32(xmax16(v));
}
template <int F8S>
__device__ __forceinline__ void p0_transpose_item(const float* W, int ldw, int K, bf16* WT, int k0, int n0, int drow, LAS float* scr, int lane) {
#pragma unroll 8
    for (int i = 0; i < 32; ++i) { const int kk = 2 * i + (lane >> 5); scr[kk * 33 + (lane & 31)] = W[(size_t)(k0 + kk) * ldw + n0 + (lane & 31)]; }
    LDS_WAIT(); asm volatile("" ::: "memory");
    const int c = lane & 7;
#pragma unroll
    for (int j = 0; j < 4; ++j) { const int n = (lane >> 3) + 8 * j; const LAS float* s = scr + (8 * c) * 33 + n;
        if (F8S) { const float sc8 = (float)(1 << F8S); int w0 = 0, w1 = 0;
            w0 = __builtin_amdgcn_cvt_pk_fp8_f32(s[0 * 33] * sc8, s[1 * 33] * sc8, w0, false); w0 = __builtin_amdgcn_cvt_pk_fp8_f32(s[2 * 33] * sc8, s[3 * 33] * sc8, w0, true);
            w1 = __builtin_amdgcn_cvt_pk_fp8_f32(s[4 * 33] * sc8, s[5 * 33] * sc8, w1, false); w1 = __builtin_amdgcn_cvt_pk_fp8_f32(s[6 * 33] * sc8, s[7 * 33] * sc8, w1, true);
            *(GAS v2u*)((unsigned char*)WT + (size_t)(drow + n) * K + k0 + 8 * c) = (v2u){(unsigned)w0, (unsigned)w1}; }
        else { v4u o; o.x = pk2(s[0 * 33], s[1 * 33]); o.y = pk2(s[2 * 33], s[3 * 33]); o.z = pk2(s[4 * 33], s[5 * 33]); o.w = pk2(s[6 * 33], s[7 * 33]);
        *(GAS v4u*)(WT + (size_t)(drow + n) * K + k0 + 8 * c) = o; } }
    LDS_WAIT(); asm volatile("" ::: "memory");
}
template <int HP, int F8S = 0>
__device__ __forceinline__ void p0_matrix(const float* W, int ldw, int K, int ncols, bf16* WT, LAS float* scr, int lane, int gw, int NGW, int& base) {
    const int nblk = ncols / 32, items = (K / 64) * nblk;
    int first = gw - (base % NGW); if (first < 0) first += NGW;
    for (int r = first; r < items; r += NGW) {
        const int kb = r / nblk, nb = r % nblk, n0 = 32 * nb;
        int drow = n0;
        if (HP == 1) { const int tile = n0 >> 8, nl = n0 & 255, wc = nl >> 6, bj = (nl >> 5) & 1; drow = tile * 256 + 128 * bj + 32 * wc; }
        if (HP == 2) { const int isg = n0 >= FF, j = isg ? n0 - FF : n0; drow = (j >> 7) * 256 + (isg ? 128 : 0) + (j & 127); }
        p0_transpose_item<F8S>(W, ldw, K, WT, 64 * kb, n0, drow, scr, lane);
    }
    base += items;
}

struct Ptrs {
    const float *x, *c, *w_ada, *b_ada, *g_mix, *g_ffn, *fox_w_in, *fox_b_f, *fox_g_q, *fox_g_k, *fox_w_out,
                *dsa_w_in, *dsa_g_q, *dsa_g_k, *dsa_g_kidx, *dsa_w_out, *ffn_w_up, *ffn_conv_w, *ffn_conv_b, *ffn_w_down;
    float* out; unsigned char* ws;
};

__device__ __forceinline__ void p0_prologue(const Ptrs& P, LAS unsigned char* lds, int tid, int lane, int wave, int vcu, int G) {
    unsigned char* ws = P.ws;
    LAS float* scr = (LAS float*)(lds + RING_OFF + wave * 16384);
    const int gw = vcu * NWAVES + wave, NGW = G * NWAVES;
    int base = 0;
    p0_matrix<1, 5>(P.fox_w_in, FOX_IN, D, 3 * D, (bf16*)(ws + WS_WFIN), scr, lane, gw, NGW, base);
    p0_matrix<0, 5>(P.fox_w_out, D, D, D, (bf16*)(ws + WS_WFOUT), scr, lane, gw, NGW, base);
    p0_matrix<2, 5>(P.ffn_w_up, FF2, D, FF2, (bf16*)(ws + WS_WUP0), scr, lane, gw, NGW, base);
    p0_matrix<0, 6>(P.ffn_w_down, D, FF, D, (bf16*)(ws + WS_WDN0), scr, lane, gw, NGW, base);
    p0_matrix<1, 5>(P.dsa_w_in, DSA_IN, D, 3 * D / 2, (bf16*)(ws + WS_WDIN), scr, lane, gw, NGW, base);
    p0_matrix<1>(P.dsa_w_in + 3 * D / 2, DSA_IN, D, D / 2, (bf16*)(ws + WS_WDIN + 2 * MiB), scr, lane, gw, NGW, base);
    p0_matrix<0, 5>(P.dsa_w_out, D, D, D, (bf16*)(ws + WS_WDOUT), scr, lane, gw, NGW, base);
    p0_matrix<2, 5>(P.ffn_w_up + (size_t)D * FF2, FF2, D, FF2, (bf16*)(ws + WS_WUP1), scr, lane, gw, NGW, base);
    p0_matrix<0, 6>(P.ffn_w_down + (size_t)FF * D, D, FF, D, (bf16*)(ws + WS_WDN1), scr, lane, gw, NGW, base);
    { bf16* wt = (bf16*)(ws + WS_WDTAIL); const int gt = vcu * NTHREADS + tid, NT_ = G * NTHREADS;
      for (int i = gt; i < 80 * D; i += NT_) { const int n = i / D, k = i % D; wt[i] = (n < 72) ? (bf16)f2bf(P.dsa_w_in[(size_t)k * DSA_IN + 2048 + n]) : (bf16)0; } }
    __syncthreads();
    { LAS float* cact = (LAS float*)(lds + RING_OFF);
      LAS float* part = (LAS float*)(lds + RING_OFF + 8192);
      for (int i = tid; i < 2 * D; i += NTHREADS) { const float v = P.c[i]; cact[i] = v / (1.f + __expf(-v)); }
      __syncthreads();
      float* MOD = (float*)(ws + WS_MOD);
      for (int task = vcu; task < 2 * 96; task += G) {
          const int layer = task / 96, cg = task % 96, col = cg * 64 + lane;
          const float* w = P.w_ada + (size_t)layer * D * 6144 + col;
          float a0 = 0.f, a1 = 0.f;
#pragma unroll 32
          for (int k = wave * 128; k < wave * 128 + 128; ++k) { const float wv = w[(size_t)k * 6144]; a0 += cact[k] * wv; a1 += cact[D + k] * wv; }
          part[(wave * 2 + 0) * 64 + lane] = a0; part[(wave * 2 + 1) * 64 + lane] = a1;
          __syncthreads();
          if (wave < 2) { float s = 0.f;
#pragma unroll
              for (int w8 = 0; w8 < 8; ++w8) s += part[(w8 * 2 + wave) * 64 + lane];
              MOD[((size_t)layer * 2 + wave) * 6144 + col] = s + P.b_ada[layer * 6144 + col]; }
          __syncthreads();
      } }
}

template <bool FGATE, bool XIN16, int OUT8 = 0>
__device__ __forceinline__ void norm_phase(const void* xin, const float* gnorm, const float* modL, int sh_chunk, int sc_chunk, bf16* hout, unsigned char* hout8,
                                           const float* fox_w_in, const float* b_f, float* logf, LAS unsigned char* lds, int tid, int lane, int wave, int vcu, int G) {
    LAS float* wft = (LAS float*)(lds + RING_OFF);
    if (FGATE) {
        for (int i = tid; i < 16 * D; i += NTHREADS) { const int c = i >> 4, hh = i & 15; wft[hh * D + c] = fox_w_in[(size_t)c * FOX_IN + 3 * D + hh]; }
        __syncthreads();
    }
    const int gw = vcu * NWAVES + wave, NGW = G * NWAVES;
    for (int b = 0; b < BATCH; ++b) {
        f32x4 Gv[4], Sv[4];
#pragma unroll
        for (int j = 0; j < 4; ++j) { const int c = 4 * lane + 256 * j;
            const f32x4 g4 = *(const f32x4*)(gnorm + c), sc4 = *(const f32x4*)(modL + (size_t)b * 6144 + sc_chunk * D + c);
            Gv[j] = g4 * (sc4 + 1.0f); Sv[j] = *(const f32x4*)(modL + (size_t)b * 6144 + sh_chunk * D + c); }
        for (int t = gw; t < T; t += NGW) {
            const size_t m = (size_t)b * T + t;
            f32x4 v[4]; float ss = 0.f;
            if (XIN16) { const GAS v2u* xr = (const GAS v2u*)((const bf16*)xin + m * D) + lane;
#pragma unroll
                for (int j = 0; j < 4; ++j) { const v2u r = xr[64 * j]; v[j] = (f32x4){__uint_as_float(r.x << 16), __uint_as_float(r.x & 0xffff0000u), __uint_as_float(r.y << 16), __uint_as_float(r.y & 0xffff0000u)}; }
            } else { const GAS f32x4* xr = (const GAS f32x4*)((const float*)xin + m * D) + lane;
#pragma unroll
                for (int j = 0; j < 4; ++j) v[j] = xr[64 * j]; }
#pragma unroll
            for (int j = 0; j < 4; ++j) ss += (v[j].x * v[j].x + v[j].y * v[j].y) + (v[j].z * v[j].z + v[j].w * v[j].w);
            const float rstd = __builtin_amdgcn_rsqf(wave_sum(ss) * (1.f / D) + EPS);
            GAS unsigned long long* o8 = (GAS unsigned long long*)(hout + m * D) + lane;
#pragma unroll
            for (int j = 0; j < 4; ++j) { v[j] = v[j] * rstd * Gv[j] + Sv[j];
                if (OUT8) { int w8 = 0; w8 = __builtin_amdgcn_cvt_pk_fp8_f32(v[j].x, v[j].y, w8, false); w8 = __builtin_amdgcn_cvt_pk_fp8_f32(v[j].z, v[j].w, w8, true);
                    ((GAS unsigned*)(hout8 + m * D))[lane + 64 * j] = (unsigned)w8; }
                if (OUT8 != 1) o8[64 * j] = (unsigned long long)pk2(v[j].x, v[j].y) | ((unsigned long long)pk2(v[j].z, v[j].w) << 32); }
            if (FGATE) {
                float acc[16];
                typedef float f32x2 __attribute__((ext_vector_type(2)));
#pragma unroll
                for (int hh = 0; hh < 16; ++hh) { f32x2 a2 = (f32x2){0.f, 0.f};
#pragma unroll
                    for (int j = 0; j < 4; ++j) { const f32x4 w4 = *(const LAS f32x4*)(wft + hh * D + 256 * j + 4 * lane);
                        a2 = (f32x2){v[j].x, v[j].y} * (f32x2){w4.x, w4.y} + a2; a2 = (f32x2){v[j].z, v[j].w} * (f32x2){w4.z, w4.w} + a2; }
                    acc[hh] = a2.x + a2.y; if ((hh & 3) == 3) asm volatile("" : "+v"(acc[hh]) :: "memory"); }
                float b8[8], c4[4];
#pragma unroll
                for (int i = 0; i < 8; ++i) { const auto rr = __builtin_amdgcn_permlane32_swap(__builtin_bit_cast(unsigned, acc[i]), __builtin_bit_cast(unsigned, acc[i + 8]), false, false); const unsigned r0 = rr[0], r1 = rr[1];
                    b8[i] = __builtin_bit_cast(float, r0) + __builtin_bit_cast(float, r1); }
#pragma unroll
                for (int i = 0; i < 4; ++i) { const auto rr = __builtin_amdgcn_permlane16_swap(__builtin_bit_cast(unsigned, b8[i]), __builtin_bit_cast(unsigned, b8[i + 4]), false, false); const unsigned r0 = rr[0], r1 = rr[1];
                    c4[i] = __builtin_bit_cast(float, r0) + __builtin_bit_cast(float, r1); }
#pragma unroll
                for (int i = 0; i < 4; ++i) { float t = c4[i]; t += dppf<0xB1>(t); t += dppf<0x4E>(t); t += dppf<0x141>(t); t += dppf<0x140>(t); c4[i] = t; }
                const int j4 = lane & 15; float r = c4[0]; r = (j4 == 1) ? c4[1] : r; r = (j4 == 2) ? c4[2] : r; r = (j4 == 3) ? c4[3] : r;
                const int row16 = lane >> 4, head = (row16 >> 1) * 8 + (row16 & 1) * 4 + j4;
                if (j4 < 4) { const float z = r + b_f[head]; logf[m * 16 + head] = fminf(z, 0.f) - log1pf(__expf(-fabsf(z))); }
            }
        }
    }
    if (FGATE) __syncthreads();
}

__device__ __forceinline__ void fox_scan(const float* logf, float* BETA, unsigned char* KE, int seq, LAS float* red  , int tid, int lane, int wave) {
    const int b = seq >> 4, hh = seq & 15;
    float v[16]; float run = 0.f;
#pragma unroll
    for (int k = 0; k < 16; ++k) { run += logf[((size_t)b * T + 16 * tid + k) * 16 + hh]; v[k] = run; }
    float inc = run;
#pragma unroll
    for (int o = 1; o < 64; o <<= 1) { const float n = __shfl_up(inc, o); if (lane >= o) inc += n; }
    if (lane == 63) red[wave] = inc;
    __syncthreads();
    float pre = inc - run;
#pragma unroll
    for (int w8 = 0; w8 < 8; ++w8) if (w8 < wave) pre += red[w8];
#pragma unroll
    for (int k = 0; k < 16; ++k) {
        const int t = 16 * tid + k; const float be = -(pre + v[k]) * LOG2E;
        BETA[(size_t)seq * T + t] = be;
        const unsigned h0 = f2bf(be); const float r1 = be - bf2f(h0); const unsigned h1 = f2bf(r1); const float r2 = r1 - bf2f(h1); const unsigned h2 = f2bf(r2);
        unsigned char* tile = KE + ((size_t)seq * (T / 64) + (t >> 6)) * 2048 + (t & 63) * 16;
        v4u e; e.x = h0 | (h1 << 16); e.y = h2 | 0x3f800000u; e.z = 0x3f803f80u; e.w = 0u;
        *(GAS v4u*)tile = e; *(GAS v4u*)(tile + 1024) = (v4u){0u, 0u, 0u, 0u};
    }
    __syncthreads();
}

__device__ __forceinline__ void conv_fixup(bf16* U, const float* sideA0, const float* sideG0, const float* sideA1, const float* cw, const float* cb, int pm, int tid) {
    const bool bstart = (pm % (T / 256)) == 0;
    for (int i = tid; i < 2 * (FF / 4); i += NTHREADS) {
        const int r = i / (FF / 4), c = (i % (FF / 4)) * 4;
        const f32x4 a0 = *(const f32x4*)(sideA0 + ((size_t)pm * 2 + r) * FF + c), g0 = *(const f32x4*)(sideG0 + ((size_t)pm * 2 + r) * FF + c);
        const f32x4 z = (f32x4){0.f, 0.f, 0.f, 0.f};
        f32x4 m1, m2;
        if (r == 1) { m1 = *(const f32x4*)(sideA0 + ((size_t)pm * 2) * FF + c); m2 = bstart ? z : *(const f32x4*)(sideA1 + ((size_t)(pm - 1) * 2 + 1) * FF + c); }
        else { m1 = bstart ? z : *(const f32x4*)(sideA1 + ((size_t)(pm - 1) * 2 + 1) * FF + c); m2 = bstart ? z : *(const f32x4*)(sideA1 + ((size_t)(pm - 1) * 2) * FF + c); }
        const f32x4 w0 = *(const f32x4*)(cw + c), w1 = *(const f32x4*)(cw + FF + c), w2 = *(const f32x4*)(cw + 2 * FF + c), bb = *(const f32x4*)(cb + c);
        float uo[4];
#pragma unroll
        for (int e = 0; e < 4; ++e) { const float s = fmaf(w0[e], m2[e], fmaf(w1[e], m1[e], fmaf(w2[e], a0[e], bb[e]))); uo[e] = s * __builtin_amdgcn_rcpf(1.f + __builtin_amdgcn_exp2f(-LOG2E * s)) * g0[e]; }
        { int w8 = 0; w8 = __builtin_amdgcn_cvt_pk_fp8_f32(uo[0], uo[1], w8, false); w8 = __builtin_amdgcn_cvt_pk_fp8_f32(uo[2], uo[3], w8, true);
          *(GAS unsigned*)((unsigned char*)U + ((size_t)pm * 256 + r) * FF + c) = (unsigned)w8; }
    }
    asm volatile("s_waitcnt vmcnt(0)" ::: "memory");
    __syncthreads();
}
namespace dsa {
typedef float f32x16 __attribute__((ext_vector_type(16)));
typedef unsigned long long u64;
constexpr int QT = 16;
constexpr int TOPK = 256;
constexpr int HIST_OFF = 0;
constexpr int SEL_OFF = 135168;
constexpr int ST_OFF = 143360;
constexpr int CAP = 1024;
constexpr float WSCALE = 0.04419417382415922f;

__device__ __forceinline__ void tail_phase(const bf16* Hb, const bf16* WT, const float* g_kidx, bf16* KI, float* WI, int lane, int gw, int NGW) {
    const int n16 = lane & 15, q4 = lane >> 4;
    for (int task = gw; task < M / 16; task += NGW) {
        const int row0 = task * 16;
        f32x4 acc[5];
#pragma unroll
        for (int cb = 0; cb < 5; ++cb) acc[cb] = (f32x4){0.f, 0.f, 0.f, 0.f};
        const bf16* ap = Hb + (size_t)(row0 + n16) * D + 8 * q4;
        const bf16* bp = WT + (size_t)n16 * D + 8 * q4;
#pragma unroll 4
        for (int s = 0; s < 32; ++s) {
            const bf16x8 a = *(const GAS bf16x8*)(ap + 32 * s);
#pragma unroll
            for (int cb = 0; cb < 5; ++cb) { const bf16x8 b = *(const GAS bf16x8*)(bp + (size_t)cb * 16 * D + 32 * s); acc[cb] = __builtin_amdgcn_mfma_f32_16x16x32_bf16(a, b, acc[cb], 0, 0, 0); }
        }
        float gk[4];
#pragma unroll
        for (int cb = 0; cb < 4; ++cb) gk[cb] = g_kidx[16 * cb + n16];
#pragma unroll
        for (int i = 0; i < 4; ++i) {
            const int tok = row0 + 4 * q4 + i;
            float ss = (acc[0][i] * acc[0][i] + acc[1][i] * acc[1][i]) + (acc[2][i] * acc[2][i] + acc[3][i] * acc[3][i]);
            ss += __shfl_xor(ss, 1); ss += __shfl_xor(ss, 2); ss += __shfl_xor(ss, 4); ss += __shfl_xor(ss, 8);
            const float rs = __builtin_amdgcn_rsqf(ss * (1.f / 64.f) + EPS);
#pragma unroll
            for (int cb = 0; cb < 4; ++cb) KI[(size_t)tok * 64 + 16 * cb + n16] = (bf16)f2bf(acc[cb][i] * rs * gk[cb]);
            if (n16 < 8) WI[(size_t)tok * 8 + n16] = acc[4][i] * WSCALE;
        }
    }
}

__device__ __forceinline__ v4u f8x8_to_bf16(unsigned a, unsigned b) {
    typedef float f32x2 __attribute__((ext_vector_type(2)));
    const f32x2 a0 = __builtin_amdgcn_cvt_pk_f32_fp8((int)a, false), a1 = __builtin_amdgcn_cvt_pk_f32_fp8((int)a, true), b0 = __builtin_amdgcn_cvt_pk_f32_fp8((int)b, false), b1 = __builtin_amdgcn_cvt_pk_f32_fp8((int)b, true);
    v4u r; r.x = __builtin_amdgcn_perm(__float_as_uint(a0.y), __float_as_uint(a0.x), 0x07060302u); r.y = __builtin_amdgcn_perm(__float_as_uint(a1.y), __float_as_uint(a1.x), 0x07060302u);
    r.z = __builtin_amdgcn_perm(__float_as_uint(b0.y), __float_as_uint(b0.x), 0x07060302u); r.w = __builtin_amdgcn_perm(__float_as_uint(b1.y), __float_as_uint(b1.x), 0x07060302u); return r;
}
__device__ __forceinline__ u64 make_key(float s, int kidx) {
    const unsigned u = __float_as_uint(s); const unsigned sk = u ^ ((unsigned)((int)u >> 31) | 0x80000000u);
    return ((u64)sk << 13) | (u64)(8191 - kidx);
}
__device__ __forceinline__ float relu_i(float x) { const int b = __float_as_int(x); return __int_as_float(b > 0 ? b : 0); }
__device__ __forceinline__ unsigned skey32(float s) { const unsigned u = __float_as_uint(s); return u ^ ((unsigned)((int)u >> 31) | 0x80000000u); }
template <int MODE, bool L0, int PROBE, bool ALLV, int SMUL>
__device__ __forceinline__ void idx_loop(const bf16x8 (&qa)[4][4], const bf16* KIb, int t0q, int nst, int st_begin, int st_end, int key_l, int hi, LAS unsigned char* lds, const u64 (&Pq)[4][2], unsigned hbase,
                                         bf16x8 (&kb)[4], bf16x8 (&kn)[4], f32x16& acc, int level, int hi_shift, int lo_shift, unsigned mask) {
    for (int st_ = st_begin; st_ < st_end; st_ += 8) {
        const int kidx = 32 * SMUL * st_ + key_l;
        unsigned sks[4][2];
        constexpr bool allvalid = ALLV;
#pragma unroll
        for (int rb = 0; rb < 4; ++rb) {
            f32x16 accN = f32x16{};
            if (rb < 3) {
#pragma unroll
                for (int ks = 0; ks < 4; ++ks) accN = __builtin_amdgcn_mfma_f32_32x32x16_bf16(qa[rb + 1][ks], kb[ks], accN, 0, 0, 0);
            } else {
#pragma unroll
                for (int ks = 0; ks < 4; ++ks) kb[ks] = kn[ks];
                { const int kx = (st_ + 16 < nst) ? kidx + 512 * SMUL : kidx;
#pragma unroll
                  for (int ks = 0; ks < 4; ++ks) kn[ks] = *(const GAS bf16x8*)(KIb + (size_t)(PROBE == 2 ? key_l : kx) * 64 + 16 * ks + 8 * hi); }
#pragma unroll
                for (int ks = 0; ks < 4; ++ks) accN = __builtin_amdgcn_mfma_f32_32x32x16_bf16(qa[0][ks], kb[ks], accN, 0, 0, 0);
            }
            __builtin_amdgcn_sched_barrier(0);
            float sc[2];
            { LAS const f32x4* wp = (LAS const f32x4*)(lds + ST_OFF + 1024 + (4 * rb + 2 * hi) * 32);
              const f32x4 w0 = wp[0], w1 = wp[1], w2 = wp[2], w3 = wp[3];
              float s0 = relu_i(acc[0]) * w0[0];
#pragma unroll
              for (int i = 1; i < 4; ++i) s0 = fmaf(relu_i(acc[i]), w0[i], s0);
#pragma unroll
              for (int i = 0; i < 4; ++i) s0 = fmaf(relu_i(acc[4 + i]), w1[i], s0);
              asm volatile("" : "+v"(s0));
              float s1 = relu_i(acc[8]) * w2[0];
#pragma unroll
              for (int i = 1; i < 4; ++i) s1 = fmaf(relu_i(acc[8 + i]), w2[i], s1);
#pragma unroll
              for (int i = 0; i < 4; ++i) s1 = fmaf(relu_i(acc[12 + i]), w3[i], s1);
              sc[0] = s0; sc[1] = s1; }
#pragma unroll
            for (int e = 0; e < 2; ++e) {
                const int ql = 4 * rb + 2 * hi + e; const int t = t0q + ql;
                const unsigned sk = skey32(sc[e]);
                if (L0 && MODE == 0) {
                    const unsigned skv = allvalid ? sk : ((kidx <= t) ? sk : 0u);
                    const unsigned addr = hbase + (unsigned)(4 * rb + e) * 8192u + ((skv >> 21) << 2);
                    const unsigned vv = (skv & 0x100000u) ? 0x10000u : 1u;
                    if (PROBE == 1) { asm volatile("" :: "v"(addr), "v"(vv)); }
                    else __hip_atomic_fetch_add((LAS unsigned*)(uintptr_t)addr, vv, __ATOMIC_RELAXED, __HIP_MEMORY_SCOPE_WORKGROUP);
                } else if (L0 && (MODE == 1 || MODE == 3)) {
                    sks[rb][e] = sk;
                } else {
                    const bool valid = kidx <= t;
                    const u64 K = ((u64)sk << 13) | (u64)(8191 - kidx);
                    if (MODE == 0) {
                        bool ok = valid;
                        if (level > 0) ok = ok && ((K >> hi_shift) == Pq[rb][e]);
                        if (ok) { const unsigned bin = (unsigned)(K >> lo_shift) & mask;
                            __hip_atomic_fetch_add((LAS unsigned*)(lds + HIST_OFF + ql * 8192) + (bin >> 1), 1u << (16 * (bin & 1)), __ATOMIC_RELAXED, __HIP_MEMORY_SCOPE_WORKGROUP); }
                    } else if (valid) {
                        const u64 pfx = K >> lo_shift;
                        LAS unsigned* st = (LAS unsigned*)(lds + ST_OFF + ql * 32);
                        if (pfx > Pq[rb][e]) {
                            const unsigned slot = __hip_atomic_fetch_add(st + 3, 1u, __ATOMIC_RELAXED, __HIP_MEMORY_SCOPE_WORKGROUP) & 0xffffu;
                            if (slot < (unsigned)TOPK) ((LAS unsigned short*)(lds + SEL_OFF))[ql * TOPK + slot] = (unsigned short)kidx;
                        } else if (pfx == Pq[rb][e]) {
                            const unsigned slot = __hip_atomic_fetch_add(st + 3, 0x10000u, __ATOMIC_RELAXED, __HIP_MEMORY_SCOPE_WORKGROUP) >> 16;
                            if (slot < (unsigned)CAP) ((LAS u64*)(lds + HIST_OFF))[ql * CAP + slot] = K;
                        }
                    }
                }
            }
            if (L0 && (MODE == 1 || MODE == 3) && (rb & 1)) {
                unsigned old[2][2];
#pragma unroll
                for (int r2 = 0; r2 < 2; ++r2)
#pragma unroll
                    for (int e = 0; e < 2; ++e) { const int rbb = rb - 1 + r2, ql = 4 * rbb + 2 * hi + e; const unsigned bin = sks[rbb][e] >> 20, Tb = (unsigned)Pq[rbb][e]; const bool valid = allvalid || (kidx <= t0q + ql);
                        old[r2][e] = 0u;
                        if (valid && bin >= Tb) old[r2][e] = __hip_atomic_fetch_add((LAS unsigned*)(lds + ST_OFF + ql * 32) + 3, (MODE == 1 && bin > Tb) ? 1u : 0x10000u, __ATOMIC_RELAXED, __HIP_MEMORY_SCOPE_WORKGROUP); }
#pragma unroll
                for (int r2 = 0; r2 < 2; ++r2)
#pragma unroll
                    for (int e = 0; e < 2; ++e) { const int rbb = rb - 1 + r2, ql = 4 * rbb + 2 * hi + e; const unsigned bin = sks[rbb][e] >> 20, Tb = (unsigned)Pq[rbb][e]; const bool valid = allvalid || (kidx <= t0q + ql);
                        if (MODE == 1 && valid && bin > Tb) { const unsigned slot = old[r2][e] & 0xffffu; if (slot < (unsigned)TOPK) ((LAS unsigned short*)(lds + SEL_OFF))[ql * TOPK + slot] = (unsigned short)kidx; }
                        else if (valid && (MODE == 3 ? bin >= Tb : bin == Tb)) { const unsigned slot = old[r2][e] >> 16; if (slot < (unsigned)CAP) ((LAS u64*)(lds + HIST_OFF))[ql * CAP + slot] = ((u64)sks[rbb][e] << 13) | (u64)(8191 - kidx); } }
            }
            acc = accN;
        }
    }
}
template <int MODE, bool L0, int PROBE = 0, int SMUL = 1>
__device__ __forceinline__ void idx_pass(const bf16x8 (&qa)[4][4], const bf16* KIb, int t0q, int nst, int wave, int lane_in, LAS unsigned char* lds, int level, int hi_shift, int lo_shift, unsigned mask) {
    int lane = lane_in; asm volatile("" : "+v"(lane));
    const int key_l = lane & 31, hi = lane >> 5;
    u64 Pq[4][2];
#pragma unroll
    for (int rb = 0; rb < 4; ++rb)
#pragma unroll
        for (int e = 0; e < 2; ++e) { const int ql = 4 * rb + 2 * hi + e; LAS const unsigned* st = (LAS const unsigned*)(lds + ST_OFF + ql * 32);
            Pq[rb][e] = (u64)st[0] | ((u64)st[1] << 32); }
    const unsigned hbase = (unsigned)(uintptr_t)(lds + HIST_OFF) + (unsigned)hi * 16384u;
    bf16x8 kb[4], kn[4];
    { const int kc = (wave < nst) ? 32 * SMUL * wave + key_l : key_l;
      const int kc2 = (wave + 8 < nst) ? kc + 256 * SMUL : kc;
#pragma unroll
      for (int ks = 0; ks < 4; ++ks) { kb[ks] = *(const GAS bf16x8*)(KIb + (size_t)kc * 64 + 16 * ks + 8 * hi); kn[ks] = *(const GAS bf16x8*)(KIb + (size_t)(PROBE == 2 ? key_l : kc2) * 64 + 16 * ks + 8 * hi); } }
    f32x16 acc = f32x16{};
#pragma unroll
    for (int ks = 0; ks < 4; ++ks) acc = __builtin_amdgcn_mfma_f32_32x32x16_bf16(qa[0][ks], kb[ks], acc, 0, 0, 0);
    if (SMUL != 1) {
        idx_loop<MODE, L0, PROBE, true, SMUL>(qa, KIb, t0q, nst, wave, nst, key_l, hi, lds, Pq, hbase, kb, kn, acc, level, hi_shift, lo_shift, mask);
        return;
    }
    const int nfull = (t0q + 1) >> 5; int st_split = wave; if (nfull > wave) st_split = wave + ((nfull - wave + 7) >> 3) * 8;
    idx_loop<MODE, L0, PROBE, true, 1>(qa, KIb, t0q, nst, wave, nfull, key_l, hi, lds, Pq, hbase, kb, kn, acc, level, hi_shift, lo_shift, mask);
    idx_loop<MODE, L0, PROBE, false, 1>(qa, KIb, t0q, nst, st_split, nst, key_l, hi, lds, Pq, hbase, kb, kn, acc, level, hi_shift, lo_shift, mask);
}

__device__ __forceinline__ void find_bin(LAS unsigned char* lds, int row, int lane_in, int bits) {
    int lane = lane_in; asm volatile("" : "+v"(lane));
    LAS unsigned* st = (LAS unsigned*)(lds + ST_OFF + row * 32);
    if (st[6] != 0u) return;
    const unsigned need = st[2];
    LAS const unsigned* hrow = (LAS const unsigned*)(lds + HIST_OFF + row * 8192) + 32 * lane;
    v4u hw[8]; unsigned tot = 0;
#pragma unroll
    for (int i = 0; i < 8; ++i) { hw[i] = *(LAS const v4u*)(hrow + 4 * i);
#pragma unroll
        for (int e = 0; e < 4; ++e) tot += (hw[i][e] & 0xffffu) + (hw[i][e] >> 16); }
    unsigned suf = tot;
#pragma unroll
    for (int o = 1; o < 64; o <<= 1) { const unsigned n = (unsigned)__builtin_amdgcn_ds_bpermute(((lane + o) & 63) << 2, (int)suf); if (lane + o < 64) suf += n; }
    const unsigned above = suf - tot;
    if (above < need && need <= suf) {
        unsigned running = above, T = 0, cT = 0; bool found = false;
#pragma unroll
        for (int i = 31; i >= 0; --i) {
            const unsigned w = hw[i >> 2][i & 3], h16 = w >> 16, l16 = w & 0xffffu;
            if (!found) {
                if (running + h16 >= need) { T = 64 * lane + 2 * i + 1; cT = h16; found = true; }
                else { running += h16;
                    if (running + l16 >= need) { T = 64 * lane + 2 * i; cT = l16; found = true; } else running += l16; } }
        }
        const u64 Pold = (u64)st[0] | ((u64)st[1] << 32); const u64 Pn = (Pold << bits) | (u64)T;
        st[0] = (unsigned)Pn; st[1] = (unsigned)(Pn >> 32); st[2] = need - running; st[5] = cT;
    }
}

template <int NCH>
__device__ __forceinline__ unsigned finish_regs(LAS unsigned char* lds, int row, int lane, int nbits, LAS const u64* cand, unsigned nc, unsigned need, unsigned base, u64 Pfix) {
    u64 k[NCH];
#pragma unroll
    for (int ch = 0; ch < NCH; ++ch) { const unsigned i = 64u * ch + lane; k[ch] = (i < nc) ? cand[i] : 0ull; }
    u64 thr = Pfix;
    if (nbits == 45) {
        unsigned hi[NCH];
#pragma unroll
        for (int ch = 0; ch < NCH; ++ch) hi[ch] = (unsigned)(k[ch] >> 13);
        unsigned t = 0u, cge = 0xffffffffu;
        for (int bit = 31; bit >= 0; --bit) {
            const unsigned c = t | (1u << bit); unsigned cnt = 0;
#pragma unroll
            for (int ch = 0; ch < NCH; ++ch) cnt += (unsigned)__builtin_popcountll(__ballot(hi[ch] >= c));
            if (cnt >= need) { t = c; cge = cnt; }
        }
        thr = (u64)t << 13;
        if (cge != need) {
            for (int bit = 12; bit >= 0; --bit) {
                const u64 c = thr | (1ull << bit); unsigned cnt = 0;
#pragma unroll
                for (int ch = 0; ch < NCH; ++ch) cnt += (unsigned)__builtin_popcountll(__ballot(k[ch] >= c));
                if (cnt >= need) thr = c;
            }
        }
    } else {
        for (int bit = nbits - 1; bit >= 0; --bit) {
            const u64 c = thr | (1ull << bit); unsigned cnt = 0;
#pragma unroll
            for (int ch = 0; ch < NCH; ++ch) cnt += (unsigned)__builtin_popcountll(__ballot(k[ch] >= c));
            if (cnt >= need) thr = c;
        }
    }
#pragma unroll
    for (int ch = 0; ch < NCH; ++ch) {
        const unsigned i = 64u * ch + lane; const bool s = (i < nc) && (k[ch] >= thr);
        const unsigned long long m = __ballot(s); const unsigned pos = base + (unsigned)__builtin_popcountll(m & ((1ull << lane) - 1ull));
        if (s && pos < (unsigned)TOPK) ((LAS unsigned short*)(lds + SEL_OFF))[row * TOPK + pos] = (unsigned short)(8191u - (unsigned)(k[ch] & 0x1fffull));
        base += (unsigned)__builtin_popcountll(m);
    }
    return base;
}
__device__ __forceinline__ void finish_row(LAS unsigned char* lds, int row, int lane_in, int nbits) {
    int lane = lane_in; asm volatile("" : "+v"(lane));
    LAS unsigned* st = (LAS unsigned*)(lds + ST_OFF + row * 32);
    if (st[6] != 0u) return;
    const unsigned need = st[2]; unsigned nc = st[3] >> 16; if (nc > (unsigned)CAP) nc = CAP;
    unsigned base = st[3] & 0xffffu; if (base > (unsigned)TOPK) base = TOPK;
    LAS const u64* cand = (LAS const u64*)(lds + HIST_OFF) + row * CAP;
    const int nch = (int)((nc + 63u) >> 6);
    const u64 Pfix = ((u64)st[0] | ((u64)st[1] << 32)) << nbits;
    u64 thr = Pfix;
    if ((MK_DUP & 16384) && nch <= 8) (void)finish_regs<8>(lds, row, lane, nbits, cand, nc, need, base, Pfix);
    if (nch <= 4) base = finish_regs<4>(lds, row, lane, nbits, cand, nc, need, base, Pfix);
    else if (nch <= 8) base = finish_regs<8>(lds, row, lane, nbits, cand, nc, need, base, Pfix);
    else if (nch <= 12) base = finish_regs<12>(lds, row, lane, nbits, cand, nc, need, base, Pfix);
    else if (nch <= 16) base = finish_regs<16>(lds, row, lane, nbits, cand, nc, need, base, Pfix);
    else {
        for (int bit = nbits - 1; bit >= 0; --bit) {
            const u64 c = thr | (1ull << bit); unsigned cnt = 0;
            for (int ch = 0; ch < nch; ++ch) { const unsigned i = 64u * ch + lane; const u64 k = (i < nc) ? cand[i] : 0ull; cnt += (unsigned)__builtin_popcountll(__ballot(k >= c)); }
            if (cnt >= need) thr = c;
        }
        for (int ch = 0; ch < nch; ++ch) {
            const unsigned i = 64u * ch + lane; const u64 k = (i < nc) ? cand[i] : 0ull; const bool s = (i < nc) && (k >= thr);
            const unsigned long long m = __ballot(s); const unsigned pos = base + (unsigned)__builtin_popcountll(m & ((1ull << lane) - 1ull));
            if (s && pos < (unsigned)TOPK) ((LAS unsigned short*)(lds + SEL_OFF))[row * TOPK + pos] = (unsigned short)(8191u - (unsigned)(k & 0x1fffull));
            base += (unsigned)__builtin_popcountll(m);
        }
    }
    if (lane == 0) st[3] = base;
}

__device__ __forceinline__ void sparse_attn_row(LAS unsigned char* lds, int row, int b, int t, const bf16* Q1, bf16* O1, const unsigned char* K1, const unsigned char* V1, int wave, int lane_in) {
    int lane = lane_in; asm volatile("" : "+v"(lane));
    const int n16 = lane & 15, q4 = lane >> 4, gl = n16 >> 2;
    LAS const unsigned short* sel = (LAS const unsigned short*)(lds + SEL_OFF) + row * TOPK;
    unsigned cnt = ((LAS const unsigned*)(lds + ST_OFF + row * 32))[3] & 0xffffu; if (cnt > (unsigned)TOPK) cnt = TOPK;
    const bf16* qrow = Q1 + ((size_t)b * T + t) * D; bf16* orow = O1 + ((size_t)b * T + t) * D;
    bf16x8 bq[8];
    { const bf16x8 q0 = *(const GAS bf16x8*)(qrow + n16 * 64 + 16 * q4), q1 = *(const GAS bf16x8*)(qrow + n16 * 64 + 16 * q4 + 8); const bf16x8 z = (bf16x8){0, 0, 0, 0, 0, 0, 0, 0};
#pragma unroll
      for (int s = 0; s < 8; ++s) bq[s] = ((s >> 1) == gl) ? ((s & 1) ? q1 : q0) : z; }
    const float slope = __builtin_amdgcn_exp2f(-0.5f * (float)(n16 + 1)) * LOG2E;
    const unsigned char* Kb = K1 + (size_t)b * T * 256; const unsigned char* Vb = V1 + (size_t)b * T * 256;
    f32x4 sc[16];
    v4u vst[2][8];
    constexpr int KD = 3;
    v4u kfn[KD][4];
#pragma unroll
    for (int d = 0; d < KD; ++d) { const unsigned pos = 16u * d + n16; const unsigned kidx = (pos < cnt) ? (unsigned)sel[pos] : 0u; const unsigned char* kp = Kb + (size_t)kidx * 256 + 16 * q4;
#pragma unroll
      for (int g = 0; g < 4; ++g) kfn[d][g] = *(const GAS v4u*)(kp + 64 * g); }
#pragma unroll
    for (int blk = 0; blk < 16; ++blk) {
        bf16x8 kf[8];
#pragma unroll
        for (int g = 0; g < 4; ++g) { const v4u lo = f8x8_to_bf16(kfn[blk % KD][g].x, kfn[blk % KD][g].y), hi8 = f8x8_to_bf16(kfn[blk % KD][g].z, kfn[blk % KD][g].w); kf[2 * g] = __builtin_bit_cast(bf16x8, lo); kf[2 * g + 1] = __builtin_bit_cast(bf16x8, hi8); }
        if (blk + KD < 16) { const unsigned pos = 16u * (blk + KD) + n16; const unsigned kidx = (pos < cnt) ? (unsigned)sel[pos] : 0u; const unsigned char* kp = Kb + (size_t)kidx * 256 + 16 * q4;
#pragma unroll
            for (int g = 0; g < 4; ++g) kfn[blk % KD][g] = *(const GAS v4u*)(kp + 64 * g); }
        if (blk >= 14) {
            const int d = blk - 14;
#pragma unroll
            for (int i = 0; i < 8; ++i) { const unsigned pos = 32u * d + 4u * i + q4; const unsigned kidx = (pos < cnt) ? (unsigned)sel[pos] : 0u; vst[d][i] = *(const GAS v4u*)(Vb + (size_t)kidx * 256 + 16 * n16); }
        }
        f32x4 a = (f32x4){0.f, 0.f, 0.f, 0.f};
#pragma unroll
        for (int s = 0; s < 8; ++s) a = __builtin_amdgcn_mfma_f32_16x16x32_bf16(kf[s], bq[s], a, 0, 0, 0);
        const unsigned long long i4 = *(LAS const unsigned long long*)(sel + 16 * blk + 4 * q4);
#pragma unroll
        for (int i = 0; i < 4; ++i) { const unsigned p = 16u * blk + 4u * q4 + i; const int ki = (int)((i4 >> (16 * i)) & 0xffffull);
            a[i] = (p < cnt) ? (a[i] - slope * (float)(t - ki)) : -INFINITY; }
        sc[blk] = a;
    }
    float mx = -INFINITY;
#pragma unroll
    for (int blk = 0; blk < 16; ++blk) mx = fmaxf(fmaxf(fmaxf(mx, sc[blk][0]), fmaxf(sc[blk][1], sc[blk][2])), sc[blk][3]);
    mx = xmax32(xmax16(mx));
    float lsum = 0.f;
#pragma unroll
    for (int blk = 0; blk < 16; ++blk)
#pragma unroll
        for (int i = 0; i < 4; ++i) { const float p = __builtin_amdgcn_exp2f(sc[blk][i] - mx); sc[blk][i] = p; lsum += p; }
    lsum = xsum32(xsum16(lsum));
    LAS unsigned char* vbuf = lds + HIST_OFF + wave * 16384;
    f32x4 o[4];
#pragma unroll
    for (int db = 0; db < 4; ++db) o[db] = (f32x4){0.f, 0.f, 0.f, 0.f};
#pragma unroll
    for (int J = 0; J < 8; ++J) {
#pragma unroll
        for (int i = 0; i < 8; ++i) { const int key = 4 * i + q4; LAS unsigned char* dst = vbuf + key * 512 + ((n16 ^ (key & 7)) << 5);
            *(LAS v4u*)dst = f8x8_to_bf16(vst[J & 1][i].x, vst[J & 1][i].y); *(LAS v4u*)(dst + 16) = f8x8_to_bf16(vst[J & 1][i].z, vst[J & 1][i].w); }
        if (J + 2 < 8) {
#pragma unroll
            for (int i = 0; i < 8; ++i) { const unsigned pos = 32u * (J + 2) + 4u * i + q4; const unsigned kidx = (pos < cnt) ? (unsigned)sel[pos] : 0u; vst[J & 1][i] = *(const GAS v4u*)(Vb + (size_t)kidx * 256 + 16 * n16); }
        }
        asm volatile("s_waitcnt lgkmcnt(0)" ::: "memory");
        v4u pb; pb.x = pk2(sc[2 * J][0], sc[2 * J][1]); pb.y = pk2(sc[2 * J][2], sc[2 * J][3]); pb.z = pk2(sc[2 * J + 1][0], sc[2 * J + 1][1]); pb.w = pk2(sc[2 * J + 1][2], sc[2 * J + 1][3]);
#pragma unroll
        for (int g = 0; g < 4; ++g) {
            const v4u pg = (g == gl) ? pb : (v4u){0u, 0u, 0u, 0u};
#pragma unroll
            for (int db = 0; db < 4; ++db) {
                const int qq = n16 >> 2, pp = n16 & 3; const int col = 64 * g + 16 * db + 4 * pp;
                const int r0 = 4 * q4 + qq, r1 = 16 + 4 * q4 + qq;
                const int a0 = r0 * 512 + ((((col >> 4) ^ (r0 & 7)) << 5) | ((col & 15) << 1)), a1 = r1 * 512 + ((((col >> 4) ^ (r1 & 7)) << 5) | ((col & 15) << 1));
                v2u lo, hi2;
                asm volatile("ds_read_b64_tr_b16 %0, %1" : "=v"(lo) : "v"((unsigned)(uintptr_t)(vbuf + a0)) : "memory");
                asm volatile("ds_read_b64_tr_b16 %0, %1" : "=v"(hi2) : "v"((unsigned)(uintptr_t)(vbuf + a1)) : "memory");
                asm volatile("s_waitcnt lgkmcnt(0)" : "+v"(lo), "+v"(hi2) :: "memory");
                const v4u av = (v4u){lo.x, lo.y, hi2.x, hi2.y};
                o[db] = __builtin_amdgcn_mfma_f32_16x16x32_bf16(__builtin_bit_cast(bf16x8, av), __builtin_bit_cast(bf16x8, pg), o[db], 0, 0, 0);
            }
        }
        asm volatile("s_waitcnt lgkmcnt(0)" ::: "memory");
    }
    const float rl = 1.f / lsum;
#pragma unroll
    for (int db = 0; db < 4; ++db) { v2u w; w.x = pk2(o[db][0] * rl, o[db][1] * rl); w.y = pk2(o[db][2] * rl, o[db][3] * rl);
        *(GAS v2u*)(orow + n16 * 64 + 16 * db + 4 * q4) = w; }
}

typedef long i64_t;
__device__ __forceinline__ void canon_sel(LAS unsigned char* lds, LAS unsigned short* sel, unsigned cnt, int wave, int lane) {
    LAS unsigned* bm = (LAS unsigned*)(lds + HIST_OFF + wave * 16384); LAS unsigned* pf = bm + 256;
    *(LAS v4u*)(bm + 4 * lane) = (v4u){0u, 0u, 0u, 0u};
    const v2u e = *(const LAS v2u*)(sel + 4 * lane);
    unsigned idx[4] = {e.x & 0xffffu, e.x >> 16, e.y & 0xffffu, e.y >> 16};
    LDS_WAIT();
#pragma unroll
    for (int i = 0; i < 4; ++i) if ((unsigned)(4 * lane + i) < cnt) __hip_atomic_fetch_or(bm + (idx[i] >> 5), 1u << (idx[i] & 31u), __ATOMIC_RELAXED, __HIP_MEMORY_SCOPE_WORKGROUP);
    LDS_WAIT();
    const v4u w = *(const LAS v4u*)(bm + 4 * lane);
    const unsigned c0 = __builtin_popcount(w.x), c1 = __builtin_popcount(w.y), c2 = __builtin_popcount(w.z), c3 = __builtin_popcount(w.w), tot = c0 + c1 + c2 + c3;
    int sc = (int)tot;
    sc += __builtin_amdgcn_update_dpp(0, sc, 0x111, 0xf, 0xf, false); sc += __builtin_amdgcn_update_dpp(0, sc, 0x112, 0xf, 0xf, false);
    sc += __builtin_amdgcn_update_dpp(0, sc, 0x114, 0xf, 0xf, false); sc += __builtin_amdgcn_update_dpp(0, sc, 0x118, 0xf, 0xf, false);
    sc += __builtin_amdgcn_update_dpp(0, sc, 0x142, 0xa, 0xf, false);
    sc += __builtin_amdgcn_update_dpp(0, sc, 0x143, 0xc, 0xf, false);
    const unsigned ex = (unsigned)sc - tot;
    *(LAS v4u*)(pf + 4 * lane) = (v4u){ex, ex + c0, ex + c0 + c1, ex + c0 + c1 + c2};
    LDS_WAIT();
#pragma unroll
    for (int i = 0; i < 4; ++i) if ((unsigned)(4 * lane + i) < cnt) { const unsigned wd = idx[i] >> 5; const unsigned r = pf[wd] + __builtin_popcount(bm[wd] & ((1u << (idx[i] & 31u)) - 1u)); sel[r] = (unsigned short)idx[i]; }
    LDS_WAIT();
}
__device__ __forceinline__ void sparse_attn_row8(LAS unsigned char* lds, int row, int b, int t, const bf16* Q1, bf16* O1, const unsigned char* K1, const unsigned char* V1, int wave, int lane_in) {
    int lane = lane_in; asm volatile("" : "+v"(lane));
    const int n16 = lane & 15, q4 = lane >> 4, gl = n16 >> 2;
    LAS unsigned short* sel = (LAS unsigned short*)(lds + SEL_OFF) + row * TOPK;
    unsigned cnt = ((LAS const unsigned*)(lds + ST_OFF + row * 32))[3] & 0xffffu; if (cnt > (unsigned)TOPK) cnt = TOPK;
    canon_sel(lds, sel, cnt, wave, lane);
    if (cnt < (unsigned)TOPK) {
        for (unsigned i = cnt + lane; i < (unsigned)TOPK; i += 64u) sel[i] = 0;
        asm volatile("s_waitcnt lgkmcnt(0)" ::: "memory");
    }
    const bf16* qrow = Q1 + ((size_t)b * T + t) * D; bf16* orow = O1 + ((size_t)b * T + t) * D;
    i64_t qs0, qs1;
    { const v4u a = *(const GAS v4u*)(qrow + n16 * 64 + 16 * q4), c = *(const GAS v4u*)(qrow + n16 * 64 + 16 * q4 + 8);
      int w0 = 0, w1 = 0, w2 = 0, w3 = 0;
      w0 = __builtin_amdgcn_cvt_pk_fp8_f32(bf2f(a.x & 0xffffu), bf2f(a.x >> 16), w0, false); w0 = __builtin_amdgcn_cvt_pk_fp8_f32(bf2f(a.y & 0xffffu), bf2f(a.y >> 16), w0, true);
      w1 = __builtin_amdgcn_cvt_pk_fp8_f32(bf2f(a.z & 0xffffu), bf2f(a.z >> 16), w1, false); w1 = __builtin_amdgcn_cvt_pk_fp8_f32(bf2f(a.w & 0xffffu), bf2f(a.w >> 16), w1, true);
      w2 = __builtin_amdgcn_cvt_pk_fp8_f32(bf2f(c.x & 0xffffu), bf2f(c.x >> 16), w2, false); w2 = __builtin_amdgcn_cvt_pk_fp8_f32(bf2f(c.y & 0xffffu), bf2f(c.y >> 16), w2, true);
      w3 = __builtin_amdgcn_cvt_pk_fp8_f32(bf2f(c.z & 0xffffu), bf2f(c.z >> 16), w3, false); w3 = __builtin_amdgcn_cvt_pk_fp8_f32(bf2f(c.w & 0xffffu), bf2f(c.w >> 16), w3, true);
      qs0 = (i64_t)(((u64)(unsigned)w1 << 32) | (u64)(unsigned)w0); qs1 = (i64_t)(((u64)(unsigned)w3 << 32) | (u64)(unsigned)w2); }
    i64_t bq0[4], bq1[4];
#pragma unroll
    for (int g = 0; g < 4; ++g) { bq0[g] = (g == gl) ? qs0 : (i64_t)0; bq1[g] = (g == gl) ? qs1 : (i64_t)0; }
    const float slope = __builtin_amdgcn_exp2f(-0.5f * (float)(n16 + 1)) * LOG2E;
    const unsigned char* Kb = K1 + (size_t)b * T * 256; const unsigned char* Vb = V1 + (size_t)b * T * 256;
    const int vkey = lane >> 1, vpar = lane & 1;
    f32x4 sc[16];
    v4u vst[2][8];
    constexpr int KD = 3;
    v4u kfn[KD][4];
#pragma unroll
    for (int d = 0; d < KD; ++d) { const unsigned kidx = (unsigned)sel[16 * d + n16]; const unsigned char* kp = Kb + (size_t)kidx * 256 + 16 * q4;
#pragma unroll
      for (int g = 0; g < 4; ++g) kfn[d][g] = *(const GAS v4u*)(kp + 64 * g); }
#pragma unroll
    for (int blk = 0; blk < 16; ++blk) {
        f32x4 a = (f32x4){0.f, 0.f, 0.f, 0.f};
#pragma unroll
        for (int g = 0; g < 4; ++g) {
            const v4u ch = kfn[blk % KD][g];
            const i64_t k0 = (i64_t)(((u64)ch.y << 32) | (u64)ch.x), k1 = (i64_t)(((u64)ch.w << 32) | (u64)ch.z);
            a = __builtin_amdgcn_mfma_f32_16x16x32_fp8_fp8(k0, bq0[g], a, 0, 0, 0);
            a = __builtin_amdgcn_mfma_f32_16x16x32_fp8_fp8(k1, bq1[g], a, 0, 0, 0);
        }
        if (blk + KD < 16) { const unsigned kidx = (unsigned)sel[16 * (blk + KD) + n16]; const unsigned char* kp = Kb + (size_t)kidx * 256 + 16 * q4;
#pragma unroll
            for (int g = 0; g < 4; ++g) kfn[blk % KD][g] = *(const GAS v4u*)(kp + 64 * g); }
        if (blk >= 14) { const int d = blk - 14;
#pragma unroll
            for (int k = 0; k < 8; ++k) vst[d][k] = *(const GAS v4u*)(Vb + (size_t)sel[32 * d + 4 * k + q4] * 256 + 16 * n16); }
        const unsigned long long i4 = *(LAS const unsigned long long*)(sel + 16 * blk + 4 * q4);
#pragma unroll
        for (int i = 0; i < 4; ++i) { const unsigned pz = 16u * blk + 4u * q4 + i; const int ki = (int)((i4 >> (16 * i)) & 0xffffull);
            a[i] = (pz < cnt) ? (a[i] - slope * (float)(t - ki)) : -INFINITY; }
        sc[blk] = a;
    }
    float mx = -INFINITY;
#pragma unroll
    for (int blk = 0; blk < 16; ++blk) mx = fmaxf(fmaxf(fmaxf(mx, sc[blk][0]), fmaxf(sc[blk][1], sc[blk][2])), sc[blk][3]);
    mx = xmax32(xmax16(mx));
    float lsum = 0.f;
    mx -= 8.f;
#pragma unroll
    for (int blk = 0; blk < 16; ++blk)
#pragma unroll
        for (int i = 0; i < 4; ++i) { const float pv = __builtin_amdgcn_exp2f(sc[blk][i] - mx); sc[blk][i] = pv; lsum += pv; }
    lsum = xsum32(xsum16(lsum));
    LAS unsigned char* vbuf = lds + HIST_OFF + wave * 16384;
    unsigned vdst[4];
#pragma unroll
    for (int j = 0; j < 4; ++j) vdst[j] = (unsigned)(uintptr_t)vbuf + (unsigned)vkey * 256u + (unsigned)((((2 * j) ^ (vkey & 7)) << 5) | (vpar << 4));
    const int qq = n16 >> 2, pp = n16 & 3; const int r0 = 4 * q4 + qq, r1 = 16 + 4 * q4 + qq;
    f32x4 oe[2], oo[2];
#pragma unroll
    for (int d = 0; d < 2; ++d) { oe[d] = (f32x4){0.f, 0.f, 0.f, 0.f}; oo[d] = (f32x4){0.f, 0.f, 0.f, 0.f}; }
#pragma unroll
    for (int J = 0; J < 8; ++J) {
        LAS unsigned char* slot = vbuf + (J & 1) * 8192;
#pragma unroll
        for (int k = 0; k < 8; ++k) { const int key = 4 * k + q4; *(LAS v4u*)(slot + key * 256 + ((((n16 >> 1) ^ (key & 7)) << 5) | ((n16 & 1) << 4))) = vst[J & 1][k]; }
        if (J + 2 < 8) {
#pragma unroll
            for (int k = 0; k < 8; ++k) vst[J & 1][k] = *(const GAS v4u*)(Vb + (size_t)sel[32 * (J + 2) + 4 * k + q4] * 256 + 16 * n16); }
        asm volatile("s_waitcnt lgkmcnt(0)" ::: "memory");
        int p0 = 0, p1 = 0;
        p0 = __builtin_amdgcn_cvt_pk_fp8_f32(sc[2 * J][0], sc[2 * J][1], p0, false); p0 = __builtin_amdgcn_cvt_pk_fp8_f32(sc[2 * J][2], sc[2 * J][3], p0, true);
        p1 = __builtin_amdgcn_cvt_pk_fp8_f32(sc[2 * J + 1][0], sc[2 * J + 1][1], p1, false); p1 = __builtin_amdgcn_cvt_pk_fp8_f32(sc[2 * J + 1][2], sc[2 * J + 1][3], p1, true);
        const i64_t pb = (i64_t)(((u64)(unsigned)p1 << 32) | (u64)(unsigned)p0);
        v2u trl[8], trh[8];
#pragma unroll
        for (int sg = 0; sg < 8; ++sg) {
            const int a0 = r0 * 256 + (((sg ^ (r0 & 7)) << 5) | (pp << 3)), a1 = r1 * 256 + (((sg ^ (r1 & 7)) << 5) | (pp << 3));
            asm volatile("ds_read_b64_tr_b16 %0, %1" : "=v"(trl[sg]) : "v"((unsigned)(uintptr_t)(slot + a0)) : "memory");
            asm volatile("ds_read_b64_tr_b16 %0, %1" : "=v"(trh[sg]) : "v"((unsigned)(uintptr_t)(slot + a1)) : "memory");
        }
        asm volatile("s_waitcnt lgkmcnt(0)" : "+v"(trl[0]), "+v"(trl[1]), "+v"(trl[2]), "+v"(trl[3]), "+v"(trl[4]), "+v"(trl[5]), "+v"(trl[6]), "+v"(trl[7]),
                                               "+v"(trh[0]), "+v"(trh[1]), "+v"(trh[2]), "+v"(trh[3]), "+v"(trh[4]), "+v"(trh[5]), "+v"(trh[6]), "+v"(trh[7]) :: "memory");
#pragma unroll
        for (int g = 0; g < 4; ++g) {
            const i64_t pg = (g == gl) ? pb : (i64_t)0;
#pragma unroll
            for (int dbp = 0; dbp < 2; ++dbp) {
                const v2u lo = trl[2 * g + dbp], hi2 = trh[2 * g + dbp];
                const unsigned e0 = __builtin_amdgcn_perm(lo.y, lo.x, 0x06040200u), o0 = __builtin_amdgcn_perm(lo.y, lo.x, 0x07050301u);
                const unsigned e1 = __builtin_amdgcn_perm(hi2.y, hi2.x, 0x06040200u), o1 = __builtin_amdgcn_perm(hi2.y, hi2.x, 0x07050301u);
                const i64_t ae = (i64_t)(((u64)e1 << 32) | (u64)e0), ao = (i64_t)(((u64)o1 << 32) | (u64)o0);
                oe[dbp] = __builtin_amdgcn_mfma_f32_16x16x32_fp8_fp8(ae, pg, oe[dbp], 0, 0, 0);
                oo[dbp] = __builtin_amdgcn_mfma_f32_16x16x32_fp8_fp8(ao, pg, oo[dbp], 0, 0, 0);
            }
        }
    }
    (void)vdst;
    const float rl = 32.f / lsum;
#pragma unroll
    for (int dbp = 0; dbp < 2; ++dbp) {
        int w0 = 0, w1 = 0;
        w0 = __builtin_amdgcn_cvt_pk_fp8_f32(oe[dbp][0] * rl, oo[dbp][0] * rl, w0, false); w0 = __builtin_amdgcn_cvt_pk_fp8_f32(oe[dbp][1] * rl, oo[dbp][1] * rl, w0, true);
        w1 = __builtin_amdgcn_cvt_pk_fp8_f32(oe[dbp][2] * rl, oo[dbp][2] * rl, w1, false); w1 = __builtin_amdgcn_cvt_pk_fp8_f32(oe[dbp][3] * rl, oo[dbp][3] * rl, w1, true);
        *(GAS v2u*)((unsigned char*)O1 + ((size_t)b * T + t) * D + n16 * 64 + 32 * dbp + 8 * q4) = (v2u){(unsigned)w0, (unsigned)w1}; }
}

__device__ __forceinline__ void unit(LAS unsigned char* lds, int b, int t0q, const bf16* Q1, bf16* O1, const unsigned char* K1, const unsigned char* V1, const bf16* QI, const bf16* KI, const float* WI, int tid_in, int wave) {
    int tid = tid_in; asm volatile("" : "+v"(tid)); const int lane = tid & 63;
    const int hi = lane >> 5, r32 = lane & 31;
    if (tid < QT * 8) ((LAS float*)(lds + ST_OFF + 1024))[tid] = WI[((size_t)b * T + t0q) * 8 + tid];
    if (tid < QT) { LAS unsigned* st = (LAS unsigned*)(lds + ST_OFF + tid * 32); const int t = t0q + tid;
        unsigned z; asm volatile("v_mov_b32 %0, 0" : "=v"(z));
        st[0] = z; st[1] = z; st[2] = z + (unsigned)TOPK; st[3] = z; st[4] = z; st[5] = z; st[6] = (t + 1 <= TOPK) ? 1u : z; st[7] = z; }
    for (int i = tid; i < 32768 / 4; i += NTHREADS) ((LAS v4u*)(lds + HIST_OFF))[i] = (v4u){0u, 0u, 0u, 0u};
    bf16x8 qa[4][4];
    { const int qlr = 2 * ((r32 >> 2) & 1) + (r32 >> 4), hd = 4 * ((r32 >> 3) & 1) + (r32 & 3);
#pragma unroll
      for (int rb = 0; rb < 4; ++rb) { const bf16* qp = QI + ((size_t)b * T + t0q + 4 * rb + qlr) * 512 + hd * 64 + 8 * hi;
#pragma unroll
          for (int ks = 0; ks < 4; ++ks) qa[rb][ks] = *(const GAS bf16x8*)(qp + 16 * ks); } }
    const int nst = (t0q + QT + 31) >> 5;
    const bf16* KIb = KI + (size_t)b * T * 64;
    bool done = false;
    if (t0q >= 2048) {
        const int nfull_ = (t0q + 1) >> 5, nsamp = (nfull_ + 7) >> 3;
        if (tid < QT) { LAS unsigned* st = (LAS unsigned*)(lds + ST_OFF + tid * 32); const unsigned n = (unsigned)(t0q + tid + 1), ns = 32u * (unsigned)nsamp; st[2] = (416u * ns + n - 1u) / n; }
        __syncthreads();
        idx_pass<0, true, 0, 8>(qa, KIb, t0q, nsamp, wave, lane, lds, 0, 45, 33, 4095u);
        __syncthreads();
        find_bin(lds, 2 * wave, lane, 12); find_bin(lds, 2 * wave + 1, lane, 12);
        __syncthreads();
        idx_pass<3, true>(qa, KIb, t0q, nst, wave, lane, lds, 0, 0, 33, 0u);
        __syncthreads();
        bool bad = false;
#pragma unroll
        for (int r = 0; r < QT; ++r) { const unsigned c = ((LAS const unsigned*)(lds + ST_OFF + r * 32))[3] >> 16; bad = bad || c < (unsigned)TOPK || c > (unsigned)CAP; }
        __syncthreads();
        if (!bad) {
            if (tid < QT) { LAS unsigned* st = (LAS unsigned*)(lds + ST_OFF + tid * 32); st[0] = 0u; st[1] = 0u; st[2] = (unsigned)TOPK; }
            __syncthreads();
            { int lane_c; asm volatile("v_mbcnt_lo_u32_b32 %0, -1, 0\n\tv_mbcnt_hi_u32_b32 %0, -1, %0" : "=v"(lane_c));
              finish_row(lds, 2 * wave, lane_c, 45); finish_row(lds, 2 * wave + 1, lane_c, 45); }
            __syncthreads();
            done = true;
        } else {
            if (tid < QT) { LAS unsigned* st = (LAS unsigned*)(lds + ST_OFF + tid * 32); st[0] = 0u; st[1] = 0u; st[2] = (unsigned)TOPK; st[3] = 0u; st[4] = 0u; st[5] = 0u; }
            for (int i = tid; i < 32768 / 4; i += NTHREADS) ((LAS v4u*)(lds + HIST_OFF))[i] = (v4u){0u, 0u, 0u, 0u};
            __syncthreads();
        }
    }
    int level = 0, lo_shift = 33;
    if (!done) {
    for (;;) {
        const int hi_shift = 45 - 12 * level; lo_shift = (level == 3) ? 0 : 33 - 12 * level; const int bits = (level == 3) ? 9 : 12; const unsigned mask = (1u << bits) - 1u;
        if (level > 0) { for (int i = tid; i < 32768 / 4; i += NTHREADS) ((LAS v4u*)(lds + HIST_OFF))[i] = (v4u){0u, 0u, 0u, 0u}; }
        __syncthreads();
        if (MK_DUP & 512) {
            if (MK_DUP & 1024) idx_pass<0, true, 1>(qa, KIb, t0q, nst, wave, lane, lds, level, hi_shift, lo_shift, mask);
            else if (MK_DUP & 2048) idx_pass<0, true, 2>(qa, KIb, t0q, nst, wave, lane, lds, level, hi_shift, lo_shift, mask);
            else idx_pass<0, true>(qa, KIb, t0q, nst, wave, lane, lds, level, hi_shift, lo_shift, mask);
            __syncthreads();
            for (int i = tid; i < 32768 / 4; i += NTHREADS) ((LAS v4u*)(lds + HIST_OFF))[i] = (v4u){0u, 0u, 0u, 0u};
            __syncthreads();
        }
        if (level == 0) idx_pass<0, true>(qa, KIb, t0q, nst, wave, lane, lds, level, hi_shift, lo_shift, mask);
        else idx_pass<0, false>(qa, KIb, t0q, nst, wave, lane, lds, level, hi_shift, lo_shift, mask);
        __syncthreads();
        find_bin(lds, 2 * wave, lane, bits); find_bin(lds, 2 * wave + 1, lane, bits);
        __syncthreads();
        bool more = false;
        if (level < 3) {
#pragma unroll
            for (int r = 0; r < QT; ++r) { LAS const unsigned* st = (LAS const unsigned*)(lds + ST_OFF + r * 32); more = more || (st[6] == 0u && st[5] > (unsigned)CAP); }
        }
        if (!more) break;
        ++level;
    }
    __syncthreads();
    if (MK_DUP & 4096) { idx_pass<1, true>(qa, KIb, t0q, nst, wave, lane, lds, level, 0, lo_shift, 0u); __syncthreads(); if (tid < QT) ((LAS unsigned*)(lds + ST_OFF + tid * 32))[3] = 0u; __syncthreads(); }
    if (level == 0) idx_pass<1, true>(qa, KIb, t0q, nst, wave, lane, lds, level, 0, lo_shift, 0u);
    else idx_pass<1, false>(qa, KIb, t0q, nst, wave, lane, lds, level, 0, lo_shift, 0u);
    __syncthreads();
    finish_row(lds, 2 * wave, lane, lo_shift); finish_row(lds, 2 * wave + 1, lane, lo_shift);
    __syncthreads();
    }
#pragma unroll 1
    for (int rr = 0; rr < (MK_DUP & 256 ? 4 : 2); ++rr) sparse_attn_row8(lds, 2 * wave + (rr & 1), b, t0q + 2 * wave + (rr & 1), Q1, O1, K1, V1, wave, lane);
    __syncthreads();
}
}
#if defined(__HIP_DEVICE_COMPILE__)
typedef const __attribute__((address_space(4))) Ptrs* KArgs;
__device__ __forceinline__ const Ptrs* get_args() { KArgs p = (KArgs)__builtin_amdgcn_kernarg_segment_ptr(); asm volatile("" : "+s"(p)); return (const Ptrs*)p; }
#else
__device__ __forceinline__ const Ptrs* get_args() { return nullptr; }
#endif
#define DUP(bit, ...) do { if (MK_DUP & (1 << (bit))) { __VA_ARGS__; GRID_BAR(); } } while (0)
__global__ void __launch_bounds__(NTHREADS, 2) hybrid_fwd(Ptrs Pbyval) {
    extern __shared__ __attribute__((aligned(16))) unsigned char lds_raw[];
    LAS unsigned char* lds = (LAS unsigned char*)lds_raw;
    volatile LAS unsigned* MISC = (volatile LAS unsigned*)(lds + MISC_OFF);
    const int tid0 = threadIdx.x; const int wave_s = __builtin_amdgcn_readfirstlane(tid0 >> 6);
#define FRESH_IDS() const Ptrs P = *get_args(); unsigned char* ws = P.ws; gu32* ctl = (gu32*)(ws + WS_CTL); float* MOD = (float*)(ws + WS_MOD); bf16* Hb = (bf16*)(ws + WS_H); (void)ctl; (void)MOD; (void)Hb; int tid; asm volatile("v_mbcnt_lo_u32_b32 %0, -1, 0\n\tv_mbcnt_hi_u32_b32 %0, -1, %0\n\tv_lshl_or_b32 %0, %1, 6, %0" : "=&v"(tid) : "s"(wave_s)); const int lane = tid & 63; const int wave = __builtin_amdgcn_readfirstlane(tid >> 6); (void)lane; (void)wave
    const int G = gridDim.x; const int bx = blockIdx.x; const int vcu = (G % 8 == 0) ? (bx % 8) * (G / 8) + bx / 8 : bx;
    for (int u = tid0; u < (LDS_BYTES - LDSCTL_OFF) / 4; u += NTHREADS) ((LAS unsigned*)(lds + LDSCTL_OFF))[u] = 0u;
    __syncthreads();
    XcdBarrier bar = xcd_barrier_post((unsigned*)((gu32*)(Pbyval.ws + WS_CTL) + CW_BAR), MISC + 8);
#define GRID_BAR() xcd_barrier(bar)

#define PH_PROLOGUE() do { FRESH_IDS(); p0_prologue(P, lds, tid, lane, wave, vcu, G); } while (0)
#define PH_NORM1_L0() do { FRESH_IDS(); norm_phase<true, false, 1>(P.x, P.g_mix, MOD, 0, 1, Hb, (unsigned char*)Hb, P.fox_w_in, P.fox_b_f, (float*)(ws + WS_LOGF), lds, tid, lane, wave, vcu, G); } while (0)
#define PH_NORM1_L1() do { FRESH_IDS(); norm_phase<false, true, 2>((const bf16*)(ws + WS_XB), P.g_mix + D, MOD + (size_t)2 * 6144, 0, 1, Hb, ws + WS_H8, nullptr, nullptr, nullptr, lds, tid, lane, wave, vcu, G); } while (0)
#define PH_NORM2(layer) do { FRESH_IDS(); norm_phase<false, true, 1>((const bf16*)(ws + WS_XB), P.g_ffn + layer * D, MOD + (size_t)layer * 2 * 6144, 3, 4, Hb, (unsigned char*)Hb, nullptr, nullptr, nullptr, lds, tid, lane, wave, vcu, G); } while (0)
#define PH_QKV() do { \
        { FRESH_IDS(); for (int seq = bx; seq < 32; seq += G) fox_scan((const float*)(ws + WS_LOGF), (float*)(ws + WS_BETA), ws + WS_KE, seq, (LAS float*)(lds + RING_OFF), tid, lane, wave); } \
        { FRESH_IDS(); \
            pg8::Gemm g{Hb, (const bf16*)(ws + WS_WFIN), M, 3 * D, D / 2, D / 2, D / 2, 0x7f7f7f7f, 0x7a7a7a7a}; pg8::StaticOrder S; S.init(M, 3 * D, G, bx, ORD_QKV); \
            pg8::EpiHeads E{}; E.ntens = 3; \
            E.base[0] = (bf16*)(ws + WS_Q); E.tile0[0] = 0; E.ldc[0] = D; E.kind[0] = 1; E.gain[0] = P.fox_g_q; E.scale[0] = attn_body::C2; \
            E.base[1] = (bf16*)(ws + WS_K); E.tile0[1] = 4; E.ldc[1] = D; E.kind[1] = 1; E.gain[1] = P.fox_g_k; E.scale[1] = 1.f; \
            E.base[2] = (bf16*)(ws + WS_V); E.tile0[2] = 8; E.ldc[2] = D; E.kind[2] = 0; E.gain[2] = P.fox_g_k; E.scale[2] = 1.f; \
            E.base[3] = E.base[2]; E.tile0[3] = 1 << 30; E.ldc[3] = D; E.kind[3] = 0; E.gain[3] = P.fox_g_k; E.scale[3] = 1.f; \
            pg8::gemm_phase<pg8::EpiHeads, pg8::StaticOrder, true, true, true>(lds + RING_OFF, g, S, E, tid); } } while (0)
#define PH_FOXATTN(qword) do { FRESH_IDS(); \
            float qkmax; \
            { const float gq = wave_max(fabsf(P.fox_g_q[lane])), gk = wave_max(fabsf(P.fox_g_k[lane])); qkmax = 64.f * attn_body::C2 * gq * gk * 1.02f + 0.5f; } \
            for (;;) { \
                if (tid == 0) MISC[16] = __hip_atomic_fetch_add(ctl + (qword), 1u, RLX_AGENT); \
                __syncthreads(); \
                const int id = (int)MISC[16]; \
                __syncthreads(); \
                if (id >= 32 * 32) break; \
                const int qb = 31 - (id >> 5), bh = id & 31; \
                attn_body::attn_unit<8>(bh >> 4, bh & 15, qb, (const attn_body::bf16*)(ws + WS_Q), (const attn_body::bf16*)(ws + WS_K), (const attn_body::bf16*)(ws + WS_V), \
                                        (attn_body::bf16*)(ws + WS_O), (const attn_body::bf16*)(ws + WS_KE), (const float*)(ws + WS_BETA), qkmax, (char*)lds_raw + RING_OFF, tid); \
            } } while (0)
#define PH_OUTPROJ(layer, OBUF, WBUF) do { FRESH_IDS(); \
            pg8::Gemm g{(const bf16*)(ws + (OBUF)), (const bf16*)(ws + (WBUF)), M, D, D / 2, D / 2, D / 2, 0x7a7a7a7a, 0x7a7a7a7a}; pg8::StaticOrder S; S.init(M, D, G, bx); \
              \
            if (layer == 0) { if (S.nwg <= G) { pg8::EpiResNormStaged<false, 1> E{P.x, ws + WS_XB, MOD + 2 * D, 6144, T, P.g_ffn, MOD, 3, 4, Hb, (unsigned char*)Hb, (float*)(ws + WS_XS), (unsigned*)(ctl + CW_NS), lds + HALO_OFF}; \
                    pg8::gemm_phase<pg8::EpiResNormStaged<false, 1>, pg8::StaticOrder, true, true, true>(lds + RING_OFF, g, S, E, tid); } \
                else { pg8::EpiRes<false, true> E{P.x, ws + WS_XB, MOD + 2 * D, 6144, T}; pg8::gemm_phase<pg8::EpiRes<false, true>, pg8::StaticOrder, true, true, true>(lds + RING_OFF, g, S, E, tid); } } \
            else { if (S.nwg <= G) { pg8::EpiResNormStaged<true, 1> E{ws + WS_XB, ws + WS_XB, MOD + (size_t)2 * 6144 + 2 * D, 6144, T, P.g_ffn + D, MOD + (size_t)2 * 6144, 3, 4, Hb, (unsigned char*)Hb, (float*)(ws + WS_XS) + (size_t)2 * M * 4, (unsigned*)(ctl + CW_NS + 2048), lds + HALO_OFF}; \
                    pg8::gemm_phase<pg8::EpiResNormStaged<true, 1>, pg8::StaticOrder, true, true, true>(lds + RING_OFF, g, S, E, tid); } \
                else { pg8::EpiRes<true, true> E{ws + WS_XB, ws + WS_XB, MOD + (size_t)2 * 6144 + 2 * D, 6144, T}; pg8::gemm_phase<pg8::EpiRes<true, true>, pg8::StaticOrder, true, true, true>(lds + RING_OFF, g, S, E, tid); } } } while (0)
#define PH_UP(layer) do { FRESH_IDS(); \
            pg8::Gemm g{Hb, (const bf16*)(ws + (layer == 0 ? WS_WUP0 : WS_WUP1)), M, FF2, D / 2, D / 2, D / 2, 0x7f7f7f7f, 0x7a7a7a7a}; pg8::StaticOrder S; S.init(M, FF2, G, (G % 16 == 0) ? (bx % 8) + 8 * ((((bx / 8) & 1) * (G / 16)) + ((bx / 8) >> 1)) : bx, ORD_UP);   \
            pg8::EpiConvGate E{(bf16*)(ws + WS_U), P.ffn_conv_w + (size_t)layer * 3 * FF, P.ffn_conv_b + (size_t)layer * FF, (float*)(ws + WS_SA0), (float*)(ws + WS_SG0), (float*)(ws + WS_SA1), (LAS float*)(lds + HALO_OFF), lds + RING_OFF + 3 * 16384  }; \
            pg8::gemm_phase<pg8::EpiConvGate, pg8::StaticOrder, true, true, true>(lds + RING_OFF, g, S, E, tid); } while (0)
#define PH_DOWN(layer) do { FRESH_IDS(); \
            pg8::Gemm g{(const bf16*)(ws + WS_U), (const bf16*)(ws + (layer == 0 ? WS_WDN0 : WS_WDN1)), M, D, FF / 2, FF / 2, FF / 2, 0x7f7f7f7f, 0x79797979}; pg8::StaticOrder S; S.init(M, D, G, bx); \
            { pg8::Unit u0; for (int i_ = 0; S.next(i_, u0); ++i_) conv_fixup((bf16*)(ws + WS_U), (const float*)(ws + WS_SA0), (const float*)(ws + WS_SG0), (const float*)(ws + WS_SA1), P.ffn_conv_w + (size_t)layer * 3 * FF, P.ffn_conv_b + (size_t)layer * FF, u0.pm, tid); } \
            if (layer == 0) { if (S.nwg <= G) { pg8::EpiResNormStaged<true, 2> E{ws + WS_XB, ws + WS_XB, MOD + 5 * D, 6144, T, P.g_mix + D, MOD + (size_t)2 * 6144, 0, 1, Hb, ws + WS_H8, (float*)(ws + WS_XS) + (size_t)M * 4, (unsigned*)(ctl + CW_NS + 1024), lds + HALO_OFF}; \
                    pg8::gemm_phase<pg8::EpiResNormStaged<true, 2>, pg8::StaticOrder, true, true, true>(lds + RING_OFF, g, S, E, tid); } \
                else { pg8::EpiRes<true, true> E{ws + WS_XB, ws + WS_XB, MOD + 5 * D, 6144, T}; pg8::gemm_phase<pg8::EpiRes<true, true>, pg8::StaticOrder, true, true, true>(lds + RING_OFF, g, S, E, tid); } } \
            else { if (S.nwg <= G) { pg8::EpiResStaged<true, false> E{ws + WS_XB, P.out, MOD + (size_t)2 * 6144 + 5 * D, 6144, T}; pg8::gemm_phase<pg8::EpiResStaged<true, false>, pg8::StaticOrder, true, true, true>(lds + RING_OFF, g, S, E, tid); } \
                else { pg8::EpiRes<true, false> E{ws + WS_XB, P.out, MOD + (size_t)2 * 6144 + 5 * D, 6144, T}; pg8::gemm_phase<pg8::EpiRes<true, false>, pg8::StaticOrder, true, true, true>(lds + RING_OFF, g, S, E, tid); } } } while (0)
#define PH_DSAIN() do { FRESH_IDS(); \
              \
            if (G % 16 != 0) dsa::tail_phase(Hb, (const bf16*)(ws + WS_WDTAIL), P.dsa_g_kidx, (bf16*)(ws + WS_KI), (float*)(ws + WS_WI), lane, vcu * NWAVES + wave, G * NWAVES); \
            else if (bx < G / 2) dsa::tail_phase(Hb, (const bf16*)(ws + WS_WDTAIL), P.dsa_g_kidx, (bf16*)(ws + WS_KI), (float*)(ws + WS_WI), lane, bx * NWAVES + wave, (G / 2) * NWAVES); \
              \
            { pg8::Gemm g{(const bf16*)(ws + WS_H8), (const bf16*)(ws + WS_WDIN), M, 3 * D / 2, D / 2, D / 2, D / 2, 0x7f7f7f7f, 0x7a7a7a7a}; pg8::StaticOrder S; S.init(M, 3 * D / 2, G, bx, ORD_DIN); \
              pg8::EpiHeads E{}; E.ntens = 3; \
              E.base[0] = (bf16*)(ws + WS_Q1); E.tile0[0] = 0; E.ldc[0] = D; E.kind[0] = 1; E.gain[0] = P.dsa_g_q; E.scale[0] = attn_body::C2; \
              E.base[1] = (bf16*)(ws + WS_K1); E.tile0[1] = 4; E.ldc[1] = 256; E.kind[1] = 1; E.gain[1] = P.dsa_g_k; E.scale[1] = 1.f; E.f8[1] = 1; \
              E.base[2] = (bf16*)(ws + WS_V1); E.tile0[2] = 5; E.ldc[2] = 256; E.kind[2] = 0; E.gain[2] = P.dsa_g_k; E.scale[2] = 1.f; E.f8[2] = 1; \
              E.base[3] = E.base[2]; E.tile0[3] = 1 << 30; E.ldc[3] = 256; E.kind[3] = 0; E.gain[3] = P.dsa_g_k; E.scale[3] = 1.f; \
              pg8::gemm_phase<pg8::EpiHeads, pg8::StaticOrder, true, true, true>(lds + RING_OFF, g, S, E, tid); } \
            { FRESH_IDS(); pg8::Gemm g{Hb, (const bf16*)(ws + WS_WDIN + 2 * MiB), M, D / 2, D, D, D, 0, 0}; pg8::StaticOrder S; S.init(M, D / 2, G, (G % 16 == 0) ? (bx + G / 2) % G : bx, ORD_QI); \
              pg8::EpiHeads E{}; E.ntens = 1; \
              E.base[0] = (bf16*)(ws + WS_QI); E.tile0[0] = 0; E.ldc[0] = 512; E.kind[0] = 0; E.gain[0] = P.dsa_g_k; E.scale[0] = 1.f; \
              for (int i_ = 1; i_ < 4; ++i_) { E.base[i_] = E.base[0]; E.tile0[i_] = 1 << 30; E.ldc[i_] = 512; E.kind[i_] = 0; E.gain[i_] = P.dsa_g_k; E.scale[i_] = 1.f; } \
              pg8::gemm_phase<pg8::EpiHeads, pg8::StaticOrder, true, true>(lds + RING_OFF, g, S, E, tid); } } while (0)
#define PH_DSAUNITS(qword) do { FRESH_IDS(); \
            int qb_ = (bx & 1), tries_ = 0;      \
            for (;;) { \
                if (tid == 0) MISC[16] = __hip_atomic_fetch_add(ctl + (qword) + 64 * qb_, 1u, RLX_AGENT); \
                __syncthreads(); \
                const int id = (int)MISC[16]; \
                __syncthreads(); \
                if (id >= T / dsa::QT) { if (++tries_ >= 2) break; qb_ ^= 1; continue; } \
                const int b = qb_, t0q = (T / dsa::QT - 1 - id) * dsa::QT; \
                dsa::unit(lds, b, t0q, (const bf16*)(ws + WS_Q1), (bf16*)(ws + WS_O1), (const unsigned char*)(ws + WS_K1), (const unsigned char*)(ws + WS_V1), (const bf16*)(ws + WS_QI), (const bf16*)(ws + WS_KI), (const float*)(ws + WS_WI), tid, wave); \
            } } while (0)

    const bool fusedn = (M / 256) * (D / 256) <= G;
    PH_PROLOGUE(); GRID_BAR();                       DUP(0, PH_PROLOGUE());
    PH_NORM1_L0(); GRID_BAR();                       DUP(1, PH_NORM1_L0());
    PH_QKV(); GRID_BAR();                            DUP(2, PH_QKV());
    PH_FOXATTN(CW_AQ); GRID_BAR();                   DUP(3, PH_FOXATTN(CW_AQ + 64));
    PH_OUTPROJ(0, WS_O, WS_WFOUT); GRID_BAR();       DUP(10, PH_OUTPROJ(0, WS_O, WS_WFOUT));
    if (!fusedn) { PH_NORM2(0); GRID_BAR(); }
    PH_UP(0); GRID_BAR();                            DUP(5, PH_UP(0));
    PH_DOWN(0); GRID_BAR();
    if (!fusedn) { PH_NORM1_L1(); GRID_BAR(); }
    PH_DSAIN(); GRID_BAR();                          DUP(6, PH_DSAIN());
    PH_DSAUNITS(CW_DQ); GRID_BAR();                  DUP(7, PH_DSAUNITS(CW_DQ + 128));
    PH_OUTPROJ(1, WS_O1, WS_WDOUT); GRID_BAR();
    if (!fusedn) { PH_NORM2(1); GRID_BAR(); }
    PH_UP(1); GRID_BAR();
    PH_DOWN(1);
    if (MK_DUP & 512) { GRID_BAR(); PH_DOWN(1); }
}

extern "C" void kernel_launch(void* const* d_in, const int* in_sizes, int n_in, void* d_out, int out_size, void* d_ws, size_t ws_size, hipStream_t stream) {
    static int grid = 0;
    if (grid == 0) {
        if (n_in != 20 || in_sizes[0] != M * D || out_size != M * D || ws_size < WS_END) { fprintf(stderr, "kernel_launch: unexpected problem (n_in %d, in0 %d, out %d, ws %zu); nothing launched\n", n_in, n_in > 0 ? in_sizes[0] : -1, out_size, ws_size); grid = -1; return; }
        int dev = 0, cus = 0, per_cu = 0;
        if (hipGetDevice(&dev) != hipSuccess || hipDeviceGetAttribute(&cus, hipDeviceAttributeMultiprocessorCount, dev) != hipSuccess) { grid = -1; return; }
        if (hipFuncSetAttribute((const void*)hybrid_fwd, hipFuncAttributeMaxDynamicSharedMemorySize, LDS_BYTES) != hipSuccess) { fprintf(stderr, "kernel_launch: hipFuncSetAttribute failed\n"); grid = -1; return; }
        if (hipOccupancyMaxActiveBlocksPerMultiprocessor(&per_cu, (const void*)hybrid_fwd, NTHREADS, LDS_BYTES) != hipSuccess || per_cu < 1)
            fprintf(stderr, "kernel_launch: note: occupancy query reports %d workgroups per CU\n", per_cu);
        (void)hipGetLastError();
        grid = cus;
    }
    if (grid < 0) return;
    if (hipMemsetAsync((char*)d_ws + WS_CTL, 0, CTL_ZERO_BYTES, stream) != hipSuccess) return;
    Ptrs p{};
    p.x = (const float*)d_in[0]; p.c = (const float*)d_in[1]; p.w_ada = (const float*)d_in[2]; p.b_ada = (const float*)d_in[3]; p.g_mix = (const float*)d_in[4]; p.g_ffn = (const float*)d_in[5];
    p.fox_w_in = (const float*)d_in[6]; p.fox_b_f = (const float*)d_in[7]; p.fox_g_q = (const float*)d_in[8]; p.fox_g_k = (const float*)d_in[9]; p.fox_w_out = (const float*)d_in[10];
    p.dsa_w_in = (const float*)d_in[11]; p.dsa_g_q = (const float*)d_in[12]; p.dsa_g_k = (const float*)d_in[13]; p.dsa_g_kidx = (const float*)d_in[14]; p.dsa_w_out = (const float*)d_in[15];
    p.ffn_w_up = (const float*)d_in[16]; p.ffn_conv_w = (const float*)d_in[17]; p.ffn_conv_b = (const float*)d_in[18]; p.ffn_w_down = (const float*)d_in[19];
    p.out = (float*)d_out; p.ws = (unsigned char*)d_ws;
    hipLaunchKernelGGL(hybrid_fwd, dim3(grid), dim3(NTHREADS), LDS_BYTES, stream, p);
}
```

```cpp
#include <hip/hip_runtime.h>
#include <cstdio>
#include <cstdint>
__device__ __forceinline__ float xsum16(float v) { const unsigned a = __builtin_bit_cast(unsigned, v); const auto r = __builtin_amdgcn_permlane16_swap(a, a, false, false); const unsigned r0 = r[0], r1 = r[1]; return __builtin_bit_cast(float, r0) + __builtin_bit_cast(float, r1); }
__device__ __forceinline__ float xsum32(float v) { const unsigned a = __builtin_bit_cast(unsigned, v); const auto r = __builtin_amdgcn_permlane32_swap(a, a, false, false); const unsigned r0 = r[0], r1 = r[1]; return __builtin_bit_cast(float, r0) + __builtin_bit_cast(float, r1); }
__device__ __forceinline__ float xmax16(float v) { const unsigned a = __builtin_bit_cast(unsigned, v); const auto r = __builtin_amdgcn_permlane16_swap(a, a, false, false); const unsigned r0 = r[0], r1 = r[1]; return fmaxf(__builtin_bit_cast(float, r0), __builtin_bit_cast(float, r1)); }
__device__ __forceinline__ float xmax32(float v) { const unsigned a = __builtin_bit_cast(unsigned, v); const auto r = __builtin_amdgcn_permlane32_swap(a, a, false, false); const unsigned r0 = r[0], r1 = r[1]; return fmaxf(__builtin_bit_cast(float, r0), __builtin_bit_cast(float, r1)); }
template <int CTRL> __device__ __forceinline__ float dppf(float v) { return __builtin_bit_cast(float, __builtin_amdgcn_update_dpp(0, __builtin_bit_cast(int, v), CTRL, 0xf, 0xf, true)); }
namespace pg8 {
#define PG8_LAS __attribute__((address_space(3)))
typedef unsigned short bf16_t;
typedef short bf16x8 __attribute__((ext_vector_type(8)));
typedef float f32x4 __attribute__((ext_vector_type(4)));
typedef unsigned u32x4 __attribute__((ext_vector_type(4)));
typedef int pg8_v8i __attribute__((ext_vector_type(8)));
typedef short pg8_bf16x16 __attribute__((ext_vector_type(16)));
constexpr int BM = 256, BK = 64, HALF = 128, HTB = HALF * BK * 2  , STAGE_BYTES = 8 * HTB, NXCD = 8, WGM = 4;

__host__ __device__ __forceinline__ int lds_byte(int r, int c) { const int st = (r >> 4) * 2 + (c >> 5), rr = r & 15, cc = c & 31, ob = rr * 64 + cc * 2; return st * 1024 + (ob ^ (((ob >> 9) & 1) << 5)); }
__host__ __device__ __forceinline__ void stage_rc(int b, int& R, int& C) { const int st = b / 1024, sb = b % 1024, swz = sb ^ (((sb >> 9) & 1) << 5); R = (st >> 1) * 16 + swz / 64; C = (st & 1) * 32 + (swz % 64) / 2; }
__host__ __device__ __forceinline__ int perm32(int rho) { const int n = rho >> 4, i = rho & 15; return 8 * (i >> 2) + 4 * n + (i & 3); }

struct Unit { int pm, pn; };
struct Gemm { const bf16_t* A; const bf16_t* Bt; int M, N, K, lda, ldb; int sa, sb; };

struct StaticOrder {
    int nM, nN, nwg, G, c, wgm, rot;
    __host__ __device__ void init(int M, int N, int G_, int c_, int wgm_ = WGM, int rot_ = 3) { nM = M / BM; nN = N / BM; nwg = nM * nN; G = G_; c = c_; wgm = wgm_; rot = rot_; }
    __host__ __device__ __forceinline__ bool next(int i, Unit& u) const {
        const long L = (long)i * G + c; if (L >= nwg) return false;
        int wgid = (int)L; { const int q = nwg / NXCD, r = nwg % NXCD, xcd = wgid % NXCD, off = wgid / NXCD; wgid = (xcd < r ? xcd * (q + 1) : r * (q + 1) + (xcd - r) * q) + off; }
        const int nig = wgm * nN, gid = wgid / nig, fm = gid * wgm, gsz = (nM - fm) < wgm ? (nM - fm) : wgm;
        u.pm = fm + ((wgid % nig) % gsz); u.pn = ((wgid % nig) / gsz + rot * (int)(L % NXCD)) % nN; return true;
    }
    __device__ __forceinline__ void a_ready(const Unit&) const {}
    __device__ __forceinline__ void done(const Unit&) const {}
};

__device__ __forceinline__ unsigned cvt_pk_bf16(float lo, float hi) { unsigned r; asm volatile("v_cvt_pk_bf16_f32 %0, %1, %2" : "=v"(r) : "v"(lo), "v"(hi)); return r; }
typedef float f32x2 __attribute__((ext_vector_type(2)));
struct EpiBf16 {
    static constexpr bool PERM = true, AFTER_DRAIN = false;
    bf16_t* O; int ldc;
    __device__ __forceinline__ void operator()(const f32x4 (&acc)[2][2][4][2], const Unit& u, int wr, int wc, int fr, int fq) const {
        const int row0 = u.pm * BM + wr * 64 + fr; const int col0 = u.pn * BM + wc * 32 + 8 * fq;
#pragma unroll
        for (int ai = 0; ai < 2; ++ai)
#pragma unroll
            for (int m = 0; m < 4; ++m) { bf16_t* rowp = O + (size_t)(row0 + ai * HALF + m * 16) * ldc + col0;
#pragma unroll
                for (int bj = 0; bj < 2; ++bj) { const f32x4 v0 = acc[ai][bj][m][0], v1 = acc[ai][bj][m][1];
                    u32x4 w; w.x = cvt_pk_bf16(v0[0], v0[1]); w.y = cvt_pk_bf16(v0[2], v0[3]); w.z = cvt_pk_bf16(v1[0], v1[1]); w.w = cvt_pk_bf16(v1[2], v1[3]);
                    *(u32x4*)(rowp + bj * HALF) = w; } }
    }
};
struct EpiHeads {
    static constexpr bool PERM = true, AFTER_DRAIN = false;
    bf16_t* base[4]; int tile0[4]; int ldc[4]; int kind[4]; const float* gain[4]; float scale[4]; int f8[4];
    int ntens;
    __device__ __forceinline__ void operator()(const f32x4 (&acc)[2][2][4][2], const Unit& u, int wr, int wc, int fr, int fq) const {
        bf16_t* O = base[0]; int t0 = tile0[0], ld = ldc[0], kd = kind[0], o8 = f8[0]; const float* gn = gain[0]; float sc = scale[0];
#pragma unroll
        for (int i = 1; i < 4; ++i) if (i < ntens && u.pn >= tile0[i]) { O = base[i]; t0 = tile0[i]; ld = ldc[i]; kd = kind[i]; gn = gain[i]; sc = scale[i]; o8 = f8[i]; }
        const int head = (u.pn - t0) * 4 + wc; const int row0 = u.pm * BM + wr * 64 + fr;
        f32x4 gv[2][2];
#pragma unroll
        for (int bj = 0; bj < 2; ++bj)
#pragma unroll
            for (int n = 0; n < 2; ++n) gv[bj][n] = (kd == 1) ? *(const f32x4*)(gn + 32 * bj + 8 * fq + 4 * n) * sc : (f32x4){sc, sc, sc, sc};
#pragma unroll
        for (int ai = 0; ai < 2; ++ai)
#pragma unroll
            for (int m = 0; m < 4; ++m) {
                float rs = 1.f;
                if (kd == 1) { float ss = 0.f;
#pragma unroll
                    for (int bj = 0; bj < 2; ++bj)
#pragma unroll
                        for (int n = 0; n < 2; ++n) { const f32x4 x = acc[ai][bj][m][n]; ss += (x[0] * x[0] + x[1] * x[1]) + (x[2] * x[2] + x[3] * x[3]); }
                    ss = xsum32(xsum16(ss));
                    rs = __builtin_amdgcn_rsqf(ss * (1.0f / 64.0f) + 1e-6f); }
                if (o8) {
                    unsigned char* rowb = (unsigned char*)O + (size_t)(row0 + ai * HALF + m * 16) * ld + head * 64 + 8 * fq;
#pragma unroll
                    for (int bj = 0; bj < 2; ++bj) { const f32x4 v0 = acc[ai][bj][m][0] * rs * gv[bj][0], v1 = acc[ai][bj][m][1] * rs * gv[bj][1];
                        int w0 = 0, w1 = 0; w0 = __builtin_amdgcn_cvt_pk_fp8_f32(v0[0], v0[1], w0, false); w0 = __builtin_amdgcn_cvt_pk_fp8_f32(v0[2], v0[3], w0, true);
                        w1 = __builtin_amdgcn_cvt_pk_fp8_f32(v1[0], v1[1], w1, false); w1 = __builtin_amdgcn_cvt_pk_fp8_f32(v1[2], v1[3], w1, true);
                        typedef unsigned u32x2 __attribute__((ext_vector_type(2))); *(u32x2*)(rowb + bj * 32) = (u32x2){(unsigned)w0, (unsigned)w1}; }
                } else {
                bf16_t* rowp = O + (size_t)(row0 + ai * HALF + m * 16) * ld + head * 64 + 8 * fq;
#pragma unroll
                for (int bj = 0; bj < 2; ++bj) { const f32x4 v0 = acc[ai][bj][m][0] * rs * gv[bj][0], v1 = acc[ai][bj][m][1] * rs * gv[bj][1];
                    u32x4 w; w.x = cvt_pk_bf16(v0[0], v0[1]); w.y = cvt_pk_bf16(v0[2], v0[3]); w.z = cvt_pk_bf16(v1[0], v1[1]); w.w = cvt_pk_bf16(v1[2], v1[3]);
                    *(u32x4*)(rowp + bj * 32) = w; } } }
    }
};
template <bool BIN16, bool BOUT16>
struct EpiRes {
    static constexpr bool PERM = false, AFTER_DRAIN = false;
    const void* base; void* out; const float* gate; int gate_bstride; int rows_per_batch;
    __device__ __forceinline__ void operator()(const f32x4 (&acc)[2][2][4][2], const Unit& u, int wr, int wc, int fr, int fq) const {
        typedef unsigned u32x2 __attribute__((ext_vector_type(2)));
        const int col0 = u.pn * BM + wc * 32 + 4 * fq; const int b = (u.pm * BM) / rows_per_batch;
        f32x4 gv[2][2];
#pragma unroll
        for (int bj = 0; bj < 2; ++bj)
#pragma unroll
            for (int n = 0; n < 2; ++n) gv[bj][n] = *(const f32x4*)(gate + (size_t)b * gate_bstride + col0 + bj * HALF + n * 16);
#pragma unroll
        for (int ai = 0; ai < 2; ++ai)
#pragma unroll
            for (int m = 0; m < 4; ++m) { const size_t off = (size_t)(u.pm * BM + ai * HALF + wr * 64 + m * 16 + fr) * 1024 + col0;
#pragma unroll
                for (int bj = 0; bj < 2; ++bj)
#pragma unroll
                    for (int n = 0; n < 2; ++n) { const size_t o2 = off + bj * HALF + n * 16; f32x4 bs;
                        if (BIN16) { const u32x2 r = *(const u32x2*)((const bf16_t*)base + o2); bs = (f32x4){__uint_as_float(r.x << 16), __uint_as_float(r.x & 0xffff0000u), __uint_as_float(r.y << 16), __uint_as_float(r.y & 0xffff0000u)}; }
                        else bs = *(const f32x4*)((const float*)base + o2);
                        const f32x4 v = bs + gv[bj][n] * acc[ai][bj][m][n];
                        if (BOUT16) *(u32x2*)((bf16_t*)out + o2) = (u32x2){cvt_pk_bf16(v[0], v[1]), cvt_pk_bf16(v[2], v[3])};
                        else *(f32x4*)((float*)out + o2) = v; }
                if (m & 1) asm volatile("" ::: "memory"); }
    }
};
template <bool BIN16, bool BOUT16>
struct EpiResStaged {
    static constexpr bool PERM = false, AFTER_DRAIN = true;
    const void* base; void* out; const float* gate; int gate_bstride; int rows_per_batch;
    __device__ __forceinline__ void operator()(const f32x4 (&)[2][2][4][2], const Unit&, int, int, int, int) const {}
    __device__ __forceinline__ void fused(const f32x4 (&acc)[2][2][4][2], const Unit& u, int wr, int wc, int fr_in, int fq_in, PG8_LAS unsigned char* img, int wid, int lane_in) const {
        int fr = fr_in, fq = fq_in, lane = lane_in; asm volatile("" : "+v"(fr), "+v"(fq), "+v"(lane));
        const int col0 = u.pn * BM + wc * 32 + 4 * fq; const int b = (u.pm * BM) / rows_per_batch;
        f32x4 gv[2][2];
#pragma unroll
        for (int bj = 0; bj < 2; ++bj)
#pragma unroll
            for (int n = 0; n < 2; ++n) gv[bj][n] = *(const f32x4*)(gate + (size_t)b * gate_bstride + col0 + bj * HALF + n * 16);
#pragma unroll
        for (int ai = 0; ai < 2; ++ai) {
            u32x4 bs16[8]; f32x4 bs32[BIN16 ? 1 : 8][2];
#pragma unroll
            for (int rnd = 0; rnd < 8; ++rnd) { const int q = rnd * 512 + wid * 64 + lane, row = q >> 5, c8 = q & 31; const size_t o = (size_t)(u.pm * BM + ai * HALF + row) * 1024 + u.pn * BM + 8 * c8;
                if constexpr (BIN16) bs16[rnd] = *(const u32x4*)((const bf16_t*)base + o);
                else { bs32[rnd][0] = *(const f32x4*)((const float*)base + o); bs32[rnd][1] = *(const f32x4*)((const float*)base + o + 4); } }
#pragma unroll
            for (int bj = 0; bj < 2; ++bj)
#pragma unroll
                for (int m = 0; m < 4; ++m)
#pragma unroll
                    for (int n = 0; n < 2; ++n) { const int hrow = wr * 64 + m * 16 + fr, chunk = (bj * HALF + wc * 32 + n * 16 + 4 * fq) >> 2;
                        *(PG8_LAS f32x4*)(img + hrow * 1024 + ((chunk ^ ((hrow & 15) << 2)) << 4)) = gv[bj][n] * acc[ai][bj][m][n]; }
            asm volatile("s_waitcnt lgkmcnt(0)" ::: "memory"); __builtin_amdgcn_s_barrier(); asm volatile("" ::: "memory");
#pragma unroll
            for (int rnd = 0; rnd < 8; ++rnd) { const int q = rnd * 512 + wid * 64 + lane, row = q >> 5, c8 = q & 31; const size_t o = (size_t)(u.pm * BM + ai * HALF + row) * 1024 + u.pn * BM + 8 * c8;
                const PG8_LAS unsigned char* ip = img + row * 1024 + (((2 * c8) ^ ((row & 15) << 2)) << 4);
                const f32x4 g0 = *(const PG8_LAS f32x4*)ip, g1 = *(const PG8_LAS f32x4*)(ip + 16);
                f32x4 b0, b1;
                if constexpr (BIN16) { const u32x4 r = bs16[rnd];
                    b0 = (f32x4){__uint_as_float(r.x << 16), __uint_as_float(r.x & 0xffff0000u), __uint_as_float(r.y << 16), __uint_as_float(r.y & 0xffff0000u)};
                    b1 = (f32x4){__uint_as_float(r.z << 16), __uint_as_float(r.z & 0xffff0000u), __uint_as_float(r.w << 16), __uint_as_float(r.w & 0xffff0000u)}; }
                else { b0 = bs32[rnd][0]; b1 = bs32[rnd][1]; }
                const f32x4 v0 = b0 + g0, v1 = b1 + g1;
                if constexpr (BOUT16) *(u32x4*)((bf16_t*)out + o) = (u32x4){cvt_pk_bf16(v0[0], v0[1]), cvt_pk_bf16(v0[2], v0[3]), cvt_pk_bf16(v1[0], v1[1]), cvt_pk_bf16(v1[2], v1[3])};
                else { *(f32x4*)((float*)out + o) = v0; *(f32x4*)((float*)out + o + 4) = v1; } }
            if (ai == 0) { asm volatile("s_waitcnt lgkmcnt(0)" ::: "memory"); __builtin_amdgcn_s_barrier(); asm volatile("" ::: "memory"); }
        }
    }
};
template <bool BIN16, int HMODE>
struct EpiResNormStaged {
    static constexpr bool PERM = false, AFTER_DRAIN = true;
    const void* base; void* out; const float* gate; int gate_bstride; int rows_per_batch;
    const float* gnorm; const float* modL; int sh_chunk, sc_chunk; bf16_t* hout; unsigned char* hout8; float* xslots; unsigned* cnt; PG8_LAS unsigned char* tbl;
    __device__ __forceinline__ void operator()(const f32x4 (&)[2][2][4][2], const Unit&, int, int, int, int) const {}
    __device__ __forceinline__ void fused(const f32x4 (&acc)[2][2][4][2], const Unit& u, int wr, int wc, int fr_in, int fq_in, PG8_LAS unsigned char* img, int wid, int lane_in) const {
        int fr = fr_in, fq = fq_in, lane = lane_in; asm volatile("" : "+v"(fr), "+v"(fq), "+v"(lane));
        const int col0 = u.pn * BM + wc * 32 + 4 * fq; const int b = (u.pm * BM) / rows_per_batch;
        PG8_LAS float* Pt = (PG8_LAS float*)tbl; PG8_LAS float* St = (PG8_LAS float*)(tbl + 1024); PG8_LAS unsigned* flag = (PG8_LAS unsigned*)(tbl + 2048);
        f32x4 gv[2][2];
#pragma unroll
        for (int bj = 0; bj < 2; ++bj)
#pragma unroll
            for (int n = 0; n < 2; ++n) gv[bj][n] = *(const f32x4*)(gate + (size_t)b * gate_bstride + col0 + bj * HALF + n * 16);
        constexpr bool KEEP = BIN16;
        u32x4 wk[KEEP ? 8 : 1];
#pragma unroll
        for (int ai = 0; ai < 2; ++ai) {
            u32x4 bs16[8]; f32x4 bs32[BIN16 ? 1 : 8][2];
#pragma unroll
            for (int rnd = 0; rnd < 8; ++rnd) { const int q = rnd * 512 + wid * 64 + lane, row = q >> 5, c8 = q & 31; const size_t o = (size_t)(u.pm * BM + ai * HALF + row) * 1024 + u.pn * BM + 8 * c8;
                if constexpr (BIN16) bs16[rnd] = *(const u32x4*)((const bf16_t*)base + o);
                else { bs32[rnd][0] = *(const f32x4*)((const float*)base + o); bs32[rnd][1] = *(const f32x4*)((const float*)base + o + 4); } }
#pragma unroll
            for (int bj = 0; bj < 2; ++bj)
#pragma unroll
                for (int m = 0; m < 4; ++m)
#pragma unroll
                    for (int n = 0; n < 2; ++n) { const int hrow = wr * 64 + m * 16 + fr, chunk = (bj * HALF + wc * 32 + n * 16 + 4 * fq) >> 2;
                        *(PG8_LAS f32x4*)(img + hrow * 1024 + ((chunk ^ ((hrow & 15) << 2)) << 4)) = gv[bj][n] * acc[ai][bj][m][n]; }
            asm volatile("s_waitcnt lgkmcnt(0)" ::: "memory"); __builtin_amdgcn_s_barrier(); asm volatile("" ::: "memory");
#pragma unroll
            for (int rnd = 0; rnd < 8; ++rnd) { const int q = rnd * 512 + wid * 64 + lane, row = q >> 5, c8 = q & 31; const size_t o = (size_t)(u.pm * BM + ai * HALF + row) * 1024 + u.pn * BM + 8 * c8;
                const PG8_LAS unsigned char* ip = img + row * 1024 + (((2 * c8) ^ ((row & 15) << 2)) << 4);
                const f32x4 g0 = *(const PG8_LAS f32x4*)ip, g1 = *(const PG8_LAS f32x4*)(ip + 16);
                f32x4 b0, b1;
                if constexpr (BIN16) { const u32x4 r = bs16[rnd];
                    b0 = (f32x4){__uint_as_float(r.x << 16), __uint_as_float(r.x & 0xffff0000u), __uint_as_float(r.y << 16), __uint_as_float(r.y & 0xffff0000u)};
                    b1 = (f32x4){__uint_as_float(r.z << 16), __uint_as_float(r.z & 0xffff0000u), __uint_as_float(r.w << 16), __uint_as_float(r.w & 0xffff0000u)}; }
                else { b0 = bs32[rnd][0]; b1 = bs32[rnd][1]; }
                const f32x4 v0 = b0 + g0, v1 = b1 + g1;
                const u32x4 w = (u32x4){cvt_pk_bf16(v0[0], v0[1]), cvt_pk_bf16(v0[2], v0[3]), cvt_pk_bf16(v1[0], v1[1]), cvt_pk_bf16(v1[2], v1[3])};
                *(u32x4*)((bf16_t*)out + o) = w; if constexpr (KEEP) { if (ai == 1) wk[rnd] = w; }
                float ss = 0.f;
#pragma unroll
                for (int k = 0; k < 4; ++k) { const float lo = __uint_as_float(w[k] << 16), hi = __uint_as_float(w[k] & 0xffff0000u); ss += lo * lo + hi * hi; }
                ss += dppf<0xB1>(ss); ss += dppf<0x4E>(ss); ss += dppf<0x141>(ss); ss += dppf<0x140>(ss); ss = xsum16(ss);
                if (c8 == 0) Pt[ai * HALF + row] = ss; }
            asm volatile("s_waitcnt lgkmcnt(0)" ::: "memory"); __builtin_amdgcn_s_barrier(); asm volatile("" ::: "memory");
        }
        const int c8n = lane & 31; const int gcol = u.pn * BM + 8 * c8n;
        f32x4 G0, G1, S0, S1;
        { const f32x4 g0 = *(const f32x4*)(gnorm + gcol), g1 = *(const f32x4*)(gnorm + gcol + 4);
          const f32x4 c0 = *(const f32x4*)(modL + (size_t)b * 6144 + sc_chunk * 1024 + gcol), c1 = *(const f32x4*)(modL + (size_t)b * 6144 + sc_chunk * 1024 + gcol + 4);
          G0 = g0 * (c0 + 1.0f); G1 = g1 * (c1 + 1.0f); S0 = *(const f32x4*)(modL + (size_t)b * 6144 + sh_chunk * 1024 + gcol); S1 = *(const f32x4*)(modL + (size_t)b * 6144 + sh_chunk * 1024 + gcol + 4); }
        const int trow = wid * 32 + (lane & 31);
        if (lane < 32) __hip_atomic_store(xslots + ((size_t)(u.pm * BM + trow) * 4 + u.pn), Pt[trow], __ATOMIC_RELAXED, __HIP_MEMORY_SCOPE_AGENT);
        asm volatile("s_waitcnt vmcnt(0)" ::: "memory");
        if (lane == 0) __hip_atomic_fetch_add(cnt + 16 * u.pm, 1u, __ATOMIC_RELAXED, __HIP_MEMORY_SCOPE_AGENT);
        if (wid == 0) {
            unsigned sp = 0u;
            while ((unsigned)__builtin_amdgcn_readfirstlane(__hip_atomic_load(cnt + 16 * u.pm, __ATOMIC_RELAXED, __HIP_MEMORY_SCOPE_AGENT)) < 32u) { __builtin_amdgcn_s_sleep(1); if (++sp > (1u << 22)) break; }
            __builtin_amdgcn_fence(__ATOMIC_ACQUIRE, "agent");
            if (lane == 0) flag[0] = sp;
        }
        asm volatile("s_waitcnt vmcnt(0) lgkmcnt(0)" ::: "memory"); __builtin_amdgcn_s_barrier(); asm volatile("" ::: "memory");
        if (lane < 32) { const float* sl = xslots + (size_t)(u.pm * BM + trow) * 4; float t = 0.f;
#pragma unroll
            for (int k = 0; k < 4; ++k) t += __hip_atomic_load(sl + k, __ATOMIC_RELAXED, __HIP_MEMORY_SCOPE_AGENT);
            St[trow] = __builtin_amdgcn_rsqf(t * (1.0f / 1024.0f) + 1e-6f); }
        asm volatile("s_waitcnt lgkmcnt(0)" ::: "memory"); __builtin_amdgcn_s_barrier(); asm volatile("" ::: "memory");
#pragma unroll
        for (int hf = 0; hf < 2; ++hf) {
            u32x4 xr[8];
            if (!KEEP || hf == 0) {
#pragma unroll
                for (int rnd = 0; rnd < 8; ++rnd) { const int q = rnd * 512 + wid * 64 + lane, row = q >> 5; xr[rnd] = *(const u32x4*)((const bf16_t*)out + (size_t)(u.pm * BM + hf * HALF + row) * 1024 + gcol); } }
#pragma unroll
            for (int rnd = 0; rnd < 8; ++rnd) { const int q = rnd * 512 + wid * 64 + lane, row = q >> 5; const size_t o = (size_t)(u.pm * BM + hf * HALF + row) * 1024 + gcol;
                const float rs = St[hf * HALF + row]; u32x4 r; if (KEEP && hf == 1) r = wk[KEEP ? rnd : 0]; else r = xr[rnd];
                const f32x4 x0 = (f32x4){__uint_as_float(r.x << 16), __uint_as_float(r.x & 0xffff0000u), __uint_as_float(r.y << 16), __uint_as_float(r.y & 0xffff0000u)};
                const f32x4 x1 = (f32x4){__uint_as_float(r.z << 16), __uint_as_float(r.z & 0xffff0000u), __uint_as_float(r.w << 16), __uint_as_float(r.w & 0xffff0000u)};
                const f32x4 h0 = x0 * rs * G0 + S0, h1 = x1 * rs * G1 + S1;
                int w0 = 0, w1 = 0; w0 = __builtin_amdgcn_cvt_pk_fp8_f32(h0[0], h0[1], w0, false); w0 = __builtin_amdgcn_cvt_pk_fp8_f32(h0[2], h0[3], w0, true);
                w1 = __builtin_amdgcn_cvt_pk_fp8_f32(h1[0], h1[1], w1, false); w1 = __builtin_amdgcn_cvt_pk_fp8_f32(h1[2], h1[3], w1, true);
                typedef unsigned u32x2 __attribute__((ext_vector_type(2)));
                *(u32x2*)(hout8 + o) = (u32x2){(unsigned)w0, (unsigned)w1};
                if constexpr (HMODE == 2) *(u32x4*)(hout + o) = (u32x4){cvt_pk_bf16(h0[0], h0[1]), cvt_pk_bf16(h0[2], h0[3]), cvt_pk_bf16(h1[0], h1[1]), cvt_pk_bf16(h1[2], h1[3])}; }
        }
    }
};
struct EpiConvGate {
    static constexpr bool PERM = true, AFTER_DRAIN = false;
    bf16_t* U; const float* cw; const float* cb; float* sideA0; float* sideG0; float* sideA1; PG8_LAS float* halo; PG8_LAS unsigned char* stage;
    __device__ __forceinline__ void operator()(const f32x4 (&acc)[2][2][4][2], const Unit& u, int wr, int wc, int fr_in, int fq_in) const {
        constexpr int FFc = 2816;
        int fr = fr_in, fq = fq_in; asm volatile("" : "+v"(fr), "+v"(fq));
        const int colt = u.pn * 128 + wc * 32 + 8 * fq;
        const int lcol = wc * 32 + 8 * fq;
        if (fr >= 14) {
#pragma unroll
            for (int ai = 0; ai < 2; ++ai)
#pragma unroll
                for (int n = 0; n < 2; ++n) *(PG8_LAS f32x4*)(halo + ((ai * 2 + wr) * 2 + (fr - 14)) * 128 + lcol + 4 * n) = acc[ai][0][3][n];
        }
        asm volatile("s_waitcnt lgkmcnt(0)" ::: "memory"); __builtin_amdgcn_s_barrier(); asm volatile("" ::: "memory");
        typedef float f32x2 __attribute__((ext_vector_type(2)));
#define CG_DPP(x, ctrl) __int_as_float(__builtin_amdgcn_update_dpp(0, __float_as_int(x), ctrl, 0xf, 0xf, true))
        const bool lane0 = (fr == 0), lane01 = (fr < 2);
        const int wid8 = wr * 4 + wc, lane64 = fq * 16 + fr;
#pragma unroll
        for (int ai = 0; ai < 2; ++ai) {
#pragma unroll
            for (int n = 0; n < 2; ++n) {
                const f32x4 w0 = *(const f32x4*)(cw + colt + 4 * n), w1 = *(const f32x4*)(cw + FFc + colt + 4 * n), w2 = *(const f32x4*)(cw + 2 * FFc + colt + 4 * n), bb = *(const f32x4*)(cb + colt + 4 * n);
                f32x4 w1b, w0b;
#pragma unroll
                for (int e4 = 0; e4 < 4; ++e4) { w1b[e4] = lane0 ? w1[e4] : 0.f; w0b[e4] = lane01 ? w0[e4] : 0.f; }
                const int pb = (wr == 1) ? (ai * 2) : ((ai == 1) ? 1 : 0); const int hr = (fr >= 14) ? (fr - 14) : 0;
                const f32x4 prv = *(const PG8_LAS f32x4*)(halo + (pb * 2 + hr) * 128 + lcol + 4 * n);
#pragma unroll
                for (int m = 0; m < 4; ++m) {
                    const f32x4 x = acc[ai][0][m][n], gt = acc[ai][1][m][n]; const f32x4 pv = (m == 0) ? prv : acc[ai][0][m - 1][n];
                    f32x4 sv;
#pragma unroll
                    for (int e4 = 0; e4 < 4; ++e4) {
                        float t = fmaf(w2[e4], x[e4], bb[e4]);
                        t = fmaf(CG_DPP(x[e4], 0x111), w1[e4], t);
                        t = fmaf(CG_DPP(pv[e4], 0x121), w1b[e4], t);
                        t = fmaf(CG_DPP(x[e4], 0x112), w0[e4], t);
                        t = fmaf(CG_DPP(pv[e4], 0x122), w0b[e4], t);
                        sv[e4] = t;
                    }
                    f32x4 uo;
#pragma unroll
                    for (int p = 0; p < 2; ++p) {
                        const f32x2 s2 = (f32x2){sv[2 * p], sv[2 * p + 1]}; const f32x2 g2 = (f32x2){gt[2 * p], gt[2 * p + 1]};
                        const f32x2 a2 = s2 * -1.4426950408889634f;
                        const f32x2 d2 = (f32x2){__builtin_amdgcn_exp2f(fminf(a2[0], 60.f)), __builtin_amdgcn_exp2f(fminf(a2[1], 60.f))} + 1.0f;
                        const float r = __builtin_amdgcn_rcpf(d2[0] * d2[1]);
                        const f32x2 inv = (f32x2){d2[1], d2[0]} * r;
                        const f32x2 u2 = (s2 * g2) * inv;
                        uo[2 * p] = u2[0]; uo[2 * p + 1] = u2[1];
                    }
                    const int hrow = wr * 64 + m * 16 + fr, trow = ai * HALF + hrow;
                    int w8 = 0; w8 = __builtin_amdgcn_cvt_pk_fp8_f32(uo[0], uo[1], w8, false); w8 = __builtin_amdgcn_cvt_pk_fp8_f32(uo[2], uo[3], w8, true);
                    { const int cb4 = lcol + 4 * n; *(PG8_LAS unsigned*)(stage + hrow * 128 + ((((cb4 >> 4) ^ ((hrow >> 1) & 7)) << 4) | (cb4 & 15))) = (unsigned)w8; }
                    if (ai == 0 && m == 0) {
                        if (trow < 2) { *(f32x4*)(sideA0 + ((size_t)u.pm * 2 + trow) * FFc + colt + 4 * n) = x; *(f32x4*)(sideG0 + ((size_t)u.pm * 2 + trow) * FFc + colt + 4 * n) = gt; } }
                    if (ai == 1 && m == 3) { if (trow >= 254) *(f32x4*)(sideA1 + ((size_t)u.pm * 2 + (trow - 254)) * FFc + colt + 4 * n) = x; }
                }
            }
            asm volatile("s_waitcnt lgkmcnt(0)" ::: "memory"); __builtin_amdgcn_s_barrier(); asm volatile("" ::: "memory");
#pragma unroll
            for (int rnd = 0; rnd < 2; ++rnd) { const int q = rnd * 512 + wid8 * 64 + lane64, hrow = q >> 3, c = q & 7;
                const u32x4 v = *(const PG8_LAS u32x4*)(stage + hrow * 128 + ((c ^ ((hrow >> 1) & 7)) << 4));
                if (ai == 1 || hrow >= 2) __builtin_nontemporal_store(v, (u32x4*)((unsigned char*)U + (size_t)(u.pm * BM + ai * HALF + hrow) * FFc + u.pn * 128 + c * 16)); }
            if (ai == 0) { asm volatile("s_waitcnt lgkmcnt(0)" ::: "memory"); __builtin_amdgcn_s_barrier(); asm volatile("" ::: "memory"); }
        }
#undef CG_DPP
        asm volatile("s_waitcnt lgkmcnt(0)" ::: "memory"); __builtin_amdgcn_s_barrier(); asm volatile("" ::: "memory");
    }
};
template <class Epi, class Sched, bool ALIGN_EPI = false, bool SP2 = false, bool F8 = false>
__device__ __forceinline__ void gemm_phase(PG8_LAS unsigned char* lds, const Gemm g, const Sched& S, const Epi& E, const int tid) {
    const int wid = __builtin_amdgcn_readfirstlane(tid >> 6), lane = tid & 63, wr = wid >> 2, wc = wid & 3, fr = lane & 15, fq = lane >> 4;
    const int K = g.K, nt = K / BK;
    unsigned voffA[2], voffB[2];
#pragma unroll
    for (int i = 0; i < 2; ++i) { int R, C; stage_rc(tid * 16 + i * 8192, R, C); const int Rb = Epi::PERM ? ((R & ~31) + perm32(R & 31)) : R;
        voffA[i] = (unsigned)(R * g.lda + C) * 2u; voffB[i] = (unsigned)(Rb * g.ldb + C) * 2u; }
    const size_t kstep = (size_t)(BK * 2);
    const size_t hstepA = (size_t)HALF * g.lda * 2, hstepB = (size_t)HALF * g.ldb * 2;
    const size_t tstepA = 2 * hstepA, tstepB = 2 * hstepB;
    const unsigned ldsw = (unsigned)wid * 1024u;
    const int aoff = lds_byte(wr * 64 + fr, fq * 8), boff = lds_byte(wc * 32 + fr, fq * 8);
#define PG8_SA(b, h) (((b) * 2 + (h)) * HTB)
#define PG8_SB(b, h) ((4 + (b) * 2 + (h)) * HTB)
    const __amdgpu_buffer_rsrc_t rsA = __builtin_amdgcn_make_buffer_rsrc((void*)g.A, 0, 0x7fffffff, 0x00020000), rsB = __builtin_amdgcn_make_buffer_rsrc((void*)g.Bt, 0, 0x7fffffff, 0x00020000);
#define PG8_STAGE(bufoff, gbase, voff) do { const int _so = (int)(unsigned)((const char*)(gbase) - (((bufoff) < 4 * HTB) ? (const char*)g.A : (const char*)g.Bt)); _Pragma("unroll") for (int _i = 0; _i < 2; ++_i) \
        __builtin_amdgcn_raw_ptr_buffer_load_lds(((bufoff) < 4 * HTB) ? rsA : rsB, (PG8_LAS unsigned*)(lds + (bufoff) + ldsw + _i * 8192), 16, (int)(voff)[_i], _so, 0, 0); } while (0)
#define PG8_LDA(dst, b, h) do { _Pragma("unroll") for (int m = 0; m < 4; ++m) { dst[m].lo = *(const PG8_LAS bf16x8*)(lds + PG8_SA(b, h) + aoff + m * 2048); dst[m].hi = *(const PG8_LAS bf16x8*)(lds + PG8_SA(b, h) + aoff + m * 2048 + 1024); } } while (0)
#define PG8_LDB(dst, b, h) do { _Pragma("unroll") for (int n = 0; n < 2; ++n) { dst[n].lo = *(const PG8_LAS bf16x8*)(lds + PG8_SB(b, h) + boff + n * 2048); dst[n].hi = *(const PG8_LAS bf16x8*)(lds + PG8_SB(b, h) + boff + n * 2048 + 1024); } } while (0)
#define PG8_MMA(ai, bj, At, Bt) do { __builtin_amdgcn_s_setprio(1); _Pragma("unroll") for (int m = 0; m < 4; ++m) _Pragma("unroll") for (int n = 0; n < 2; ++n) { \
        if constexpr (F8) asm volatile("v_mfma_scale_f32_16x16x128_f8f6f4 %0, %1, %2, %0, %3, %4 op_sel_hi:[0,0,0]" : "+v"(acc[ai][bj][m][n]) : "v"(__builtin_bit_cast(pg8_v8i, Bt[n])), "v"(__builtin_bit_cast(pg8_v8i, At[m])), "v"(f8sb), "v"(f8sa));   \
        else { acc[ai][bj][m][n] = __builtin_amdgcn_mfma_f32_16x16x32_bf16(Bt[n].lo, At[m].lo, acc[ai][bj][m][n], 0, 0, 0); acc[ai][bj][m][n] = __builtin_amdgcn_mfma_f32_16x16x32_bf16(Bt[n].hi, At[m].hi, acc[ai][bj][m][n], 0, 0, 0); } } \
        __builtin_amdgcn_s_setprio(0); } while (0)
#define PG8_WAIT_V(n) asm volatile("s_waitcnt vmcnt(" #n ")" ::: "memory")
#define PG8_WAIT_L(n) asm volatile("s_waitcnt lgkmcnt(" #n ")" ::: "memory")
#define PG8_BAR __builtin_amdgcn_s_barrier()
#define PG8_SCHED __builtin_amdgcn_sched_barrier(0)
    Unit cur, nxt; int ui = 0;
    if (!S.next(0, cur)) return;
    f32x4 acc[2][2][4][2];
#pragma unroll
    for (int a = 0; a < 2; ++a)
#pragma unroll
        for (int b = 0; b < 2; ++b)
#pragma unroll
            for (int m = 0; m < 4; ++m)
#pragma unroll
                for (int n = 0; n < 2; ++n) acc[a][b][m][n] = (f32x4){0.f, 0.f, 0.f, 0.f};
    const int f8sa = g.sa, f8sb = g.sb; (void)f8sa; (void)f8sb;
    pg8_bf16x16 At[4], B0[2], B1[2];
    const char* cA = (const char*)g.A + (size_t)cur.pm * tstepA; const char* cB = (const char*)g.Bt + (size_t)cur.pn * tstepB;
    S.a_ready(cur);
    if constexpr (SP2) {
        PG8_STAGE(PG8_SB(0, 0), cB, voffB); PG8_STAGE(PG8_SB(0, 1), cB + hstepB, voffB); PG8_STAGE(PG8_SA(0, 0), cA, voffA); PG8_STAGE(PG8_SA(0, 1), cA + hstepA, voffA);
        if (wr == 1) PG8_BAR;
        PG8_WAIT_V(2); PG8_BAR;
        PG8_STAGE(PG8_SB(1, 0), cB + kstep, voffB); PG8_STAGE(PG8_SA(1, 0), cA + kstep, voffA); PG8_STAGE(PG8_SB(1, 1), cB + hstepB + kstep, voffB);
        PG8_WAIT_V(6); PG8_BAR;
    } else {
        PG8_STAGE(PG8_SB(0, 0), cB, voffB); PG8_STAGE(PG8_SA(0, 0), cA, voffA); PG8_STAGE(PG8_SB(0, 1), cB + hstepB, voffB); PG8_STAGE(PG8_SA(0, 1), cA + hstepA, voffA);
        if (wr == 1) PG8_BAR;
        PG8_WAIT_V(4); PG8_BAR;
        PG8_STAGE(PG8_SB(1, 0), cB + kstep, voffB); PG8_STAGE(PG8_SA(1, 0), cA + kstep, voffA); PG8_STAGE(PG8_SB(1, 1), cB + hstepB + kstep, voffB);
        PG8_WAIT_V(6); PG8_BAR;
    }
    for (;;) {
        const bool has_next = S.next(ui + 1, nxt);
        const char* nA = has_next ? (const char*)g.A + (size_t)nxt.pm * tstepA : cA; const char* nB = has_next ? (const char*)g.Bt + (size_t)nxt.pn * tstepB : cB;
#pragma unroll 1
        for (int t = 0; t < nt; t += 2) {
            const bool last = (t == nt - 2);
            const char* a1 = cA + (size_t)(t + 1) * kstep;
            const char* a2 = last ? nA : cA + (size_t)(t + 2) * kstep; const char* b2 = last ? nB : cB + (size_t)(t + 2) * kstep;
            const char* a3 = a2 + kstep; const char* b3 = b2 + kstep;
            if (last && has_next) S.a_ready(nxt);
            if constexpr (SP2) {
            PG8_LDB(B0, 0, 0); PG8_LDB(B1, 0, 1); PG8_SCHED; PG8_LDA(At, 0, 0); PG8_STAGE(PG8_SA(1, 1), a1 + hstepA, voffA);
            PG8_WAIT_V(8); PG8_WAIT_L(0); PG8_BAR; PG8_MMA(0, 0, At, B0); PG8_MMA(0, 1, At, B1); PG8_BAR; PG8_SCHED;
            PG8_LDA(At, 0, 1); PG8_STAGE(PG8_SB(0, 0), b2, voffB); PG8_STAGE(PG8_SB(0, 1), b2 + hstepB, voffB); PG8_STAGE(PG8_SA(0, 0), a2, voffA);
            PG8_WAIT_V(8); PG8_WAIT_L(0); PG8_BAR; PG8_MMA(1, 0, At, B0); PG8_MMA(1, 1, At, B1); PG8_BAR; PG8_SCHED;
            PG8_LDB(B0, 1, 0); PG8_LDB(B1, 1, 1); PG8_SCHED; PG8_LDA(At, 1, 0); PG8_STAGE(PG8_SA(0, 1), a2 + hstepA, voffA);
            PG8_WAIT_V(8); PG8_WAIT_L(0); PG8_BAR; PG8_MMA(0, 0, At, B0); PG8_MMA(0, 1, At, B1); PG8_BAR; PG8_SCHED;
            PG8_LDA(At, 1, 1); PG8_STAGE(PG8_SB(1, 0), b3, voffB); PG8_STAGE(PG8_SB(1, 1), b3 + hstepB, voffB); PG8_STAGE(PG8_SA(1, 0), a3, voffA);
            PG8_WAIT_V(8); PG8_WAIT_L(0); PG8_BAR; PG8_MMA(1, 0, At, B0); PG8_MMA(1, 1, At, B1); PG8_BAR; PG8_SCHED;
            } else {
            PG8_LDB(B0, 0, 0); PG8_SCHED; PG8_LDA(At, 0, 0); PG8_STAGE(PG8_SA(1, 1), a1 + hstepA, voffA);
            PG8_WAIT_L(8); PG8_BAR; PG8_WAIT_L(0); PG8_MMA(0, 0, At, B0); PG8_BAR; PG8_SCHED;
            PG8_LDB(B1, 0, 1); PG8_STAGE(PG8_SB(0, 0), b2, voffB);
            PG8_BAR; PG8_WAIT_L(0); PG8_MMA(0, 1, At, B1); PG8_BAR;
            PG8_LDA(At, 0, 1); PG8_STAGE(PG8_SA(0, 0), a2, voffA);
            PG8_BAR; PG8_WAIT_L(0); PG8_MMA(1, 0, At, B0); PG8_BAR; PG8_SCHED;
            PG8_STAGE(PG8_SB(0, 1), b2 + hstepB, voffB);
            PG8_WAIT_V(6); PG8_BAR; PG8_MMA(1, 1, At, B1); PG8_BAR;
            PG8_LDB(B0, 1, 0); PG8_SCHED; PG8_LDA(At, 1, 0); PG8_STAGE(PG8_SA(0, 1), a2 + hstepA, voffA);
            PG8_WAIT_L(8); PG8_BAR; PG8_WAIT_L(0); PG8_MMA(0, 0, At, B0); PG8_BAR; PG8_SCHED;
            PG8_LDB(B1, 1, 1); PG8_STAGE(PG8_SB(1, 0), b3, voffB);
            PG8_BAR; PG8_WAIT_L(0); PG8_MMA(0, 1, At, B1); PG8_BAR;
            PG8_LDA(At, 1, 1); PG8_STAGE(PG8_SA(1, 0), a3, voffA);
            PG8_BAR; PG8_WAIT_L(0); PG8_MMA(1, 0, At, B0); PG8_BAR; PG8_SCHED;
            PG8_STAGE(PG8_SB(1, 1), b3 + hstepB, voffB);
            PG8_WAIT_V(6); PG8_BAR; PG8_MMA(1, 1, At, B1); PG8_BAR;
            }
        }
        if constexpr (ALIGN_EPI) { if (wr == 0) PG8_BAR; }
        if constexpr (F8) {
            asm volatile("s_nop 15\n\ts_nop 7" : "+v"(acc[0][0][0][0]), "+v"(acc[0][0][0][1]), "+v"(acc[0][0][1][0]), "+v"(acc[0][0][1][1]), "+v"(acc[0][0][2][0]), "+v"(acc[0][0][2][1]), "+v"(acc[0][0][3][0]), "+v"(acc[0][0][3][1]), "+v"(acc[0][1][0][0]), "+v"(acc[0][1][0][1]), "+v"(acc[0][1][1][0]), "+v"(acc[0][1][1][1]), "+v"(acc[0][1][2][0]), "+v"(acc[0][1][2][1]), "+v"(acc[0][1][3][0]), "+v"(acc[0][1][3][1]) :: "memory");
            asm volatile("" : "+v"(acc[1][0][0][0]), "+v"(acc[1][0][0][1]), "+v"(acc[1][0][1][0]), "+v"(acc[1][0][1][1]), "+v"(acc[1][0][2][0]), "+v"(acc[1][0][2][1]), "+v"(acc[1][0][3][0]), "+v"(acc[1][0][3][1]), "+v"(acc[1][1][0][0]), "+v"(acc[1][1][0][1]), "+v"(acc[1][1][1][0]), "+v"(acc[1][1][1][1]), "+v"(acc[1][1][2][0]), "+v"(acc[1][1][2][1]), "+v"(acc[1][1][3][0]), "+v"(acc[1][1][3][1]) :: "memory"); }
        if constexpr (!Epi::AFTER_DRAIN) { E(acc, cur, wr, wc, fr, fq); S.done(cur); }
        if (!has_next) break;
#pragma unroll
        for (int a = 0; a < 2; ++a)
#pragma unroll
            for (int b = 0; b < 2; ++b)
#pragma unroll
                for (int m = 0; m < 4; ++m)
#pragma unroll
                    for (int n = 0; n < 2; ++n) acc[a][b][m][n] = (f32x4){0.f, 0.f, 0.f, 0.f};
        cur = nxt; cA = nA; cB = nB; ++ui;
        if constexpr (ALIGN_EPI) { if (wr == 1) PG8_BAR; }
    }
    PG8_WAIT_V(0);
    if constexpr (!ALIGN_EPI) { if (wr == 0) PG8_BAR; }
    PG8_BAR;
    if constexpr (Epi::AFTER_DRAIN) { E.fused(acc, cur, wr, wc, fr, fq, lds, wid, lane); S.done(cur); }
#undef PG8_SA
#undef PG8_SB
#undef PG8_STAGE
#undef PG8_LDA
#undef PG8_LDB
#undef PG8_MMA
#undef PG8_WAIT_V
#undef PG8_WAIT_L
#undef PG8_BAR
#undef PG8_SCHED
}
}

#include <hip/hip_bf16.h>
#include <cmath>
namespace attn_body {
using bf16=__hip_bfloat16;
using bf16x8=__attribute__((ext_vector_type(8)))short;
using s16x4=__attribute__((ext_vector_type(4)))short;
using f32x16=__attribute__((ext_vector_type(16)))float;
using u32x4=__attribute__((ext_vector_type(4)))unsigned;
constexpr int BATCH=2,NHEAD=16,SEQ=8192,D=64,DM=NHEAD*D;
constexpr int NW=8,QBLK=32,QB=QBLK*NW,KVBLK=64,NQB=SEQ/QB;
constexpr int ATTN_PITCH=DM, ATTN_UNIT_ROWS=QB;
__device__ __forceinline__ int crow(int r,int hi){return (r&3)+8*(r>>2)+4*hi;}
#define SBAR() __builtin_amdgcn_sched_barrier(0)
__device__ __forceinline__ void cmask(f32x16&p0,f32x16&p1,int jb,int qrel,int hi){
  const float NEG=-INFINITY; int kb=64*jb+4*hi;
  #pragma unroll
  for(int r=0;r<16;++r){int kv=kb+(r&3)+8*(r>>2); if(kv>qrel)p0[r]=NEG; if(kv+32>qrel)p1[r]=NEG;}
}

constexpr int NSLOT=3, SLOTB=8192, KSLOTB=10240;
constexpr int LDS_K=0, LDS_V=NSLOT*KSLOTB, LDS_WS=LDS_V+NSLOT*SLOTB, LDS_OST=LDS_WS+NW*64*4, LDS_BYTES=LDS_OST+NW*4096;
#define KOFF(sl) ((sl)+((sl)>>2))
constexpr float C2=0.125f*1.4426950408889634f;
__device__ __forceinline__ void glds16(const void*gsrc,unsigned lds_dst){unsigned keep;
  asm volatile("s_mov_b32 %0, m0\n\ts_mov_b32 m0, %2\n\ts_nop 0\n\tglobal_load_lds_dwordx4 %1, off\n\ts_mov_b32 m0, %0":"=&s"(keep):"v"(gsrc),"s"(lds_dst):"memory");}
__device__ __forceinline__ void glds4(const void*gsrc,unsigned lds_dst){unsigned keep;
  asm volatile("s_mov_b32 %0, m0\n\ts_mov_b32 m0, %2\n\ts_nop 0\n\tglobal_load_lds_dword %1, off\n\ts_mov_b32 m0, %0":"=&s"(keep):"v"(gsrc),"s"(lds_dst):"memory");}
__device__ __forceinline__ float max3f(float a,float b,float c){float r;asm("v_max3_f32 %0, %1, %2, %3":"=v"(r):"v"(a),"v"(b),"v"(c));return r;}
__device__ __forceinline__ float max2f(float a,float b){float r;asm("v_max_f32_e32 %0, %1, %2":"=v"(r):"v"(a),"v"(b));return r;}
__device__ __forceinline__ float fadd_s(float a,float b){float r;asm("v_add_f32_e32 %0, %1, %2":"=v"(r):"v"(a),"v"(b));return r;}
__device__ __forceinline__ float fsub_s(float a,float b){float r;asm("v_sub_f32_e32 %0, %1, %2":"=v"(r):"v"(a),"v"(b));return r;}
typedef float f32x2_t __attribute__((ext_vector_type(2))); typedef __bf16 bf16x2_t __attribute__((ext_vector_type(2)));
__device__ __forceinline__ unsigned cvtpk_s(float lo,float hi){f32x2_t v={lo,hi};bf16x2_t b=__builtin_convertvector(v,bf16x2_t);return __builtin_bit_cast(unsigned,b);}
#define WAIT_BAR(N) asm volatile("s_waitcnt vmcnt(" #N ") lgkmcnt(0)\n\ts_barrier":::"memory")

__device__ __forceinline__ void qkt(f32x16&p0,f32x16&p1,const char*Kslot,const bf16x8*qr,const bf16x8 qe,int r32,int hi){
  const char*kb=Kslot+hi*1024+r32*16;
  { const bf16x8 e0=*reinterpret_cast<const bf16x8*>(kb+8192); const bf16x8 e1=*reinterpret_cast<const bf16x8*>(kb+8192+512); const f32x16 z=f32x16{};
    p0=__builtin_amdgcn_mfma_f32_32x32x16_bf16(e0,qe,z,0,0,0); p1=__builtin_amdgcn_mfma_f32_32x32x16_bf16(e1,qe,z,0,0,0); }
  #pragma unroll
  for(int d0=0;d0<4;++d0){
    const bf16x8 b0=*reinterpret_cast<const bf16x8*>(kb+d0*2048);
    const bf16x8 b1=*reinterpret_cast<const bf16x8*>(kb+d0*2048+512);
    {p0=__builtin_amdgcn_mfma_f32_32x32x16_bf16(b0,qr[d0],p0,0,0,0);p1=__builtin_amdgcn_mfma_f32_32x32x16_bf16(b1,qr[d0],p1,0,0,0);}}
}
typedef __attribute__((address_space(3))) const char* lds_cptr;
typedef short v4i16_t __attribute__((ext_vector_type(4)));
__device__ __forceinline__ void kload8(bf16x8*kf,lds_cptr kp){
  kf[0]=*(const __attribute__((address_space(3))) bf16x8*)(kp);      kf[1]=*(const __attribute__((address_space(3))) bf16x8*)(kp+512);
  kf[2]=*(const __attribute__((address_space(3))) bf16x8*)(kp+2048); kf[3]=*(const __attribute__((address_space(3))) bf16x8*)(kp+2560);
  kf[4]=*(const __attribute__((address_space(3))) bf16x8*)(kp+4096); kf[5]=*(const __attribute__((address_space(3))) bf16x8*)(kp+4608);
  kf[6]=*(const __attribute__((address_space(3))) bf16x8*)(kp+6144); kf[7]=*(const __attribute__((address_space(3))) bf16x8*)(kp+6656);
  kf[8]=*(const __attribute__((address_space(3))) bf16x8*)(kp+8192); kf[9]=*(const __attribute__((address_space(3))) bf16x8*)(kp+8704);
}
__device__ __forceinline__ void kload2(bf16x8*kf,lds_cptr kp,int j){ kf[2*j]=*(const __attribute__((address_space(3))) bf16x8*)(kp+j*2048); kf[2*j+1]=*(const __attribute__((address_space(3))) bf16x8*)(kp+j*2048+512); }
__device__ __forceinline__ s16x4 vtr(lds_cptr p){ return __builtin_bit_cast(s16x4,__builtin_amdgcn_ds_read_tr16_b64_v4i16((__attribute__((address_space(3))) v4i16_t*)p)); }
__device__ __forceinline__ float rowmax(const f32x16&p0,const f32x16&p1){
  float a=max3f(p0[0],p0[1],p1[0]),b=max3f(p0[2],p0[3],p1[1]);a=max3f(a,p1[2],p1[3]);
  #pragma unroll
  for(int r=4;r<16;r+=4){a=max3f(a,p0[r],p0[r+1]);b=max3f(b,p0[r+2],p0[r+3]);a=max3f(a,p1[r],p1[r+1]);b=max3f(b,p1[r+2],p1[r+3]);}
  const float m=max2f(a,b);
  auto rr=__builtin_amdgcn_permlane32_swap(__float_as_uint(m),__float_as_uint(m),false,false);
  return max2f(__uint_as_float(rr[0]),__uint_as_float(rr[1]));
}
__device__ __forceinline__ void pv(f32x16*o,int vb,bf16x8 pa0,bf16x8 pa1,bf16x8 pa2,bf16x8 pa3){
  #pragma unroll
  for(int d0=0;d0<2;++d0){s16x4 lo[4],hi[4];
    #pragma unroll
    for(int ks=0;ks<4;++ks){
      asm volatile("ds_read_b64_tr_b16 %0,%1 offset:%c2":"=&v"(lo[ks]):"v"(vb),"i"(d0*4096+ks*1024):"memory");
      asm volatile("ds_read_b64_tr_b16 %0,%1 offset:%c2":"=&v"(hi[ks]):"v"(vb),"i"(d0*4096+ks*1024+512):"memory");}
    asm volatile("s_waitcnt lgkmcnt(0)":::"memory");SBAR();
    #define PK(k) (bf16x8){lo[k][0],lo[k][1],lo[k][2],lo[k][3],hi[k][0],hi[k][1],hi[k][2],hi[k][3]}
    o[d0]=__builtin_amdgcn_mfma_f32_32x32x16_bf16(pa0,PK(0),o[d0],0,0,0);
    o[d0]=__builtin_amdgcn_mfma_f32_32x32x16_bf16(pa1,PK(1),o[d0],0,0,0);
    o[d0]=__builtin_amdgcn_mfma_f32_32x32x16_bf16(pa2,PK(2),o[d0],0,0,0);
    o[d0]=__builtin_amdgcn_mfma_f32_32x32x16_bf16(pa3,PK(3),o[d0],0,0,0);
    #undef PK
  }
}

#ifndef ATTN_STORE16
#define ATTN_STORE16(p,v) (*(u32x4*)(p)=(v))
#endif
__device__ __forceinline__ bf16x8 make_qe(float m,int hi){
  const unsigned um=__float_as_uint(m); unsigned h0=(um+0x7fffu+((um>>16)&1u))&0xffff0000u; const float r1=m-__uint_as_float(h0);
  const unsigned u1=__float_as_uint(r1); unsigned h1=(u1+0x7fffu+((u1>>16)&1u))&0xffff0000u; const float r2=r1-__uint_as_float(h1);
  const unsigned u2=__float_as_uint(r2); unsigned h2=(u2+0x7fffu+((u2>>16)&1u))&0xffff0000u;
  u32x4 w; w.x=0x3f803f80u; w.y=0x3f80u|(h0^0x80000000u); w.z=((h1^0x80000000u)>>16)|(h2^0x80000000u); w.w=0u;
  if(hi){w.x=0u;w.y=0u;w.z=0u;} return __builtin_bit_cast(bf16x8,w); }
template<int THRL> __device__ __forceinline__ void attn_unit(int b,int h,int qb,const bf16*Q,const bf16*__restrict__ K,const bf16*__restrict__ V,bf16*O,const bf16*__restrict__ KE,const float*__restrict__ BETA,float qkmax,char*shm,const int tid){
  const int lane=tid&63,r32=lane&31,hi=lane>>5; const int wid=__builtin_amdgcn_readfirstlane(tid>>6);
  const long rowbase=(long)b*SEQ; const int q0=qb*QB;
  const bf16*Qw=Q+(rowbase+q0+wid*QBLK)*DM+h*D;
  const float*bet=BETA+(long)(b*NHEAD+h)*SEQ; const int NTF=(q0+QB)/KVBLK; int t0;
  { const float thr=bet[q0]-37.f-2.f*qkmax; const int l0=lane,l1=lane+64;
    const bool s0=(l0<NTF-4)&&(bet[64*l0+63]<thr), s1=(l1<NTF-4)&&(bet[64*l1+63]<thr);
    const unsigned long long m0=__ballot(s0), m1=__ballot(s1);
    int n0=(~m0)?__builtin_ctzll(~m0):64; if(n0==64) n0+=(~m1)?__builtin_ctzll(~m1):64;
    t0=__builtin_amdgcn_readfirstlane(n0)&~1; }
  const bf16*Kh=K+(rowbase+(long)t0*KVBLK)*DM+h*D,*Vh=V+(rowbase+(long)t0*KVBLK)*DM+h*D;
  const char*KEh=(const char*)KE+((long)(b*NHEAD+h)*(SEQ/KVBLK)+t0)*2048+wid*256+lane*4;
  const unsigned lds0=(unsigned)(uintptr_t)shm;
  float*wsf=(float*)(shm+LDS_WS)+wid*64;
  const bf16*ksrc=Kh+(long)lane*DM+wid*8;
  const bf16*vsrc=Vh+(long)(16*(wid&3)+(lane>>2))*DM+(wid>>2)*32+(lane&3)*8;
  const unsigned kdst=lds0+LDS_K+wid*1024, vdst=lds0+LDS_V+wid*1024, kedst=lds0+LDS_K+8192+wid*256;
  #define DMA_K(t,slot) do{ glds16(ksrc+(long)(t)*KVBLK*DM,(unsigned)__builtin_amdgcn_readfirstlane(kdst+KOFF(slot))); glds4(KEh+(long)(t)*2048,(unsigned)__builtin_amdgcn_readfirstlane(kedst+KOFF(slot))); }while(0)
  #define DMA_V(t,slot) glds16(vsrc+(long)(t)*KVBLK*DM,(unsigned)__builtin_amdgcn_readfirstlane(vdst+(slot)))
  const int vb0=(int)(lds0+LDS_V)+((lane>>4)&1)*32+(lane&3)*8+(4*hi+((lane&15)>>2))*64;
  const char*Kbase=shm+LDS_K; bf16x8 kf[10];
  const lds_cptr shm3=(lds_cptr)shm; const lds_cptr kp0=shm3+LDS_K+hi*1024+r32*16; const lds_cptr vp0=shm3+LDS_V+((lane>>4)&1)*32+(lane&3)*8+(4*hi+((lane&15)>>2))*64;
  const int NT=NTF-t0;
  DMA_K(0,0);DMA_V(0,0);DMA_K(1,SLOTB);
  bf16x8 qr[4];
  #pragma unroll
  for(int d0=0;d0<4;++d0)qr[d0]=*reinterpret_cast<const bf16x8*>(&Qw[(long)r32*DM+d0*16+hi*8]);
  float mhat=bet[q0+wid*QBLK+r32],l_reg=0.f;f32x16 o[2];o[0]=f32x16{};o[1]=f32x16{}; bf16x8 qe=make_qe(mhat,hi);
  const int qrel=wid*QBLK+r32;
  #define CMASK(P0,P1,t) do{int jb_=(t)-(NT-4); if(jb_>=0)cmask(P0,P1,jb_,qrel,hi);}while(0)
  bool resc=false;
  #define START(P0,P1) do{ resc=false; _Pragma("unroll") for(int r=0;r<16;++r)P0[r]=__builtin_amdgcn_exp2f(P0[r]); }while(0)
  #define RESC() do{ if(resc){ asm volatile("s_waitcnt lgkmcnt(0)":::"memory"); \
      _Pragma("unroll") for(int d_=0;d_<2;++d_) _Pragma("unroll") for(int r=0;r<16;++r)o[d_][r]*=wsf[crow(r,hi)]; } }while(0)
  f32x16 pA0,pA1,pB0,pB1;
  int sl_prev=0,sl_cur=0,sl_next=SLOTB;
  #define ROT() do{sl_prev=sl_cur;sl_cur=sl_next;sl_next=(sl_next==(NSLOT-1)*SLOTB)?0:sl_next+SLOTB;}while(0)
  DMA_K(2,2*SLOTB);
  WAIT_BAR(5);
  qkt(pA0,pA1,Kbase,qr,qe,r32,hi);asm volatile("s_nop 15\n\ts_nop 7":"+v"(pA0),"+v"(pA1));CMASK(pA0,pA1,0);
  START(pA0,pA1);
  _Pragma("unroll") for(int r=0;r<16;++r)pA1[r]=__builtin_amdgcn_exp2f(pA1[r]);
  WAIT_BAR(0);
  DMA_K(3,0);DMA_V(1,SLOTB);
  ROT();
  kload8(kf,kp0+KOFF(sl_cur));
  WAIT_BAR(3);
  s16x4 vlo[8],vhi[8]; u32x4 pw0,pw1,pw2,pw3;
  #define PKW(P,B) cvtpk_s(P[B],P[B+1])
  #define PAF(k) __builtin_bit_cast(bf16x8,pw##k)
  #define VFR(i) (bf16x8){vlo[i][0],vlo[i][1],vlo[i][2],vlo[i][3],vhi[i][0],vhi[i][1],vhi[i][2],vhi[i][3]}
  #define PIN(x) asm volatile("":"+v"(x))
  #define MX3(a,b,c) __builtin_fmaxf(__builtin_fmaxf((a),(b)),(c))
  #define GAPA(MF,A0,A1,A2,A3,W0,W1,PW) do{ MF; sacc+=A0; sacc+=A1; sacc+=A2; sacc+=A3; PIN(sacc); W0; W1; PIN(PW); SBAR(); }while(0)
  #define EX(v) __builtin_amdgcn_exp2f(v)
  #define GAPB(MF,X,B) do{ MF; X[B]=EX(X[B]); X[B+1]=EX(X[B+1]); X[B+2]=EX(X[B+2]); X[B+3]=EX(X[B+3]); PIN(X); SBAR(); }while(0)
  #define VRD(i) do{ vlo[i]=vtr(vp_+(((i)>>2)*4096+((i)&3)*1024)); vhi[i]=vtr(vp_+(((i)>>2)*4096+((i)&3)*1024+512)); }while(0)
  #define KRD(G,j) do{ if(G){ kload2(kf,kp0+KOFF(sl_next),j); SBAR(); } }while(0)
  #define KRDE(G) do{ if(G){ kf[8]=*(const __attribute__((address_space(3))) bf16x8*)(kp0+KOFF(sl_next)+8192); kf[9]=*(const __attribute__((address_space(3))) bf16x8*)(kp0+KOFF(sl_next)+8704); SBAR(); } }while(0)
  #define STEP(C0,C1,P0,P1,t,GK,GV,GL) do{ SBAR(); \
    const lds_cptr vp_=vp0+sl_prev; \
    VRD(0); SBAR(); float sacc=(P0[0]+P0[1]); \
    C0=__builtin_amdgcn_mfma_f32_32x32x16_bf16(kf[8],qe,f32x16{},0,0,0); C1=__builtin_amdgcn_mfma_f32_32x32x16_bf16(kf[9],qe,f32x16{},0,0,0); SBAR(); \
    GAPA(C0=__builtin_amdgcn_mfma_f32_32x32x16_bf16(kf[0],qr[0],C0,0,0,0), P0[2],P0[3],P0[4],P0[5],     pw0[0]=PKW(P0,0), pw0[1]=PKW(P0,2), pw0); \
    VRD(4); SBAR(); GAPA(C1=__builtin_amdgcn_mfma_f32_32x32x16_bf16(kf[1],qr[0],C1,0,0,0), P0[6],P0[7],P0[8],P0[9],     pw0[2]=PKW(P0,4), pw0[3]=PKW(P0,6), pw0); \
    VRD(1); SBAR(); GAPA(C0=__builtin_amdgcn_mfma_f32_32x32x16_bf16(kf[2],qr[1],C0,0,0,0),   P0[10],P0[11],P0[12],P0[13], pw1[0]=PKW(P0,8), pw1[1]=PKW(P0,10), pw1); \
    VRD(5); SBAR(); GAPA(C1=__builtin_amdgcn_mfma_f32_32x32x16_bf16(kf[3],qr[1],C1,0,0,0),   P0[14],P0[15],P1[0],P1[1],   pw1[2]=PKW(P0,12),pw1[3]=PKW(P0,14), pw1); \
    VRD(2); SBAR(); GAPA(C0=__builtin_amdgcn_mfma_f32_32x32x16_bf16(kf[4],qr[2],C0,0,0,0),   P1[2],P1[3],P1[4],P1[5],     pw2[0]=PKW(P1,0), pw2[1]=PKW(P1,2), pw2); \
    VRD(6); SBAR(); GAPA(C1=__builtin_amdgcn_mfma_f32_32x32x16_bf16(kf[5],qr[2],C1,0,0,0),   P1[6],P1[7],P1[8],P1[9],     pw2[2]=PKW(P1,4), pw2[3]=PKW(P1,6), pw2); \
    VRD(3); SBAR(); GAPA(C0=__builtin_amdgcn_mfma_f32_32x32x16_bf16(kf[6],qr[3],C0,0,0,0),   P1[10],P1[11],P1[12],P1[13], pw3[0]=PKW(P1,8), pw3[1]=PKW(P1,10), pw3); \
    VRD(7); SBAR(); GAPA(C1=__builtin_amdgcn_mfma_f32_32x32x16_bf16(kf[7],qr[3],C1,0,0,0),   P1[14],P1[15],0.f,0.f,       pw3[2]=PKW(P1,12),pw3[3]=PKW(P1,14), pw3); \
    l_reg+=sacc; \
    if(GK){DMA_K((t)+3,sl_cur);} if(GV){DMA_V((t)+1,sl_next);} \
    CMASK(C0,C1,t); \
    { float a=MX3(C0[0],C0[1],C1[0]),b=MX3(C0[2],C0[3],C1[1]); a=MX3(a,C1[2],C1[3]); \
      _Pragma("unroll") for(int r=4;r<16;r+=4){a=MX3(a,C0[r],C0[r+1]);b=MX3(b,C0[r+2],C0[r+3]);a=MX3(a,C1[r],C1[r+1]);b=MX3(b,C1[r+2],C1[r+3]);} \
      float rm=__builtin_fmaxf(a,b); { auto rr=__builtin_amdgcn_permlane32_swap(__float_as_uint(rm),__float_as_uint(rm),false,false); rm=__builtin_fmaxf(__uint_as_float(rr[0]),__uint_as_float(rr[1])); } \
      resc=false; \
      if(__builtin_expect(__any(rm>(float)THRL),0)){ const float dl=__builtin_fmaxf(rm,0.f); mhat+=dl; \
        _Pragma("unroll") for(int r=0;r<16;++r){C0[r]-=dl;C1[r]-=dl;} \
        qe=make_qe(mhat,hi); \
        const float f=__builtin_amdgcn_exp2f(-dl); l_reg*=f; if(hi==0)wsf[r32]=f; resc=true; } } \
    SBAR(); \
    GAPB(o[0]=__builtin_amdgcn_mfma_f32_32x32x16_bf16(PAF(0),VFR(0),o[0],0,0,0), C0,0); \
    GAPB(o[1]=__builtin_amdgcn_mfma_f32_32x32x16_bf16(PAF(0),VFR(4),o[1],0,0,0), C0,4); \
    KRD(GL,0); GAPB(o[0]=__builtin_amdgcn_mfma_f32_32x32x16_bf16(PAF(1),VFR(1),o[0],0,0,0), C0,8); \
    KRD(GL,1); GAPB(o[1]=__builtin_amdgcn_mfma_f32_32x32x16_bf16(PAF(1),VFR(5),o[1],0,0,0), C0,12); \
    KRD(GL,2); GAPB(o[0]=__builtin_amdgcn_mfma_f32_32x32x16_bf16(PAF(2),VFR(2),o[0],0,0,0), C1,0); \
    KRD(GL,3); GAPB(o[1]=__builtin_amdgcn_mfma_f32_32x32x16_bf16(PAF(2),VFR(6),o[1],0,0,0), C1,4); \
    KRDE(GL); GAPB(o[0]=__builtin_amdgcn_mfma_f32_32x32x16_bf16(PAF(3),VFR(3),o[0],0,0,0), C1,8); \
    GAPB(o[1]=__builtin_amdgcn_mfma_f32_32x32x16_bf16(PAF(3),VFR(7),o[1],0,0,0), C1,12); \
    }while(0)
  int t=1;
  #undef CMASK
  #define CMASK(P0,P1,t) do{}while(0)
  for(;t+5<NT;t+=2){
    STEP(pB0,pB1,pA0,pA1,t,true,true,true);     WAIT_BAR(3); RESC(); ROT();
    STEP(pA0,pA1,pB0,pB1,t+1,true,true,true);   WAIT_BAR(3); RESC(); ROT();
  }
  #undef CMASK
  #define CMASK(P0,P1,t) do{int jb_=(t)-(NT-4); if(jb_>=0)cmask(P0,P1,jb_,qrel,hi);}while(0)
  #define ENDW(tt) do{ if((tt)+3<NT){WAIT_BAR(3);} else if((tt)+2<NT){WAIT_BAR(1);} else {WAIT_BAR(0);} }while(0)
  for(;t+1<NT;t+=2){
    STEP(pB0,pB1,pA0,pA1,t,(t+3<NT),(t+1<NT),(t+1<NT));       ENDW(t);   RESC(); ROT();
    STEP(pA0,pA1,pB0,pB1,t+1,(t+4<NT),(t+2<NT),(t+2<NT));     ENDW(t+1); RESC(); ROT();
  }
  STEP(pB0,pB1,pA0,pA1,NT-1,false,false,false); RESC();
  { float sacc=pB0[0]+pB0[1]; _Pragma("unroll") for(int r=2;r<16;++r)sacc+=pB0[r]; _Pragma("unroll") for(int r=0;r<16;++r)sacc+=pB1[r]; l_reg+=sacc;
    pw0=(u32x4){PKW(pB0,0),PKW(pB0,2),PKW(pB0,4),PKW(pB0,6)};pw1=(u32x4){PKW(pB0,8),PKW(pB0,10),PKW(pB0,12),PKW(pB0,14)};pw2=(u32x4){PKW(pB1,0),PKW(pB1,2),PKW(pB1,4),PKW(pB1,6)};pw3=(u32x4){PKW(pB1,8),PKW(pB1,10),PKW(pB1,12),PKW(pB1,14)};
    SBAR(); pv(o,vb0+sl_cur,PAF(0),PAF(1),PAF(2),PAF(3)); }
  #undef PKW
  #undef PAF
  #undef VFR
  #undef PIN
  #undef MX3
  #undef GAPA
  #undef GAPB
  #undef EX
  #undef VRD
  #undef KRD
  #undef KRDE
  #undef STEP
  #undef ENDW
  {auto rr=__builtin_amdgcn_permlane32_swap(__float_as_uint(l_reg),__float_as_uint(l_reg),false,false);l_reg=__uint_as_float(rr[0])+__uint_as_float(rr[1]);}
  if(hi==0)wsf[32+r32]=l_reg;asm volatile("s_waitcnt lgkmcnt(0)":::"memory");
  float rli[16];
  #pragma unroll
  for(int r=0;r<16;++r)rli[r]=__builtin_amdgcn_rcpf(wsf[32+crow(r,hi)]);
  int lane_e=lane; asm volatile("":"+v"(lane_e));
  const int r32e=lane_e&31,hie=lane_e>>5;
  unsigned char*Ow=(unsigned char*)O+((rowbase+q0+wid*QBLK)*DM+h*D);
  { unsigned char*stg=(unsigned char*)(shm+LDS_OST)+wid*4096;
    #pragma unroll
    for(int r=0;r<16;++r){const int orow=crow(r,hie); const float sc32=32.f*rli[r];
      #pragma unroll
      for(int d0=0;d0<2;++d0)stg[orow*64+d0*32+r32e]=(unsigned char)__builtin_amdgcn_cvt_pk_fp8_f32(o[d0][r]*sc32,0.f,0,false);}
    asm volatile("s_waitcnt lgkmcnt(0)":::"memory");
    typedef unsigned u32x2_t __attribute__((ext_vector_type(2)));
    #pragma unroll
    for(int i=0;i<4;++i){const int row=i*8+(lane_e>>3),ch=lane_e&7; const u32x2_t v=*(const u32x2_t*)(stg+row*64+ch*8); *(u32x2_t*)(Ow+(long)row*DM+ch*8)=v;} }
  asm volatile("s_waitcnt lgkmcnt(0)\n\ts_barrier":::"memory");
  #undef DMA_K
  #undef DMA_V
  #undef CMASK
  #undef START
  #undef RESC
  #undef ROT
}
constexpr int ATTN_LDS_BYTES=LDS_BYTES;
struct AttnTensors { const bf16* Q; const bf16* K; const bf16* V; bf16* O; };
struct AttnUnit { int bh; int qb; };
struct StaticOrder {
  int vcu;
  __device__ __forceinline__ explicit StaticOrder(int grid,int block):vcu((block%8)*(grid/8)+block/8){}
  __device__ __forceinline__ bool next(int i,AttnUnit&u)const{ if(i>=4)return false; const int s=vcu&7; u.bh=vcu>>3; u.qb=(i==0)?s:(i==1)?15-s:(i==2)?16+s:31-s; return true; }
  __device__ __forceinline__ void a_ready(const AttnUnit&)const{}
  __device__ __forceinline__ void done(const AttnUnit&)const{}
};
template<class Sched,int THRL=8> __device__ __forceinline__ void attn_phase(char*lds,const AttnTensors&T,const Sched&S){
  AttnUnit u;
  for(int i=0;S.next(i,u);++i){ S.a_ready(u); attn_unit<THRL>(u.bh/NHEAD,u.bh%NHEAD,u.qb,T.Q,T.K,T.V,T.O,lds); S.done(u); }
}
#undef SBAR
#undef WAIT_BAR
}

#ifndef MK_DUP
#define MK_DUP 0
#endif
#define ORD_QKV 4, 3
#define ORD_UP 4, 3
#define ORD_DIN 4, 3
#define ORD_QI 4, 3
constexpr int NWAVES = 8, NTHREADS = 512;
constexpr int BATCH = 2, T = 8192, D = 1024, H = 16, HD = 64, FF = 2816, FF2 = 5632;
constexpr int M = BATCH * T;
constexpr int FOX_IN = 3088, DSA_IN = 2120;
constexpr float EPS = 1e-6f;
constexpr float LOG2E = 1.4426950408889634f;

constexpr size_t MiB = 1u << 20;
constexpr size_t WS_CTL = 0, CTL_ZERO_BYTES = 32 * 1024;
constexpr size_t WS_MOD = 1 * MiB;
constexpr size_t WS_XS = 2 * MiB;
constexpr int CW_NS = 1024;
constexpr size_t WS_WUP0 = 8 * MiB, WS_WUP1 = 19 * MiB;
constexpr size_t WS_WDN0 = 30 * MiB, WS_WDN1 = 35 * MiB + 512 * 1024;
constexpr size_t WS_WDIN = 41 * MiB;
constexpr size_t WS_WDTAIL = 45 * MiB;
constexpr size_t WS_WDOUT = 45 * MiB + 512 * 1024;
constexpr size_t WS_H = 48 * MiB;
constexpr size_t WS_R = 80 * MiB;
constexpr size_t WS_WFIN = WS_R, WS_WFOUT = WS_R + 6 * MiB;
constexpr size_t WS_Q = WS_R + 8 * MiB, WS_K = WS_R + 40 * MiB, WS_V = WS_R + 72 * MiB;
constexpr size_t WS_LOGF = WS_R + 104 * MiB;
constexpr size_t WS_BETA = WS_R + 105 * MiB;
constexpr size_t WS_KE = WS_R + 106 * MiB;
constexpr size_t WS_O = WS_R + 114 * MiB;
constexpr size_t WS_XB = WS_R + 144 * MiB;
constexpr size_t WS_U = WS_R;
constexpr size_t WS_SA0 = WS_R + 96 * MiB, WS_SG0 = WS_R + 98 * MiB, WS_SA1 = WS_R + 100 * MiB;
constexpr size_t WS_Q1 = WS_R, WS_K1 = WS_R + 32 * MiB, WS_V1 = WS_R + 40 * MiB;
constexpr size_t WS_QI = WS_R + 48 * MiB;
constexpr size_t WS_KI = WS_R + 64 * MiB;
constexpr size_t WS_WI = WS_R + 66 * MiB;
constexpr size_t WS_H8 = WS_R + 84 * MiB;
constexpr size_t WS_O1 = WS_R + 67 * MiB;
constexpr size_t WS_END = 256 * MiB;
static_assert(WS_U + (size_t)M * FF * 2 <= WS_SA0 && WS_SA1 + 2 * MiB <= WS_END, "d_ws map");
constexpr int CW_BAR = 4096;
static_assert((CW_BAR + 3456) * 4 <= 32 * 1024, "control words inside the per-call memset");
constexpr int CW_AQ = 256;
constexpr int CW_DQ = 512;

constexpr int RING_OFF = 0, RING_BYTES = 131072;
constexpr int LDSCTL_OFF = RING_BYTES, MISC_OFF = LDSCTL_OFF + 320;
constexpr int HALO_OFF = 131584;
constexpr int LDS_BYTES = 147456;

#define GAS __attribute__((address_space(1)))
#define LAS __attribute__((address_space(3)))
typedef unsigned short bf16;
typedef unsigned v4u __attribute__((ext_vector_type(4)));
typedef unsigned v2u __attribute__((ext_vector_type(2)));
typedef float f32x4 __attribute__((ext_vector_type(4)));
typedef short bf16x8 __attribute__((ext_vector_type(8)));
typedef GAS unsigned gu32;
#define RLX_AGENT __ATOMIC_RELAXED, __HIP_MEMORY_SCOPE_AGENT
#define LDS_WAIT() asm volatile("s_waitcnt lgkmcnt(0)" ::: "memory")
#define VM_WAIT() asm volatile("s_waitcnt vmcnt(0)" ::: "memory")
__device__ __forceinline__ unsigned f2bf(float f) { unsigned u = __builtin_bit_cast(unsigned, f); return (u + 0x7fffu + ((u >> 16) & 1u)) >> 16; }
__device__ __forceinline__ unsigned pk2(float lo, float hi) { return f2bf(lo) | (f2bf(hi) << 16); }
__device__ __forceinline__ float bf2f(unsigned b) { return __builtin_bit_cast(float, b << 16); }
#define XB_TMO      128
#define XB_XCNT(j)  (256  + 64 * (j))
#define XB_XSUB(j)  (1280 + 64 * (j))
#define XB_XGEN(j)  (2304 + 64 * (j))
#define XB_TOP      3328
#define XB_TOPGEN   3392
#define XCD_BAR_WORDS 3456
#define XB_SPIN_CAP (1u << 18)

__device__ __forceinline__ unsigned xb_ld(unsigned* p)              { return __hip_atomic_load(p, __ATOMIC_RELAXED, __HIP_MEMORY_SCOPE_AGENT); }
__device__ __forceinline__ unsigned xb_add(unsigned* p, unsigned v) { return __hip_atomic_fetch_add(p, v, __ATOMIC_RELAXED, __HIP_MEMORY_SCOPE_AGENT); }
__device__ __forceinline__ unsigned xb_xcc_id() { return (unsigned)__builtin_amdgcn_s_getreg((3 << 11) | 20) & 0xFu; }
#define XB_SPIN(cond, bar) do { unsigned _sp = 0; while (cond) { __builtin_amdgcn_s_sleep(1); \
    if ((++_sp & 255u) == 0u) { if (xb_ld(&(bar)[XB_TMO])) break; if (_sp > XB_SPIN_CAP) { atomicAdd(&(bar)[XB_TMO], 1u); break; } } } } while (0)

struct XcdBarrier {
    unsigned* bar; unsigned x;
    volatile LAS unsigned* st;
};

__device__ __forceinline__ XcdBarrier xcd_barrier_post(unsigned* bar, volatile LAS unsigned* st) {
    XcdBarrier b; b.bar = bar; b.x = xb_xcc_id(); b.st = st;
    if (threadIdx.x == 0) (void)xb_add(&bar[XB_XCNT(b.x)], 1u);
    return b;
}
__device__ __forceinline__ void xcd_barrier_complete(unsigned* bar, unsigned x, unsigned& nloc, unsigned& nx) {
    const unsigned G = gridDim.x * gridDim.y * gridDim.z;
    unsigned sum, cnt, mine, sp = 0u;
    for (;;) {
        sum = 0u; cnt = 0u; mine = 0u;
#pragma unroll
        for (unsigned j = 0; j < 16; ++j) { const unsigned c = xb_ld(&bar[XB_XCNT(j)]); sum += c; cnt += (c > 0u) ? 1u : 0u; mine = (j == x) ? c : mine; }
        if (sum == G) break;
        __builtin_amdgcn_s_sleep(1);
        if ((++sp & 255u) == 0u) { if (xb_ld(&bar[XB_TMO])) break; if (sp > XB_SPIN_CAP) { atomicAdd(&bar[XB_TMO], 1u); break; } }
    }
    nloc = mine > 0u ? mine : 1u; nx = cnt > 0u ? cnt : 1u;
}

__device__ __forceinline__ void xcd_barrier(const XcdBarrier& b) {
    asm volatile("s_waitcnt vmcnt(0)" ::: "memory");
    __syncthreads();
    if (threadIdx.x == 0) {
        unsigned* bar = b.bar;
        __builtin_amdgcn_s_waitcnt(0);
        unsigned nloc = b.st[0], nx = b.st[1];
        if (nloc == 0u) { xcd_barrier_complete(bar, b.x, nloc, nx); b.st[0] = nloc; b.st[1] = nx; }
        const unsigned old = xb_add(&bar[XB_XSUB(b.x)], 1u);
        const unsigned gen = old / nloc;
        if (old + 1u == (gen + 1u) * nloc) {
            __builtin_amdgcn_fence(__ATOMIC_RELEASE, "agent");
            asm volatile("s_waitcnt vmcnt(0)" ::: "memory");
            const unsigned og = xb_add(&bar[XB_TOP], 1u);
            const unsigned tg = og / nx;
            if (og + 1u == (tg + 1u) * nx) xb_add(&bar[XB_TOPGEN], 1u);
            else XB_SPIN(xb_ld(&bar[XB_TOPGEN]) == tg, bar);
            __builtin_amdgcn_fence(__ATOMIC_ACQUIRE, "agent");
            xb_add(&bar[XB_XGEN(b.x)], 1u);
            asm volatile("s_waitcnt vmcnt(0)" ::: "memory");
        } else {
            XB_SPIN(xb_ld(&bar[XB_XGEN(b.x)]) == gen, bar);
            __builtin_amdgcn_fence(__ATOMIC_ACQUIRE, "agent");
            asm volatile("s_waitcnt vmcnt(0)" ::: "memory");
        }
    }
    __syncthreads();
}

__device__ __forceinline__ float wave_sum(float v) {
    v += dppf<0xB1>(v); v += dppf<0x4E>(v); v += dppf<0x141>(v); v += dppf<0x140>(v);
    return xsum32(xsum16(v));
}
__device__ __forceinline__ float wave_max(float v) {
    v = fmaxf(v, dppf<0xB1>(v)); v = fmaxf(v, dppf<0x4E>(v)); v = fmaxf(v, dppf<0x141>(v)); v = fmaxf(v, dppf<0x140>(v));
    return xmax32(xmax16(v));
}
template <int F8S>
__device__ __forceinline__ void p0_transpose_item(const float* W, int ldw, int K, bf16* WT, int k0, int n0, int drow, LAS float* scr, int lane) {
#pragma unroll 8
    for (int i = 0; i < 32; ++i) { const int kk = 2 * i + (lane >> 5); scr[kk * 33 + (lane & 31)] = W[(size_t)(k0 + kk) * ldw + n0 + (lane & 31)]; }
    LDS_WAIT(); asm volatile("" ::: "memory");
    const int c = lane & 7;
#pragma unroll
    for (int j = 0; j < 4; ++j) { const int n = (lane >> 3) + 8 * j; const LAS float* s = scr + (8 * c) * 33 + n;
        if (F8S) { const float sc8 = (float)(1 << F8S); int w0 = 0, w1 = 0;
            w0 = __builtin_amdgcn_cvt_pk_fp8_f32(s[0 * 33] * sc8, s[1 * 33] * sc8, w0, false); w0 = __builtin_amdgcn_cvt_pk_fp8_f32(s[2 * 33] * sc8, s[3 * 33] * sc8, w0, true);
            w1 = __builtin_amdgcn_cvt_pk_fp8_f32(s[4 * 33] * sc8, s[5 * 33] * sc8, w1, false); w1 = __builtin_amdgcn_cvt_pk_fp8_f32(s[6 * 33] * sc8, s[7 * 33] * sc8, w1, true);
            *(GAS v2u*)((unsigned char*)WT + (size_t)(drow + n) * K + k0 + 8 * c) = (v2u){(unsigned)w0, (unsigned)w1}; }
        else { v4u o; o.x = pk2(s[0 * 33], s[1 * 33]); o.y = pk2(s[2 * 33], s[3 * 33]); o.z = pk2(s[4 * 33], s[5 * 33]); o.w = pk2(s[6 * 33], s[7 * 33]);
        *(GAS v4u*)(WT + (size_t)(drow + n) * K + k0 + 8 * c) = o; } }
    LDS_WAIT(); asm volatile("" ::: "memory");
}
template <int HP, int F8S = 0>
__device__ __forceinline__ void p0_matrix(const float* W, int ldw, int K, int ncols, bf16* WT, LAS float* scr, int lane, int gw, int NGW, int& base) {
    const int nblk = ncols / 32, items = (K / 64) * nblk;
    int first = gw - (base % NGW); if (first < 0) first += NGW;
    for (int r = first; r < items; r += NGW) {
        const int kb = r / nblk, nb = r % nblk, n0 = 32 * nb;
        int drow = n0;
        if (HP == 1) { const int tile = n0 >> 8, nl = n0 & 255, wc = nl >> 6, bj = (nl >> 5) & 1; drow = tile * 256 + 128 * bj + 32 * wc; }
        if (HP == 2) { const int isg = n0 >= FF, j = isg ? n0 - FF : n0; drow = (j >> 7) * 256 + (isg ? 128 : 0) + (j & 127); }
        p0_transpose_item<F8S>(W, ldw, K, WT, 64 * kb, n0, drow, scr, lane);
    }
    base += items;
}

struct Ptrs {
    const float *x, *c, *w_ada, *b_ada, *g_mix, *g_ffn, *fox_w_in, *fox_b_f, *fox_g_q, *fox_g_k, *fox_w_out,
                *dsa_w_in, *dsa_g_q, *dsa_g_k, *dsa_g_kidx, *dsa_w_out, *ffn_w_up, *ffn_conv_w, *ffn_conv_b, *ffn_w_down;
    float* out; unsigned char* ws;
};

__device__ __forceinline__ void p0_prologue(const Ptrs& P, LAS unsigned char* lds, int tid, int lane, int wave, int vcu, int G) {
    unsigned char* ws = P.ws;
    LAS float* scr = (LAS float*)(lds + RING_OFF + wave * 16384);
    const int gw = vcu * NWAVES + wave, NGW = G * NWAVES;
    int base = 0;
    p0_matrix<1, 5>(P.fox_w_in, FOX_IN, D, 3 * D, (bf16*)(ws + WS_WFIN), scr, lane, gw, NGW, base);
    p0_matrix<0, 5>(P.fox_w_out, D, D, D, (bf16*)(ws + WS_WFOUT), scr, lane, gw, NGW, base);
    p0_matrix<2, 5>(P.ffn_w_up, FF2, D, FF2, (bf16*)(ws + WS_WUP0), scr, lane, gw, NGW, base);
    p0_matrix<0, 6>(P.ffn_w_down, D, FF, D, (bf16*)(ws + WS_WDN0), scr, lane, gw, NGW, base);
    if (G % 16 != 0) {
    p0_matrix<1, 5>(P.dsa_w_in, DSA_IN, D, 3 * D / 2, (bf16*)(ws + WS_WDIN), scr, lane, gw, NGW, base);
    p0_matrix<1>(P.dsa_w_in + 3 * D / 2, DSA_IN, D, D / 2, (bf16*)(ws + WS_WDIN + 2 * MiB), scr, lane, gw, NGW, base);
    p0_matrix<0, 5>(P.dsa_w_out, D, D, D, (bf16*)(ws + WS_WDOUT), scr, lane, gw, NGW, base);
    }
    if (G % 16 != 0) {
    p0_matrix<2, 5>(P.ffn_w_up + (size_t)D * FF2, FF2, D, FF2, (bf16*)(ws + WS_WUP1), scr, lane, gw, NGW, base);
    p0_matrix<0, 6>(P.ffn_w_down + (size_t)FF * D, D, FF, D, (bf16*)(ws + WS_WDN1), scr, lane, gw, NGW, base);
    }
    if (G % 16 != 0) { bf16* wt = (bf16*)(ws + WS_WDTAIL); const int gt = vcu * NTHREADS + tid, NT_ = G * NTHREADS;
      for (int i = gt; i < 80 * D; i += NT_) { const int n = i / D, k = i % D; wt[i] = (n < 72) ? (bf16)f2bf(P.dsa_w_in[(size_t)k * DSA_IN + 2048 + n]) : (bf16)0; } }
    __syncthreads();
    { LAS float* cact = (LAS float*)(lds + RING_OFF);
      LAS float* part = (LAS float*)(lds + RING_OFF + 8192);
      for (int i = tid; i < 2 * D; i += NTHREADS) { const float v = P.c[i]; cact[i] = v / (1.f + __expf(-v)); }
      __syncthreads();
      float* MOD = (float*)(ws + WS_MOD);
      for (int task = vcu; task < 2 * 128; task += G) {
          const int layer = task / 128, cg = task % 128, lc = lane < 48 ? lane : 47, col = cg * 48 + lc;
          const float* w = P.w_ada + (size_t)layer * D * 6144 + col;
          float a0 = 0.f, a1 = 0.f;
#pragma unroll 32
          for (int k = wave * 128; k < wave * 128 + 128; ++k) { const float wv = w[(size_t)k * 6144]; a0 += cact[k] * wv; a1 += cact[D + k] * wv; }
          part[(wave * 2 + 0) * 64 + lane] = a0; part[(wave * 2 + 1) * 64 + lane] = a1;
          __syncthreads();
          if (wave < 2 && lane < 48) { float s = 0.f;
#pragma unroll
              for (int w8 = 0; w8 < 8; ++w8) s += part[(w8 * 2 + wave) * 64 + lane];
              MOD[((size_t)layer * 2 + wave) * 6144 + col] = s + P.b_ada[layer * 6144 + col]; }
          __syncthreads();
      } }
}

__device__ __forceinline__ void p0_late(const Ptrs& P, LAS unsigned char* lds, int tid, int lane, int wave, int widx, int nw, int which) {
    unsigned char* ws = P.ws;
    LAS float* scr = (LAS float*)(lds + RING_OFF + wave * 16384);
    const int gw = widx * NWAVES + wave, NGW = nw * NWAVES;
    int base = 0;
    if (which == 0) {
        p0_matrix<2, 5>(P.ffn_w_up + (size_t)D * FF2, FF2, D, FF2, (bf16*)(ws + WS_WUP1), scr, lane, gw, NGW, base);
        p0_matrix<1, 5>(P.dsa_w_in, DSA_IN, D, 3 * D / 2, (bf16*)(ws + WS_WDIN), scr, lane, gw, NGW, base);
        p0_matrix<1>(P.dsa_w_in + 3 * D / 2, DSA_IN, D, D / 2, (bf16*)(ws + WS_WDIN + 2 * MiB), scr, lane, gw, NGW, base);
        p0_matrix<0, 5>(P.dsa_w_out, D, D, D, (bf16*)(ws + WS_WDOUT), scr, lane, gw, NGW, base);
        bf16* wt = (bf16*)(ws + WS_WDTAIL); const int gt = widx * NTHREADS + tid, NT_ = nw * NTHREADS;
        for (int i = gt; i < 80 * D; i += NT_) { const int n = i / D, k = i % D; wt[i] = (n < 72) ? (bf16)f2bf(P.dsa_w_in[(size_t)k * DSA_IN + 2048 + n]) : (bf16)0; }
    } else {
        p0_matrix<0, 6>(P.ffn_w_down + (size_t)FF * D, D, FF, D, (bf16*)(ws + WS_WDN1), scr, lane, gw, NGW, base);
    }
}

template <bool FGATE, bool XIN16, int OUT8 = 0>
__device__ __forceinline__ void norm_phase(const void* xin, const float* gnorm, const float* modL, int sh_chunk, int sc_chunk, bf16* hout, unsigned char* hout8,
                                           const float* fox_w_in, const float* b_f, float* logf, LAS unsigned char* lds, int tid, int lane, int wave, int vcu, int G) {
    LAS float* wft = (LAS float*)(lds + RING_OFF);
    if (FGATE) {
        for (int i = tid; i < 16 * D; i += NTHREADS) { const int c = i >> 4, hh = i & 15; wft[hh * D + c] = fox_w_in[(size_t)c * FOX_IN + 3 * D + hh]; }
        __syncthreads();
    }
    const int gw = vcu * NWAVES + wave, NGW = G * NWAVES;
    for (int b = 0; b < BATCH; ++b) {
        f32x4 Gv[4], Sv[4];
#pragma unroll
        for (int j = 0; j < 4; ++j) { const int c = 4 * lane + 256 * j;
            const f32x4 g4 = *(const f32x4*)(gnorm + c), sc4 = *(const f32x4*)(modL + (size_t)b * 6144 + sc_chunk * D + c);
            Gv[j] = g4 * (sc4 + 1.0f); Sv[j] = *(const f32x4*)(modL + (size_t)b * 6144 + sh_chunk * D + c); }
        for (int t = gw; t < T; t += NGW) {
            const size_t m = (size_t)b * T + t;
            f32x4 v[4]; float ss = 0.f;
            if (XIN16) { const GAS v2u* xr = (const GAS v2u*)((const bf16*)xin + m * D) + lane;
#pragma unroll
                for (int j = 0; j < 4; ++j) { const v2u r = xr[64 * j]; v[j] = (f32x4){__uint_as_float(r.x << 16), __uint_as_float(r.x & 0xffff0000u), __uint_as_float(r.y << 16), __uint_as_float(r.y & 0xffff0000u)}; }
            } else { const GAS f32x4* xr = (const GAS f32x4*)((const float*)xin + m * D) + lane;
#pragma unroll
                for (int j = 0; j < 4; ++j) v[j] = xr[64 * j]; }
#pragma unroll
            for (int j = 0; j < 4; ++j) ss += (v[j].x * v[j].x + v[j].y * v[j].y) + (v[j].z * v[j].z + v[j].w * v[j].w);
            const float rstd = __builtin_amdgcn_rsqf(wave_sum(ss) * (1.f / D) + EPS);
            GAS unsigned long long* o8 = (GAS unsigned long long*)(hout + m * D) + lane;
#pragma unroll
            for (int j = 0; j < 4; ++j) { v[j] = v[j] * rstd * Gv[j] + Sv[j];
                if (OUT8) { int w8 = 0; w8 = __builtin_amdgcn_cvt_pk_fp8_f32(v[j].x, v[j].y, w8, false); w8 = __builtin_amdgcn_cvt_pk_fp8_f32(v[j].z, v[j].w, w8, true);
                    ((GAS unsigned*)(hout8 + m * D))[lane + 64 * j] = (unsigned)w8; }
                if (OUT8 != 1) o8[64 * j] = (unsigned long long)pk2(v[j].x, v[j].y) | ((unsigned long long)pk2(v[j].z, v[j].w) << 32); }
            if (FGATE) {
                float acc[16];
                typedef float f32x2 __attribute__((ext_vector_type(2)));
#pragma unroll
                for (int hh = 0; hh < 16; ++hh) { f32x2 a2 = (f32x2){0.f, 0.f};
#pragma unroll
                    for (int j = 0; j < 4; ++j) { const f32x4 w4 = *(const LAS f32x4*)(wft + hh * D + 256 * j + 4 * lane);
                        a2 = (f32x2){v[j].x, v[j].y} * (f32x2){w4.x, w4.y} + a2; a2 = (f32x2){v[j].z, v[j].w} * (f32x2){w4.z, w4.w} + a2; }
                    acc[hh] = a2.x + a2.y; if ((hh & 3) == 3) asm volatile("" : "+v"(acc[hh]) :: "memory"); }
                float b8[8], c4[4];
#pragma unroll
                for (int i = 0; i < 8; ++i) { const auto rr = __builtin_amdgcn_permlane32_swap(__builtin_bit_cast(unsigned, acc[i]), __builtin_bit_cast(unsigned, acc[i + 8]), false, false); const unsigned r0 = rr[0], r1 = rr[1];
                    b8[i] = __builtin_bit_cast(float, r0) + __builtin_bit_cast(float, r1); }
#pragma unroll
                for (int i = 0; i < 4; ++i) { const auto rr = __builtin_amdgcn_permlane16_swap(__builtin_bit_cast(unsigned, b8[i]), __builtin_bit_cast(unsigned, b8[i + 4]), false, false); const unsigned r0 = rr[0], r1 = rr[1];
                    c4[i] = __builtin_bit_cast(float, r0) + __builtin_bit_cast(float, r1); }
#pragma unroll
                for (int i = 0; i < 4; ++i) { float t = c4[i]; t += dppf<0xB1>(t); t += dppf<0x4E>(t); t += dppf<0x141>(t); t += dppf<0x140>(t); c4[i] = t; }
                const int j4 = lane & 15; float r = c4[0]; r = (j4 == 1) ? c4[1] : r; r = (j4 == 2) ? c4[2] : r; r = (j4 == 3) ? c4[3] : r;
                const int row16 = lane >> 4, head = (row16 >> 1) * 8 + (row16 & 1) * 4 + j4;
                if (j4 < 4) { const float z = r + b_f[head]; logf[m * 16 + head] = fminf(z, 0.f) - log1pf(__expf(-fabsf(z))); }
            }
        }
    }
    if (FGATE) __syncthreads();
}

__device__ __forceinline__ void fox_scan(const float* logf, float* BETA, unsigned char* KE, int seq, LAS float* red  , int tid, int lane, int wave) {
    const int b = seq >> 4, hh = seq & 15;
    float v[16]; float run = 0.f;
#pragma unroll
    for (int k = 0; k < 16; ++k) { run += logf[((size_t)b * T + 16 * tid + k) * 16 + hh]; v[k] = run; }
    float inc = run;
#pragma unroll
    for (int o = 1; o < 64; o <<= 1) { const float n = __shfl_up(inc, o); if (lane >= o) inc += n; }
    if (lane == 63) red[wave] = inc;
    __syncthreads();
    float pre = inc - run;
#pragma unroll
    for (int w8 = 0; w8 < 8; ++w8) if (w8 < wave) pre += red[w8];
#pragma unroll
    for (int k = 0; k < 16; ++k) {
        const int t = 16 * tid + k; const float be = -(pre + v[k]) * LOG2E;
        BETA[(size_t)seq * T + t] = be;
        const unsigned h0 = f2bf(be); const float r1 = be - bf2f(h0); const unsigned h1 = f2bf(r1); const float r2 = r1 - bf2f(h1); const unsigned h2 = f2bf(r2);
        unsigned char* tile = KE + ((size_t)seq * (T / 64) + (t >> 6)) * 2048 + (t & 63) * 16;
        v4u e; e.x = h0 | (h1 << 16); e.y = h2 | 0x3f800000u; e.z = 0x3f803f80u; e.w = 0u;
        *(GAS v4u*)tile = e; *(GAS v4u*)(tile + 1024) = (v4u){0u, 0u, 0u, 0u};
    }
    __syncthreads();
}

__device__ __forceinline__ void fox_scan8(const float* logf, float* BETA, unsigned char* KE, int seq, int c, LAS float* red  , int tid, int lane, int wave) {
    const int b = seq >> 4, hh = seq & 15;
    const float* lf = logf + (size_t)b * T * 16 + hh;
    float p = 0.f;
    for (int t = tid; t < 1024 * c; t += NTHREADS) p += lf[(size_t)t * 16];
    p = wave_sum(p);
    if (lane == 0) red[8 + wave] = p;
    const int t0 = 1024 * c + 2 * tid;
    const float v0 = lf[(size_t)t0 * 16], v1 = v0 + lf[(size_t)(t0 + 1) * 16];
    const float run = v1; float inc = run;
#pragma unroll
    for (int o = 1; o < 64; o <<= 1) { const float n = __shfl_up(inc, o); if (lane >= o) inc += n; }
    if (lane == 63) red[wave] = inc;
    __syncthreads();
    float pre = inc - run;
#pragma unroll
    for (int w8 = 0; w8 < 8; ++w8) { if (w8 < wave) pre += red[w8]; pre += red[8 + w8]; }
#pragma unroll
    for (int k = 0; k < 2; ++k) {
        const int t = t0 + k; const float be = -(pre + (k == 0 ? v0 : v1)) * LOG2E;
        BETA[(size_t)seq * T + t] = be;
        const unsigned h0 = f2bf(be); const float r1 = be - bf2f(h0); const unsigned h1 = f2bf(r1); const float r2 = r1 - bf2f(h1); const unsigned h2 = f2bf(r2);
        unsigned char* tile = KE + ((size_t)seq * (T / 64) + (t >> 6)) * 2048 + (t & 63) * 16;
        v4u e; e.x = h0 | (h1 << 16); e.y = h2 | 0x3f800000u; e.z = 0x3f803f80u; e.w = 0u;
        *(GAS v4u*)tile = e; *(GAS v4u*)(tile + 1024) = (v4u){0u, 0u, 0u, 0u};
    }
    __syncthreads();
}

__device__ __forceinline__ void conv_fixup(bf16* U, const float* sideA0, const float* sideG0, const float* sideA1, const float* cw, const float* cb, int pm, int tid) {
    const bool bstart = (pm % (T / 256)) == 0;
    for (int i = tid; i < 2 * (FF / 4); i += NTHREADS) {
        const int r = i / (FF / 4), c = (i % (FF / 4)) * 4;
        const f32x4 a0 = *(const f32x4*)(sideA0 + ((size_t)pm * 2 + r) * FF + c), g0 = *(const f32x4*)(sideG0 + ((size_t)pm * 2 + r) * FF + c);
        const f32x4 z = (f32x4){0.f, 0.f, 0.f, 0.f};
        f32x4 m1, m2;
        if (r == 1) { m1 = *(const f32x4*)(sideA0 + ((size_t)pm * 2) * FF + c); m2 = bstart ? z : *(const f32x4*)(sideA1 + ((size_t)(pm - 1) * 2 + 1) * FF + c); }
        else { m1 = bstart ? z : *(const f32x4*)(sideA1 + ((size_t)(pm - 1) * 2 + 1) * FF + c); m2 = bstart ? z : *(const f32x4*)(sideA1 + ((size_t)(pm - 1) * 2) * FF + c); }
        const f32x4 w0 = *(const f32x4*)(cw + c), w1 = *(const f32x4*)(cw + FF + c), w2 = *(const f32x4*)(cw + 2 * FF + c), bb = *(const f32x4*)(cb + c);
        float uo[4];
#pragma unroll
        for (int e = 0; e < 4; ++e) { const float s = fmaf(w0[e], m2[e], fmaf(w1[e], m1[e], fmaf(w2[e], a0[e], bb[e]))); uo[e] = s * __builtin_amdgcn_rcpf(1.f + __builtin_amdgcn_exp2f(-LOG2E * s)) * g0[e]; }
        { int w8 = 0; w8 = __builtin_amdgcn_cvt_pk_fp8_f32(uo[0], uo[1], w8, false); w8 = __builtin_amdgcn_cvt_pk_fp8_f32(uo[2], uo[3], w8, true);
          *(GAS unsigned*)((unsigned char*)U + ((size_t)pm * 256 + r) * FF + c) = (unsigned)w8; }
    }
    asm volatile("s_waitcnt vmcnt(0)" ::: "memory");
    __syncthreads();
}
namespace dsa {
typedef float f32x16 __attribute__((ext_vector_type(16)));
typedef unsigned long long u64;
constexpr int QT = 16;
constexpr int TOPK = 256;
constexpr int HIST_OFF = 0;
constexpr int SEL_OFF = 135168;
constexpr int ST_OFF = 143360;
constexpr int CAP = 1024;
constexpr int DUMMY_OFF = 131584;
constexpr float WSCALE = 0.04419417382415922f;

__device__ __forceinline__ void tail_phase(const bf16* Hb, const bf16* WT, const float* g_kidx, bf16* KI, float* WI, int lane, int gw, int NGW) {
    const int n16 = lane & 15, q4 = lane >> 4;
    for (int task = gw; task < M / 16; task += NGW) {
        const int row0 = task * 16;
        f32x4 acc[5];
#pragma unroll
        for (int cb = 0; cb < 5; ++cb) acc[cb] = (f32x4){0.f, 0.f, 0.f, 0.f};
        const bf16* ap = Hb + (size_t)(row0 + n16) * D + 8 * q4;
        const bf16* bp = WT + (size_t)n16 * D + 8 * q4;
#pragma unroll 4
        for (int s = 0; s < 32; ++s) {
            const bf16x8 a = *(const GAS bf16x8*)(ap + 32 * s);
#pragma unroll
            for (int cb = 0; cb < 5; ++cb) { const bf16x8 b = *(const GAS bf16x8*)(bp + (size_t)cb * 16 * D + 32 * s); acc[cb] = __builtin_amdgcn_mfma_f32_16x16x32_bf16(a, b, acc[cb], 0, 0, 0); }
        }
        float gk[4];
#pragma unroll
        for (int cb = 0; cb < 4; ++cb) gk[cb] = g_kidx[16 * cb + n16];
#pragma unroll
        for (int i = 0; i < 4; ++i) {
            const int tok = row0 + 4 * q4 + i;
            float ss = (acc[0][i] * acc[0][i] + acc[1][i] * acc[1][i]) + (acc[2][i] * acc[2][i] + acc[3][i] * acc[3][i]);
            ss += __shfl_xor(ss, 1); ss += __shfl_xor(ss, 2); ss += __shfl_xor(ss, 4); ss += __shfl_xor(ss, 8);
            const float rs = __builtin_amdgcn_rsqf(ss * (1.f / 64.f) + EPS);
#pragma unroll
            for (int cb = 0; cb < 4; ++cb) KI[(size_t)tok * 64 + 16 * cb + n16] = (bf16)f2bf(acc[cb][i] * rs * gk[cb]);
            if (n16 < 8) WI[(size_t)tok * 8 + n16] = acc[4][i] * WSCALE;
        }
    }
}

__device__ __forceinline__ void tail_phase_ks(const bf16* Hb, const bf16* WT, const float* g_kidx, bf16* KI, float* WI, LAS unsigned char* lds, int lane, int wave, int task0, int ntask) {
    const int n16 = lane & 15, q4 = lane >> 4, k0 = 128 * wave + 8 * q4;
    bf16x8 bw[4][5];
#pragma unroll
    for (int s = 0; s < 4; ++s)
#pragma unroll
        for (int cb = 0; cb < 5; ++cb) bw[s][cb] = *(const GAS bf16x8*)(WT + (size_t)(cb * 16 + n16) * D + k0 + 32 * s);
#pragma unroll 1
    for (int j = 0; j < ntask; ++j) {
        bf16x8 an[4];
#pragma unroll
        for (int s = 0; s < 4; ++s) an[s] = *(const GAS bf16x8*)(Hb + (size_t)((task0 + j) * 16 + n16) * D + k0 + 32 * s);
        f32x4 acc[5];
#pragma unroll
        for (int cb = 0; cb < 5; ++cb) { acc[cb] = (f32x4){0.f, 0.f, 0.f, 0.f};
#pragma unroll
            for (int s = 0; s < 4; ++s) acc[cb] = __builtin_amdgcn_mfma_f32_16x16x32_bf16(an[s], bw[s][cb], acc[cb], 0, 0, 0); }
        LAS f32x4* buf = (LAS f32x4*)(lds + (j & 1) * 40960);
#pragma unroll
        for (int cb = 0; cb < 5; ++cb) buf[(wave * 5 + cb) * 64 + lane] = acc[cb];
        __syncthreads();
        if (wave == (j & 7)) {
#pragma unroll
            for (int cb = 0; cb < 5; ++cb) { f32x4 t = buf[cb * 64 + lane];
#pragma unroll
                for (int w8 = 1; w8 < 8; ++w8) t += buf[(w8 * 5 + cb) * 64 + lane];
                acc[cb] = t; }
            const int row0 = (task0 + j) * 16;
            float gk[4];
#pragma unroll
            for (int cb = 0; cb < 4; ++cb) gk[cb] = g_kidx[16 * cb + n16];
#pragma unroll
            for (int i = 0; i < 4; ++i) {
                const int tok = row0 + 4 * q4 + i;
                float ss = (acc[0][i] * acc[0][i] + acc[1][i] * acc[1][i]) + (acc[2][i] * acc[2][i] + acc[3][i] * acc[3][i]);
                ss += dppf<0xB1>(ss); ss += dppf<0x4E>(ss); ss += dppf<0x141>(ss); ss += dppf<0x140>(ss);
                const float rs = __builtin_amdgcn_rsqf(ss * (1.f / 64.f) + EPS);
#pragma unroll
                for (int cb = 0; cb < 4; ++cb) KI[(size_t)tok * 64 + 16 * cb + n16] = (bf16)f2bf(acc[cb][i] * rs * gk[cb]);
                if (n16 < 8) WI[(size_t)tok * 8 + n16] = acc[4][i] * WSCALE;
            }
        }
    }
    __syncthreads();
}

__device__ __forceinline__ v4u f8x8_to_bf16(unsigned a, unsigned b) {
    typedef float f32x2 __attribute__((ext_vector_type(2)));
    const f32x2 a0 = __builtin_amdgcn_cvt_pk_f32_fp8((int)a, false), a1 = __builtin_amdgcn_cvt_pk_f32_fp8((int)a, true), b0 = __builtin_amdgcn_cvt_pk_f32_fp8((int)b, false), b1 = __builtin_amdgcn_cvt_pk_f32_fp8((int)b, true);
    v4u r; r.x = __builtin_amdgcn_perm(__float_as_uint(a0.y), __float_as_uint(a0.x), 0x07060302u); r.y = __builtin_amdgcn_perm(__float_as_uint(a1.y), __float_as_uint(a1.x), 0x07060302u);
    r.z = __builtin_amdgcn_perm(__float_as_uint(b0.y), __float_as_uint(b0.x), 0x07060302u); r.w = __builtin_amdgcn_perm(__float_as_uint(b1.y), __float_as_uint(b1.x), 0x07060302u); return r;
}
__device__ __forceinline__ u64 make_key(float s, int kidx) {
    const unsigned u = __float_as_uint(s); const unsigned sk = u ^ ((unsigned)((int)u >> 31) | 0x80000000u);
    return ((u64)sk << 13) | (u64)(8191 - kidx);
}
__device__ __forceinline__ float relu_i(float x) { const int b = __float_as_int(x); return __int_as_float(b > 0 ? b : 0); }
__device__ __forceinline__ unsigned skey32(float s) { const unsigned u = __float_as_uint(s); return u ^ ((unsigned)((int)u >> 31) | 0x80000000u); }
template <int MODE, bool L0, int PROBE, bool ALLV, int SMUL, bool RINGB>
__device__ __forceinline__ void idx_body(const bf16x8 (&qa)[4][4], const bf16* KIb, int t0q, int nst, int st_, int key_l, int hi, LAS unsigned char* lds, const u64 (&Pq)[4][2], unsigned hbase,
                                         bf16x8 (&kb)[4], bf16x8 (&kn)[4], f32x16& acc, int level, int hi_shift, int lo_shift, unsigned mask) {
    {
        const int kidx = 32 * SMUL * st_ + key_l;
        unsigned sks[4][2];
        constexpr bool allvalid = ALLV;
#pragma unroll
        for (int rb = 0; rb < 4; ++rb) {
            f32x16 accN = f32x16{};
            if (rb < 3) {
#pragma unroll
                for (int ks = 0; ks < 4; ++ks) accN = __builtin_amdgcn_mfma_f32_32x32x16_bf16(qa[rb + 1][ks], kb[ks], accN, 0, 0, 0);
            } else if (RINGB) {
                { const int kx = (st_ + 24 < nst) ? kidx + 768 * SMUL : kidx;
#pragma unroll
                  for (int ks = 0; ks < 4; ++ks) kb[ks] = *(const GAS bf16x8*)(KIb + (size_t)kx * 64 + 16 * ks + 8 * hi); }
#pragma unroll
                for (int ks = 0; ks < 4; ++ks) accN = __builtin_amdgcn_mfma_f32_32x32x16_bf16(qa[0][ks], kn[ks], accN, 0, 0, 0);
            } else {
#pragma unroll
                for (int ks = 0; ks < 4; ++ks) kb[ks] = kn[ks];
                { const int kx = (st_ + 16 < nst) ? kidx + 512 * SMUL : kidx;
#pragma unroll
                  for (int ks = 0; ks < 4; ++ks) kn[ks] = *(const GAS bf16x8*)(KIb + (size_t)(PROBE == 2 ? key_l : kx) * 64 + 16 * ks + 8 * hi); }
#pragma unroll
                for (int ks = 0; ks < 4; ++ks) accN = __builtin_amdgcn_mfma_f32_32x32x16_bf16(qa[0][ks], kb[ks], accN, 0, 0, 0);
            }
            __builtin_amdgcn_sched_barrier(0);
            float sc[2];
            { LAS const f32x4* wp = (LAS const f32x4*)(lds + ST_OFF + 1024 + (4 * rb + 2 * hi) * 32);
              const f32x4 w0 = wp[0], w1 = wp[1], w2 = wp[2], w3 = wp[3];
              float s0 = relu_i(acc[0]) * w0[0];
#pragma unroll
              for (int i = 1; i < 4; ++i) s0 = fmaf(relu_i(acc[i]), w0[i], s0);
#pragma unroll
              for (int i = 0; i < 4; ++i) s0 = fmaf(relu_i(acc[4 + i]), w1[i], s0);
              asm volatile("" : "+v"(s0));
              float s1 = relu_i(acc[8]) * w2[0];
#pragma unroll
              for (int i = 1; i < 4; ++i) s1 = fmaf(relu_i(acc[8 + i]), w2[i], s1);
#pragma unroll
              for (int i = 0; i < 4; ++i) s1 = fmaf(relu_i(acc[12 + i]), w3[i], s1);
              sc[0] = s0; sc[1] = s1; }
#pragma unroll
            for (int e = 0; e < 2; ++e) {
                const int ql = 4 * rb + 2 * hi + e; const int t = t0q + ql;
                const unsigned sk = skey32(sc[e]);
                if (L0 && MODE == 0) {
                    const unsigned skv = allvalid ? sk : ((kidx <= t) ? sk : 0u);
                    const unsigned addr = hbase + (unsigned)(4 * rb + e) * 8192u + ((skv >> 21) << 2);
                    const unsigned vv = (skv & 0x100000u) ? 0x10000u : 1u;
                    if (PROBE == 1) { asm volatile("" :: "v"(addr), "v"(vv)); }
                    else __hip_atomic_fetch_add((LAS unsigned*)(uintptr_t)addr, vv, __ATOMIC_RELAXED, __HIP_MEMORY_SCOPE_WORKGROUP);
                } else if (L0 && MODE == 3) {
                    sks[rb][e] = __float_as_uint(sc[e]);
                } else if (L0 && MODE == 1) {
                    sks[rb][e] = sk;
                } else {
                    const bool valid = kidx <= t;
                    const u64 K = ((u64)sk << 13) | (u64)(8191 - kidx);
                    if (MODE == 0) {
                        bool ok = valid;
                        if (level > 0) ok = ok && ((K >> hi_shift) == Pq[rb][e]);
                        if (ok) { const unsigned bin = (unsigned)(K >> lo_shift) & mask;
                            __hip_atomic_fetch_add((LAS unsigned*)(lds + HIST_OFF + ql * 8192) + (bin >> 1), 1u << (16 * (bin & 1)), __ATOMIC_RELAXED, __HIP_MEMORY_SCOPE_WORKGROUP); }
                    } else if (valid) {
                        const u64 pfx = K >> lo_shift;
                        LAS unsigned* st = (LAS unsigned*)(lds + ST_OFF + ql * 32);
                        if (pfx > Pq[rb][e]) {
                            const unsigned slot = __hip_atomic_fetch_add(st + 3, 1u, __ATOMIC_RELAXED, __HIP_MEMORY_SCOPE_WORKGROUP) & 0xffffu;
                            if (slot < (unsigned)TOPK) ((LAS unsigned short*)(lds + SEL_OFF))[ql * TOPK + slot] = (unsigned short)kidx;
                        } else if (pfx == Pq[rb][e]) {
                            const unsigned slot = __hip_atomic_fetch_add(st + 3, 0x10000u, __ATOMIC_RELAXED, __HIP_MEMORY_SCOPE_WORKGROUP) >> 16;
                            if (slot < (unsigned)CAP) ((LAS u64*)(lds + HIST_OFF))[ql * CAP + slot] = K;
                        }
                    }
                }
            }
            if (L0 && MODE == 3 && (rb & 1)) {
                const unsigned dmy = (unsigned)(uintptr_t)(lds + DUMMY_OFF) + 8u * (unsigned)(key_l + 32 * hi);
                unsigned old[2][2]; bool ps[2][2];
#pragma unroll
                for (int r2 = 0; r2 < 2; ++r2)
#pragma unroll
                    for (int e = 0; e < 2; ++e) { const int rbb = rb - 1 + r2, ql = 4 * rbb + 2 * hi + e; const bool valid = allvalid || (kidx <= t0q + ql);
                        ps[r2][e] = valid && (__uint_as_float(sks[rbb][e]) >= __uint_as_float((unsigned)Pq[rbb][e]));
                        const unsigned a = ps[r2][e] ? (unsigned)(uintptr_t)(lds + ST_OFF + ql * 32 + 12) : dmy;
                        old[r2][e] = __hip_atomic_fetch_add((LAS unsigned*)(uintptr_t)a, 0x10000u, __ATOMIC_RELAXED, __HIP_MEMORY_SCOPE_WORKGROUP); }
#pragma unroll
                for (int r2 = 0; r2 < 2; ++r2)
#pragma unroll
                    for (int e = 0; e < 2; ++e) { const int rbb = rb - 1 + r2, ql = 4 * rbb + 2 * hi + e;
                        unsigned slot = old[r2][e] >> 16; slot = slot < (unsigned)(CAP - 1) ? slot : (unsigned)(CAP - 1);
                        const unsigned a = ps[r2][e] ? (unsigned)(uintptr_t)(lds + HIST_OFF) + ((unsigned)(ql * CAP) + slot) * 8u : dmy;
                        LAS unsigned* pa = (LAS unsigned*)(uintptr_t)a; pa[0] = (unsigned)(8191 - kidx); pa[1] = sks[rbb][e]; }
            }
            if (L0 && MODE == 1 && (rb & 1)) {
                unsigned old[2][2];
#pragma unroll
                for (int r2 = 0; r2 < 2; ++r2)
#pragma unroll
                    for (int e = 0; e < 2; ++e) { const int rbb = rb - 1 + r2, ql = 4 * rbb + 2 * hi + e; const unsigned bin = sks[rbb][e] >> 20, Tb = (unsigned)Pq[rbb][e]; const bool valid = allvalid || (kidx <= t0q + ql);
                        old[r2][e] = 0u;
                        if (valid && bin >= Tb) old[r2][e] = __hip_atomic_fetch_add((LAS unsigned*)(lds + ST_OFF + ql * 32) + 3, (MODE == 1 && bin > Tb) ? 1u : 0x10000u, __ATOMIC_RELAXED, __HIP_MEMORY_SCOPE_WORKGROUP); }
#pragma unroll
                for (int r2 = 0; r2 < 2; ++r2)
#pragma unroll
                    for (int e = 0; e < 2; ++e) { const int rbb = rb - 1 + r2, ql = 4 * rbb + 2 * hi + e; const unsigned bin = sks[rbb][e] >> 20, Tb = (unsigned)Pq[rbb][e]; const bool valid = allvalid || (kidx <= t0q + ql);
                        if (MODE == 1 && valid && bin > Tb) { const unsigned slot = old[r2][e] & 0xffffu; if (slot < (unsigned)TOPK) ((LAS unsigned short*)(lds + SEL_OFF))[ql * TOPK + slot] = (unsigned short)kidx; }
                        else if (valid && (MODE == 3 ? bin >= Tb : bin == Tb)) { const unsigned slot = old[r2][e] >> 16; if (slot < (unsigned)CAP) ((LAS u64*)(lds + HIST_OFF))[ql * CAP + slot] = ((u64)sks[rbb][e] << 13) | (u64)(8191 - kidx); } }
            }
            acc = accN;
        }
    }
}
template <int MODE, bool L0, int PROBE, bool ALLV, int SMUL>
__device__ __forceinline__ void idx_loop(const bf16x8 (&qa)[4][4], const bf16* KIb, int t0q, int nst, int st_begin, int st_end, int key_l, int hi, LAS unsigned char* lds, const u64 (&Pq)[4][2], unsigned hbase,
                                         bf16x8 (&kb)[4], bf16x8 (&kn)[4], f32x16& acc, int level, int hi_shift, int lo_shift, unsigned mask) {
    for (int st_ = st_begin; st_ < st_end; st_ += 8)
        idx_body<MODE, L0, PROBE, ALLV, SMUL, false>(qa, KIb, t0q, nst, st_, key_l, hi, lds, Pq, hbase, kb, kn, acc, level, hi_shift, lo_shift, mask);
}
template <int MODE, bool L0, int SMUL>
__device__ __forceinline__ int idx_loop_ring(const bf16x8 (&qa)[4][4], const bf16* KIb, int t0q, int nst, int st_begin, int st_end, int key_l, int hi, LAS unsigned char* lds, const u64 (&Pq)[4][2], unsigned hbase,
                                             bf16x8 (&k0)[4], bf16x8 (&k1)[4], bf16x8 (&k2)[4], f32x16& acc, int level, int hi_shift, int lo_shift, unsigned mask) {
    int st_ = st_begin;
    for (; st_ + 16 < st_end; st_ += 24) {
        idx_body<MODE, L0, 0, true, SMUL, true>(qa, KIb, t0q, nst, st_, key_l, hi, lds, Pq, hbase, k0, k1, acc, level, hi_shift, lo_shift, mask);
        idx_body<MODE, L0, 0, true, SMUL, true>(qa, KIb, t0q, nst, st_ + 8, key_l, hi, lds, Pq, hbase, k1, k2, acc, level, hi_shift, lo_shift, mask);
        idx_body<MODE, L0, 0, true, SMUL, true>(qa, KIb, t0q, nst, st_ + 16, key_l, hi, lds, Pq, hbase, k2, k0, acc, level, hi_shift, lo_shift, mask);
    }
    return st_;
}
template <int SMUL>
__device__ __forceinline__ void idx_preload(const bf16* KIb, int nst, int wave, int lane, bf16x8 (&kb)[4], bf16x8 (&kn)[4]) {
    const int key_l = lane & 31, hi = lane >> 5;
    const int kc = (wave < nst) ? 32 * SMUL * wave + key_l : key_l;
    const int kc2 = (wave + 8 < nst) ? kc + 256 * SMUL : kc;
#pragma unroll
    for (int ks = 0; ks < 4; ++ks) { kb[ks] = *(const GAS bf16x8*)(KIb + (size_t)kc * 64 + 16 * ks + 8 * hi); kn[ks] = *(const GAS bf16x8*)(KIb + (size_t)kc2 * 64 + 16 * ks + 8 * hi); }
}
template <int MODE, bool L0, int PROBE = 0, int SMUL = 1>
__device__ __forceinline__ void idx_pass(const bf16x8 (&qa)[4][4], const bf16* KIb, int t0q, int nst, int wave, int lane_in, LAS unsigned char* lds, int level, int hi_shift, int lo_shift, unsigned mask, const bf16x8 (*pre)[8] = nullptr) {
    int lane = lane_in; asm volatile("" : "+v"(lane));
    const int key_l = lane & 31, hi = lane >> 5;
    u64 Pq[4][2];
#pragma unroll
    for (int rb = 0; rb < 4; ++rb)
#pragma unroll
        for (int e = 0; e < 2; ++e) { const int ql = 4 * rb + 2 * hi + e; LAS const unsigned* st = (LAS const unsigned*)(lds + ST_OFF + ql * 32);
            Pq[rb][e] = (u64)st[0] | ((u64)st[1] << 32);
            if (L0 && MODE == 3) { const unsigned Tb = (unsigned)Pq[rb][e], kb_ = Tb << 20;
                Pq[rb][e] = (u64)((kb_ & 0x80000000u) ? (kb_ ^ 0x80000000u) : ~kb_); } }
    const unsigned hbase = (unsigned)(uintptr_t)(lds + HIST_OFF) + (unsigned)hi * 16384u;
    bf16x8 kb[4], kn[4];
    if (pre) {
#pragma unroll
        for (int ks = 0; ks < 4; ++ks) { kb[ks] = (*pre)[ks]; kn[ks] = (*pre)[4 + ks]; }
    } else idx_preload<SMUL>(KIb, nst, wave, lane, kb, kn);
    constexpr bool RING = (PROBE == 0) && (MODE == 3);
    bf16x8 k2[4];
    if (RING) { const int kc3 = (wave + 16 < nst) ? 32 * SMUL * (wave + 16) + key_l : key_l;
#pragma unroll
        for (int ks = 0; ks < 4; ++ks) k2[ks] = *(const GAS bf16x8*)(KIb + (size_t)kc3 * 64 + 16 * ks + 8 * hi); }
    f32x16 acc = f32x16{};
#pragma unroll
    for (int ks = 0; ks < 4; ++ks) acc = __builtin_amdgcn_mfma_f32_32x32x16_bf16(qa[0][ks], kb[ks], acc, 0, 0, 0);
    if (SMUL != 1) {
        int st0 = wave;
        if (RING) st0 = idx_loop_ring<MODE, L0, SMUL>(qa, KIb, t0q, nst, wave, nst, key_l, hi, lds, Pq, hbase, kb, kn, k2, acc, level, hi_shift, lo_shift, mask);
        idx_loop<MODE, L0, PROBE, true, SMUL>(qa, KIb, t0q, nst, st0, nst, key_l, hi, lds, Pq, hbase, kb, kn, acc, level, hi_shift, lo_shift, mask);
        return;
    }
    const int nfull = (t0q + 1) >> 5; int st_split = wave; if (nfull > wave) st_split = wave + ((nfull - wave + 7) >> 3) * 8;
    int st0 = wave;
    if (RING) st0 = idx_loop_ring<MODE, L0, 1>(qa, KIb, t0q, nst, wave, nfull, key_l, hi, lds, Pq, hbase, kb, kn, k2, acc, level, hi_shift, lo_shift, mask);
    idx_loop<MODE, L0, PROBE, true, 1>(qa, KIb, t0q, nst, st0, nfull, key_l, hi, lds, Pq, hbase, kb, kn, acc, level, hi_shift, lo_shift, mask);
    idx_loop<MODE, L0, PROBE, false, 1>(qa, KIb, t0q, nst, st_split, nst, key_l, hi, lds, Pq, hbase, kb, kn, acc, level, hi_shift, lo_shift, mask);
}

__device__ __forceinline__ void find_bin(LAS unsigned char* lds, int row, int lane_in, int bits) {
    int lane = lane_in; asm volatile("" : "+v"(lane));
    LAS unsigned* st = (LAS unsigned*)(lds + ST_OFF + row * 32);
    if (st[6] != 0u) return;
    const unsigned need = st[2];
    LAS const unsigned* hrow = (LAS const unsigned*)(lds + HIST_OFF + row * 8192) + 32 * lane;
    v4u hw[8]; unsigned tot = 0;
#pragma unroll
    for (int i = 0; i < 8; ++i) { hw[i] = *(LAS const v4u*)(hrow + 4 * i);
#pragma unroll
        for (int e = 0; e < 4; ++e) tot += (hw[i][e] & 0xffffu) + (hw[i][e] >> 16); }
    unsigned suf = tot;
#pragma unroll
    for (int o = 1; o < 64; o <<= 1) { const unsigned n = (unsigned)__builtin_amdgcn_ds_bpermute(((lane + o) & 63) << 2, (int)suf); if (lane + o < 64) suf += n; }
    const unsigned above = suf - tot;
    if (above < need && need <= suf) {
        unsigned running = above, T = 0, cT = 0; bool found = false;
#pragma unroll
        for (int i = 31; i >= 0; --i) {
            const unsigned w = hw[i >> 2][i & 3], h16 = w >> 16, l16 = w & 0xffffu;
            if (!found) {
                if (running + h16 >= need) { T = 64 * lane + 2 * i + 1; cT = h16; found = true; }
                else { running += h16;
                    if (running + l16 >= need) { T = 64 * lane + 2 * i; cT = l16; found = true; } else running += l16; } }
        }
        const u64 Pold = (u64)st[0] | ((u64)st[1] << 32); const u64 Pn = (Pold << bits) | (u64)T;
        st[0] = (unsigned)Pn; st[1] = (unsigned)(Pn >> 32); st[2] = need - running; st[5] = cT;
    }
}

template <int NCH>
__device__ __forceinline__ unsigned finish_regs(LAS unsigned char* lds, int row, int lane, int nbits, LAS const u64* cand, unsigned nc, unsigned need, unsigned base, u64 Pfix, bool raw = false) {
    u64 k[NCH];
#pragma unroll
    for (int ch = 0; ch < NCH; ++ch) { const unsigned i = 64u * ch + lane; k[ch] = (i < nc) ? cand[i] : 0ull; }
    if (raw) {
#pragma unroll
        for (int ch = 0; ch < NCH; ++ch) { const unsigned i = 64u * ch + lane; const unsigned u = (unsigned)(k[ch] >> 32), sk = u ^ ((unsigned)((int)u >> 31) | 0x80000000u);
            k[ch] = (i < nc) ? (((u64)sk << 13) | (u64)(unsigned)k[ch]) : 0ull; }
    }
    u64 thr = Pfix;
    if (nbits == 45) {
        unsigned hi[NCH];
#pragma unroll
        for (int ch = 0; ch < NCH; ++ch) hi[ch] = (unsigned)(k[ch] >> 13);
        unsigned t = 0u, cge = 0xffffffffu;
        for (int bit = 31; bit >= 0; --bit) {
            const unsigned c = t | (1u << bit); unsigned cnt = 0;
#pragma unroll
            for (int ch = 0; ch < NCH; ++ch) cnt += (unsigned)__builtin_popcountll(__ballot(hi[ch] >= c));
            if (cnt >= need) { t = c; cge = cnt; }
        }
        thr = (u64)t << 13;
        if (cge != need) {
            for (int bit = 12; bit >= 0; --bit) {
                const u64 c = thr | (1ull << bit); unsigned cnt = 0;
#pragma unroll
                for (int ch = 0; ch < NCH; ++ch) cnt += (unsigned)__builtin_popcountll(__ballot(k[ch] >= c));
                if (cnt >= need) thr = c;
            }
        }
    } else {
        for (int bit = nbits - 1; bit >= 0; --bit) {
            const u64 c = thr | (1ull << bit); unsigned cnt = 0;
#pragma unroll
            for (int ch = 0; ch < NCH; ++ch) cnt += (unsigned)__builtin_popcountll(__ballot(k[ch] >= c));
            if (cnt >= need) thr = c;
        }
    }
#pragma unroll
    for (int ch = 0; ch < NCH; ++ch) {
        const unsigned i = 64u * ch + lane; const bool s = (i < nc) && (k[ch] >= thr);
        const unsigned long long m = __ballot(s); const unsigned pos = base + (unsigned)__builtin_popcountll(m & ((1ull << lane) - 1ull));
        if (s && pos < (unsigned)TOPK) ((LAS unsigned short*)(lds + SEL_OFF))[row * TOPK + pos] = (unsigned short)(8191u - (unsigned)(k[ch] & 0x1fffull));
        base += (unsigned)__builtin_popcountll(m);
    }
    return base;
}
__device__ __forceinline__ void finish_row(LAS unsigned char* lds, int row, int lane_in, int nbits, bool whole = false) {
    int lane = lane_in; asm volatile("" : "+v"(lane));
    LAS unsigned* st = (LAS unsigned*)(lds + ST_OFF + row * 32);
    if (st[6] != 0u) return;
    const unsigned need = whole ? (unsigned)TOPK : st[2]; unsigned nc = st[3] >> 16; if (nc > (unsigned)CAP) nc = CAP;
    unsigned base = st[3] & 0xffffu; if (base > (unsigned)TOPK) base = TOPK;
    LAS const u64* cand = (LAS const u64*)(lds + HIST_OFF) + row * CAP;
    const int nch = (int)((nc + 63u) >> 6);
    const u64 Pfix = whole ? 0ull : (((u64)st[0] | ((u64)st[1] << 32)) << nbits);
    u64 thr = Pfix;
    if ((MK_DUP & 16384) && nch <= 8) (void)finish_regs<8>(lds, row, lane, nbits, cand, nc, need, base, Pfix);
    if (nch <= 4) base = finish_regs<4>(lds, row, lane, nbits, cand, nc, need, base, Pfix, whole);
    else if (nch <= 8) base = finish_regs<8>(lds, row, lane, nbits, cand, nc, need, base, Pfix, whole);
    else if (nch <= 12) base = finish_regs<12>(lds, row, lane, nbits, cand, nc, need, base, Pfix, whole);
    else if (nch <= 16) base = finish_regs<16>(lds, row, lane, nbits, cand, nc, need, base, Pfix, whole);
    else {
        for (int bit = nbits - 1; bit >= 0; --bit) {
            const u64 c = thr | (1ull << bit); unsigned cnt = 0;
            for (int ch = 0; ch < nch; ++ch) { const unsigned i = 64u * ch + lane; const u64 k = (i < nc) ? cand[i] : 0ull; cnt += (unsigned)__builtin_popcountll(__ballot(k >= c)); }
            if (cnt >= need) thr = c;
        }
        for (int ch = 0; ch < nch; ++ch) {
            const unsigned i = 64u * ch + lane; const u64 k = (i < nc) ? cand[i] : 0ull; const bool s = (i < nc) && (k >= thr);
            const unsigned long long m = __ballot(s); const unsigned pos = base + (unsigned)__builtin_popcountll(m & ((1ull << lane) - 1ull));
            if (s && pos < (unsigned)TOPK) ((LAS unsigned short*)(lds + SEL_OFF))[row * TOPK + pos] = (unsigned short)(8191u - (unsigned)(k & 0x1fffull));
            base += (unsigned)__builtin_popcountll(m);
        }
    }
    if (lane == 0) st[3] = base;
}

__device__ __forceinline__ void sparse_attn_row(LAS unsigned char* lds, int row, int b, int t, const bf16* Q1, bf16* O1, const unsigned char* K1, const unsigned char* V1, int wave, int lane_in) {
    int lane = lane_in; asm volatile("" : "+v"(lane));
    const int n16 = lane & 15, q4 = lane >> 4, gl = n16 >> 2;
    LAS const unsigned short* sel = (LAS const unsigned short*)(lds + SEL_OFF) + row * TOPK;
    unsigned cnt = ((LAS const unsigned*)(lds + ST_OFF + row * 32))[3] & 0xffffu; if (cnt > (unsigned)TOPK) cnt = TOPK;
    const bf16* qrow = Q1 + ((size_t)b * T + t) * D; bf16* orow = O1 + ((size_t)b * T + t) * D;
    bf16x8 bq[8];
    { const bf16x8 q0 = *(const GAS bf16x8*)(qrow + n16 * 64 + 16 * q4), q1 = *(const GAS bf16x8*)(qrow + n16 * 64 + 16 * q4 + 8); const bf16x8 z = (bf16x8){0, 0, 0, 0, 0, 0, 0, 0};
#pragma unroll
      for (int s = 0; s < 8; ++s) bq[s] = ((s >> 1) == gl) ? ((s & 1) ? q1 : q0) : z; }
    const float slope = __builtin_amdgcn_exp2f(-0.5f * (float)(n16 + 1)) * LOG2E;
    const unsigned char* Kb = K1 + (size_t)b * T * 256; const unsigned char* Vb = V1 + (size_t)b * T * 256;
    f32x4 sc[16];
    v4u vst[2][8];
    constexpr int KD = 3;
    v4u kfn[KD][4];
#pragma unroll
    for (int d = 0; d < KD; ++d) { const unsigned pos = 16u * d + n16; const unsigned kidx = (pos < cnt) ? (unsigned)sel[pos] : 0u; const unsigned char* kp = Kb + (size_t)kidx * 256 + 16 * q4;
#pragma unroll
      for (int g = 0; g < 4; ++g) kfn[d][g] = *(const GAS v4u*)(kp + 64 * g); }
#pragma unroll
    for (int blk = 0; blk < 16; ++blk) {
        bf16x8 kf[8];
#pragma unroll
        for (int g = 0; g < 4; ++g) { const v4u lo = f8x8_to_bf16(kfn[blk % KD][g].x, kfn[blk % KD][g].y), hi8 = f8x8_to_bf16(kfn[blk % KD][g].z, kfn[blk % KD][g].w); kf[2 * g] = __builtin_bit_cast(bf16x8, lo); kf[2 * g + 1] = __builtin_bit_cast(bf16x8, hi8); }
        if (blk + KD < 16) { const unsigned pos = 16u * (blk + KD) + n16; const unsigned kidx = (pos < cnt) ? (unsigned)sel[pos] : 0u; const unsigned char* kp = Kb + (size_t)kidx * 256 + 16 * q4;
#pragma unroll
            for (int g = 0; g < 4; ++g) kfn[blk % KD][g] = *(const GAS v4u*)(kp + 64 * g); }
        if (blk >= 14) {
            const int d = blk - 14;
#pragma unroll
            for (int i = 0; i < 8; ++i) { const unsigned pos = 32u * d + 4u * i + q4; const unsigned kidx = (pos < cnt) ? (unsigned)sel[pos] : 0u; vst[d][i] = *(const GAS v4u*)(Vb + (size_t)kidx * 256 + 16 * n16); }
        }
        f32x4 a = (f32x4){0.f, 0.f, 0.f, 0.f};
#pragma unroll
        for (int s = 0; s < 8; ++s) a = __builtin_amdgcn_mfma_f32_16x16x32_bf16(kf[s], bq[s], a, 0, 0, 0);
        const unsigned long long i4 = *(LAS const unsigned long long*)(sel + 16 * blk + 4 * q4);
#pragma unroll
        for (int i = 0; i < 4; ++i) { const unsigned p = 16u * blk + 4u * q4 + i; const int ki = (int)((i4 >> (16 * i)) & 0xffffull);
            a[i] = (p < cnt) ? (a[i] - slope * (float)(t - ki)) : -INFINITY; }
        sc[blk] = a;
    }
    float mx = -INFINITY;
#pragma unroll
    for (int blk = 0; blk < 16; ++blk) mx = fmaxf(fmaxf(fmaxf(mx, sc[blk][0]), fmaxf(sc[blk][1], sc[blk][2])), sc[blk][3]);
    mx = xmax32(xmax16(mx));
    float lsum = 0.f;
#pragma unroll
    for (int blk = 0; blk < 16; ++blk)
#pragma unroll
        for (int i = 0; i < 4; ++i) { const float p = __builtin_amdgcn_exp2f(sc[blk][i] - mx); sc[blk][i] = p; lsum += p; }
    lsum = xsum32(xsum16(lsum));
    LAS unsigned char* vbuf = lds + HIST_OFF + wave * 16384;
    f32x4 o[4];
#pragma unroll
    for (int db = 0; db < 4; ++db) o[db] = (f32x4){0.f, 0.f, 0.f, 0.f};
#pragma unroll
    for (int J = 0; J < 8; ++J) {
#pragma unroll
        for (int i = 0; i < 8; ++i) { const int key = 4 * i + q4; LAS unsigned char* dst = vbuf + key * 512 + ((n16 ^ (key & 7)) << 5);
            *(LAS v4u*)dst = f8x8_to_bf16(vst[J & 1][i].x, vst[J & 1][i].y); *(LAS v4u*)(dst + 16) = f8x8_to_bf16(vst[J & 1][i].z, vst[J & 1][i].w); }
        if (J + 2 < 8) {
#pragma unroll
            for (int i = 0; i < 8; ++i) { const unsigned pos = 32u * (J + 2) + 4u * i + q4; const unsigned kidx = (pos < cnt) ? (unsigned)sel[pos] : 0u; vst[J & 1][i] = *(const GAS v4u*)(Vb + (size_t)kidx * 256 + 16 * n16); }
        }
        asm volatile("s_waitcnt lgkmcnt(0)" ::: "memory");
        v4u pb; pb.x = pk2(sc[2 * J][0], sc[2 * J][1]); pb.y = pk2(sc[2 * J][2], sc[2 * J][3]); pb.z = pk2(sc[2 * J + 1][0], sc[2 * J + 1][1]); pb.w = pk2(sc[2 * J + 1][2], sc[2 * J + 1][3]);
#pragma unroll
        for (int g = 0; g < 4; ++g) {
            const v4u pg = (g == gl) ? pb : (v4u){0u, 0u, 0u, 0u};
#pragma unroll
            for (int db = 0; db < 4; ++db) {
                const int qq = n16 >> 2, pp = n16 & 3; const int col = 64 * g + 16 * db + 4 * pp;
                const int r0 = 4 * q4 + qq, r1 = 16 + 4 * q4 + qq;
                const int a0 = r0 * 512 + ((((col >> 4) ^ (r0 & 7)) << 5) | ((col & 15) << 1)), a1 = r1 * 512 + ((((col >> 4) ^ (r1 & 7)) << 5) | ((col & 15) << 1));
                v2u lo, hi2;
                asm volatile("ds_read_b64_tr_b16 %0, %1" : "=v"(lo) : "v"((unsigned)(uintptr_t)(vbuf + a0)) : "memory");
                asm volatile("ds_read_b64_tr_b16 %0, %1" : "=v"(hi2) : "v"((unsigned)(uintptr_t)(vbuf + a1)) : "memory");
                asm volatile("s_waitcnt lgkmcnt(0)" : "+v"(lo), "+v"(hi2) :: "memory");
                const v4u av = (v4u){lo.x, lo.y, hi2.x, hi2.y};
                o[db] = __builtin_amdgcn_mfma_f32_16x16x32_bf16(__builtin_bit_cast(bf16x8, av), __builtin_bit_cast(bf16x8, pg), o[db], 0, 0, 0);
            }
        }
        asm volatile("s_waitcnt lgkmcnt(0)" ::: "memory");
    }
    const float rl = 1.f / lsum;
#pragma unroll
    for (int db = 0; db < 4; ++db) { v2u w; w.x = pk2(o[db][0] * rl, o[db][1] * rl); w.y = pk2(o[db][2] * rl, o[db][3] * rl);
        *(GAS v2u*)(orow + n16 * 64 + 16 * db + 4 * q4) = w; }
}

typedef long i64_t;
__device__ __forceinline__ void canon_sel(LAS unsigned char* lds, LAS unsigned short* sel, unsigned cnt, int wave, int lane) {
    LAS unsigned* bm = (LAS unsigned*)(lds + HIST_OFF + wave * 16384); LAS unsigned* pf = bm + 256;
    *(LAS v4u*)(bm + 4 * lane) = (v4u){0u, 0u, 0u, 0u};
    const v2u e = *(const LAS v2u*)(sel + 4 * lane);
    unsigned idx[4] = {e.x & 0xffffu, e.x >> 16, e.y & 0xffffu, e.y >> 16};
    LDS_WAIT();
#pragma unroll
    for (int i = 0; i < 4; ++i) if ((unsigned)(4 * lane + i) < cnt) __hip_atomic_fetch_or(bm + (idx[i] >> 5), 1u << (idx[i] & 31u), __ATOMIC_RELAXED, __HIP_MEMORY_SCOPE_WORKGROUP);
    LDS_WAIT();
    const v4u w = *(const LAS v4u*)(bm + 4 * lane);
    const unsigned c0 = __builtin_popcount(w.x), c1 = __builtin_popcount(w.y), c2 = __builtin_popcount(w.z), c3 = __builtin_popcount(w.w), tot = c0 + c1 + c2 + c3;
    int sc = (int)tot;
    sc += __builtin_amdgcn_update_dpp(0, sc, 0x111, 0xf, 0xf, false); sc += __builtin_amdgcn_update_dpp(0, sc, 0x112, 0xf, 0xf, false);
    sc += __builtin_amdgcn_update_dpp(0, sc, 0x114, 0xf, 0xf, false); sc += __builtin_amdgcn_update_dpp(0, sc, 0x118, 0xf, 0xf, false);
    sc += __builtin_amdgcn_update_dpp(0, sc, 0x142, 0xa, 0xf, false);
    sc += __builtin_amdgcn_update_dpp(0, sc, 0x143, 0xc, 0xf, false);
    const unsigned ex = (unsigned)sc - tot;
    *(LAS v4u*)(pf + 4 * lane) = (v4u){ex, ex + c0, ex + c0 + c1, ex + c0 + c1 + c2};
    LDS_WAIT();
#pragma unroll
    for (int i = 0; i < 4; ++i) if ((unsigned)(4 * lane + i) < cnt) { const unsigned wd = idx[i] >> 5; const unsigned r = pf[wd] + __builtin_popcount(bm[wd] & ((1u << (idx[i] & 31u)) - 1u)); sel[r] = (unsigned short)idx[i]; }
    LDS_WAIT();
}
#define VSW_I(key) (((key) & 3) | ((((key) >> 4) & 1) << 2))
#define VSW_H(key) (((key) >> 2) & 1)
__device__ __forceinline__ void sparse_attn_row8(LAS unsigned char* lds, int row, int b, int t, const bf16* Q1, bf16* O1, const unsigned char* K1, const unsigned char* V1, int wave, int lane_in, float qkmax) {
    int lane = lane_in; asm volatile("" : "+v"(lane));
    const int n16 = lane & 15, q4 = lane >> 4, gl = n16 >> 2;
    LAS unsigned short* sel = (LAS unsigned short*)(lds + SEL_OFF) + row * TOPK;
    unsigned cnt = ((LAS const unsigned*)(lds + ST_OFF + row * 32))[3] & 0xffffu; if (cnt > (unsigned)TOPK) cnt = TOPK;
    canon_sel(lds, sel, cnt, wave, lane);
    if (MK_DUP & 65536) canon_sel(lds, sel, cnt, wave, lane);
    if (cnt < (unsigned)TOPK) {
        for (unsigned i = cnt + lane; i < (unsigned)TOPK; i += 64u) sel[i] = 0;
        asm volatile("s_waitcnt lgkmcnt(0)" ::: "memory");
    }
    const bf16* qrow = Q1 + ((size_t)b * T + t) * D; bf16* orow = O1 + ((size_t)b * T + t) * D;
    i64_t qs0, qs1;
    { const v4u a = *(const GAS v4u*)(qrow + n16 * 64 + 16 * q4), c = *(const GAS v4u*)(qrow + n16 * 64 + 16 * q4 + 8);
      int w0 = 0, w1 = 0, w2 = 0, w3 = 0;
      w0 = __builtin_amdgcn_cvt_pk_fp8_f32(bf2f(a.x & 0xffffu), bf2f(a.x >> 16), w0, false); w0 = __builtin_amdgcn_cvt_pk_fp8_f32(bf2f(a.y & 0xffffu), bf2f(a.y >> 16), w0, true);
      w1 = __builtin_amdgcn_cvt_pk_fp8_f32(bf2f(a.z & 0xffffu), bf2f(a.z >> 16), w1, false); w1 = __builtin_amdgcn_cvt_pk_fp8_f32(bf2f(a.w & 0xffffu), bf2f(a.w >> 16), w1, true);
      w2 = __builtin_amdgcn_cvt_pk_fp8_f32(bf2f(c.x & 0xffffu), bf2f(c.x >> 16), w2, false); w2 = __builtin_amdgcn_cvt_pk_fp8_f32(bf2f(c.y & 0xffffu), bf2f(c.y >> 16), w2, true);
      w3 = __builtin_amdgcn_cvt_pk_fp8_f32(bf2f(c.z & 0xffffu), bf2f(c.z >> 16), w3, false); w3 = __builtin_amdgcn_cvt_pk_fp8_f32(bf2f(c.w & 0xffffu), bf2f(c.w >> 16), w3, true);
      qs0 = (i64_t)(((u64)(unsigned)w1 << 32) | (u64)(unsigned)w0); qs1 = (i64_t)(((u64)(unsigned)w3 << 32) | (u64)(unsigned)w2); }
    i64_t bq0[4], bq1[4];
#pragma unroll
    for (int g = 0; g < 4; ++g) { bq0[g] = (g == gl) ? qs0 : (i64_t)0; bq1[g] = (g == gl) ? qs1 : (i64_t)0; }
    const float slope = __builtin_amdgcn_exp2f(-0.5f * (float)(n16 + 1)) * LOG2E;
    int lo0, lo1, lo2, lo3;
    { const int kmx = __builtin_amdgcn_readfirstlane((int)sel[cnt - 1]); const float need_ = (2.f * qkmax + 33.f) * (1.f / LOG2E);
      lo0 = kmx - (int)(need_ * 4.f) - 1; lo1 = kmx - (int)(need_ * 16.f) - 1; lo2 = kmx - (int)(need_ * 64.f) - 1; lo3 = kmx - (int)(need_ * 256.f) - 1; }
    const int lo_own = (gl == 0) ? lo0 : (gl == 1) ? lo1 : (gl == 2) ? lo2 : lo3;
    constexpr unsigned OOB = 0x40000000u;
    const unsigned char* Kb = K1 + (size_t)b * T * 256; const unsigned char* Vb = V1 + (size_t)b * T * 256;
    const __amdgpu_buffer_rsrc_t rsK = __builtin_amdgcn_make_buffer_rsrc((void*)Kb, 0, T * 256, 0x00020000), rsV = __builtin_amdgcn_make_buffer_rsrc((void*)Vb, 0, T * 256, 0x00020000);
#define SA_LD(rs, off, imm) __builtin_bit_cast(v4u, __builtin_amdgcn_raw_buffer_load_b128(rs, (int)((off) + (imm)), 0, 0))
    const int vkey = lane >> 1, vpar = lane & 1;
    f32x4 sc[16];
    v4u vst[2][8];
    constexpr int KD = 3;
    v4u kfn[KD][4];
#pragma unroll
    for (int d = 0; d < KD; ++d) { const unsigned kidx = (unsigned)sel[16 * d + n16]; const unsigned ko = kidx * 256u + 16u * (unsigned)q4;
#pragma unroll
      for (int g = 0; g < 4; ++g) kfn[d][g] = SA_LD(rsK, ((int)kidx < (g == 0 ? lo0 : g == 1 ? lo1 : g == 2 ? lo2 : lo3)) ? OOB : ko, 64 * g); }
#pragma unroll
    for (int blk = 0; blk < 16; ++blk) {
        f32x4 a = (f32x4){0.f, 0.f, 0.f, 0.f};
#pragma unroll
        for (int g = 0; g < 4; ++g) {
            const v4u ch = kfn[blk % KD][g];
            const i64_t k0 = (i64_t)(((u64)ch.y << 32) | (u64)ch.x), k1 = (i64_t)(((u64)ch.w << 32) | (u64)ch.z);
            a = __builtin_amdgcn_mfma_f32_16x16x32_fp8_fp8(k0, bq0[g], a, 0, 0, 0);
            a = __builtin_amdgcn_mfma_f32_16x16x32_fp8_fp8(k1, bq1[g], a, 0, 0, 0);
        }
        if (blk + KD < 16) { const unsigned kidx = (unsigned)sel[16 * (blk + KD) + n16]; const unsigned ko = kidx * 256u + 16u * (unsigned)q4;
#pragma unroll
            for (int g = 0; g < 4; ++g) kfn[blk % KD][g] = SA_LD(rsK, ((int)kidx < (g == 0 ? lo0 : g == 1 ? lo1 : g == 2 ? lo2 : lo3)) ? OOB : ko, 64 * g); }
        if (blk >= 14) { const int d = blk - 14;
#pragma unroll
            for (int k = 0; k < 8; ++k) { const unsigned vk = (unsigned)sel[32 * d + 4 * k + q4]; vst[d][k] = SA_LD(rsV, ((int)vk < lo_own) ? OOB : vk * 256u + 16u * (unsigned)n16, 0); } }
        const unsigned long long i4 = *(LAS const unsigned long long*)(sel + 16 * blk + 4 * q4);
#pragma unroll
        for (int i = 0; i < 4; ++i) { const unsigned pz = 16u * blk + 4u * q4 + i; const int ki = (int)((i4 >> (16 * i)) & 0xffffull);
            a[i] = (pz < cnt && ki >= lo_own) ? (a[i] - slope * (float)(t - ki)) : -INFINITY; }
        sc[blk] = a;
    }
    float mx = -INFINITY;
#pragma unroll
    for (int blk = 0; blk < 16; ++blk) mx = fmaxf(fmaxf(fmaxf(mx, sc[blk][0]), fmaxf(sc[blk][1], sc[blk][2])), sc[blk][3]);
    mx = xmax32(xmax16(mx));
    float lsum = 0.f;
    mx -= 8.f;
#pragma unroll
    for (int blk = 0; blk < 16; ++blk)
#pragma unroll
        for (int i = 0; i < 4; ++i) { const float pv = __builtin_amdgcn_exp2f(sc[blk][i] - mx); sc[blk][i] = pv; lsum += pv; }
    lsum = xsum32(xsum16(lsum));
    LAS unsigned char* vbuf = lds + HIST_OFF + wave * 16384;
    unsigned vdst[4];
#pragma unroll
    for (int j = 0; j < 4; ++j) vdst[j] = (unsigned)(uintptr_t)vbuf + (unsigned)vkey * 256u + (unsigned)((((2 * j) ^ (vkey & 7)) << 5) | (vpar << 4));
    const int trr = n16 >> 1, kr = (trr < 4) ? (4 * q4 + trr) : (12 + 4 * q4 + trr); const int trbase = kr * 256 + 8 * (n16 & 1);
    const int tri = VSW_I(kr), trh_ = VSW_H(kr);
    f32x4 oacc[4];
#pragma unroll
    for (int d = 0; d < 4; ++d) oacc[d] = (f32x4){0.f, 0.f, 0.f, 0.f};
#pragma unroll
    for (int J = 0; J < 8; ++J) {
        LAS unsigned char* slot = vbuf + (J & 1) * 8192;
#pragma unroll
        for (int k = 0; k < 8; ++k) { const int key = 4 * k + q4; *(LAS v4u*)(slot + key * 256 + ((((n16 >> 1) ^ VSW_I(key)) << 5) | (((n16 & 1) ^ VSW_H(key)) << 4))) = vst[J & 1][k]; }
        if (J + 2 < 8) {
#pragma unroll
            for (int k = 0; k < 8; ++k) { const unsigned vk = (unsigned)sel[32 * (J + 2) + 4 * k + q4]; vst[J & 1][k] = SA_LD(rsV, ((int)vk < lo_own) ? OOB : vk * 256u + 16u * (unsigned)n16, 0); } }
        asm volatile("s_waitcnt lgkmcnt(0)" ::: "memory");
        int p0 = 0, p1 = 0;
        p0 = __builtin_amdgcn_cvt_pk_fp8_f32(sc[2 * J][0], sc[2 * J][1], p0, false); p0 = __builtin_amdgcn_cvt_pk_fp8_f32(sc[2 * J][2], sc[2 * J][3], p0, true);
        p1 = __builtin_amdgcn_cvt_pk_fp8_f32(sc[2 * J + 1][0], sc[2 * J + 1][1], p1, false); p1 = __builtin_amdgcn_cvt_pk_fp8_f32(sc[2 * J + 1][2], sc[2 * J + 1][3], p1, true);
        const i64_t pb = (i64_t)(((u64)(unsigned)p1 << 32) | (u64)(unsigned)p0);
#pragma unroll
        for (int gh = 0; gh < 2; ++gh) {
            i64_t trv[8];
#pragma unroll
            for (int g2 = 0; g2 < 2; ++g2)
#pragma unroll
                for (int db = 0; db < 4; ++db) { const int g = 2 * gh + g2; const int a0 = trbase + ((((2 * g + (db >> 1)) ^ tri) << 5) | (((db & 1) ^ trh_) << 4));
                    asm volatile("ds_read_b64_tr_b8 %0, %1" : "=v"(trv[4 * g2 + db]) : "v"((unsigned)(uintptr_t)(slot + a0)) : "memory"); }
            asm volatile("s_waitcnt lgkmcnt(0)" : "+v"(trv[0]), "+v"(trv[1]), "+v"(trv[2]), "+v"(trv[3]), "+v"(trv[4]), "+v"(trv[5]), "+v"(trv[6]), "+v"(trv[7]) :: "memory");
#pragma unroll
            for (int g2 = 0; g2 < 2; ++g2) { const int g = 2 * gh + g2; const i64_t pg = (g == gl) ? pb : (i64_t)0;
#pragma unroll
                for (int db = 0; db < 4; ++db) oacc[db] = __builtin_amdgcn_mfma_f32_16x16x32_fp8_fp8(trv[4 * g2 + db], pg, oacc[db], 0, 0, 0); }
        }
    }
    (void)vdst;
    const float rl = 32.f / lsum;
#pragma unroll
    for (int db = 0; db < 4; ++db) {
        int w0 = 0;
        w0 = __builtin_amdgcn_cvt_pk_fp8_f32(oacc[db][0] * rl, oacc[db][1] * rl, w0, false); w0 = __builtin_amdgcn_cvt_pk_fp8_f32(oacc[db][2] * rl, oacc[db][3] * rl, w0, true);
        *(GAS unsigned*)((unsigned char*)O1 + ((size_t)b * T + t) * D + n16 * 64 + 16 * db + 4 * q4) = (unsigned)w0; }
}
#undef SA_LD

__device__ __forceinline__ void unit(LAS unsigned char* lds, int b, int t0q, const bf16* Q1, bf16* O1, const unsigned char* K1, const unsigned char* V1, const bf16* QI, const bf16* KI, const float* WI, int tid_in, int wave, float qkmax) {
    int tid = tid_in; asm volatile("" : "+v"(tid)); const int lane = tid & 63;
    const int hi = lane >> 5, r32 = lane & 31;
    if (tid < QT * 8) ((LAS float*)(lds + ST_OFF + 1024))[tid] = WI[((size_t)b * T + t0q) * 8 + tid];
    if (tid < QT) { LAS unsigned* st = (LAS unsigned*)(lds + ST_OFF + tid * 32); const int t = t0q + tid;
        unsigned z; asm volatile("v_mov_b32 %0, 0" : "=v"(z));
        st[0] = z; st[1] = z; st[2] = z + (unsigned)TOPK; st[3] = z; st[4] = z; st[5] = z; st[6] = (t + 1 <= TOPK) ? 1u : z; st[7] = z; }
    for (int i = tid; i < 32768 / 4; i += NTHREADS) ((LAS v4u*)(lds + HIST_OFF))[i] = (v4u){0u, 0u, 0u, 0u};
    if (MK_DUP & 131072) { for (int i = tid; i < 32768 / 4; i += NTHREADS) ((LAS v4u*)(lds + HIST_OFF))[i] = (v4u){0u, 0u, 0u, 0u}; asm volatile("" ::: "memory"); }
    bf16x8 qa[4][4];
    { const int qlr = 2 * ((r32 >> 2) & 1) + (r32 >> 4), hd = 4 * ((r32 >> 3) & 1) + (r32 & 3);
#pragma unroll
      for (int rb = 0; rb < 4; ++rb) { const bf16* qp = QI + ((size_t)b * T + t0q + 4 * rb + qlr) * 512 + hd * 64 + 8 * hi;
#pragma unroll
          for (int ks = 0; ks < 4; ++ks) qa[rb][ks] = *(const GAS bf16x8*)(qp + 16 * ks); } }
    const int nst = (t0q + QT + 31) >> 5;
    const bf16* KIb = KI + (size_t)b * T * 64;
    bool done = false;
    if (t0q >= 1024) {
        const int nfull_ = (t0q + 1) >> 5, nsamp = (nfull_ + 7) >> 3;
        if (tid < QT) { LAS unsigned* st = (LAS unsigned*)(lds + ST_OFF + tid * 32); const unsigned n = (unsigned)(t0q + tid + 1), ns = 32u * (unsigned)nsamp; st[2] = (416u * ns + n - 1u) / n; }
        bf16x8 pre[8];
        { bf16x8 (&pb_)[4] = *(bf16x8 (*)[4])&pre[0]; bf16x8 (&pn_)[4] = *(bf16x8 (*)[4])&pre[4]; idx_preload<8>(KIb, nsamp, wave, lane, pb_, pn_); }
        __syncthreads();
        idx_pass<0, true, 0, 8>(qa, KIb, t0q, nsamp, wave, lane, lds, 0, 45, 33, 4095u, &pre);
        { bf16x8 (&pb_)[4] = *(bf16x8 (*)[4])&pre[0]; bf16x8 (&pn_)[4] = *(bf16x8 (*)[4])&pre[4]; idx_preload<1>(KIb, nst, wave, lane, pb_, pn_); }
        __syncthreads();
        find_bin(lds, 2 * wave, lane, 12); find_bin(lds, 2 * wave + 1, lane, 12);
        if (MK_DUP & 32768) { __syncthreads(); find_bin(lds, 2 * wave, lane, 12); find_bin(lds, 2 * wave + 1, lane, 12); }
        __syncthreads();
        if (MK_DUP & 262144) { idx_pass<3, true>(qa, KIb, t0q, nst, wave, lane, lds, 0, 0, 33, 0u); __syncthreads(); if (tid < QT) ((LAS unsigned*)(lds + ST_OFF + tid * 32))[3] = 0u; __syncthreads(); }
        idx_pass<3, true>(qa, KIb, t0q, nst, wave, lane, lds, 0, 0, 33, 0u, &pre);
        __syncthreads();
        bool bad = false;
#pragma unroll
        for (int r = 0; r < QT; ++r) { const unsigned c = ((LAS const unsigned*)(lds + ST_OFF + r * 32))[3] >> 16; bad = bad || c < (unsigned)TOPK || c > (unsigned)CAP; }
        if (!bad) {
            { int lane_c; asm volatile("v_mbcnt_lo_u32_b32 %0, -1, 0\n\tv_mbcnt_hi_u32_b32 %0, -1, %0" : "=v"(lane_c));
              finish_row(lds, 2 * wave, lane_c, 45, true); finish_row(lds, 2 * wave + 1, lane_c, 45, true); }
            __syncthreads();
            done = true;
        } else {
            __syncthreads();
            if (tid < QT) { LAS unsigned* st = (LAS unsigned*)(lds + ST_OFF + tid * 32); st[0] = 0u; st[1] = 0u; st[2] = (unsigned)TOPK; st[3] = 0u; st[4] = 0u; st[5] = 0u; }
            for (int i = tid; i < 32768 / 4; i += NTHREADS) ((LAS v4u*)(lds + HIST_OFF))[i] = (v4u){0u, 0u, 0u, 0u};
            __syncthreads();
        }
    }
    int level = 0, lo_shift = 33;
    if (!done) {
    for (;;) {
        const int hi_shift = 45 - 12 * level; lo_shift = (level == 3) ? 0 : 33 - 12 * level; const int bits = (level == 3) ? 9 : 12; const unsigned mask = (1u << bits) - 1u;
        if (level > 0) { for (int i = tid; i < 32768 / 4; i += NTHREADS) ((LAS v4u*)(lds + HIST_OFF))[i] = (v4u){0u, 0u, 0u, 0u}; }
        __syncthreads();
        if (MK_DUP & 512) {
            if (MK_DUP & 1024) idx_pass<0, true, 1>(qa, KIb, t0q, nst, wave, lane, lds, level, hi_shift, lo_shift, mask);
            else if (MK_DUP & 2048) idx_pass<0, true, 2>(qa, KIb, t0q, nst, wave, lane, lds, level, hi_shift, lo_shift, mask);
            else idx_pass<0, true>(qa, KIb, t0q, nst, wave, lane, lds, level, hi_shift, lo_shift, mask);
            __syncthreads();
            for (int i = tid; i < 32768 / 4; i += NTHREADS) ((LAS v4u*)(lds + HIST_OFF))[i] = (v4u){0u, 0u, 0u, 0u};
            __syncthreads();
        }
        if (level == 0) idx_pass<0, true>(qa, KIb, t0q, nst, wave, lane, lds, level, hi_shift, lo_shift, mask);
        else idx_pass<0, false>(qa, KIb, t0q, nst, wave, lane, lds, level, hi_shift, lo_shift, mask);
        __syncthreads();
        find_bin(lds, 2 * wave, lane, bits); find_bin(lds, 2 * wave + 1, lane, bits);
        __syncthreads();
        bool more = false;
        if (level < 3) {
#pragma unroll
            for (int r = 0; r < QT; ++r) { LAS const unsigned* st = (LAS const unsigned*)(lds + ST_OFF + r * 32); more = more || (st[6] == 0u && st[5] > (unsigned)CAP); }
        }
        if (!more) break;
        ++level;
    }
    __syncthreads();
    if (MK_DUP & 4096) { idx_pass<1, true>(qa, KIb, t0q, nst, wave, lane, lds, level, 0, lo_shift, 0u); __syncthreads(); if (tid < QT) ((LAS unsigned*)(lds + ST_OFF + tid * 32))[3] = 0u; __syncthreads(); }
    if (level == 0) idx_pass<1, true>(qa, KIb, t0q, nst, wave, lane, lds, level, 0, lo_shift, 0u);
    else idx_pass<1, false>(qa, KIb, t0q, nst, wave, lane, lds, level, 0, lo_shift, 0u);
    __syncthreads();
    finish_row(lds, 2 * wave, lane, lo_shift); finish_row(lds, 2 * wave + 1, lane, lo_shift);
    __syncthreads();
    }
#pragma unroll 1
    for (int rr = 0; rr < (MK_DUP & 256 ? 4 : 2); ++rr) sparse_attn_row8(lds, 2 * wave + (rr & 1), b, t0q + 2 * wave + (rr & 1), Q1, O1, K1, V1, wave, lane, qkmax);
    __syncthreads();
}
}
#if defined(__HIP_DEVICE_COMPILE__)
typedef const __attribute__((address_space(4))) Ptrs* KArgs;
__device__ __forceinline__ const Ptrs* get_args() { KArgs p = (KArgs)__builtin_amdgcn_kernarg_segment_ptr(); asm volatile("" : "+s"(p)); return (const Ptrs*)p; }
#else
__device__ __forceinline__ const Ptrs* get_args() { return nullptr; }
#endif
#define DUP(bit, ...) do { if (MK_DUP & (1 << (bit))) { __VA_ARGS__; GRID_BAR(); } } while (0)
__global__ void __launch_bounds__(NTHREADS, 2) hybrid_fwd(Ptrs Pbyval) {
    extern __shared__ __attribute__((aligned(16))) unsigned char lds_raw[];
    LAS unsigned char* lds = (LAS unsigned char*)lds_raw;
    volatile LAS unsigned* MISC = (volatile LAS unsigned*)(lds + MISC_OFF);
    const int tid0 = threadIdx.x; const int wave_s = __builtin_amdgcn_readfirstlane(tid0 >> 6);
#define FRESH_IDS() const Ptrs P = *get_args(); unsigned char* ws = P.ws; gu32* ctl = (gu32*)(ws + WS_CTL); float* MOD = (float*)(ws + WS_MOD); bf16* Hb = (bf16*)(ws + WS_H); (void)ctl; (void)MOD; (void)Hb; int tid; asm volatile("v_mbcnt_lo_u32_b32 %0, -1, 0\n\tv_mbcnt_hi_u32_b32 %0, -1, %0\n\tv_lshl_or_b32 %0, %1, 6, %0" : "=&v"(tid) : "s"(wave_s)); const int lane = tid & 63; const int wave = __builtin_amdgcn_readfirstlane(tid >> 6); (void)lane; (void)wave
    const int G = gridDim.x; const int bx = blockIdx.x; const int vcu = (G % 8 == 0) ? (bx % 8) * (G / 8) + bx / 8 : bx;
    for (int u = tid0; u < (LDS_BYTES - LDSCTL_OFF) / 4; u += NTHREADS) ((LAS unsigned*)(lds + LDSCTL_OFF))[u] = 0u;
    __syncthreads();
    XcdBarrier bar = xcd_barrier_post((unsigned*)((gu32*)(Pbyval.ws + WS_CTL) + CW_BAR), MISC + 8);
#define GRID_BAR() xcd_barrier(bar)

#define PH_PROLOGUE() do { FRESH_IDS(); p0_prologue(P, lds, tid, lane, wave, vcu, G); } while (0)
#define PH_NORM1_L0() do { FRESH_IDS(); norm_phase<true, false, 1>(P.x, P.g_mix, MOD, 0, 1, Hb, (unsigned char*)Hb, P.fox_w_in, P.fox_b_f, (float*)(ws + WS_LOGF), lds, tid, lane, wave, vcu, G); } while (0)
#define PH_NORM1_L1() do { FRESH_IDS(); norm_phase<false, true, 2>((const bf16*)(ws + WS_XB), P.g_mix + D, MOD + (size_t)2 * 6144, 0, 1, Hb, ws + WS_H8, nullptr, nullptr, nullptr, lds, tid, lane, wave, vcu, G); } while (0)
#define PH_NORM2(layer) do { FRESH_IDS(); norm_phase<false, true, 1>((const bf16*)(ws + WS_XB), P.g_ffn + layer * D, MOD + (size_t)layer * 2 * 6144, 3, 4, Hb, (unsigned char*)Hb, nullptr, nullptr, nullptr, lds, tid, lane, wave, vcu, G); } while (0)
#define PH_QKV() do { \
        { FRESH_IDS(); for (int j_ = bx; j_ < 256; j_ += G) fox_scan8((const float*)(ws + WS_LOGF), (float*)(ws + WS_BETA), ws + WS_KE, j_ >> 3, j_ & 7, (LAS float*)(lds + RING_OFF), tid, lane, wave); } \
        { FRESH_IDS(); \
            pg8::Gemm g{Hb, (const bf16*)(ws + WS_WFIN), M, 3 * D, D / 2, D / 2, D / 2, 0x7f7f7f7f, 0x7a7a7a7a}; pg8::StaticOrder S; S.init(M, 3 * D, G, bx, ORD_QKV); \
            pg8::EpiHeads E{}; E.ntens = 3; \
            E.base[0] = (bf16*)(ws + WS_Q); E.tile0[0] = 0; E.ldc[0] = D; E.kind[0] = 1; E.gain[0] = P.fox_g_q; E.scale[0] = attn_body::C2; \
            E.base[1] = (bf16*)(ws + WS_K); E.tile0[1] = 4; E.ldc[1] = D; E.kind[1] = 1; E.gain[1] = P.fox_g_k; E.scale[1] = 1.f; \
            E.base[2] = (bf16*)(ws + WS_V); E.tile0[2] = 8; E.ldc[2] = D; E.kind[2] = 0; E.gain[2] = P.fox_g_k; E.scale[2] = 1.f; \
            E.base[3] = E.base[2]; E.tile0[3] = 1 << 30; E.ldc[3] = D; E.kind[3] = 0; E.gain[3] = P.fox_g_k; E.scale[3] = 1.f; \
            pg8::gemm_phase<pg8::EpiHeads, pg8::StaticOrder, true, true, true>(lds + RING_OFF, g, S, E, tid); } } while (0)
#define PH_FOXATTN(qword) do { FRESH_IDS(); \
            float qkmax; \
            { const float gq = wave_max(fabsf(P.fox_g_q[lane])), gk = wave_max(fabsf(P.fox_g_k[lane])); qkmax = 64.f * attn_body::C2 * gq * gk * 1.02f + 0.5f; } \
            for (;;) { \
                if (tid == 0) MISC[16] = __hip_atomic_fetch_add(ctl + (qword), 1u, RLX_AGENT); \
                __syncthreads(); \
                const int id = (int)MISC[16]; \
                __syncthreads(); \
                if (id >= 32 * 32) break; \
                const int qb = 31 - (id >> 5), bh = id & 31; \
                attn_body::attn_unit<8>(bh >> 4, bh & 15, qb, (const attn_body::bf16*)(ws + WS_Q), (const attn_body::bf16*)(ws + WS_K), (const attn_body::bf16*)(ws + WS_V), \
                                        (attn_body::bf16*)(ws + WS_O), (const attn_body::bf16*)(ws + WS_KE), (const float*)(ws + WS_BETA), qkmax, (char*)lds_raw + RING_OFF, tid); \
            } } while (0)
#define PH_OUTPROJ(layer, OBUF, WBUF) do { FRESH_IDS(); \
            pg8::Gemm g{(const bf16*)(ws + (OBUF)), (const bf16*)(ws + (WBUF)), M, D, D / 2, D / 2, D / 2, 0x7a7a7a7a, 0x7a7a7a7a}; pg8::StaticOrder S; S.init(M, D, G, bx); \
              \
            if (layer == 0) { if (S.nwg <= G) { pg8::EpiResNormStaged<false, 1> E{P.x, ws + WS_XB, MOD + 2 * D, 6144, T, P.g_ffn, MOD, 3, 4, Hb, (unsigned char*)Hb, (float*)(ws + WS_XS), (unsigned*)(ctl + CW_NS), lds + HALO_OFF}; \
                    pg8::gemm_phase<pg8::EpiResNormStaged<false, 1>, pg8::StaticOrder, true, true, true>(lds + RING_OFF, g, S, E, tid); } \
                else { pg8::EpiRes<false, true> E{P.x, ws + WS_XB, MOD + 2 * D, 6144, T}; pg8::gemm_phase<pg8::EpiRes<false, true>, pg8::StaticOrder, true, true, true>(lds + RING_OFF, g, S, E, tid); } } \
            else { if (S.nwg <= G) { pg8::EpiResNormStaged<true, 1> E{ws + WS_XB, ws + WS_XB, MOD + (size_t)2 * 6144 + 2 * D, 6144, T, P.g_ffn + D, MOD + (size_t)2 * 6144, 3, 4, Hb, (unsigned char*)Hb, (float*)(ws + WS_XS) + (size_t)2 * M * 4, (unsigned*)(ctl + CW_NS + 2048), lds + HALO_OFF}; \
                    pg8::gemm_phase<pg8::EpiResNormStaged<true, 1>, pg8::StaticOrder, true, true, true>(lds + RING_OFF, g, S, E, tid); } \
                else { pg8::EpiRes<true, true> E{ws + WS_XB, ws + WS_XB, MOD + (size_t)2 * 6144 + 2 * D, 6144, T}; pg8::gemm_phase<pg8::EpiRes<true, true>, pg8::StaticOrder, true, true, true>(lds + RING_OFF, g, S, E, tid); } } } while (0)
#define PH_UP(layer) do { FRESH_IDS(); \
            pg8::Gemm g{Hb, (const bf16*)(ws + (layer == 0 ? WS_WUP0 : WS_WUP1)), M, FF2, D / 2, D / 2, D / 2, 0x7f7f7f7f, 0x7a7a7a7a}; pg8::StaticOrder S; S.init(M, FF2, G, (G % 16 == 0) ? (bx % 8) + 8 * ((((bx / 8) & 1) * (G / 16)) + ((bx / 8) >> 1)) : bx, ORD_UP);   \
            pg8::EpiConvGate E{(bf16*)(ws + WS_U), P.ffn_conv_w + (size_t)layer * 3 * FF, P.ffn_conv_b + (size_t)layer * FF, (float*)(ws + WS_SA0), (float*)(ws + WS_SG0), (float*)(ws + WS_SA1), (LAS float*)(lds + HALO_OFF), lds + RING_OFF + 3 * 16384  }; \
            pg8::gemm_phase<pg8::EpiConvGate, pg8::StaticOrder, true, true, true>(lds + RING_OFF, g, S, E, tid); \
            if (G % 16 == 0 && ((bx / 8) & 1)) { __syncthreads(); p0_late(P, lds, tid, lane, wave, (bx % 8) + 8 * ((bx / 8) >> 1), G / 2, layer); } } while (0)
#define PH_DOWN(layer) do { FRESH_IDS(); \
            pg8::Gemm g{(const bf16*)(ws + WS_U), (const bf16*)(ws + (layer == 0 ? WS_WDN0 : WS_WDN1)), M, D, FF / 2, FF / 2, FF / 2, 0x7f7f7f7f, 0x79797979}; pg8::StaticOrder S; S.init(M, D, G, bx); \
            { pg8::Unit u0; for (int i_ = 0; S.next(i_, u0); ++i_) conv_fixup((bf16*)(ws + WS_U), (const float*)(ws + WS_SA0), (const float*)(ws + WS_SG0), (const float*)(ws + WS_SA1), P.ffn_conv_w + (size_t)layer * 3 * FF, P.ffn_conv_b + (size_t)layer * FF, u0.pm, tid); } \
            if (layer == 0) { if (S.nwg <= G) { pg8::EpiResNormStaged<true, 2> E{ws + WS_XB, ws + WS_XB, MOD + 5 * D, 6144, T, P.g_mix + D, MOD + (size_t)2 * 6144, 0, 1, Hb, ws + WS_H8, (float*)(ws + WS_XS) + (size_t)M * 4, (unsigned*)(ctl + CW_NS + 1024), lds + HALO_OFF}; \
                    pg8::gemm_phase<pg8::EpiResNormStaged<true, 2>, pg8::StaticOrder, true, true, true>(lds + RING_OFF, g, S, E, tid); } \
                else { pg8::EpiRes<true, true> E{ws + WS_XB, ws + WS_XB, MOD + 5 * D, 6144, T}; pg8::gemm_phase<pg8::EpiRes<true, true>, pg8::StaticOrder, true, true, true>(lds + RING_OFF, g, S, E, tid); } } \
            else { if (S.nwg <= G) { pg8::EpiResStaged<true, false> E{ws + WS_XB, P.out, MOD + (size_t)2 * 6144 + 5 * D, 6144, T}; pg8::gemm_phase<pg8::EpiResStaged<true, false>, pg8::StaticOrder, true, true, true>(lds + RING_OFF, g, S, E, tid); } \
                else { pg8::EpiRes<true, false> E{ws + WS_XB, P.out, MOD + (size_t)2 * 6144 + 5 * D, 6144, T}; pg8::gemm_phase<pg8::EpiRes<true, false>, pg8::StaticOrder, true, true, true>(lds + RING_OFF, g, S, E, tid); } } } while (0)
#define PH_DSAIN() do { FRESH_IDS(); \
              \
            if (G % 16 != 0) dsa::tail_phase(Hb, (const bf16*)(ws + WS_WDTAIL), P.dsa_g_kidx, (bf16*)(ws + WS_KI), (float*)(ws + WS_WI), lane, vcu * NWAVES + wave, G * NWAVES); \
            else if (bx < G / 2) dsa::tail_phase_ks(Hb, (const bf16*)(ws + WS_WDTAIL), P.dsa_g_kidx, (bf16*)(ws + WS_KI), (float*)(ws + WS_WI), lds + RING_OFF, lane, wave, bx * ((M / 16) / (G / 2)), (M / 16) / (G / 2)); \
              \
            { pg8::Gemm g{(const bf16*)(ws + WS_H8), (const bf16*)(ws + WS_WDIN), M, 3 * D / 2, D / 2, D / 2, D / 2, 0x7f7f7f7f, 0x7a7a7a7a}; pg8::StaticOrder S; S.init(M, 3 * D / 2, G, bx, ORD_DIN); \
              pg8::EpiHeads E{}; E.ntens = 3; \
              E.base[0] = (bf16*)(ws + WS_Q1); E.tile0[0] = 0; E.ldc[0] = D; E.kind[0] = 1; E.gain[0] = P.dsa_g_q; E.scale[0] = attn_body::C2; \
              E.base[1] = (bf16*)(ws + WS_K1); E.tile0[1] = 4; E.ldc[1] = 256; E.kind[1] = 1; E.gain[1] = P.dsa_g_k; E.scale[1] = 1.f; E.f8[1] = 1; \
              E.base[2] = (bf16*)(ws + WS_V1); E.tile0[2] = 5; E.ldc[2] = 256; E.kind[2] = 0; E.gain[2] = P.dsa_g_k; E.scale[2] = 1.f; E.f8[2] = 1; \
              E.base[3] = E.base[2]; E.tile0[3] = 1 << 30; E.ldc[3] = 256; E.kind[3] = 0; E.gain[3] = P.dsa_g_k; E.scale[3] = 1.f; \
              pg8::gemm_phase<pg8::EpiHeads, pg8::StaticOrder, true, true, true>(lds + RING_OFF, g, S, E, tid); } \
            { FRESH_IDS(); pg8::Gemm g{Hb, (const bf16*)(ws + WS_WDIN + 2 * MiB), M, D / 2, D, D, D, 0, 0}; pg8::StaticOrder S; S.init(M, D / 2, G, (G % 16 == 0) ? (bx + G / 2) % G : bx, ORD_QI); \
              pg8::EpiHeads E{}; E.ntens = 1; \
              E.base[0] = (bf16*)(ws + WS_QI); E.tile0[0] = 0; E.ldc[0] = 512; E.kind[0] = 0; E.gain[0] = P.dsa_g_k; E.scale[0] = 1.f; \
              for (int i_ = 1; i_ < 4; ++i_) { E.base[i_] = E.base[0]; E.tile0[i_] = 1 << 30; E.ldc[i_] = 512; E.kind[i_] = 0; E.gain[i_] = P.dsa_g_k; E.scale[i_] = 1.f; } \
              pg8::gemm_phase<pg8::EpiHeads, pg8::StaticOrder, true, true>(lds + RING_OFF, g, S, E, tid); } } while (0)
#define PH_DSAUNITS(qword) do { FRESH_IDS(); \
            float qkmax_;     \
            { const float gq = wave_max(fabsf(P.dsa_g_q[lane])), gk = wave_max(fabsf(P.dsa_g_k[lane])); qkmax_ = 64.f * attn_body::C2 * gq * gk * 1.15f + 0.5f; } \
            int qb_ = (bx & 1), tries_ = 0;      \
            for (;;) { \
                if (tid == 0) MISC[16] = __hip_atomic_fetch_add(ctl + (qword) + 64 * qb_, 1u, RLX_AGENT); \
                __syncthreads(); \
                const int id = (int)MISC[16]; \
                __syncthreads(); \
                if (id >= T / dsa::QT) { if (++tries_ >= 2) break; qb_ ^= 1; continue; } \
                const int b = qb_, t0q = (T / dsa::QT - 1 - id) * dsa::QT; \
                dsa::unit(lds, b, t0q, (const bf16*)(ws + WS_Q1), (bf16*)(ws + WS_O1), (const unsigned char*)(ws + WS_K1), (const unsigned char*)(ws + WS_V1), (const bf16*)(ws + WS_QI), (const bf16*)(ws + WS_KI), (const float*)(ws + WS_WI), tid, wave, qkmax_); \
            } } while (0)

    const bool fusedn = (M / 256) * (D / 256) <= G;
    PH_PROLOGUE(); GRID_BAR();                       DUP(0, PH_PROLOGUE());
    PH_NORM1_L0(); GRID_BAR();                       DUP(1, PH_NORM1_L0());
    PH_QKV(); GRID_BAR();                            DUP(2, PH_QKV());
    PH_FOXATTN(CW_AQ); GRID_BAR();                   DUP(3, PH_FOXATTN(CW_AQ + 64));
    PH_OUTPROJ(0, WS_O, WS_WFOUT); GRID_BAR();       DUP(10, PH_OUTPROJ(0, WS_O, WS_WFOUT));
    if (!fusedn) { PH_NORM2(0); GRID_BAR(); }
    PH_UP(0); GRID_BAR();                            DUP(5, PH_UP(0));
    PH_DOWN(0); GRID_BAR();
    if (!fusedn) { PH_NORM1_L1(); GRID_BAR(); }
    PH_DSAIN(); GRID_BAR();                          DUP(6, PH_DSAIN());
    PH_DSAUNITS(CW_DQ); GRID_BAR();                  DUP(7, PH_DSAUNITS(CW_DQ + 128));
    PH_OUTPROJ(1, WS_O1, WS_WDOUT); GRID_BAR();
    if (!fusedn) { PH_NORM2(1); GRID_BAR(); }
    PH_UP(1); GRID_BAR();
    PH_DOWN(1);
    if (MK_DUP & 512) { GRID_BAR(); PH_DOWN(1); }
}

extern "C" void kernel_launch(void* const* d_in, const int* in_sizes, int n_in, void* d_out, int out_size, void* d_ws, size_t ws_size, hipStream_t stream) {
    static int grid = 0;
    if (grid == 0) {
        if (n_in != 20 || in_sizes[0] != M * D || out_size != M * D || ws_size < WS_END) { fprintf(stderr, "kernel_launch: unexpected problem (n_in %d, in0 %d, out %d, ws %zu); nothing launched\n", n_in, n_in > 0 ? in_sizes[0] : -1, out_size, ws_size); grid = -1; return; }
        int dev = 0, cus = 0, per_cu = 0;
        if (hipGetDevice(&dev) != hipSuccess || hipDeviceGetAttribute(&cus, hipDeviceAttributeMultiprocessorCount, dev) != hipSuccess) { grid = -1; return; }
        if (hipFuncSetAttribute((const void*)hybrid_fwd, hipFuncAttributeMaxDynamicSharedMemorySize, LDS_BYTES) != hipSuccess) { fprintf(stderr, "kernel_launch: hipFuncSetAttribute failed\n"); grid = -1; return; }
        if (hipOccupancyMaxActiveBlocksPerMultiprocessor(&per_cu, (const void*)hybrid_fwd, NTHREADS, LDS_BYTES) != hipSuccess || per_cu < 1)
            fprintf(stderr, "kernel_launch: note: occupancy query reports %d workgroups per CU\n", per_cu);
        (void)hipGetLastError();
        grid = cus;
    }
    if (grid < 0) return;
    if (hipMemsetAsync((char*)d_ws + WS_CTL, 0, CTL_ZERO_BYTES, stream) != hipSuccess) return;
    Ptrs p{};
    p.x = (const float*)d_in[0]; p.c = (const float*)d_in[1]; p.w_ada = (const float*)d_in[2]; p.b_ada = (const float*)d_in[3]; p.g_mix = (const float*)d_in[4]; p.g_ffn = (const float*)d_in[5];
    p.fox_w_in = (const float*)d_in[6]; p.fox_b_f = (const float*)d_in[7]; p.fox_g_q = (const float*)d_in[8]; p.fox_g_k = (const float*)d_in[9]; p.fox_w_out = (const float*)d_in[10];
    p.dsa_w_in = (const float*)d_in[11]; p.dsa_g_q = (const float*)d_in[12]; p.dsa_g_k = (const float*)d_in[13]; p.dsa_g_kidx = (const float*)d_in[14]; p.dsa_w_out = (const float*)d_in[15];
    p.ffn_w_up = (const float*)d_in[16]; p.ffn_conv_w = (const float*)d_in[17]; p.ffn_conv_b = (const float*)d_in[18]; p.ffn_w_down = (const float*)d_in[19];
    p.out = (float*)d_out; p.ws = (unsigned char*)d_ws;
    hipLaunchKernelGGL(hybrid_fwd, dim3(grid), dim3(NTHREADS), LDS_BYTES, stream, p);
}
```
